# Optimizing an MI355X kernel written in HIP

```python
import jax, jax.numpy as jnp
from jax import lax
import numpy as np

D_MODEL = 2048
BATCH = 4
SEQ = 4096
DEPTH = 2

GRID_W = 64
CTX_LEN = 256
HEAD_DIM_A = 128
ATTN_WIDTH = D_MODEL // 2
N_HEADS_A = ATTN_WIDTH // HEAD_DIM_A
WIN_H = 8
WIN_W = 16
CONV_CH = D_MODEL // 2
CONV_K = 3
MIX_WIDTH = ATTN_WIDTH + CONV_CH
MIX_IN_WIDTH = 3 * ATTN_WIDTH + 3 * CONV_CH
N_FOURIER_GROUPS = 4
N_EXPERTS = 32
N_EXPERT_GROUPS = 8
EXPERTS_PER_GROUP = N_EXPERTS // N_EXPERT_GROUPS
TOP_K = 2
D_EXPERT = D_MODEL // 2
EXPERT_BLOCK = 256
ALPHA = (2 * DEPTH) ** 0.25
BETA = (8 * DEPTH) ** -0.25
LN_EPS = 1e-6
NEG_INF = -1e30

kernel_name = "hybrid_natten_shortconv_fnet_grouped_moe_dit"


def layer_norm(x, g=None, b=None):
    xf = x.astype(jnp.float32)
    mu = jnp.mean(xf, axis=-1, keepdims=True)
    var = jnp.mean(jnp.square(xf - mu), axis=-1, keepdims=True)
    y = (xf - mu) * lax.rsqrt(var + LN_EPS)
    if g is not None:
        y = y * g.astype(jnp.float32) + b.astype(jnp.float32)
    return y.astype(x.dtype)


def modulate(h, shift, scale):
    return h * (1 + scale) + shift


def split_heads(t):
    return t.reshape(t.shape[0], t.shape[1], N_HEADS_A, HEAD_DIM_A)


def neighbourhood_attention(q, k, v, k_ctx, v_ctx, rpb):
    bsz, length, heads, dh = q.shape
    rows = length // GRID_W
    kh = min(WIN_H, rows)
    scale = dh ** -0.5
    qg = q.reshape(bsz, rows, GRID_W, heads, dh)
    kg = k.reshape(bsz, rows, GRID_W, heads, dh)
    vg = v.reshape(bsz, rows, GRID_W, heads, dh)
    row_start = jnp.clip(jnp.arange(rows) - kh // 2, 0, rows - kh)
    cols = jnp.arange(GRID_W)
    col_start = jnp.clip(cols - WIN_W // 2, 0, GRID_W - WIN_W)
    col_mask = (cols[None, :] >= col_start[:, None]) & (cols[None, :] < col_start[:, None] + WIN_W)
    col_bias_idx = jnp.clip(cols[None, :] - cols[:, None], -(WIN_W - 1), WIN_W - 1) + WIN_W - 1

    def row_block(r):
        rs = row_start[r]
        q_r = lax.dynamic_index_in_dim(qg, r, axis=1, keepdims=False)
        k_b = lax.dynamic_slice_in_dim(kg, rs, kh, axis=1)
        v_b = lax.dynamic_slice_in_dim(vg, rs, kh, axis=1)
        row_bias_idx = rs + jnp.arange(kh) - r + WIN_H - 1
        bias = rpb[:, row_bias_idx[:, None, None], col_bias_idx[None, :, :]]
        bias = jnp.transpose(bias, (0, 2, 1, 3)).astype(jnp.float32)
        s_loc = jnp.einsum('bqhd,bakhd->bhqak', q_r, k_b, preferred_element_type=jnp.float32) * scale + bias
        s_loc = jnp.where(col_mask[:, None, :], s_loc, NEG_INF)
        s_ctx = jnp.einsum('bqhd,bchd->bhqc', q_r, k_ctx, preferred_element_type=jnp.float32) * scale
        s = jnp.concatenate([s_loc.reshape(bsz, heads, GRID_W, kh * GRID_W), s_ctx], axis=-1)
        p = jax.nn.softmax(s, axis=-1).astype(v.dtype)
        p_loc = p[..., :kh * GRID_W].reshape(bsz, heads, GRID_W, kh, GRID_W)
        p_ctx = p[..., kh * GRID_W:]
        return (jnp.einsum('bhqak,bakhd->bqhd', p_loc, v_b)
                + jnp.einsum('bhqc,bchd->bqhd', p_ctx, v_ctx))

    out = lax.map(row_block, jnp.arange(rows))
    return jnp.moveaxis(out, 0, 1).reshape(bsz, length, heads * dh)


def context_attention(q, k, v):
    s = jnp.einsum('bqhd,bkhd->bhqk', q, k, preferred_element_type=jnp.float32) * (q.shape[-1] ** -0.5)
    p = jax.nn.softmax(s, axis=-1).astype(v.dtype)
    o = jnp.einsum('bhqk,bkhd->bqhd', p, v)
    return o.reshape(o.shape[0], o.shape[1], -1)


def depthwise_conv3(z, w):
    return lax.conv_general_dilated(
        z, w[:, None, :].astype(z.dtype), window_strides=(1,), padding=((1, 1),),
        dimension_numbers=('NWC', 'WIO', 'NWC'), feature_group_count=z.shape[-1])


def na_conv_mixer(u, uc, w_in, rpb, conv_w, w_out, ctx_update):
    a, ch = ATTN_WIDTH, CONV_CH
    cuts = [a, 2 * a, 3 * a, 3 * a + ch, 3 * a + 2 * ch]
    q, k, v, gb, gc, xin = jnp.split(u @ w_in, cuts, axis=-1)
    if ctx_update:
        qc, kc, vc, gbc, gcc, xinc = jnp.split(uc @ w_in, cuts, axis=-1)
    else:
        kc, vc = jnp.split(uc @ w_in[:, a:3 * a], 2, axis=-1)
    attn = neighbourhood_attention(split_heads(q), split_heads(k), split_heads(v),
                                   split_heads(kc), split_heads(vc), rpb)
    conv = gb * depthwise_conv3(gc * xin, conv_w)
    y = jnp.concatenate([attn, conv], axis=-1) @ w_out
    if not ctx_update:
        return y, None
    attn_c = context_attention(split_heads(qc), split_heads(kc), split_heads(vc))
    conv_c = gbc * depthwise_conv3(gcc * xinc, conv_w)
    y_c = jnp.concatenate([attn_c, conv_c], axis=-1) @ w_out
    return y, y_c


def fourier_mix(u):
    bsz, length, d = u.shape
    z = u.astype(jnp.float32).reshape(bsz, length, N_FOURIER_GROUPS, d // N_FOURIER_GROUPS)
    f = jnp.fft.fft2(z, axes=(1, 3), norm='ortho').real
    return f.reshape(bsz, length, d).astype(u.dtype)


def moe_ffn(h, router_w, router_b, w_gate, w_up, w_down):
    n_tok, d = h.shape
    n_rows = n_tok * TOP_K
    n_blocks = -(-n_rows // EXPERT_BLOCK) + N_EXPERTS
    n_pad = n_blocks * EXPERT_BLOCK
    logits = jnp.einsum('td,de->te', h, router_w, preferred_element_type=jnp.float32)
    affinity = jax.nn.sigmoid(logits)
    biased = (affinity + router_b.astype(jnp.float32)).reshape(n_tok, N_EXPERT_GROUPS, EXPERTS_PER_GROUP)
    group_score = lax.top_k(biased, TOP_K)[0].sum(-1)
    group = jnp.argmax(group_score, axis=-1)
    in_group = jnp.take_along_axis(biased, group[:, None, None], axis=1)[:, 0]
    local = lax.top_k(in_group, TOP_K)[1]
    expert = group[:, None] * EXPERTS_PER_GROUP + local
    weight = jnp.take_along_axis(affinity, expert, axis=1)
    weight = weight / jnp.sum(weight, axis=-1, keepdims=True)
    flat_e = expert.reshape(-1)
    flat_t = jnp.repeat(jnp.arange(n_tok), TOP_K)
    flat_w = weight.reshape(-1)
    order = jnp.argsort(flat_e)
    e_s, t_s, w_s = flat_e[order], flat_t[order], flat_w[order]
    counts = jnp.bincount(flat_e, length=N_EXPERTS)
    padded = (counts + EXPERT_BLOCK - 1) // EXPERT_BLOCK * EXPERT_BLOCK
    start = jnp.cumsum(counts) - counts
    pad_end = jnp.cumsum(padded)
    pad_start = pad_end - padded
    dest = pad_start[e_s] + jnp.arange(n_rows) - start[e_s]
    row_tok = jnp.full((n_pad,), n_tok, jnp.int32).at[dest].set(t_s)
    row_w = jnp.zeros((n_pad,), jnp.float32).at[dest].set(w_s)
    block_expert = jnp.clip(jnp.searchsorted(pad_end, jnp.arange(n_blocks) * EXPERT_BLOCK, side='right'),
                            0, N_EXPERTS - 1)
    h_pad = jnp.concatenate([h, jnp.zeros((1, d), h.dtype)], axis=0)
    xb = h_pad[row_tok].reshape(n_blocks, EXPERT_BLOCK, d)

    def expert_block(args):
        xe, e = args
        return (jax.nn.silu(xe @ w_gate[e]) * (xe @ w_up[e])) @ w_down[e]

    yb = lax.map(expert_block, (xb, block_expert)).reshape(n_pad, d)
    out = jnp.zeros((n_tok + 1, d), jnp.float32).at[row_tok].add(yb.astype(jnp.float32) * row_w[:, None])
    return out[:n_tok].astype(h.dtype)


def setup_inputs(seed: int = 0) -> dict:
    key = jax.random.key(seed)
    ks = jax.random.split(key, 18)
    n_even = (DEPTH + 1) // 2
    n_odd = DEPTH // 2
    nrm = jax.random.normal
    d = D_MODEL
    return {
        'x': nrm(ks[0], (BATCH, SEQ, d), jnp.float32),
        'c': nrm(ks[1], (BATCH, d), jnp.float32),
        'ctx': nrm(ks[2], (BATCH, CTX_LEN, d), jnp.float32),
        'c_ctx': nrm(ks[3], (d,), jnp.float32),
        'ada_w': nrm(ks[4], (DEPTH, d, 6 * d), jnp.float32) * d ** -0.5,
        'ada_b': 0.01 * nrm(ks[5], (DEPTH, 6 * d), jnp.float32),
        'w_mix_in': nrm(ks[6], (n_even, d, MIX_IN_WIDTH), jnp.float32) * d ** -0.5,
        'rpb': 0.02 * nrm(ks[7], (n_even, N_HEADS_A, 2 * WIN_H - 1, 2 * WIN_W - 1), jnp.float32),
        'conv_w': nrm(ks[8], (n_even, CONV_K, CONV_CH), jnp.float32) * CONV_K ** -0.5,
        'w_mix_out': nrm(ks[9], (n_even, MIX_WIDTH, d), jnp.float32) * (MIX_WIDTH ** -0.5 * BETA),
        'w_fourier_out': nrm(ks[10], (n_odd, d, d), jnp.float32) * (d ** -0.5 * BETA),
        'router_w': nrm(ks[11], (d, N_EXPERTS), jnp.float32) * d ** -0.5,
        'router_b': 0.01 * nrm(ks[12], (N_EXPERTS,), jnp.float32),
        'w_gate': nrm(ks[13], (DEPTH, N_EXPERTS, d, D_EXPERT), jnp.float32) * d ** -0.5,
        'w_up': nrm(ks[14], (DEPTH, N_EXPERTS, d, D_EXPERT), jnp.float32) * d ** -0.5,
        'w_down': nrm(ks[15], (DEPTH, N_EXPERTS, D_EXPERT, d), jnp.float32) * (D_EXPERT ** -0.5 * BETA),
        'ln_g': 1.0 + 0.01 * nrm(ks[16], (DEPTH, 2, d), jnp.float32),
        'ln_b': 0.01 * nrm(ks[17], (DEPTH, 2, d), jnp.float32),
    }


def reference(x, c, ctx, c_ctx, ada_w, ada_b, w_mix_in, rpb, conv_w, w_mix_out, w_fourier_out,
              router_w, router_b, w_gate, w_up, w_down, ln_g, ln_b):
    bsz, length, d = x.shape
    xc = ctx
    silu_c = jax.nn.silu(c)
    silu_cc = jax.nn.silu(c_ctx)
    for i in range(DEPTH):
        even = i % 2 == 0
        ctx_update = any(j % 2 == 0 for j in range(i + 1, DEPTH))
        mods = (silu_c @ ada_w[i] + ada_b[i])[:, None, :]
        sh1, sc1, g1, sh2, sc2, g2 = jnp.split(mods, 6, axis=-1)
        u = modulate(layer_norm(x), sh1, sc1)
        uc = None
        if even or ctx_update:
            mods_c = (silu_cc @ ada_w[i] + ada_b[i])[None, None, :]
            csh1, csc1, cg1, csh2, csc2, cg2 = jnp.split(mods_c, 6, axis=-1)
            uc = modulate(layer_norm(xc), csh1, csc1)
        if even:
            y, yc = na_conv_mixer(u, uc, w_mix_in[i // 2], rpb[i // 2], conv_w[i // 2],
                                  w_mix_out[i // 2], ctx_update)
        else:
            y = fourier_mix(u) @ w_fourier_out[i // 2]
            yc = fourier_mix(uc) @ w_fourier_out[i // 2] if ctx_update else None
        x = layer_norm(ALPHA * x + g1 * y, ln_g[i, 0], ln_b[i, 0])
        u2 = modulate(layer_norm(x), sh2, sc2)
        if ctx_update:
            xc = layer_norm(ALPHA * xc + cg1 * yc, ln_g[i, 0], ln_b[i, 0])
            u2c = modulate(layer_norm(xc), csh2, csc2)
            tokens = jnp.concatenate([u2.reshape(-1, d), u2c.reshape(-1, d)], axis=0)
            f = moe_ffn(tokens, router_w, router_b, w_gate[i], w_up[i], w_down[i])
            f_lat = f[:bsz * length].reshape(bsz, length, d)
            f_ctx = f[bsz * length:].reshape(xc.shape)
            xc = layer_norm(ALPHA * xc + cg2 * f_ctx, ln_g[i, 1], ln_b[i, 1])
        else:
            f_lat = moe_ffn(u2.reshape(-1, d), router_w, router_b, w_gate[i], w_up[i],
                            w_down[i]).reshape(bsz, length, d)
        x = layer_norm(ALPHA * x + g2 * f_lat, ln_g[i, 1], ln_b[i, 1])
    return x
```

```cpp
#include <hip/hip_runtime.h>
#include <cstdio>
#include <cstdint>

#define DI __device__ __forceinline__
#define LAS __attribute__((address_space(3)))
typedef unsigned short bf16;
typedef float f32x4 __attribute__((ext_vector_type(4)));
typedef short bf16x8 __attribute__((ext_vector_type(8)));
typedef unsigned u32x4 __attribute__((ext_vector_type(4)));
typedef unsigned u32x2 __attribute__((ext_vector_type(2)));

constexpr int D = 2048, NB = 4, SEQ = 4096, T = NB * SEQ, CTXL = 256, TC = NB * CTXL, TALL = T + TC;
constexpr int NMIX = 6144, NE = 32, DE = 1024, NH = 8, HD = 128, MODW = 6 * D;
constexpr float ALPHA = 1.41421356237309515f;
constexpr float LN_EPS = 1e-6f;
constexpr int NPHASE = 16;
#ifndef MK_N_LAUNCHES
#define MK_N_LAUNCHES NPHASE
#endif
constexpr int N_LAUNCHES = MK_N_LAUNCHES;

constexpr size_t MiB = 1u << 20;
constexpr size_t WS_CTL = 0, CTL_ZERO_BYTES = 64 * 1024;
constexpr size_t WS_MODS = 1 * MiB;
constexpr size_t WS_TOKINFO = 2 * MiB;
constexpr size_t WS_TABLE = 4 * MiB;
constexpr size_t WS_WIN = 8 * MiB, WS_WO = 32 * MiB, WS_WF = 40 * MiB, WS_CS = 48 * MiB, WS_ACS = 64 * MiB;
constexpr size_t WS_U = 128 * MiB;
constexpr size_t WS_P = 196 * MiB;
constexpr size_t WS_MIX = 400 * MiB;
constexpr size_t WS_TB = 464 * MiB, WS_X1 = 592 * MiB, WS_X2 = 720 * MiB;
constexpr size_t WS_H = 848 * MiB;
constexpr size_t WS_WGU = 928 * MiB;
constexpr size_t WS_WD = 1440 * MiB;
constexpr size_t WS_END = 1696 * MiB;
constexpr int CW_CNT = 64;
constexpr int CW_BAR = 1024;

constexpr int LDS_SCR = 131072;
constexpr int LDSCTL_OFF = LDS_SCR;
constexpr int LDS_BYTES = 147456;

DI float wave_sum(float v) {
#pragma unroll
    for (int o = 1; o < 64; o <<= 1) v += __shfl_xor(v, o);
    return v;
}
DI float wave_max(float v) {
#pragma unroll
    for (int o = 1; o < 64; o <<= 1) v = fmaxf(v, __shfl_xor(v, o));
    return v;
}
DI unsigned f2bf(float f) { unsigned u = __float_as_uint(f); return (u + 0x7fffu + ((u >> 16) & 1u)) >> 16; }
DI unsigned pk2(float lo, float hi) { return f2bf(lo) | (f2bf(hi) << 16); }
DI float bflo(unsigned w) { return __uint_as_float(w << 16); }
DI float bfhi(unsigned w) { return __uint_as_float(w & 0xffff0000u); }
DI float silu_f(float v) { return v / (1.f + expf(-v)); }

#define XB_TMO      128
#define XB_XCNT(j)  (256  + 64 * (j))
#define XB_XSUB(j)  (1280 + 64 * (j))
#define XB_XGEN(j)  (2304 + 64 * (j))
#define XB_TOP      3328
#define XB_TOPGEN   3392
#define XCD_BAR_WORDS 3456
#define XB_SPIN_CAP (1u << 18)
__device__ __forceinline__ unsigned xb_ld(unsigned* p)              { return __hip_atomic_load(p, __ATOMIC_RELAXED, __HIP_MEMORY_SCOPE_AGENT); }
__device__ __forceinline__ unsigned xb_add(unsigned* p, unsigned v) { return __hip_atomic_fetch_add(p, v, __ATOMIC_RELAXED, __HIP_MEMORY_SCOPE_AGENT); }
__device__ __forceinline__ unsigned xb_xcc_id() { return (unsigned)__builtin_amdgcn_s_getreg((3 << 11) | 20) & 0xFu; }
#define XB_SPIN(cond, bar) do { unsigned _sp = 0; while (cond) { __builtin_amdgcn_s_sleep(1); \
    if ((++_sp & 255u) == 0u) { if (xb_ld(&(bar)[XB_TMO])) break; if (_sp > XB_SPIN_CAP) { atomicAdd(&(bar)[XB_TMO], 1u); break; } } } } while (0)
struct XcdBarrier { unsigned* bar; unsigned x; volatile LAS unsigned* st; };
__device__ __forceinline__ XcdBarrier xcd_barrier_post(unsigned* bar, volatile LAS unsigned* st) {
    XcdBarrier b; b.bar = bar; b.x = xb_xcc_id(); b.st = st;
    if (threadIdx.x == 0) (void)xb_add(&bar[XB_XCNT(b.x)], 1u);
    return b;
}
__device__ __forceinline__ void xcd_barrier_complete(unsigned* bar, unsigned x, unsigned& nloc, unsigned& nx) {
    const unsigned G = gridDim.x * gridDim.y * gridDim.z;
    unsigned sum, cnt, mine, sp = 0u;
    for (;;) {
        sum = 0u; cnt = 0u; mine = 0u;
#pragma unroll
        for (unsigned j = 0; j < 16; ++j) { const unsigned c = xb_ld(&bar[XB_XCNT(j)]); sum += c; cnt += (c > 0u) ? 1u : 0u; mine = (j == x) ? c : mine; }
        if (sum == G) break;
        __builtin_amdgcn_s_sleep(1);
        if ((++sp & 255u) == 0u) { if (xb_ld(&bar[XB_TMO])) break; if (sp > XB_SPIN_CAP) { atomicAdd(&bar[XB_TMO], 1u); break; } }
    }
    nloc = mine > 0u ? mine : 1u; nx = cnt > 0u ? cnt : 1u;
}
__device__ __forceinline__ void xcd_barrier(const XcdBarrier& b) {
    asm volatile("s_waitcnt vmcnt(0)" ::: "memory");
    __syncthreads();
    if (threadIdx.x == 0) {
        unsigned* bar = b.bar;
        __builtin_amdgcn_s_waitcnt(0);
        unsigned nloc = b.st[0], nx = b.st[1];
        if (nloc == 0u) { xcd_barrier_complete(bar, b.x, nloc, nx); b.st[0] = nloc; b.st[1] = nx; }
        const unsigned old = xb_add(&bar[XB_XSUB(b.x)], 1u);
        const unsigned gen = old / nloc;
        if (old + 1u == (gen + 1u) * nloc) {
            __builtin_amdgcn_fence(__ATOMIC_RELEASE, "agent");
            asm volatile("s_waitcnt vmcnt(0)" ::: "memory");
            const unsigned og = xb_add(&bar[XB_TOP], 1u);
            const unsigned tg = og / nx;
            if (og + 1u == (tg + 1u) * nx) xb_add(&bar[XB_TOPGEN], 1u);
            else XB_SPIN(xb_ld(&bar[XB_TOPGEN]) == tg, bar);
            __builtin_amdgcn_fence(__ATOMIC_ACQUIRE, "agent");
            xb_add(&bar[XB_XGEN(b.x)], 1u);
            asm volatile("s_waitcnt vmcnt(0)" ::: "memory");
        } else {
            XB_SPIN(xb_ld(&bar[XB_XGEN(b.x)]) == gen, bar);
            __builtin_amdgcn_fence(__ATOMIC_ACQUIRE, "agent");
            asm volatile("s_waitcnt vmcnt(0)" ::: "memory");
        }
    }
    __syncthreads();
}

struct Row { f32x4 v[8]; };
DI void row_load(Row& r, const float* p, int lane) { const f32x4* q = (const f32x4*)p + lane;
#pragma unroll
    for (int j = 0; j < 8; ++j) r.v[j] = q[64 * j]; }
DI void row_store(const Row& r, float* p, int lane) { f32x4* q = (f32x4*)p + lane;
#pragma unroll
    for (int j = 0; j < 8; ++j) q[64 * j] = r.v[j]; }
DI void row_store_bf16(const Row& r, bf16* p, int lane) { u32x2* q = (u32x2*)p + lane;
#pragma unroll
    for (int j = 0; j < 8; ++j) { u32x2 w; w.x = pk2(r.v[j].x, r.v[j].y); w.y = pk2(r.v[j].z, r.v[j].w); q[64 * j] = w; } }
DI void row_ln(Row& r) {
    float s = 0.f;
#pragma unroll
    for (int j = 0; j < 8; ++j) s += (r.v[j].x + r.v[j].y) + (r.v[j].z + r.v[j].w);
    const float mean = wave_sum(s) * (1.f / D); float s2 = 0.f;
#pragma unroll
    for (int j = 0; j < 8; ++j) { r.v[j] = r.v[j] - mean; s2 += (r.v[j].x * r.v[j].x + r.v[j].y * r.v[j].y) + (r.v[j].z * r.v[j].z + r.v[j].w * r.v[j].w); }
    const float rstd = 1.f / sqrtf(wave_sum(s2) * (1.f / D) + LN_EPS);
#pragma unroll
    for (int j = 0; j < 8; ++j) r.v[j] = r.v[j] * rstd;
}
DI void row_affine(Row& r, const float* g, const float* b, int lane) {
    const f32x4* gq = (const f32x4*)g + lane; const f32x4* bq = (const f32x4*)b + lane;
#pragma unroll
    for (int j = 0; j < 8; ++j) r.v[j] = r.v[j] * gq[64 * j] + bq[64 * j];
}
DI void row_modulate(Row& r, const float* sh, const float* sc, int lane) {
    const f32x4* hq = (const f32x4*)sh + lane; const f32x4* cq = (const f32x4*)sc + lane;
#pragma unroll
    for (int j = 0; j < 8; ++j) r.v[j] = r.v[j] * (cq[64 * j] + 1.f) + hq[64 * j];
}

struct Unit { const bf16* A; const bf16* B; const int* gat; int nvalid; int m0, n0, aux; };

template <class Sched, class Epi>
DI void gemm_simple(const Sched& S, const Epi& E, const int lda, const int ldb, const int K) {
    const int tid = threadIdx.x, wid = tid >> 6, lane = tid & 63, fr = lane & 15, fq = lane >> 4;
    for (int L = blockIdx.x; ; L += gridDim.x) {
        Unit u; if (!S.get(L, u)) break;
        const bf16* arow[2];
#pragma unroll
        for (int m = 0; m < 2; ++m) { const int r = 32 * wid + 16 * m + fr; size_t grow = (size_t)r; if (u.gat) grow = (size_t)(r < u.nvalid ? u.gat[r] : 0); arow[m] = u.A + grow * lda + fq * 8; }
        for (int cc = 0; cc < 4; ++cc) {
            f32x4 acc[2][4];
#pragma unroll
            for (int m = 0; m < 2; ++m)
#pragma unroll
                for (int j = 0; j < 4; ++j) acc[m][j] = (f32x4){0.f, 0.f, 0.f, 0.f};
            const bf16* brow[4];
#pragma unroll
            for (int j = 0; j < 4; ++j) { const int col = (j >> 1) * 128 + cc * 32 + (j & 1) * 16 + fr; brow[j] = u.B + (size_t)col * ldb + fq * 8; }
            for (int k = 0; k < K; k += 32) {
                bf16x8 a[2], b[4];
#pragma unroll
                for (int m = 0; m < 2; ++m) a[m] = *(const bf16x8*)(arow[m] + k);
#pragma unroll
                for (int j = 0; j < 4; ++j) b[j] = *(const bf16x8*)(brow[j] + k);
#pragma unroll
                for (int m = 0; m < 2; ++m)
#pragma unroll
                    for (int j = 0; j < 4; ++j) acc[m][j] = __builtin_amdgcn_mfma_f32_16x16x32_bf16(b[j], a[m], acc[m][j], 0, 0, 0);
            }
#pragma unroll
            for (int m = 0; m < 2; ++m)
#pragma unroll
                for (int nn = 0; nn < 2; ++nn) E(u, 32 * wid + 16 * m + fr, cc * 32 + nn * 16 + 4 * fq, acc[m][nn], acc[m][nn + 2]);
        }
    }
}

struct SchedInProj { const bf16* U; const bf16* W;
    DI bool get(int L, Unit& u) const { int pm, pn;
        if (L < 64 * 24) { pm = L / 24; pn = L % 24; } else if (L < 64 * 24 + 32) { const int l2 = L - 64 * 24; pm = 64 + (l2 >> 3); pn = 4 + (l2 & 7); } else return false;
        u.A = U + (size_t)pm * 256 * D; u.B = W + (size_t)pn * 256 * D; u.gat = nullptr; u.nvalid = 256; u.m0 = pm * 256; u.n0 = pn * 256; u.aux = 0; return true; } };
struct SchedDense { const bf16* A; const bf16* B; int nM, nN; size_t a_t, b_t;
    DI bool get(int L, Unit& u) const { if (L >= nM * nN) return false; const int pm = L / nN, pn = L % nN;
        u.A = A + (size_t)pm * a_t; u.B = B + (size_t)pn * b_t; u.gat = nullptr; u.nvalid = 256; u.m0 = pm * 256; u.n0 = pn * 256; u.aux = 0; return true; } };
struct SchedMoe { const LAS int* cnt; const LAS int* tb; const bf16* A; const bf16* W; const int* table; int gather; size_t a_t, w_e, w_t;
    DI bool get(int L, Unit& u) const { const int t = L >> 3, pn = L & 7; if (t >= tb[32]) return false;
        int e = 0;
        for (int i = 1; i < 32; ++i) e = (tb[i] <= t) ? i : e;
        const int mt = t - tb[e];
        if (gather) { u.A = A; u.gat = table + (size_t)e * T + mt * 256; } else { u.A = A + (size_t)t * a_t; u.gat = nullptr; }
        u.nvalid = min(256, cnt[e] - mt * 256);
        u.B = W + (size_t)e * w_e + (size_t)pn * w_t; u.m0 = t * 256; u.n0 = pn * 256; u.aux = e; return true; } };
struct SchedF1 { const bf16* CS; const bf16* U;
    DI bool get(int L, Unit& u) const { if (L >= 1024) return false; const int b = L >> 8, g = (L >> 6) & 3, pm = (L >> 4) & 3, pn = L & 15;
        u.A = CS + (size_t)pm * 256 * 512; u.B = U + ((size_t)b * SEQ + pn * 256) * D + g * 512; u.gat = nullptr; u.nvalid = 256; u.m0 = pm * 256; u.n0 = pn * 256; u.aux = b * 4 + g; return true; } };
struct SchedF2 { const bf16* ACS; const bf16* BT2;
    DI bool get(int L, Unit& u) const { if (L >= 512) return false; const int b = L >> 7, pm = (L >> 3) & 15, pn = L & 7;
        u.A = ACS + (size_t)pm * 256 * 8192; u.B = BT2 + ((size_t)b * D + pn * 256) * 8192; u.gat = nullptr; u.nvalid = 256; u.m0 = pm * 256; u.n0 = pn * 256; u.aux = b; return true; } };

DI void st_bf16x4(bf16* p, f32x4 v) { u32x2 w; w.x = pk2(v.x, v.y); w.y = pk2(v.z, v.w); *(u32x2*)p = w; }
struct EpiStoreBf16 { bf16* O; int ldc;
    DI void operator()(const Unit& u, int r, int c, f32x4 lo, f32x4 hi) const { bf16* p = O + (size_t)(u.m0 + r) * ldc + u.n0 + c; st_bf16x4(p, lo); st_bf16x4(p + 128, hi); } };
struct EpiResid { const float* x; float* t; const float* gate;
    DI void operator()(const Unit& u, int r, int c, f32x4 lo, f32x4 hi) const { const int row = u.m0 + r, b = row >> 12; const int col = u.n0 + c;
        const size_t o = (size_t)row * D + col; const float* g = gate + (size_t)b * MODW + col;
        *(f32x4*)(t + o) = *(const f32x4*)(x + o) * ALPHA + *(const f32x4*)g * lo;
        *(f32x4*)(t + o + 128) = *(const f32x4*)(x + o + 128) * ALPHA + *(const f32x4*)(g + 128) * hi; } };
struct EpiSwiglu { bf16* H;
    DI void operator()(const Unit& u, int r, int c, f32x4 lo, f32x4 hi) const { f32x4 h;
        h.x = silu_f(lo.x) * hi.x; h.y = silu_f(lo.y) * hi.y; h.z = silu_f(lo.z) * hi.z; h.w = silu_f(lo.w) * hi.w;
        st_bf16x4(H + (size_t)(u.m0 + r) * DE + (u.n0 >> 1) + c, h); } };
struct EpiF1 { bf16* BT2;
    DI void operator()(const Unit& u, int r, int c, f32x4 lo, f32x4 hi) const { const int b = u.aux >> 2, g = u.aux & 3, m = u.m0 + r, cs = m >> 9, cp = m & 511;
        bf16* p = BT2 + ((size_t)b * D + g * 512 + cp) * 8192 + cs * 4096 + u.n0 + c; st_bf16x4(p, lo); st_bf16x4(p + 128, hi); } };
struct EpiF2 { bf16* REZ;
    DI void operator()(const Unit& u, int r, int c, f32x4 lo, f32x4 hi) const { bf16* p = REZ + ((size_t)u.aux * SEQ + u.m0 + r) * D + u.n0 + c; st_bf16x4(p, lo); st_bf16x4(p + 128, hi); } };

DI void p0_mods(const float* c, const float* cctx, const float* ada_w, const float* ada_b, float* mods, LAS float* sl, int tid) {
    LAS float* red = sl + 5 * D;
    for (int i = tid; i < 5 * D; i += 512) { const float v = i < 4 * D ? c[i] : cctx[i - 4 * D]; sl[i] = silu_f(v); }
    __syncthreads();
    const int cq = tid & 127, ks = tid >> 7;
    for (int unit = blockIdx.x; unit < 192; unit += gridDim.x) {
        const int l = unit / 96, n = (unit % 96) * 128 + cq;
        const float* W = ada_w + (size_t)l * D * MODW + n;
        float a0 = 0.f, a1 = 0.f, a2 = 0.f, a3 = 0.f, a4 = 0.f;
#pragma unroll 8
        for (int k = ks * 512; k < ks * 512 + 512; ++k) { const float w = W[(size_t)k * MODW]; a0 += sl[k] * w; a1 += sl[D + k] * w; a2 += sl[2 * D + k] * w; a3 += sl[3 * D + k] * w; a4 += sl[4 * D + k] * w; }
        red[(ks * 5 + 0) * 128 + cq] = a0; red[(ks * 5 + 1) * 128 + cq] = a1; red[(ks * 5 + 2) * 128 + cq] = a2; red[(ks * 5 + 3) * 128 + cq] = a3; red[(ks * 5 + 4) * 128 + cq] = a4;
        __syncthreads();
        for (int i = tid; i < 640; i += 512) { const int r = i >> 7, q = i & 127, n2 = (unit % 96) * 128 + q;
            const float s = (red[(0 * 5 + r) * 128 + q] + red[(1 * 5 + r) * 128 + q]) + (red[(2 * 5 + r) * 128 + q] + red[(3 * 5 + r) * 128 + q]);
            mods[((size_t)l * 5 + r) * MODW + n2] = s + ada_b[(size_t)l * MODW + n2]; }
        __syncthreads();
    }
}
DI void tr_item(const float* W, int N, int Kd, int k0, int n0, bf16* WT, int drow0, LAS float* scr, int lane) {
#pragma unroll 8
    for (int i = 0; i < 32; ++i) { const int kk = 2 * i + (lane >> 5); scr[kk * 33 + (lane & 31)] = W[(size_t)(k0 + kk) * N + n0 + (lane & 31)]; }
    asm volatile("s_waitcnt lgkmcnt(0)" ::: "memory");
    const int c = lane & 7;
#pragma unroll
    for (int j = 0; j < 4; ++j) { const int n = (lane >> 3) + 8 * j; const LAS float* s = scr + (8 * c) * 33 + n;
        u32x4 o; o.x = pk2(s[0 * 33], s[1 * 33]); o.y = pk2(s[2 * 33], s[3 * 33]); o.z = pk2(s[4 * 33], s[5 * 33]); o.w = pk2(s[6 * 33], s[7 * 33]);
        *(u32x4*)(WT + (size_t)(drow0 + n) * Kd + k0 + 8 * c) = o; }
    asm volatile("s_waitcnt lgkmcnt(0)" ::: "memory");
}
DI void p0_weights(const float* w_in, const float* w_out, const float* w_f, const float* w_gate, const float* w_up, const float* w_down,
                   bf16* WIN, bf16* WO, bf16* WF, bf16* WGU, bf16* WD, LAS float* scr, int gw, int NGW, int lane) {
    constexpr int I_IN = 32 * 192, I_SQ = 32 * 64, I_E = 65536;
    constexpr int NIT = I_IN + 2 * I_SQ + 3 * I_E;
    for (int it = gw; it < NIT; it += NGW) {
        int r = it;
        if (r < I_IN) { const int kb = r / 192, nb = r % 192; tr_item(w_in, NMIX, D, kb * 64, nb * 32, WIN, nb * 32, scr, lane); continue; } r -= I_IN;
        if (r < I_SQ) { const int kb = r / 64, nb = r % 64; tr_item(w_out, D, D, kb * 64, nb * 32, WO, nb * 32, scr, lane); continue; } r -= I_SQ;
        if (r < I_SQ) { const int kb = r / 64, nb = r % 64; tr_item(w_f, D, D, kb * 64, nb * 32, WF, nb * 32, scr, lane); continue; } r -= I_SQ;
        if (r < 2 * I_E) { const int up = r >= I_E; if (up) r -= I_E; const int mat = r >> 10, rr = r & 1023, kb = rr >> 5, nb = rr & 31, n0 = nb * 32;
            tr_item((up ? w_up : w_gate) + (size_t)mat * D * DE, DE, D, kb * 64, n0, WGU + (size_t)mat * D * D, (n0 >> 7) * 256 + (n0 & 127) + (up ? 128 : 0), scr, lane); continue; } r -= 2 * I_E;
        { const int mat = r >> 10, rr = r & 1023, kb = rr >> 6, nb = rr & 63; tr_item(w_down + (size_t)mat * DE * D, D, DE, kb * 64, nb * 32, WD + (size_t)mat * D * DE, nb * 32, scr, lane); }
    }
}
DI void p0_dft(bf16* ACS, bf16* CS, int gtid, int GT) {
    for (int i = gtid; i < 4096 * 1024; i += GT) { const int j = i >> 10, k8 = (i & 1023) * 8; unsigned w[4];
#pragma unroll
        for (int e = 0; e < 4; ++e) { float v[2];
#pragma unroll
            for (int q = 0; q < 2; ++q) { const int kk = k8 + 2 * e + q; const int m = (j * (kk & 4095)) & 4095; const float ang = (float)m * (1.f / 2048.f); v[q] = (kk < 4096 ? cospif(ang) : -sinpif(ang)) * (1.f / 64.f); }
            w[e] = pk2(v[0], v[1]); }
        *(u32x4*)(ACS + (size_t)j * 8192 + k8) = (u32x4){w[0], w[1], w[2], w[3]}; }
    for (int i = gtid; i < 1024 * 64; i += GT) { const int rr = i >> 6, c8 = (i & 63) * 8, cs = rr >> 9, cp = rr & 511; unsigned w[4];
#pragma unroll
        for (int e = 0; e < 4; ++e) { float v[2];
#pragma unroll
            for (int q = 0; q < 2; ++q) { const int cc = c8 + 2 * e + q; const int m = (cc * cp) & 511; const float ang = (float)m * (1.f / 256.f); v[q] = (cs ? sinpif(ang) : cospif(ang)) * 0.04419417382415922f; }
            w[e] = pk2(v[0], v[1]); }
        *(u32x4*)(CS + (size_t)rr * 512 + c8) = (u32x4){w[0], w[1], w[2], w[3]}; }
}
DI void ln_mod_phase(const float* x, const float* ctx, const float* mods_l, int sh_chunk, bf16* U, int nrows, int gw, int NGW, int lane) {
    for (int row = gw; row < nrows; row += NGW) {
        const float* src = row < T ? x + (size_t)row * D : ctx + (size_t)(row - T) * D; const int rb = row < T ? (row >> 12) : 4;
        Row r; row_load(r, src, lane); row_ln(r);
        const float* mr = mods_l + (size_t)rb * MODW + sh_chunk * D;
        row_modulate(r, mr, mr + D, lane);
        row_store_bf16(r, U + (size_t)row * D, lane);
    }
}
DI void attn_simple(const bf16* P, const float* rpb, bf16* MIX, LAS float* scr, int gw, int NGW, int lane) {
    const float scale = 0.08838834764831845f;
    for (int item = gw; item < T * NH; item += NGW) {
        const int tok = item >> 3, h = item & 7, b = tok >> 12, l = tok & 4095, r = l >> 6, qc = l & 63;
        const int rs = min(max(r - 4, 0), 56), cs = min(max(qc - 8, 0), 48);
        { const unsigned w = *((const unsigned*)(P + (size_t)tok * NMIX + h * HD) + lane); scr[2 * lane] = bflo(w); scr[2 * lane + 1] = bfhi(w); }
        asm volatile("s_waitcnt lgkmcnt(0)" ::: "memory");
        float s[6];
#pragma unroll
        for (int i = 0; i < 6; ++i) {
            const int kk = lane + 64 * i; size_t krow; float bias = 0.f;
            if (kk < 128) { const int a = kk >> 4, j = kk & 15; krow = (size_t)b * SEQ + 64 * (rs + a) + cs + j; bias = rpb[(h * 15 + (rs + a - r + 7)) * 31 + (cs + j - qc + 15)]; }
            else krow = (size_t)T + b * CTXL + (kk - 128);
            const u32x4* kp = (const u32x4*)(P + krow * NMIX + D / 2 + h * HD);
            float acc = 0.f;
#pragma unroll 4
            for (int d8 = 0; d8 < 16; ++d8) { const u32x4 kv = kp[d8]; const LAS f32x4* qv = (const LAS f32x4*)scr + 2 * d8; const f32x4 q0 = qv[0], q1 = qv[1];
                acc += bflo(kv.x) * q0.x + bfhi(kv.x) * q0.y + bflo(kv.y) * q0.z + bfhi(kv.y) * q0.w + bflo(kv.z) * q1.x + bfhi(kv.z) * q1.y + bflo(kv.w) * q1.z + bfhi(kv.w) * q1.w; }
            s[i] = acc * scale + bias;
        }
        float m = s[0];
#pragma unroll
        for (int i = 1; i < 6; ++i) m = fmaxf(m, s[i]);
        m = wave_max(m); float sum = 0.f;
#pragma unroll
        for (int i = 0; i < 6; ++i) { s[i] = expf(s[i] - m); sum += s[i]; scr[128 + lane + 64 * i] = s[i]; }
        sum = wave_sum(sum);
        asm volatile("s_waitcnt lgkmcnt(0)" ::: "memory");
        float o0 = 0.f, o1 = 0.f;
        for (int kk = 0; kk < 384; ++kk) {
            size_t vrow; if (kk < 128) vrow = (size_t)b * SEQ + 64 * (rs + (kk >> 4)) + cs + (kk & 15); else vrow = (size_t)T + b * CTXL + (kk - 128);
            const unsigned w = *((const unsigned*)(P + vrow * NMIX + D + h * HD) + lane); const float p = scr[128 + kk];
            o0 += p * bflo(w); o1 += p * bfhi(w);
        }
        const float inv = 1.f / sum;
        *((unsigned*)(MIX + (size_t)tok * D + h * HD) + lane) = pk2(o0 * inv, o1 * inv);
        asm volatile("s_waitcnt lgkmcnt(0)" ::: "memory");
    }
}
DI void conv_phase(const bf16* P, const float* cw, bf16* MIX, int gtid, int GT) {
    for (int i = gtid; i < T * 128; i += GT) {
        const int tok = i >> 7, c8 = (i & 127) * 8, l = tok & 4095;
        const bf16* base = P + (size_t)tok * NMIX + 3072 + c8;
        const u32x4 gb = *(const u32x4*)base;
        float z[3][8];
#pragma unroll
        for (int j = 0; j < 3; ++j) { const int ll = l + j - 1; const bool ok = ll >= 0 && ll < SEQ;
            u32x4 gc = (u32x4){0u, 0u, 0u, 0u}, xi = gc;
            if (ok) { const bf16* pj = base + (ptrdiff_t)(j - 1) * NMIX; gc = *(const u32x4*)(pj + 1024); xi = *(const u32x4*)(pj + 2048); }
            z[j][0] = bflo(gc.x) * bflo(xi.x); z[j][1] = bfhi(gc.x) * bfhi(xi.x); z[j][2] = bflo(gc.y) * bflo(xi.y); z[j][3] = bfhi(gc.y) * bfhi(xi.y);
            z[j][4] = bflo(gc.z) * bflo(xi.z); z[j][5] = bfhi(gc.z) * bfhi(xi.z); z[j][6] = bflo(gc.w) * bflo(xi.w); z[j][7] = bfhi(gc.w) * bfhi(xi.w); }
        float gbf[8] = {bflo(gb.x), bfhi(gb.x), bflo(gb.y), bfhi(gb.y), bflo(gb.z), bfhi(gb.z), bflo(gb.w), bfhi(gb.w)};
        float o[8];
#pragma unroll
        for (int e = 0; e < 8; ++e) o[e] = gbf[e] * (cw[c8 + e] * z[0][e] + cw[1024 + c8 + e] * z[1][e] + cw[2048 + c8 + e] * z[2][e]);
        *(u32x4*)(MIX + (size_t)tok * D + 1024 + c8) = (u32x4){pk2(o[0], o[1]), pk2(o[2], o[3]), pk2(o[4], o[5]), pk2(o[6], o[7])};
    }
}
DI void ln_router_phase(const float* TB, const float* lng, const float* lnb, const float* mods_l, const float* rw, const float* rbias,
                        float* X1, bf16* U, unsigned* counts, int* table, unsigned* tokinfo, int gw, int NGW, int lane) {
    for (int row = gw; row < T; row += NGW) {
        Row r; row_load(r, TB + (size_t)row * D, lane); row_ln(r); row_affine(r, lng, lnb, lane);
        row_store(r, X1 + (size_t)row * D, lane);
        row_ln(r);
        const float* mr = mods_l + (size_t)(row >> 12) * MODW + 3 * D;
        row_modulate(r, mr, mr + D, lane);
        row_store_bf16(r, U + (size_t)row * D, lane);
        float lg[32];
#pragma unroll
        for (int e = 0; e < 32; ++e) lg[e] = 0.f;
#pragma unroll
        for (int j = 0; j < 8; ++j)
#pragma unroll
            for (int q = 0; q < 4; ++q) { const float uv = r.v[j][q]; const f32x4* wr = (const f32x4*)(rw + (size_t)(4 * lane + 256 * j + q) * NE);
#pragma unroll
                for (int e4 = 0; e4 < 8; ++e4) { const f32x4 w = wr[e4]; lg[4 * e4] += uv * w.x; lg[4 * e4 + 1] += uv * w.y; lg[4 * e4 + 2] += uv * w.z; lg[4 * e4 + 3] += uv * w.w; }
                asm volatile("" ::: "memory"); }
        float aff[32], bia[32];
#pragma unroll
        for (int e = 0; e < 32; ++e) { const float lgt = wave_sum(lg[e]); aff[e] = 1.f / (1.f + expf(-lgt)); bia[e] = aff[e] + rbias[e]; }
        float best = -1e30f; int grp = 0; float gv0 = 0.f, gv1 = 0.f, gv2 = 0.f, gv3 = 0.f, ga0 = 0.f, ga1 = 0.f, ga2 = 0.f, ga3 = 0.f;
#pragma unroll
        for (int g = 0; g < 8; ++g) { const float a = bia[4 * g], b = bia[4 * g + 1], c = bia[4 * g + 2], d = bia[4 * g + 3];
            const float h1 = fmaxf(a, b), l1 = fminf(a, b), h2 = fmaxf(c, d), l2 = fminf(c, d);
            const float sc = fmaxf(h1, h2) + fmaxf(fminf(h1, h2), fmaxf(l1, l2));
            if (sc > best) { best = sc; grp = g; gv0 = a; gv1 = b; gv2 = c; gv3 = d; ga0 = aff[4 * g]; ga1 = aff[4 * g + 1]; ga2 = aff[4 * g + 2]; ga3 = aff[4 * g + 3]; } }
        int i1 = 0; float v1 = gv0; if (gv1 > v1) { v1 = gv1; i1 = 1; } if (gv2 > v1) { v1 = gv2; i1 = 2; } if (gv3 > v1) { v1 = gv3; i1 = 3; }
        int i2 = -1; float v2 = -1e30f;
        if (i1 != 0 && gv0 > v2) { v2 = gv0; i2 = 0; } if (i1 != 1 && gv1 > v2) { v2 = gv1; i2 = 1; } if (i1 != 2 && gv2 > v2) { v2 = gv2; i2 = 2; } if (i1 != 3 && gv3 > v2) { v2 = gv3; i2 = 3; }
        const float a1 = i1 == 0 ? ga0 : i1 == 1 ? ga1 : i1 == 2 ? ga2 : ga3, a2 = i2 == 0 ? ga0 : i2 == 1 ? ga1 : i2 == 2 ? ga2 : ga3;
        const float w1 = a1 / (a1 + a2), w2 = a2 / (a1 + a2);
        const int e1 = grp * 4 + i1, e2 = grp * 4 + i2;
        if (lane == 0) {
            const unsigned p1 = __hip_atomic_fetch_add(counts + e1, 1u, __ATOMIC_RELAXED, __HIP_MEMORY_SCOPE_AGENT);
            const unsigned p2 = __hip_atomic_fetch_add(counts + e2, 1u, __ATOMIC_RELAXED, __HIP_MEMORY_SCOPE_AGENT);
            table[(size_t)e1 * T + p1] = row; table[(size_t)e2 * T + p2] = row;
            u32x4 ta; ta.x = (unsigned)e1; ta.y = (unsigned)e2; ta.z = p1; ta.w = p2; u32x4 tb2; tb2.x = __float_as_uint(w1); tb2.y = __float_as_uint(w2); tb2.z = 0u; tb2.w = 0u;
            *(u32x4*)(tokinfo + (size_t)row * 8) = ta; *(u32x4*)(tokinfo + (size_t)row * 8 + 4) = tb2;
        }
    }
}
DI void moe_prefix(const unsigned* counts, LAS int* cnt, LAS int* tb, int tid) {
    __syncthreads();
    if (tid < 32) cnt[tid] = (int)__hip_atomic_load(counts + tid, __ATOMIC_RELAXED, __HIP_MEMORY_SCOPE_AGENT);
    __syncthreads();
    if (tid == 0) { int a = 0; for (int e = 0; e < 32; ++e) { tb[e] = a; a += (cnt[e] + 255) >> 8; } tb[32] = a; }
    __syncthreads();
}
DI void combine_phase(const float* X1, const bf16* Y, const unsigned* tokinfo, const LAS int* tb, const float* mods_l, const float* lng, const float* lnb,
                      float* XO, const float* mods_next, bf16* U, int gw, int NGW, int lane) {
    for (int row = gw; row < T; row += NGW) {
        const u32x4 ta = *(const u32x4*)(tokinfo + (size_t)row * 8); const u32x4 tw = *(const u32x4*)(tokinfo + (size_t)row * 8 + 4);
        const size_t r0 = (size_t)tb[ta.x] * 256 + ta.z, r1 = (size_t)tb[ta.y] * 256 + ta.w; const float w0 = __uint_as_float(tw.x), w1 = __uint_as_float(tw.y);
        Row r; row_load(r, X1 + (size_t)row * D, lane);
        const u32x2* y0 = (const u32x2*)(Y + r0 * D) + lane; const u32x2* y1 = (const u32x2*)(Y + r1 * D) + lane;
        const f32x4* g2 = (const f32x4*)(mods_l + (size_t)(row >> 12) * MODW + 5 * D) + lane;
#pragma unroll
        for (int j = 0; j < 8; ++j) { const u32x2 a = y0[64 * j], b = y1[64 * j]; f32x4 f;
            f.x = w0 * bflo(a.x) + w1 * bflo(b.x); f.y = w0 * bfhi(a.x) + w1 * bfhi(b.x); f.z = w0 * bflo(a.y) + w1 * bflo(b.y); f.w = w0 * bfhi(a.y) + w1 * bfhi(b.y);
            r.v[j] = r.v[j] * ALPHA + g2[64 * j] * f; }
        row_ln(r); row_affine(r, lng, lnb, lane);
        row_store(r, XO + (size_t)row * D, lane);
        if (U) { row_ln(r); const float* mr = mods_next + (size_t)(row >> 12) * MODW; row_modulate(r, mr, mr + D, lane); row_store_bf16(r, U + (size_t)row * D, lane); }
    }
}

struct Args { const float* in[18]; float* out; unsigned char* ws; int ph_lo, ph_hi; };
__global__ void __launch_bounds__(512, 2) fwd(Args args) {
    extern __shared__ __attribute__((aligned(16))) unsigned char lds_raw[];
    LAS unsigned char* lds = (LAS unsigned char*)lds_raw;
    const int tid = threadIdx.x, lane = tid & 63, wave = __builtin_amdgcn_readfirstlane(tid >> 6);
    const int gw = blockIdx.x * 8 + wave, NGW = gridDim.x * 8, gtid = blockIdx.x * 512 + tid, GT = gridDim.x * 512;
    volatile LAS unsigned* LCTL = (volatile LAS unsigned*)(lds + LDSCTL_OFF);
    LAS int* l_cnt = (LAS int*)(lds + LDSCTL_OFF) + 16; LAS int* l_tb = (LAS int*)(lds + LDSCTL_OFF) + 48;
    for (int u = tid; u < (LDS_BYTES - LDSCTL_OFF) / 4; u += 512) ((LAS unsigned*)(lds + LDSCTL_OFF))[u] = 0u;
    __syncthreads();
    unsigned char* ws = args.ws;
    unsigned* ctl = (unsigned*)(ws + WS_CTL);
    const float *x = args.in[0], *c_in = args.in[1], *ctx = args.in[2], *c_ctx = args.in[3], *ada_w = args.in[4], *ada_b = args.in[5], *w_mix_in = args.in[6], *rpb = args.in[7],
                *conv_w = args.in[8], *w_mix_out = args.in[9], *w_fourier = args.in[10], *router_w = args.in[11], *router_b = args.in[12], *w_gate = args.in[13], *w_up = args.in[14],
                *w_down = args.in[15], *ln_g = args.in[16], *ln_b = args.in[17];
    float* mods = (float*)(ws + WS_MODS); unsigned* tokinfo = (unsigned*)(ws + WS_TOKINFO); int* table = (int*)(ws + WS_TABLE);
    bf16 *WIN = (bf16*)(ws + WS_WIN), *WO = (bf16*)(ws + WS_WO), *WF = (bf16*)(ws + WS_WF), *CSM = (bf16*)(ws + WS_CS), *ACS = (bf16*)(ws + WS_ACS), *U = (bf16*)(ws + WS_U), *P = (bf16*)(ws + WS_P),
         *YB = (bf16*)(ws + WS_P), *BT2 = (bf16*)(ws + WS_P), *MIX = (bf16*)(ws + WS_MIX), *REZ = (bf16*)(ws + WS_MIX), *HB = (bf16*)(ws + WS_H), *WGU = (bf16*)(ws + WS_WGU), *WD = (bf16*)(ws + WS_WD);
    float *TB = (float*)(ws + WS_TB), *X1 = (float*)(ws + WS_X1), *X2 = (float*)(ws + WS_X2);
    XcdBarrier bar; bar.bar = ctl + CW_BAR; bar.x = 0; bar.st = nullptr;
    if (N_LAUNCHES != NPHASE) bar = xcd_barrier_post(ctl + CW_BAR, LCTL);
    const int lo = args.ph_lo, hi = args.ph_hi;
#define IN(k) (lo <= (k) && (k) < hi)
#define SEAM(k) do { if (IN(k) && IN((k) + 1)) xcd_barrier(bar); } while (0)

    if (IN(0)) {
        p0_mods(c_in, c_ctx, ada_w, ada_b, mods, (LAS float*)lds, tid);
        p0_weights(w_mix_in, w_mix_out, w_fourier, w_gate, w_up, w_down, WIN, WO, WF, WGU, WD, (LAS float*)(lds + wave * 16384), gw, NGW, lane);
        p0_dft(ACS, CSM, gtid, GT);
    }
    SEAM(0);
    if (IN(1)) ln_mod_phase(x, ctx, mods, 0, U, TALL, gw, NGW, lane);
    SEAM(1);
    if (IN(2)) { SchedInProj S{U, WIN}; EpiStoreBf16 E{P, NMIX}; gemm_simple(S, E, D, D, D); }
    SEAM(2);
    if (IN(3)) { attn_simple(P, rpb, MIX, (LAS float*)(lds + wave * 4096), gw, NGW, lane); conv_phase(P, conv_w, MIX, gtid, GT); }
    SEAM(3);
    if (IN(4)) { SchedDense S{MIX, WO, 64, 8, (size_t)256 * D, (size_t)256 * D}; EpiResid E{x, TB, mods + 2 * D}; gemm_simple(S, E, D, D, D); }
    SEAM(4);
    if (IN(5)) ln_router_phase(TB, ln_g, ln_b, mods, router_w, router_b, X1, U, ctl + CW_CNT, table, tokinfo, gw, NGW, lane);
    SEAM(5);
    if (IN(6)) { moe_prefix(ctl + CW_CNT, l_cnt, l_tb, tid); SchedMoe S{l_cnt, l_tb, U, WGU, table, 1, 0, (size_t)D * D, (size_t)256 * D}; EpiSwiglu E{HB}; gemm_simple(S, E, D, D, D); }
    SEAM(6);
    if (IN(7)) { moe_prefix(ctl + CW_CNT, l_cnt, l_tb, tid); SchedMoe S{l_cnt, l_tb, HB, WD, table, 0, (size_t)256 * DE, (size_t)D * DE, (size_t)256 * DE}; EpiStoreBf16 E{YB, D}; gemm_simple(S, E, DE, DE, DE); }
    SEAM(7);
    if (IN(8)) { moe_prefix(ctl + CW_CNT, l_cnt, l_tb, tid); combine_phase(X1, YB, tokinfo, l_tb, mods, ln_g + D, ln_b + D, X2, mods + 5 * MODW, U, gw, NGW, lane); }
    SEAM(8);
    if (IN(9)) { SchedF1 S{CSM, U}; EpiF1 E{BT2}; gemm_simple(S, E, 512, D, 512); }
    SEAM(9);
    if (IN(10)) { SchedF2 S{ACS, BT2}; EpiF2 E{REZ}; gemm_simple(S, E, 8192, 8192, 8192); }
    SEAM(10);
    if (IN(11)) { SchedDense S{REZ, WF, 64, 8, (size_t)256 * D, (size_t)256 * D}; EpiResid E{X2, TB, mods + 5 * MODW + 2 * D}; gemm_simple(S, E, D, D, D); }
    SEAM(11);
    if (IN(12)) ln_router_phase(TB, ln_g + 2 * D, ln_b + 2 * D, mods + 5 * MODW, router_w, router_b, X1, U, ctl + CW_CNT + 32, table + (size_t)NE * T, tokinfo + (size_t)T * 8, gw, NGW, lane);
    SEAM(12);
    if (IN(13)) { moe_prefix(ctl + CW_CNT + 32, l_cnt, l_tb, tid); SchedMoe S{l_cnt, l_tb, U, WGU + (size_t)NE * D * D, table + (size_t)NE * T, 1, 0, (size_t)D * D, (size_t)256 * D}; EpiSwiglu E{HB}; gemm_simple(S, E, D, D, D); }
    SEAM(13);
    if (IN(14)) { moe_prefix(ctl + CW_CNT + 32, l_cnt, l_tb, tid); SchedMoe S{l_cnt, l_tb, HB, WD + (size_t)NE * D * DE, table, 0, (size_t)256 * DE, (size_t)D * DE, (size_t)256 * DE}; EpiStoreBf16 E{YB, D}; gemm_simple(S, E, DE, DE, DE); }
    SEAM(14);
    if (IN(15)) { moe_prefix(ctl + CW_CNT + 32, l_cnt, l_tb, tid); combine_phase(X1, YB, tokinfo + (size_t)T * 8, l_tb, mods + 5 * MODW, ln_g + 3 * D, ln_b + 3 * D, args.out, nullptr, nullptr, gw, NGW, lane); }
#undef IN
#undef SEAM
}

extern "C" void kernel_launch(void* const* d_in, const int* in_sizes, int n_in, void* d_out, int out_size, void* d_ws, size_t ws_size, hipStream_t stream) {
    static int grid = 0;
    if (grid == 0) {
        if (n_in != 18 || out_size != T * D || ws_size < WS_END) { fprintf(stderr, "kernel_launch: unexpected shapes (n_in %d, out %d, ws %zu)\n", n_in, out_size, ws_size); grid = -1; return; }
        int dev = 0, cus = 0, per_cu = 0;
        if (hipGetDevice(&dev) != hipSuccess || hipDeviceGetAttribute(&cus, hipDeviceAttributeMultiprocessorCount, dev) != hipSuccess) { grid = -1; return; }
        if (hipFuncSetAttribute((const void*)fwd, hipFuncAttributeMaxDynamicSharedMemorySize, LDS_BYTES) != hipSuccess) { fprintf(stderr, "kernel_launch: hipFuncSetAttribute failed\n"); grid = -1; return; }
        if (hipOccupancyMaxActiveBlocksPerMultiprocessor(&per_cu, (const void*)fwd, 512, LDS_BYTES) != hipSuccess || per_cu < 1) fprintf(stderr, "kernel_launch: occupancy query says %d\n", per_cu);
        (void)hipGetLastError();
        grid = cus;
    }
    if (grid < 0) return;
    (void)hipMemsetAsync((char*)d_ws + WS_CTL, 0, CTL_ZERO_BYTES, stream);
    Args a{};
    for (int i = 0; i < 18; ++i) a.in[i] = (const float*)d_in[i];
    a.out = (float*)d_out; a.ws = (unsigned char*)d_ws;
    if (N_LAUNCHES == 1) { a.ph_lo = 0; a.ph_hi = NPHASE; hipLaunchKernelGGL(fwd, dim3(grid), dim3(512), LDS_BYTES, stream, a); }
    else for (int p = 0; p < NPHASE; ++p) { a.ph_lo = p; a.ph_hi = p + 1; hipLaunchKernelGGL(fwd, dim3(grid), dim3(512), LDS_BYTES, stream, a); }
}
```

```cpp
#include <hip/hip_runtime.h>
#include <cstdio>
#include <cstdint>

#define DI __device__ __forceinline__
#define LAS __attribute__((address_space(3)))
typedef unsigned short bf16;
typedef float f32x4 __attribute__((ext_vector_type(4)));
typedef short bf16x8 __attribute__((ext_vector_type(8)));
typedef unsigned u32x4 __attribute__((ext_vector_type(4)));
typedef unsigned u32x2 __attribute__((ext_vector_type(2)));

constexpr int D = 2048, NB = 4, SEQ = 4096, T = NB * SEQ, CTXL = 256, TC = NB * CTXL, TALL = T + TC;
constexpr int NMIX = 6144, NE = 32, DE = 1024, NH = 8, HD = 128, MODW = 6 * D;
constexpr float ALPHA = 1.41421356237309515f;
constexpr float LN_EPS = 1e-6f;
constexpr int NPHASE = 16;
#ifndef MK_N_LAUNCHES
#define MK_N_LAUNCHES 1
#endif
constexpr int N_LAUNCHES = MK_N_LAUNCHES;

constexpr size_t MiB = 1u << 20;
constexpr size_t WS_CTL = 0, CTL_ZERO_BYTES = 64 * 1024;
constexpr size_t WS_MODS = 1 * MiB;
constexpr size_t WS_TOKINFO = 2 * MiB;
constexpr size_t WS_TABLE = 4 * MiB;
constexpr size_t WS_WIN = 8 * MiB, WS_WO = 32 * MiB, WS_WF = 40 * MiB, WS_CS = 48 * MiB, WS_ACS = 64 * MiB;
constexpr size_t WS_U = 128 * MiB;
constexpr size_t WS_P = 196 * MiB;
constexpr size_t WS_MIX = 400 * MiB;
constexpr size_t WS_TB = 464 * MiB, WS_X1 = 592 * MiB, WS_X2 = 720 * MiB;
constexpr size_t WS_H = 848 * MiB;
constexpr size_t WS_WGU = 928 * MiB;
constexpr size_t WS_WD = 1440 * MiB;
constexpr size_t WS_END = 1696 * MiB;
constexpr int CW_CNT = 64;
constexpr int CW_BAR = 1024;

constexpr int LDS_SCR = 131072;
constexpr int LDSCTL_OFF = LDS_SCR;
constexpr int LDS_BYTES = 147456;

DI float wave_sum(float v) {
#pragma unroll
    for (int o = 1; o < 64; o <<= 1) v += __shfl_xor(v, o);
    return v;
}
DI float wave_max(float v) {
#pragma unroll
    for (int o = 1; o < 64; o <<= 1) v = fmaxf(v, __shfl_xor(v, o));
    return v;
}
DI unsigned f2bf(float f) { unsigned u = __float_as_uint(f); return (u + 0x7fffu + ((u >> 16) & 1u)) >> 16; }
DI unsigned pk2(float lo, float hi) { return f2bf(lo) | (f2bf(hi) << 16); }
DI float bflo(unsigned w) { return __uint_as_float(w << 16); }
DI float bfhi(unsigned w) { return __uint_as_float(w & 0xffff0000u); }
DI float silu_f(float v) { return v / (1.f + expf(-v)); }

#define XB_TMO      128
#define XB_XCNT(j)  (256  + 64 * (j))
#define XB_XSUB(j)  (1280 + 64 * (j))
#define XB_XGEN(j)  (2304 + 64 * (j))
#define XB_TOP      3328
#define XB_TOPGEN   3392
#define XCD_BAR_WORDS 3456
#define XB_SPIN_CAP (1u << 18)
__device__ __forceinline__ unsigned xb_ld(unsigned* p)              { return __hip_atomic_load(p, __ATOMIC_RELAXED, __HIP_MEMORY_SCOPE_AGENT); }
__device__ __forceinline__ unsigned xb_add(unsigned* p, unsigned v) { return __hip_atomic_fetch_add(p, v, __ATOMIC_RELAXED, __HIP_MEMORY_SCOPE_AGENT); }
__device__ __forceinline__ unsigned xb_xcc_id() { return (unsigned)__builtin_amdgcn_s_getreg((3 << 11) | 20) & 0xFu; }
#define XB_SPIN(cond, bar) do { unsigned _sp = 0; while (cond) { __builtin_amdgcn_s_sleep(1); \
    if ((++_sp & 255u) == 0u) { if (xb_ld(&(bar)[XB_TMO])) break; if (_sp > XB_SPIN_CAP) { atomicAdd(&(bar)[XB_TMO], 1u); break; } } } } while (0)
struct XcdBarrier { unsigned* bar; unsigned x; volatile LAS unsigned* st; };
__device__ __forceinline__ XcdBarrier xcd_barrier_post(unsigned* bar, volatile LAS unsigned* st) {
    XcdBarrier b; b.bar = bar; b.x = xb_xcc_id(); b.st = st;
    if (threadIdx.x == 0) (void)xb_add(&bar[XB_XCNT(b.x)], 1u);
    return b;
}
__device__ __forceinline__ void xcd_barrier_complete(unsigned* bar, unsigned x, unsigned& nloc, unsigned& nx) {
    const unsigned G = gridDim.x * gridDim.y * gridDim.z;
    unsigned sum, cnt, mine, sp = 0u;
    for (;;) {
        sum = 0u; cnt = 0u; mine = 0u;
#pragma unroll
        for (unsigned j = 0; j < 16; ++j) { const unsigned c = xb_ld(&bar[XB_XCNT(j)]); sum += c; cnt += (c > 0u) ? 1u : 0u; mine = (j == x) ? c : mine; }
        if (sum == G) break;
        __builtin_amdgcn_s_sleep(1);
        if ((++sp & 255u) == 0u) { if (xb_ld(&bar[XB_TMO])) break; if (sp > XB_SPIN_CAP) { atomicAdd(&bar[XB_TMO], 1u); break; } }
    }
    nloc = mine > 0u ? mine : 1u; nx = cnt > 0u ? cnt : 1u;
}
__device__ __forceinline__ void xcd_barrier(const XcdBarrier& b) {
    asm volatile("s_waitcnt vmcnt(0)" ::: "memory");
    __syncthreads();
    if (threadIdx.x == 0) {
        unsigned* bar = b.bar;
        __builtin_amdgcn_s_waitcnt(0);
        unsigned nloc = b.st[0], nx = b.st[1];
        if (nloc == 0u) { xcd_barrier_complete(bar, b.x, nloc, nx); b.st[0] = nloc; b.st[1] = nx; }
        const unsigned old = xb_add(&bar[XB_XSUB(b.x)], 1u);
        const unsigned gen = old / nloc;
        if (old + 1u == (gen + 1u) * nloc) {
            __builtin_amdgcn_fence(__ATOMIC_RELEASE, "agent");
            asm volatile("s_waitcnt vmcnt(0)" ::: "memory");
            const unsigned og = xb_add(&bar[XB_TOP], 1u);
            const unsigned tg = og / nx;
            if (og + 1u == (tg + 1u) * nx) xb_add(&bar[XB_TOPGEN], 1u);
            else XB_SPIN(xb_ld(&bar[XB_TOPGEN]) == tg, bar);
            __builtin_amdgcn_fence(__ATOMIC_ACQUIRE, "agent");
            xb_add(&bar[XB_XGEN(b.x)], 1u);
            asm volatile("s_waitcnt vmcnt(0)" ::: "memory");
        } else {
            XB_SPIN(xb_ld(&bar[XB_XGEN(b.x)]) == gen, bar);
            __builtin_amdgcn_fence(__ATOMIC_ACQUIRE, "agent");
            asm volatile("s_waitcnt vmcnt(0)" ::: "memory");
        }
    }
    __syncthreads();
}

struct Row { f32x4 v[8]; };
DI void row_load(Row& r, const float* p, int lane) { const f32x4* q = (const f32x4*)p + lane;
#pragma unroll
    for (int j = 0; j < 8; ++j) r.v[j] = q[64 * j]; }
DI void row_store(const Row& r, float* p, int lane) { f32x4* q = (f32x4*)p + lane;
#pragma unroll
    for (int j = 0; j < 8; ++j) q[64 * j] = r.v[j]; }
DI void row_store_bf16(const Row& r, bf16* p, int lane) { u32x2* q = (u32x2*)p + lane;
#pragma unroll
    for (int j = 0; j < 8; ++j) { u32x2 w; w.x = pk2(r.v[j].x, r.v[j].y); w.y = pk2(r.v[j].z, r.v[j].w); q[64 * j] = w; } }
DI void row_ln(Row& r) {
    float s = 0.f;
#pragma unroll
    for (int j = 0; j < 8; ++j) s += (r.v[j].x + r.v[j].y) + (r.v[j].z + r.v[j].w);
    const float mean = wave_sum(s) * (1.f / D); float s2 = 0.f;
#pragma unroll
    for (int j = 0; j < 8; ++j) { r.v[j] = r.v[j] - mean; s2 += (r.v[j].x * r.v[j].x + r.v[j].y * r.v[j].y) + (r.v[j].z * r.v[j].z + r.v[j].w * r.v[j].w); }
    const float rstd = 1.f / sqrtf(wave_sum(s2) * (1.f / D) + LN_EPS);
#pragma unroll
    for (int j = 0; j < 8; ++j) r.v[j] = r.v[j] * rstd;
}
DI void row_affine(Row& r, const float* g, const float* b, int lane) {
    const f32x4* gq = (const f32x4*)g + lane; const f32x4* bq = (const f32x4*)b + lane;
#pragma unroll
    for (int j = 0; j < 8; ++j) r.v[j] = r.v[j] * gq[64 * j] + bq[64 * j];
}
DI void row_modulate(Row& r, const float* sh, const float* sc, int lane) {
    const f32x4* hq = (const f32x4*)sh + lane; const f32x4* cq = (const f32x4*)sc + lane;
#pragma unroll
    for (int j = 0; j < 8; ++j) r.v[j] = r.v[j] * (cq[64 * j] + 1.f) + hq[64 * j];
}

struct Unit { const bf16* A; const bf16* B; const int* gat; int nvalid; int m0, n0, aux; };

template <class Sched, class Epi>
DI void gemm_simple(const Sched& S, const Epi& E, const int lda, const int ldb, const int K) {
    const int tid = threadIdx.x, wid = tid >> 6, lane = tid & 63, fr = lane & 15, fq = lane >> 4;
    for (int L = blockIdx.x; ; L += gridDim.x) {
        Unit u; if (!S.get(L, u)) break;
        const bf16* arow[2];
#pragma unroll
        for (int m = 0; m < 2; ++m) { const int r = 32 * wid + 16 * m + fr; size_t grow = (size_t)r; if (u.gat) grow = (size_t)(r < u.nvalid ? u.gat[r] : 0); arow[m] = u.A + grow * lda + fq * 8; }
        for (int cc = 0; cc < 4; ++cc) {
            f32x4 acc[2][4];
#pragma unroll
            for (int m = 0; m < 2; ++m)
#pragma unroll
                for (int j = 0; j < 4; ++j) acc[m][j] = (f32x4){0.f, 0.f, 0.f, 0.f};
            const bf16* brow[4];
#pragma unroll
            for (int j = 0; j < 4; ++j) { const int col = (j >> 1) * 128 + cc * 32 + (j & 1) * 16 + fr; brow[j] = u.B + (size_t)col * ldb + fq * 8; }
            for (int k = 0; k < K; k += 32) {
                bf16x8 a[2], b[4];
#pragma unroll
                for (int m = 0; m < 2; ++m) a[m] = *(const bf16x8*)(arow[m] + k);
#pragma unroll
                for (int j = 0; j < 4; ++j) b[j] = *(const bf16x8*)(brow[j] + k);
#pragma unroll
                for (int m = 0; m < 2; ++m)
#pragma unroll
                    for (int j = 0; j < 4; ++j) acc[m][j] = __builtin_amdgcn_mfma_f32_16x16x32_bf16(b[j], a[m], acc[m][j], 0, 0, 0);
            }
#pragma unroll
            for (int m = 0; m < 2; ++m)
#pragma unroll
                for (int nn = 0; nn < 2; ++nn) E(u, 32 * wid + 16 * m + fr, cc * 32 + nn * 16 + 4 * fq, acc[m][nn], acc[m][nn + 2]);
        }
    }
}

struct SchedInProj { const bf16* U; const bf16* W;
    DI bool get(int L, Unit& u) const { int pm, pn;
        if (L < 64 * 24) { pm = L / 24; pn = L % 24; } else if (L < 64 * 24 + 32) { const int l2 = L - 64 * 24; pm = 64 + (l2 >> 3); pn = 4 + (l2 & 7); } else return false;
        u.A = U + (size_t)pm * 256 * D; u.B = W + (size_t)pn * 256 * D; u.gat = nullptr; u.nvalid = 256; u.m0 = pm * 256; u.n0 = pn * 256; u.aux = 0; return true; } };
struct SchedDense { const bf16* A; const bf16* B; int nM, nN; size_t a_t, b_t;
    DI bool get(int L, Unit& u) const { if (L >= nM * nN) return false; const int pm = L / nN, pn = L % nN;
        u.A = A + (size_t)pm * a_t; u.B = B + (size_t)pn * b_t; u.gat = nullptr; u.nvalid = 256; u.m0 = pm * 256; u.n0 = pn * 256; u.aux = 0; return true; } };
struct SchedMoe { const LAS int* cnt; const LAS int* tb; const bf16* A; const bf16* W; const int* table; int gather; size_t a_t, w_e, w_t;
    DI bool get(int L, Unit& u) const { const int t = L >> 3, pn = L & 7; if (t >= tb[32]) return false;
        int e = 0;
        for (int i = 1; i < 32; ++i) e = (tb[i] <= t) ? i : e;
        const int mt = t - tb[e];
        if (gather) { u.A = A; u.gat = table + (size_t)e * T + mt * 256; } else { u.A = A + (size_t)t * a_t; u.gat = nullptr; }
        u.nvalid = min(256, cnt[e] - mt * 256);
        u.B = W + (size_t)e * w_e + (size_t)pn * w_t; u.m0 = t * 256; u.n0 = pn * 256; u.aux = e; return true; } };
struct SchedF1 { const bf16* CS; const bf16* U;
    DI bool get(int L, Unit& u) const { if (L >= 1024) return false; const int b = L >> 8, g = (L >> 6) & 3, pm = (L >> 4) & 3, pn = L & 15;
        u.A = CS + (size_t)pm * 256 * 512; u.B = U + ((size_t)b * SEQ + pn * 256) * D + g * 512; u.gat = nullptr; u.nvalid = 256; u.m0 = pm * 256; u.n0 = pn * 256; u.aux = b * 4 + g; return true; } };
struct SchedF2 { const bf16* ACS; const bf16* BT2;
    DI bool get(int L, Unit& u) const { if (L >= 512) return false; const int b = L >> 7, pm = (L >> 3) & 15, pn = L & 7;
        u.A = ACS + (size_t)pm * 256 * 8192; u.B = BT2 + ((size_t)b * D + pn * 256) * 8192; u.gat = nullptr; u.nvalid = 256; u.m0 = pm * 256; u.n0 = pn * 256; u.aux = b; return true; } };

DI void st_bf16x4(bf16* p, f32x4 v) { u32x2 w; w.x = pk2(v.x, v.y); w.y = pk2(v.z, v.w); *(u32x2*)p = w; }
struct EpiStoreBf16 { bf16* O; int ldc;
    DI void operator()(const Unit& u, int r, int c, f32x4 lo, f32x4 hi) const { bf16* p = O + (size_t)(u.m0 + r) * ldc + u.n0 + c; st_bf16x4(p, lo); st_bf16x4(p + 128, hi); } };
struct EpiResid { const float* x; float* t; const float* gate;
    DI void operator()(const Unit& u, int r, int c, f32x4 lo, f32x4 hi) const { const int row = u.m0 + r, b = row >> 12; const int col = u.n0 + c;
        const size_t o = (size_t)row * D + col; const float* g = gate + (size_t)b * MODW + col;
        *(f32x4*)(t + o) = *(const f32x4*)(x + o) * ALPHA + *(const f32x4*)g * lo;
        *(f32x4*)(t + o + 128) = *(const f32x4*)(x + o + 128) * ALPHA + *(const f32x4*)(g + 128) * hi; } };
struct EpiSwiglu { bf16* H;
    DI void operator()(const Unit& u, int r, int c, f32x4 lo, f32x4 hi) const { f32x4 h;
        h.x = silu_f(lo.x) * hi.x; h.y = silu_f(lo.y) * hi.y; h.z = silu_f(lo.z) * hi.z; h.w = silu_f(lo.w) * hi.w;
        st_bf16x4(H + (size_t)(u.m0 + r) * DE + (u.n0 >> 1) + c, h); } };
struct EpiF1 { bf16* BT2;
    DI void operator()(const Unit& u, int r, int c, f32x4 lo, f32x4 hi) const { const int b = u.aux >> 2, g = u.aux & 3, m = u.m0 + r, cs = m >> 9, cp = m & 511;
        bf16* p = BT2 + ((size_t)b * D + g * 512 + cp) * 8192 + cs * 4096 + u.n0 + c; st_bf16x4(p, lo); st_bf16x4(p + 128, hi); } };
struct EpiF2 { bf16* REZ;
    DI void operator()(const Unit& u, int r, int c, f32x4 lo, f32x4 hi) const { bf16* p = REZ + ((size_t)u.aux * SEQ + u.m0 + r) * D + u.n0 + c; st_bf16x4(p, lo); st_bf16x4(p + 128, hi); } };

DI void p0_mods(const float* c, const float* cctx, const float* ada_w, const float* ada_b, float* mods, LAS float* sl, int tid) {
    LAS float* red = sl + 5 * D;
    for (int i = tid; i < 5 * D; i += 512) { const float v = i < 4 * D ? c[i] : cctx[i - 4 * D]; sl[i] = silu_f(v); }
    __syncthreads();
    const int cq = tid & 127, ks = tid >> 7;
    for (int unit = blockIdx.x; unit < 192; unit += gridDim.x) {
        const int l = unit / 96, n = (unit % 96) * 128 + cq;
        const float* W = ada_w + (size_t)l * D * MODW + n;
        float a0 = 0.f, a1 = 0.f, a2 = 0.f, a3 = 0.f, a4 = 0.f;
#pragma unroll 8
        for (int k = ks * 512; k < ks * 512 + 512; ++k) { const float w = W[(size_t)k * MODW]; a0 += sl[k] * w; a1 += sl[D + k] * w; a2 += sl[2 * D + k] * w; a3 += sl[3 * D + k] * w; a4 += sl[4 * D + k] * w; }
        red[(ks * 5 + 0) * 128 + cq] = a0; red[(ks * 5 + 1) * 128 + cq] = a1; red[(ks * 5 + 2) * 128 + cq] = a2; red[(ks * 5 + 3) * 128 + cq] = a3; red[(ks * 5 + 4) * 128 + cq] = a4;
        __syncthreads();
        for (int i = tid; i < 640; i += 512) { const int r = i >> 7, q = i & 127, n2 = (unit % 96) * 128 + q;
            const float s = (red[(0 * 5 + r) * 128 + q] + red[(1 * 5 + r) * 128 + q]) + (red[(2 * 5 + r) * 128 + q] + red[(3 * 5 + r) * 128 + q]);
            mods[((size_t)l * 5 + r) * MODW + n2] = s + ada_b[(size_t)l * MODW + n2]; }
        __syncthreads();
    }
}
DI void tr_item(const float* W, int N, int Kd, int k0, int n0, bf16* WT, int drow0, LAS float* scr, int lane) {
#pragma unroll 8
    for (int i = 0; i < 32; ++i) { const int kk = 2 * i + (lane >> 5); scr[kk * 33 + (lane & 31)] = W[(size_t)(k0 + kk) * N + n0 + (lane & 31)]; }
    asm volatile("s_waitcnt lgkmcnt(0)" ::: "memory");
    const int c = lane & 7;
#pragma unroll
    for (int j = 0; j < 4; ++j) { const int n = (lane >> 3) + 8 * j; const LAS float* s = scr + (8 * c) * 33 + n;
        u32x4 o; o.x = pk2(s[0 * 33], s[1 * 33]); o.y = pk2(s[2 * 33], s[3 * 33]); o.z = pk2(s[4 * 33], s[5 * 33]); o.w = pk2(s[6 * 33], s[7 * 33]);
        *(u32x4*)(WT + (size_t)(drow0 + n) * Kd + k0 + 8 * c) = o; }
    asm volatile("s_waitcnt lgkmcnt(0)" ::: "memory");
}
DI void p0_weights(const float* w_in, const float* w_out, const float* w_f, const float* w_gate, const float* w_up, const float* w_down,
                   bf16* WIN, bf16* WO, bf16* WF, bf16* WGU, bf16* WD, LAS float* scr, int gw, int NGW, int lane) {
    constexpr int I_IN = 32 * 192, I_SQ = 32 * 64, I_E = 65536;
    constexpr int NIT = I_IN + 2 * I_SQ + 3 * I_E;
    for (int it = gw; it < NIT; it += NGW) {
        int r = it;
        if (r < I_IN) { const int kb = r / 192, nb = r % 192; tr_item(w_in, NMIX, D, kb * 64, nb * 32, WIN, nb * 32, scr, lane); continue; } r -= I_IN;
        if (r < I_SQ) { const int kb = r / 64, nb = r % 64; tr_item(w_out, D, D, kb * 64, nb * 32, WO, nb * 32, scr, lane); continue; } r -= I_SQ;
        if (r < I_SQ) { const int kb = r / 64, nb = r % 64; tr_item(w_f, D, D, kb * 64, nb * 32, WF, nb * 32, scr, lane); continue; } r -= I_SQ;
        if (r < 2 * I_E) { const int up = r >= I_E; if (up) r -= I_E; const int mat = r >> 10, rr = r & 1023, kb = rr >> 5, nb = rr & 31, n0 = nb * 32;
            tr_item((up ? w_up : w_gate) + (size_t)mat * D * DE, DE, D, kb * 64, n0, WGU + (size_t)mat * D * D, (n0 >> 7) * 256 + (n0 & 127) + (up ? 128 : 0), scr, lane); continue; } r -= 2 * I_E;
        { const int mat = r >> 10, rr = r & 1023, kb = rr >> 6, nb = rr & 63; tr_item(w_down + (size_t)mat * DE * D, D, DE, kb * 64, nb * 32, WD + (size_t)mat * D * DE, nb * 32, scr, lane); }
    }
}
DI void p0_dft(bf16* ACS, bf16* CS, int gtid, int GT) {
    for (int i = gtid; i < 4096 * 1024; i += GT) { const int j = i >> 10, k8 = (i & 1023) * 8; unsigned w[4];
#pragma unroll
        for (int e = 0; e < 4; ++e) { float v[2];
#pragma unroll
            for (int q = 0; q < 2; ++q) { const int kk = k8 + 2 * e + q; const int m = (j * (kk & 4095)) & 4095; const float ang = (float)m * (1.f / 2048.f); v[q] = (kk < 4096 ? cospif(ang) : -sinpif(ang)) * (1.f / 64.f); }
            w[e] = pk2(v[0], v[1]); }
        *(u32x4*)(ACS + (size_t)j * 8192 + k8) = (u32x4){w[0], w[1], w[2], w[3]}; }
    for (int i = gtid; i < 1024 * 64; i += GT) { const int rr = i >> 6, c8 = (i & 63) * 8, cs = rr >> 9, cp = rr & 511; unsigned w[4];
#pragma unroll
        for (int e = 0; e < 4; ++e) { float v[2];
#pragma unroll
            for (int q = 0; q < 2; ++q) { const int cc = c8 + 2 * e + q; const int m = (cc * cp) & 511; const float ang = (float)m * (1.f / 256.f); v[q] = (cs ? sinpif(ang) : cospif(ang)) * 0.04419417382415922f; }
            w[e] = pk2(v[0], v[1]); }
        *(u32x4*)(CS + (size_t)rr * 512 + c8) = (u32x4){w[0], w[1], w[2], w[3]}; }
}
DI void ln_mod_phase(const float* x, const float* ctx, const float* mods_l, int sh_chunk, bf16* U, int nrows, int gw, int NGW, int lane) {
    for (int row = gw; row < nrows; row += NGW) {
        const float* src = row < T ? x + (size_t)row * D : ctx + (size_t)(row - T) * D; const int rb = row < T ? (row >> 12) : 4;
        Row r; row_load(r, src, lane); row_ln(r);
        const float* mr = mods_l + (size_t)rb * MODW + sh_chunk * D;
        row_modulate(r, mr, mr + D, lane);
        row_store_bf16(r, U + (size_t)row * D, lane);
    }
}
DI void attn_simple(const bf16* P, const float* rpb, bf16* MIX, LAS float* scr, int gw, int NGW, int lane) {
    const float scale = 0.08838834764831845f;
    for (int item = gw; item < T * NH; item += NGW) {
        const int tok = item >> 3, h = item & 7, b = tok >> 12, l = tok & 4095, r = l >> 6, qc = l & 63;
        const int rs = min(max(r - 4, 0), 56), cs = min(max(qc - 8, 0), 48);
        { const unsigned w = *((const unsigned*)(P + (size_t)tok * NMIX + h * HD) + lane); scr[2 * lane] = bflo(w); scr[2 * lane + 1] = bfhi(w); }
        asm volatile("s_waitcnt lgkmcnt(0)" ::: "memory");
        float s[6];
#pragma unroll
        for (int i = 0; i < 6; ++i) {
            const int kk = lane + 64 * i; size_t krow; float bias = 0.f;
            if (kk < 128) { const int a = kk >> 4, j = kk & 15; krow = (size_t)b * SEQ + 64 * (rs + a) + cs + j; bias = rpb[(h * 15 + (rs + a - r + 7)) * 31 + (cs + j - qc + 15)]; }
            else krow = (size_t)T + b * CTXL + (kk - 128);
            const u32x4* kp = (const u32x4*)(P + krow * NMIX + D / 2 + h * HD);
            float acc = 0.f;
#pragma unroll 4
            for (int d8 = 0; d8 < 16; ++d8) { const u32x4 kv = kp[d8]; const LAS f32x4* qv = (const LAS f32x4*)scr + 2 * d8; const f32x4 q0 = qv[0], q1 = qv[1];
                acc += bflo(kv.x) * q0.x + bfhi(kv.x) * q0.y + bflo(kv.y) * q0.z + bfhi(kv.y) * q0.w + bflo(kv.z) * q1.x + bfhi(kv.z) * q1.y + bflo(kv.w) * q1.z + bfhi(kv.w) * q1.w; }
            s[i] = acc * scale + bias;
        }
        float m = s[0];
#pragma unroll
        for (int i = 1; i < 6; ++i) m = fmaxf(m, s[i]);
        m = wave_max(m); float sum = 0.f;
#pragma unroll
        for (int i = 0; i < 6; ++i) { s[i] = expf(s[i] - m); sum += s[i]; scr[128 + lane + 64 * i] = s[i]; }
        sum = wave_sum(sum);
        asm volatile("s_waitcnt lgkmcnt(0)" ::: "memory");
        float o0 = 0.f, o1 = 0.f;
        for (int kk = 0; kk < 384; ++kk) {
            size_t vrow; if (kk < 128) vrow = (size_t)b * SEQ + 64 * (rs + (kk >> 4)) + cs + (kk & 15); else vrow = (size_t)T + b * CTXL + (kk - 128);
            const unsigned w = *((const unsigned*)(P + vrow * NMIX + D + h * HD) + lane); const float p = scr[128 + kk];
            o0 += p * bflo(w); o1 += p * bfhi(w);
        }
        const float inv = 1.f / sum;
        *((unsigned*)(MIX + (size_t)tok * D + h * HD) + lane) = pk2(o0 * inv, o1 * inv);
        asm volatile("s_waitcnt lgkmcnt(0)" ::: "memory");
    }
}
DI void conv_phase(const bf16* P, const float* cw, bf16* MIX, int gtid, int GT) {
    for (int i = gtid; i < T * 128; i += GT) {
        const int tok = i >> 7, c8 = (i & 127) * 8, l = tok & 4095;
        const bf16* base = P + (size_t)tok * NMIX + 3072 + c8;
        const u32x4 gb = *(const u32x4*)base;
        float z[3][8];
#pragma unroll
        for (int j = 0; j < 3; ++j) { const int ll = l + j - 1; const bool ok = ll >= 0 && ll < SEQ;
            u32x4 gc = (u32x4){0u, 0u, 0u, 0u}, xi = gc;
            if (ok) { const bf16* pj = base + (ptrdiff_t)(j - 1) * NMIX; gc = *(const u32x4*)(pj + 1024); xi = *(const u32x4*)(pj + 2048); }
            z[j][0] = bflo(gc.x) * bflo(xi.x); z[j][1] = bfhi(gc.x) * bfhi(xi.x); z[j][2] = bflo(gc.y) * bflo(xi.y); z[j][3] = bfhi(gc.y) * bfhi(xi.y);
            z[j][4] = bflo(gc.z) * bflo(xi.z); z[j][5] = bfhi(gc.z) * bfhi(xi.z); z[j][6] = bflo(gc.w) * bflo(xi.w); z[j][7] = bfhi(gc.w) * bfhi(xi.w); }
        float gbf[8] = {bflo(gb.x), bfhi(gb.x), bflo(gb.y), bfhi(gb.y), bflo(gb.z), bfhi(gb.z), bflo(gb.w), bfhi(gb.w)};
        float o[8];
#pragma unroll
        for (int e = 0; e < 8; ++e) o[e] = gbf[e] * (cw[c8 + e] * z[0][e] + cw[1024 + c8 + e] * z[1][e] + cw[2048 + c8 + e] * z[2][e]);
        *(u32x4*)(MIX + (size_t)tok * D + 1024 + c8) = (u32x4){pk2(o[0], o[1]), pk2(o[2], o[3]), pk2(o[4], o[5]), pk2(o[6], o[7])};
    }
}
DI void ln_router_phase(const float* TB, const float* lng, const float* lnb, const float* mods_l, const float* rw, const float* rbias,
                        float* X1, bf16* U, unsigned* counts, int* table, unsigned* tokinfo, int gw, int NGW, int lane) {
    for (int row = gw; row < T; row += NGW) {
        Row r; row_load(r, TB + (size_t)row * D, lane); row_ln(r); row_affine(r, lng, lnb, lane);
        row_store(r, X1 + (size_t)row * D, lane);
        row_ln(r);
        const float* mr = mods_l + (size_t)(row >> 12) * MODW + 3 * D;
        row_modulate(r, mr, mr + D, lane);
        row_store_bf16(r, U + (size_t)row * D, lane);
        float lg[32];
#pragma unroll
        for (int e = 0; e < 32; ++e) lg[e] = 0.f;
#pragma unroll
        for (int j = 0; j < 8; ++j)
#pragma unroll
            for (int q = 0; q < 4; ++q) { const float uv = r.v[j][q]; const f32x4* wr = (const f32x4*)(rw + (size_t)(4 * lane + 256 * j + q) * NE);
#pragma unroll
                for (int e4 = 0; e4 < 8; ++e4) { const f32x4 w = wr[e4]; lg[4 * e4] += uv * w.x; lg[4 * e4 + 1] += uv * w.y; lg[4 * e4 + 2] += uv * w.z; lg[4 * e4 + 3] += uv * w.w; }
                asm volatile("" ::: "memory"); }
        float aff[32], bia[32];
#pragma unroll
        for (int e = 0; e < 32; ++e) { const float lgt = wave_sum(lg[e]); aff[e] = 1.f / (1.f + expf(-lgt)); bia[e] = aff[e] + rbias[e]; }
        float best = -1e30f; int grp = 0; float gv0 = 0.f, gv1 = 0.f, gv2 = 0.f, gv3 = 0.f, ga0 = 0.f, ga1 = 0.f, ga2 = 0.f, ga3 = 0.f;
#pragma unroll
        for (int g = 0; g < 8; ++g) { const float a = bia[4 * g], b = bia[4 * g + 1], c = bia[4 * g + 2], d = bia[4 * g + 3];
            const float h1 = fmaxf(a, b), l1 = fminf(a, b), h2 = fmaxf(c, d), l2 = fminf(c, d);
            const float sc = fmaxf(h1, h2) + fmaxf(fminf(h1, h2), fmaxf(l1, l2));
            if (sc > best) { best = sc; grp = g; gv0 = a; gv1 = b; gv2 = c; gv3 = d; ga0 = aff[4 * g]; ga1 = aff[4 * g + 1]; ga2 = aff[4 * g + 2]; ga3 = aff[4 * g + 3]; } }
        int i1 = 0; float v1 = gv0; if (gv1 > v1) { v1 = gv1; i1 = 1; } if (gv2 > v1) { v1 = gv2; i1 = 2; } if (gv3 > v1) { v1 = gv3; i1 = 3; }
        int i2 = -1; float v2 = -1e30f;
        if (i1 != 0 && gv0 > v2) { v2 = gv0; i2 = 0; } if (i1 != 1 && gv1 > v2) { v2 = gv1; i2 = 1; } if (i1 != 2 && gv2 > v2) { v2 = gv2; i2 = 2; } if (i1 != 3 && gv3 > v2) { v2 = gv3; i2 = 3; }
        const float a1 = i1 == 0 ? ga0 : i1 == 1 ? ga1 : i1 == 2 ? ga2 : ga3, a2 = i2 == 0 ? ga0 : i2 == 1 ? ga1 : i2 == 2 ? ga2 : ga3;
        const float w1 = a1 / (a1 + a2), w2 = a2 / (a1 + a2);
        const int e1 = grp * 4 + i1, e2 = grp * 4 + i2;
        if (lane == 0) {
            const unsigned p1 = __hip_atomic_fetch_add(counts + e1, 1u, __ATOMIC_RELAXED, __HIP_MEMORY_SCOPE_AGENT);
            const unsigned p2 = __hip_atomic_fetch_add(counts + e2, 1u, __ATOMIC_RELAXED, __HIP_MEMORY_SCOPE_AGENT);
            table[(size_t)e1 * T + p1] = row; table[(size_t)e2 * T + p2] = row;
            u32x4 ta; ta.x = (unsigned)e1; ta.y = (unsigned)e2; ta.z = p1; ta.w = p2; u32x4 tb2; tb2.x = __float_as_uint(w1); tb2.y = __float_as_uint(w2); tb2.z = 0u; tb2.w = 0u;
            *(u32x4*)(tokinfo + (size_t)row * 8) = ta; *(u32x4*)(tokinfo + (size_t)row * 8 + 4) = tb2;
        }
    }
}
DI void moe_prefix(const unsigned* counts, LAS int* cnt, LAS int* tb, int tid) {
    __syncthreads();
    if (tid < 32) cnt[tid] = (int)__hip_atomic_load(counts + tid, __ATOMIC_RELAXED, __HIP_MEMORY_SCOPE_AGENT);
    __syncthreads();
    if (tid == 0) { int a = 0; for (int e = 0; e < 32; ++e) { tb[e] = a; a += (cnt[e] + 255) >> 8; } tb[32] = a; }
    __syncthreads();
}
DI void combine_phase(const float* X1, const bf16* Y, const unsigned* tokinfo, const LAS int* tb, const float* mods_l, const float* lng, const float* lnb,
                      float* XO, const float* mods_next, bf16* U, int gw, int NGW, int lane) {
    for (int row = gw; row < T; row += NGW) {
        const u32x4 ta = *(const u32x4*)(tokinfo + (size_t)row * 8); const u32x4 tw = *(const u32x4*)(tokinfo + (size_t)row * 8 + 4);
        const size_t r0 = (size_t)tb[ta.x] * 256 + ta.z, r1 = (size_t)tb[ta.y] * 256 + ta.w; const float w0 = __uint_as_float(tw.x), w1 = __uint_as_float(tw.y);
        Row r; row_load(r, X1 + (size_t)row * D, lane);
        const u32x2* y0 = (const u32x2*)(Y + r0 * D) + lane; const u32x2* y1 = (const u32x2*)(Y + r1 * D) + lane;
        const f32x4* g2 = (const f32x4*)(mods_l + (size_t)(row >> 12) * MODW + 5 * D) + lane;
#pragma unroll
        for (int j = 0; j < 8; ++j) { const u32x2 a = y0[64 * j], b = y1[64 * j]; f32x4 f;
            f.x = w0 * bflo(a.x) + w1 * bflo(b.x); f.y = w0 * bfhi(a.x) + w1 * bfhi(b.x); f.z = w0 * bflo(a.y) + w1 * bflo(b.y); f.w = w0 * bfhi(a.y) + w1 * bfhi(b.y);
            r.v[j] = r.v[j] * ALPHA + g2[64 * j] * f; }
        row_ln(r); row_affine(r, lng, lnb, lane);
        row_store(r, XO + (size_t)row * D, lane);
        if (U) { row_ln(r); const float* mr = mods_next + (size_t)(row >> 12) * MODW; row_modulate(r, mr, mr + D, lane); row_store_bf16(r, U + (size_t)row * D, lane); }
    }
}

struct Args { const float* in[18]; float* out; unsigned char* ws; int ph_lo, ph_hi; };
__global__ void __launch_bounds__(512, 2) fwd(Args args) {
    extern __shared__ __attribute__((aligned(16))) unsigned char lds_raw[];
    LAS unsigned char* lds = (LAS unsigned char*)lds_raw;
    const int tid = threadIdx.x, lane = tid & 63, wave = __builtin_amdgcn_readfirstlane(tid >> 6);
    const int gw = blockIdx.x * 8 + wave, NGW = gridDim.x * 8, gtid = blockIdx.x * 512 + tid, GT = gridDim.x * 512;
    volatile LAS unsigned* LCTL = (volatile LAS unsigned*)(lds + LDSCTL_OFF);
    LAS int* l_cnt = (LAS int*)(lds + LDSCTL_OFF) + 16; LAS int* l_tb = (LAS int*)(lds + LDSCTL_OFF) + 48;
    for (int u = tid; u < (LDS_BYTES - LDSCTL_OFF) / 4; u += 512) ((LAS unsigned*)(lds + LDSCTL_OFF))[u] = 0u;
    __syncthreads();
    unsigned char* ws = args.ws;
    unsigned* ctl = (unsigned*)(ws + WS_CTL);
    const float *x = args.in[0], *c_in = args.in[1], *ctx = args.in[2], *c_ctx = args.in[3], *ada_w = args.in[4], *ada_b = args.in[5], *w_mix_in = args.in[6], *rpb = args.in[7],
                *conv_w = args.in[8], *w_mix_out = args.in[9], *w_fourier = args.in[10], *router_w = args.in[11], *router_b = args.in[12], *w_gate = args.in[13], *w_up = args.in[14],
                *w_down = args.in[15], *ln_g = args.in[16], *ln_b = args.in[17];
    float* mods = (float*)(ws + WS_MODS); unsigned* tokinfo = (unsigned*)(ws + WS_TOKINFO); int* table = (int*)(ws + WS_TABLE);
    bf16 *WIN = (bf16*)(ws + WS_WIN), *WO = (bf16*)(ws + WS_WO), *WF = (bf16*)(ws + WS_WF), *CSM = (bf16*)(ws + WS_CS), *ACS = (bf16*)(ws + WS_ACS), *U = (bf16*)(ws + WS_U), *P = (bf16*)(ws + WS_P),
         *YB = (bf16*)(ws + WS_P), *BT2 = (bf16*)(ws + WS_P), *MIX = (bf16*)(ws + WS_MIX), *REZ = (bf16*)(ws + WS_MIX), *HB = (bf16*)(ws + WS_H), *WGU = (bf16*)(ws + WS_WGU), *WD = (bf16*)(ws + WS_WD);
    float *TB = (float*)(ws + WS_TB), *X1 = (float*)(ws + WS_X1), *X2 = (float*)(ws + WS_X2);
    XcdBarrier bar; bar.bar = ctl + CW_BAR; bar.x = 0; bar.st = nullptr;
    if (N_LAUNCHES != NPHASE) bar = xcd_barrier_post(ctl + CW_BAR, LCTL);
    const int lo = args.ph_lo, hi = args.ph_hi;
#define IN(k) (lo <= (k) && (k) < hi)
#define SEAM(k) do { if (IN(k) && IN((k) + 1)) xcd_barrier(bar); } while (0)

    if (IN(0)) {
        p0_mods(c_in, c_ctx, ada_w, ada_b, mods, (LAS float*)lds, tid);
        p0_weights(w_mix_in, w_mix_out, w_fourier, w_gate, w_up, w_down, WIN, WO, WF, WGU, WD, (LAS float*)(lds + wave * 16384), gw, NGW, lane);
        p0_dft(ACS, CSM, gtid, GT);
    }
    SEAM(0);
    if (IN(1)) ln_mod_phase(x, ctx, mods, 0, U, TALL, gw, NGW, lane);
    SEAM(1);
    if (IN(2)) { SchedInProj S{U, WIN}; EpiStoreBf16 E{P, NMIX}; gemm_simple(S, E, D, D, D); }
    SEAM(2);
    if (IN(3)) { attn_simple(P, rpb, MIX, (LAS float*)(lds + wave * 4096), gw, NGW, lane); conv_phase(P, conv_w, MIX, gtid, GT); }
    SEAM(3);
    if (IN(4)) { SchedDense S{MIX, WO, 64, 8, (size_t)256 * D, (size_t)256 * D}; EpiResid E{x, TB, mods + 2 * D}; gemm_simple(S, E, D, D, D); }
    SEAM(4);
    if (IN(5)) ln_router_phase(TB, ln_g, ln_b, mods, router_w, router_b, X1, U, ctl + CW_CNT, table, tokinfo, gw, NGW, lane);
    SEAM(5);
    if (IN(6)) { moe_prefix(ctl + CW_CNT, l_cnt, l_tb, tid); SchedMoe S{l_cnt, l_tb, U, WGU, table, 1, 0, (size_t)D * D, (size_t)256 * D}; EpiSwiglu E{HB}; gemm_simple(S, E, D, D, D); }
    SEAM(6);
    if (IN(7)) { moe_prefix(ctl + CW_CNT, l_cnt, l_tb, tid); SchedMoe S{l_cnt, l_tb, HB, WD, table, 0, (size_t)256 * DE, (size_t)D * DE, (size_t)256 * DE}; EpiStoreBf16 E{YB, D}; gemm_simple(S, E, DE, DE, DE); }
    SEAM(7);
    if (IN(8)) { moe_prefix(ctl + CW_CNT, l_cnt, l_tb, tid); combine_phase(X1, YB, tokinfo, l_tb, mods, ln_g + D, ln_b + D, X2, mods + 5 * MODW, U, gw, NGW, lane); }
    SEAM(8);
    if (IN(9)) { SchedF1 S{CSM, U}; EpiF1 E{BT2}; gemm_simple(S, E, 512, D, 512); }
    SEAM(9);
    if (IN(10)) { SchedF2 S{ACS, BT2}; EpiF2 E{REZ}; gemm_simple(S, E, 8192, 8192, 8192); }
    SEAM(10);
    if (IN(11)) { SchedDense S{REZ, WF, 64, 8, (size_t)256 * D, (size_t)256 * D}; EpiResid E{X2, TB, mods + 5 * MODW + 2 * D}; gemm_simple(S, E, D, D, D); }
    SEAM(11);
    if (IN(12)) ln_router_phase(TB, ln_g + 2 * D, ln_b + 2 * D, mods + 5 * MODW, router_w, router_b, X1, U, ctl + CW_CNT + 32, table + (size_t)NE * T, tokinfo + (size_t)T * 8, gw, NGW, lane);
    SEAM(12);
    if (IN(13)) { moe_prefix(ctl + CW_CNT + 32, l_cnt, l_tb, tid); SchedMoe S{l_cnt, l_tb, U, WGU + (size_t)NE * D * D, table + (size_t)NE * T, 1, 0, (size_t)D * D, (size_t)256 * D}; EpiSwiglu E{HB}; gemm_simple(S, E, D, D, D); }
    SEAM(13);
    if (IN(14)) { moe_prefix(ctl + CW_CNT + 32, l_cnt, l_tb, tid); SchedMoe S{l_cnt, l_tb, HB, WD + (size_t)NE * D * DE, table, 0, (size_t)256 * DE, (size_t)D * DE, (size_t)256 * DE}; EpiStoreBf16 E{YB, D}; gemm_simple(S, E, DE, DE, DE); }
    SEAM(14);
    if (IN(15)) { moe_prefix(ctl + CW_CNT + 32, l_cnt, l_tb, tid); combine_phase(X1, YB, tokinfo + (size_t)T * 8, l_tb, mods + 5 * MODW, ln_g + 3 * D, ln_b + 3 * D, args.out, nullptr, nullptr, gw, NGW, lane); }
#undef IN
#undef SEAM
}

extern "C" void kernel_launch(void* const* d_in, const int* in_sizes, int n_in, void* d_out, int out_size, void* d_ws, size_t ws_size, hipStream_t stream) {
    static int grid = 0;
    if (grid == 0) {
        if (n_in != 18 || out_size != T * D || ws_size < WS_END) { fprintf(stderr, "kernel_launch: unexpected shapes (n_in %d, out %d, ws %zu)\n", n_in, out_size, ws_size); grid = -1; return; }
        int dev = 0, cus = 0, per_cu = 0;
        if (hipGetDevice(&dev) != hipSuccess || hipDeviceGetAttribute(&cus, hipDeviceAttributeMultiprocessorCount, dev) != hipSuccess) { grid = -1; return; }
        if (hipFuncSetAttribute((const void*)fwd, hipFuncAttributeMaxDynamicSharedMemorySize, LDS_BYTES) != hipSuccess) { fprintf(stderr, "kernel_launch: hipFuncSetAttribute failed\n"); grid = -1; return; }
        if (hipOccupancyMaxActiveBlocksPerMultiprocessor(&per_cu, (const void*)fwd, 512, LDS_BYTES) != hipSuccess || per_cu < 1) fprintf(stderr, "kernel_launch: occupancy query says %d\n", per_cu);
        (void)hipGetLastError();
        grid = cus;
    }
    if (grid < 0) return;
    (void)hipMemsetAsync((char*)d_ws + WS_CTL, 0, CTL_ZERO_BYTES, stream);
    Args a{};
    for (int i = 0; i < 18; ++i) a.in[i] = (const float*)d_in[i];
    a.out = (float*)d_out; a.ws = (unsigned char*)d_ws;
    if (N_LAUNCHES == 1) { a.ph_lo = 0; a.ph_hi = NPHASE; hipLaunchKernelGGL(fwd, dim3(grid), dim3(512), LDS_BYTES, stream, a); }
    else for (int p = 0; p < NPHASE; ++p) { a.ph_lo = p; a.ph_hi = p + 1; hipLaunchKernelGGL(fwd, dim3(grid), dim3(512), LDS_BYTES, stream, a); }
}
```

```cpp
#include <hip/hip_runtime.h>
#include <cstdio>
#include <cstdint>

#define DI __device__ __forceinline__
#define LAS __attribute__((address_space(3)))
typedef unsigned short bf16;
typedef float f32x4 __attribute__((ext_vector_type(4)));
typedef short bf16x8 __attribute__((ext_vector_type(8)));
typedef unsigned u32x4 __attribute__((ext_vector_type(4)));
typedef unsigned u32x2 __attribute__((ext_vector_type(2)));

constexpr int D = 2048, NB = 4, SEQ = 4096, T = NB * SEQ, CTXL = 256, TC = NB * CTXL, TALL = T + TC;
constexpr int NMIX = 6144, NE = 32, DE = 1024, NH = 8, HD = 128, MODW = 6 * D;
constexpr float ALPHA = 1.41421356237309515f;
constexpr float LN_EPS = 1e-6f;
constexpr int NPHASE = 16;
#ifndef MK_N_LAUNCHES
#define MK_N_LAUNCHES 1
#endif
constexpr int N_LAUNCHES = MK_N_LAUNCHES;

constexpr size_t MiB = 1u << 20;
constexpr size_t WS_CTL = 0, CTL_ZERO_BYTES = 64 * 1024;
constexpr size_t WS_MODS = 1 * MiB;
constexpr size_t WS_TOKINFO = 2 * MiB;
constexpr size_t WS_TABLE = 4 * MiB;
constexpr size_t WS_WIN = 8 * MiB, WS_WO = 32 * MiB, WS_WF = 40 * MiB, WS_CS = 48 * MiB, WS_ACS = 64 * MiB;
constexpr size_t WS_U = 128 * MiB;
constexpr size_t WS_P = 196 * MiB;
constexpr size_t WS_MIX = 400 * MiB;
constexpr size_t WS_TB = 464 * MiB, WS_X1 = 592 * MiB, WS_X2 = 720 * MiB;
constexpr size_t WS_H = 848 * MiB;
constexpr size_t WS_WGU = 928 * MiB;
constexpr size_t WS_WD = 1440 * MiB;
constexpr size_t WS_END = 1696 * MiB;
constexpr int CW_CNT = 64;
constexpr int CW_BAR = 1024;

constexpr int LDS_SCR = 131072;
constexpr int LDSCTL_OFF = LDS_SCR;
constexpr int LDS_BYTES = 147456;

DI float wave_sum(float v) {
#pragma unroll
    for (int o = 1; o < 64; o <<= 1) v += __shfl_xor(v, o);
    return v;
}
DI float wave_max(float v) {
#pragma unroll
    for (int o = 1; o < 64; o <<= 1) v = fmaxf(v, __shfl_xor(v, o));
    return v;
}
DI unsigned f2bf(float f) { unsigned u = __float_as_uint(f); return (u + 0x7fffu + ((u >> 16) & 1u)) >> 16; }
DI unsigned pk2(float lo, float hi) { return f2bf(lo) | (f2bf(hi) << 16); }
DI float bflo(unsigned w) { return __uint_as_float(w << 16); }
DI float bfhi(unsigned w) { return __uint_as_float(w & 0xffff0000u); }
DI float silu_f(float v) { return v / (1.f + expf(-v)); }

#define XB_TMO      128
#define XB_XCNT(j)  (256  + 64 * (j))
#define XB_XSUB(j)  (1280 + 64 * (j))
#define XB_XGEN(j)  (2304 + 64 * (j))
#define XB_TOP      3328
#define XB_TOPGEN   3392
#define XCD_BAR_WORDS 3456
#define XB_SPIN_CAP (1u << 18)
__device__ __forceinline__ unsigned xb_ld(unsigned* p)              { return __hip_atomic_load(p, __ATOMIC_RELAXED, __HIP_MEMORY_SCOPE_AGENT); }
__device__ __forceinline__ unsigned xb_add(unsigned* p, unsigned v) { return __hip_atomic_fetch_add(p, v, __ATOMIC_RELAXED, __HIP_MEMORY_SCOPE_AGENT); }
__device__ __forceinline__ unsigned xb_xcc_id() { return (unsigned)__builtin_amdgcn_s_getreg((3 << 11) | 20) & 0xFu; }
#define XB_SPIN(cond, bar) do { unsigned _sp = 0; while (cond) { __builtin_amdgcn_s_sleep(1); \
    if ((++_sp & 255u) == 0u) { if (xb_ld(&(bar)[XB_TMO])) break; if (_sp > XB_SPIN_CAP) { atomicAdd(&(bar)[XB_TMO], 1u); break; } } } } while (0)
struct XcdBarrier { unsigned* bar; unsigned x; volatile LAS unsigned* st; };
__device__ __forceinline__ XcdBarrier xcd_barrier_post(unsigned* bar, volatile LAS unsigned* st) {
    XcdBarrier b; b.bar = bar; b.x = xb_xcc_id(); b.st = st;
    if (threadIdx.x == 0) (void)xb_add(&bar[XB_XCNT(b.x)], 1u);
    return b;
}
__device__ __forceinline__ void xcd_barrier_complete(unsigned* bar, unsigned x, unsigned& nloc, unsigned& nx) {
    const unsigned G = gridDim.x * gridDim.y * gridDim.z;
    unsigned sum, cnt, mine, sp = 0u;
    for (;;) {
        sum = 0u; cnt = 0u; mine = 0u;
#pragma unroll
        for (unsigned j = 0; j < 16; ++j) { const unsigned c = xb_ld(&bar[XB_XCNT(j)]); sum += c; cnt += (c > 0u) ? 1u : 0u; mine = (j == x) ? c : mine; }
        if (sum == G) break;
        __builtin_amdgcn_s_sleep(1);
        if ((++sp & 255u) == 0u) { if (xb_ld(&bar[XB_TMO])) break; if (sp > XB_SPIN_CAP) { atomicAdd(&bar[XB_TMO], 1u); break; } }
    }
    nloc = mine > 0u ? mine : 1u; nx = cnt > 0u ? cnt : 1u;
}
__device__ __forceinline__ void xcd_barrier(const XcdBarrier& b) {
    asm volatile("s_waitcnt vmcnt(0)" ::: "memory");
    __syncthreads();
    if (threadIdx.x == 0) {
        unsigned* bar = b.bar;
        __builtin_amdgcn_s_waitcnt(0);
        unsigned nloc = b.st[0], nx = b.st[1];
        if (nloc == 0u) { xcd_barrier_complete(bar, b.x, nloc, nx); b.st[0] = nloc; b.st[1] = nx; }
        const unsigned old = xb_add(&bar[XB_XSUB(b.x)], 1u);
        const unsigned gen = old / nloc;
        if (old + 1u == (gen + 1u) * nloc) {
            __builtin_amdgcn_fence(__ATOMIC_RELEASE, "agent");
            asm volatile("s_waitcnt vmcnt(0)" ::: "memory");
            const unsigned og = xb_add(&bar[XB_TOP], 1u);
            const unsigned tg = og / nx;
            if (og + 1u == (tg + 1u) * nx) xb_add(&bar[XB_TOPGEN], 1u);
            else XB_SPIN(xb_ld(&bar[XB_TOPGEN]) == tg, bar);
            __builtin_amdgcn_fence(__ATOMIC_ACQUIRE, "agent");
            xb_add(&bar[XB_XGEN(b.x)], 1u);
            asm volatile("s_waitcnt vmcnt(0)" ::: "memory");
        } else {
            XB_SPIN(xb_ld(&bar[XB_XGEN(b.x)]) == gen, bar);
            __builtin_amdgcn_fence(__ATOMIC_ACQUIRE, "agent");
            asm volatile("s_waitcnt vmcnt(0)" ::: "memory");
        }
    }
    __syncthreads();
}

struct Row { f32x4 v[8]; };
DI void row_load(Row& r, const float* p, int lane) { const f32x4* q = (const f32x4*)p + lane;
#pragma unroll
    for (int j = 0; j < 8; ++j) r.v[j] = q[64 * j]; }
DI void row_store(const Row& r, float* p, int lane) { f32x4* q = (f32x4*)p + lane;
#pragma unroll
    for (int j = 0; j < 8; ++j) q[64 * j] = r.v[j]; }
DI void row_store_bf16(const Row& r, bf16* p, int lane) { u32x2* q = (u32x2*)p + lane;
#pragma unroll
    for (int j = 0; j < 8; ++j) { u32x2 w; w.x = pk2(r.v[j].x, r.v[j].y); w.y = pk2(r.v[j].z, r.v[j].w); q[64 * j] = w; } }
DI void row_ln(Row& r) {
    float s = 0.f;
#pragma unroll
    for (int j = 0; j < 8; ++j) s += (r.v[j].x + r.v[j].y) + (r.v[j].z + r.v[j].w);
    const float mean = wave_sum(s) * (1.f / D); float s2 = 0.f;
#pragma unroll
    for (int j = 0; j < 8; ++j) { r.v[j] = r.v[j] - mean; s2 += (r.v[j].x * r.v[j].x + r.v[j].y * r.v[j].y) + (r.v[j].z * r.v[j].z + r.v[j].w * r.v[j].w); }
    const float rstd = 1.f / sqrtf(wave_sum(s2) * (1.f / D) + LN_EPS);
#pragma unroll
    for (int j = 0; j < 8; ++j) r.v[j] = r.v[j] * rstd;
}
DI void row_affine(Row& r, const float* g, const float* b, int lane) {
    const f32x4* gq = (const f32x4*)g + lane; const f32x4* bq = (const f32x4*)b + lane;
#pragma unroll
    for (int j = 0; j < 8; ++j) r.v[j] = r.v[j] * gq[64 * j] + bq[64 * j];
}
DI void row_modulate(Row& r, const float* sh, const float* sc, int lane) {
    const f32x4* hq = (const f32x4*)sh + lane; const f32x4* cq = (const f32x4*)sc + lane;
#pragma unroll
    for (int j = 0; j < 8; ++j) r.v[j] = r.v[j] * (cq[64 * j] + 1.f) + hq[64 * j];
}

struct Unit { const bf16* A; const bf16* B; const int* gat; int nvalid; int m0, n0, aux; };

template <class Sched, class Epi>
DI void gemm_simple(const Sched& S, const Epi& E, const int lda, const int ldb, const int K) {
    const int tid = threadIdx.x, wid = tid >> 6, lane = tid & 63, fr = lane & 15, fq = lane >> 4;
    for (int L = blockIdx.x; ; L += gridDim.x) {
        Unit u; if (!S.get(L, u)) break;
        const bf16* arow[2];
#pragma unroll
        for (int m = 0; m < 2; ++m) { const int r = 32 * wid + 16 * m + fr; size_t grow = (size_t)r; if (u.gat) grow = (size_t)(r < u.nvalid ? u.gat[r] : 0); arow[m] = u.A + grow * lda + fq * 8; }
        for (int cc = 0; cc < 4; ++cc) {
            f32x4 acc[2][4];
#pragma unroll
            for (int m = 0; m < 2; ++m)
#pragma unroll
                for (int j = 0; j < 4; ++j) acc[m][j] = (f32x4){0.f, 0.f, 0.f, 0.f};
            const bf16* brow[4];
#pragma unroll
            for (int j = 0; j < 4; ++j) { const int col = (j >> 1) * 128 + cc * 32 + (j & 1) * 16 + fr; brow[j] = u.B + (size_t)col * ldb + fq * 8; }
            for (int k = 0; k < K; k += 32) {
                bf16x8 a[2], b[4];
#pragma unroll
                for (int m = 0; m < 2; ++m) a[m] = *(const bf16x8*)(arow[m] + k);
#pragma unroll
                for (int j = 0; j < 4; ++j) b[j] = *(const bf16x8*)(brow[j] + k);
#pragma unroll
                for (int m = 0; m < 2; ++m)
#pragma unroll
                    for (int j = 0; j < 4; ++j) acc[m][j] = __builtin_amdgcn_mfma_f32_16x16x32_bf16(b[j], a[m], acc[m][j], 0, 0, 0);
            }
#pragma unroll
            for (int m = 0; m < 2; ++m)
#pragma unroll
                for (int nn = 0; nn < 2; ++nn) E(u, 32 * wid + 16 * m + fr, cc * 32 + nn * 16 + 4 * fq, acc[m][nn], acc[m][nn + 2]);
        }
    }
}


namespace pg8 {
constexpr int BK = 64, HALF = 128, HTB = HALF * BK * 2, STAGE_BYTES = 8 * HTB;
DI int lds_byte(int r, int c) { const int st = (r >> 4) * 2 + (c >> 5), rr = r & 15, cc = c & 31, ob = rr * 64 + cc * 2; return st * 1024 + (ob ^ (((ob >> 9) & 1) << 5)); }
DI void stage_rc(int b, int& R, int& C) { const int st = b / 1024, sb = b % 1024, swz = sb ^ (((sb >> 9) & 1) << 5); R = (st >> 1) * 16 + swz / 64; C = (st & 1) * 32 + (swz % 64) / 2; }
}
template <bool GATHER, class Sched, class Epi>
DI void gemm_pg8(LAS unsigned char* lds, const Sched& S, const Epi& E, const int lda, const int ldb, const int K) {
    using namespace pg8;
    const int tid = threadIdx.x, wid = __builtin_amdgcn_readfirstlane(tid >> 6), lane = tid & 63, wr = wid >> 2, wc = wid & 3, fr = lane & 15, fq = lane >> 4;
    const int nt = K / BK, G = gridDim.x, cblk = blockIdx.x;
    int Rs[2], Cs[2]; unsigned voffB[2], vA[2][2], nvA[2][2];
#pragma unroll
    for (int i = 0; i < 2; ++i) { stage_rc(tid * 16 + i * 8192, Rs[i], Cs[i]); voffB[i] = (unsigned)(Rs[i] * ldb + Cs[i]) * 2u; }
    const size_t kstep = (size_t)(BK * 2), hstepA = (size_t)HALF * lda * 2, hstepB = (size_t)HALF * ldb * 2;
    const unsigned ldsw = (unsigned)wid * 1024u;
    const int aoff = lds_byte(wr * 64 + fr, fq * 8), boff = lds_byte(wc * 32 + fr, fq * 8);
#define PG8_SA(b, h) (((b) * 2 + (h)) * HTB)
#define PG8_SB(b, h) ((4 + (b) * 2 + (h)) * HTB)
#define PG8_STAGE(bufoff, gbase, voff) do { _Pragma("unroll") for (int _i = 0; _i < 2; ++_i) \
        __builtin_amdgcn_global_load_lds((const unsigned*)((const char*)(gbase) + (voff)[_i]), (LAS unsigned*)(lds + (bufoff) + ldsw + _i * 8192), 16, 0, 0); } while (0)
#define PG8_STAGE_A(bufoff, gbase, h) do { if constexpr (GATHER) PG8_STAGE(bufoff, gbase, vA[h]); else PG8_STAGE(bufoff, (gbase) + (h) * hstepA, vA[0]); } while (0)
#define PG8_LDA(dst, b, h) do { _Pragma("unroll") for (int m = 0; m < 4; ++m) _Pragma("unroll") for (int k = 0; k < 2; ++k) dst[m][k] = *(const LAS bf16x8*)(lds + PG8_SA(b, h) + aoff + m * 2048 + k * 1024); } while (0)
#define PG8_LDB(dst, b, h) do { _Pragma("unroll") for (int n = 0; n < 2; ++n) _Pragma("unroll") for (int k = 0; k < 2; ++k) dst[n][k] = *(const LAS bf16x8*)(lds + PG8_SB(b, h) + boff + n * 2048 + k * 1024); } while (0)
#define PG8_MMA(ai, bj, At, Bt) do { __builtin_amdgcn_s_setprio(1); _Pragma("unroll") for (int m = 0; m < 4; ++m) _Pragma("unroll") for (int n = 0; n < 2; ++n) _Pragma("unroll") for (int k = 0; k < 2; ++k) \
        acc[ai][bj][m][n] = __builtin_amdgcn_mfma_f32_16x16x32_bf16(Bt[n][k], At[m][k], acc[ai][bj][m][n], 0, 0, 0); __builtin_amdgcn_s_setprio(0); } while (0)
#define PG8_WAIT_V(n) asm volatile("s_waitcnt vmcnt(" #n ")" ::: "memory")
#define PG8_WAIT_L(n) asm volatile("s_waitcnt lgkmcnt(" #n ")" ::: "memory")
#define PG8_BAR __builtin_amdgcn_s_barrier()
#define PG8_SCHED __builtin_amdgcn_sched_barrier(0)
#define PG8_SETV(dst, u) do { _Pragma("unroll") for (int _h = 0; _h < 2; ++_h) _Pragma("unroll") for (int _i = 0; _i < 2; ++_i) { const int _r = _h * HALF + Rs[_i]; \
        if constexpr (GATHER) { const int _g = _r < (u).nvalid ? (u).gat[_r] : 0; dst[_h][_i] = (unsigned)(_g * lda + Cs[_i]) * 2u; } else dst[_h][_i] = (unsigned)(Rs[_i] * lda + Cs[_i]) * 2u; } } while (0)
    Unit cur, nxt; int ui = 0;
    if (!S.get(cblk, cur)) return;
    f32x4 acc[2][2][4][2];
#pragma unroll
    for (int a = 0; a < 2; ++a)
#pragma unroll
        for (int b = 0; b < 2; ++b)
#pragma unroll
            for (int m = 0; m < 4; ++m)
#pragma unroll
                for (int n = 0; n < 2; ++n) acc[a][b][m][n] = (f32x4){0.f, 0.f, 0.f, 0.f};
    bf16x8 At[4][2], B0[2][2], B1[2][2];
    const char* cA = (const char*)cur.A; const char* cB = (const char*)cur.B;
    PG8_SETV(vA, cur);
    PG8_STAGE(PG8_SB(0, 0), cB, voffB); PG8_STAGE(PG8_SB(0, 1), cB + hstepB, voffB); PG8_STAGE_A(PG8_SA(0, 0), cA, 0); PG8_STAGE_A(PG8_SA(0, 1), cA, 1);
    if (wr == 1) PG8_BAR;
    PG8_WAIT_V(2); PG8_BAR;
    PG8_STAGE(PG8_SB(1, 0), cB + kstep, voffB); PG8_STAGE_A(PG8_SA(1, 0), cA + kstep, 0); PG8_STAGE(PG8_SB(1, 1), cB + hstepB + kstep, voffB);
    PG8_WAIT_V(6); PG8_BAR;
    for (;;) {
        const bool has_next = S.get((ui + 1) * G + cblk, nxt);
        const char* nA = has_next ? (const char*)nxt.A : cA; const char* nB = has_next ? (const char*)nxt.B : cB;
        for (int t = 0; t < nt; t += 2) {
            const bool last = (t == nt - 2);
            const char* a1 = cA + (size_t)(t + 1) * kstep;
            const char* a2 = last ? nA : cA + (size_t)(t + 2) * kstep; const char* b2 = last ? nB : cB + (size_t)(t + 2) * kstep;
            const char* a3 = a2 + kstep; const char* b3 = b2 + kstep;
            if constexpr (GATHER) { if (last && has_next) PG8_SETV(nvA, nxt); }
            PG8_LDB(B0, 0, 0); PG8_LDB(B1, 0, 1); PG8_SCHED; PG8_LDA(At, 0, 0); PG8_STAGE_A(PG8_SA(1, 1), a1, 1);
            PG8_WAIT_V(8); PG8_WAIT_L(0); PG8_BAR; PG8_MMA(0, 0, At, B0); PG8_MMA(0, 1, At, B1); PG8_BAR; PG8_SCHED;
            if constexpr (GATHER) { if (last && has_next) {
#pragma unroll
                for (int _h = 0; _h < 2; ++_h)
#pragma unroll
                    for (int _i = 0; _i < 2; ++_i) vA[_h][_i] = nvA[_h][_i]; } }
            PG8_LDA(At, 0, 1); PG8_STAGE(PG8_SB(0, 0), b2, voffB); PG8_STAGE(PG8_SB(0, 1), b2 + hstepB, voffB); PG8_STAGE_A(PG8_SA(0, 0), a2, 0);
            PG8_WAIT_V(8); PG8_WAIT_L(0); PG8_BAR; PG8_MMA(1, 0, At, B0); PG8_MMA(1, 1, At, B1); PG8_BAR; PG8_SCHED;
            PG8_LDB(B0, 1, 0); PG8_LDB(B1, 1, 1); PG8_SCHED; PG8_LDA(At, 1, 0); PG8_STAGE_A(PG8_SA(0, 1), a2, 1);
            PG8_WAIT_V(8); PG8_WAIT_L(0); PG8_BAR; PG8_MMA(0, 0, At, B0); PG8_MMA(0, 1, At, B1); PG8_BAR; PG8_SCHED;
            PG8_LDA(At, 1, 1); PG8_STAGE(PG8_SB(1, 0), b3, voffB); PG8_STAGE(PG8_SB(1, 1), b3 + hstepB, voffB); PG8_STAGE_A(PG8_SA(1, 0), a3, 0);
            PG8_WAIT_V(8); PG8_WAIT_L(0); PG8_BAR; PG8_MMA(1, 0, At, B0); PG8_MMA(1, 1, At, B1); PG8_BAR; PG8_SCHED;
        }
        if (wr == 0) PG8_BAR;
#pragma unroll
        for (int ai = 0; ai < 2; ++ai)
#pragma unroll
            for (int m = 0; m < 4; ++m)
#pragma unroll
                for (int n = 0; n < 2; ++n) E(cur, ai * HALF + wr * 64 + m * 16 + fr, wc * 32 + n * 16 + 4 * fq, acc[ai][0][m][n], acc[ai][1][m][n]);
        if (!has_next) break;
#pragma unroll
        for (int a = 0; a < 2; ++a)
#pragma unroll
            for (int b = 0; b < 2; ++b)
#pragma unroll
                for (int m = 0; m < 4; ++m)
#pragma unroll
                    for (int n = 0; n < 2; ++n) acc[a][b][m][n] = (f32x4){0.f, 0.f, 0.f, 0.f};
        cur = nxt; cA = nA; cB = nB; ++ui;
        if (wr == 1) PG8_BAR;
    }
    PG8_WAIT_V(0);
    PG8_BAR;
#undef PG8_SA
#undef PG8_SB
#undef PG8_STAGE
#undef PG8_STAGE_A
#undef PG8_LDA
#undef PG8_LDB
#undef PG8_MMA
#undef PG8_WAIT_V
#undef PG8_WAIT_L
#undef PG8_BAR
#undef PG8_SCHED
#undef PG8_SETV
}

DI int xcd_remap(int L, int n) { const int q = n >> 3, r = n & 7, xcd = L & 7, off = L >> 3; return (xcd < r ? xcd * (q + 1) : r * (q + 1) + (xcd - r) * q) + off; }
DI void grouped(int wgid, int nM, int nN, int& pm, int& pn) { const int nig = 8 * nN, gid = wgid / nig, fm = gid * 8, gsz = min(nM - fm, 8); pm = fm + (wgid % nig) % gsz; pn = (wgid % nig) / gsz; }

struct SchedInProj { const bf16* U; const bf16* W;
    DI bool get(int L, Unit& u) const { int pm, pn;
        if (L >= 64 * 24 + 32) return false; const int w = xcd_remap(L, 64 * 24 + 32);
        if (w < 64 * 24) grouped(w, 64, 24, pm, pn); else { const int l2 = w - 64 * 24; pm = 64 + (l2 >> 3); pn = 4 + (l2 & 7); }
        u.A = U + (size_t)pm * 256 * D; u.B = W + (size_t)pn * 256 * D; u.gat = nullptr; u.nvalid = 256; u.m0 = pm * 256; u.n0 = pn * 256; u.aux = 0; return true; } };
struct SchedDense { const bf16* A; const bf16* B; int nM, nN; size_t a_t, b_t;
    DI bool get(int L, Unit& u) const { if (L >= nM * nN) return false; int pm, pn; grouped(xcd_remap(L, nM * nN), nM, nN, pm, pn);
        u.A = A + (size_t)pm * a_t; u.B = B + (size_t)pn * b_t; u.gat = nullptr; u.nvalid = 256; u.m0 = pm * 256; u.n0 = pn * 256; u.aux = 0; return true; } };
struct SchedMoe { const LAS int* cnt; const LAS int* tb; const bf16* A; const bf16* W; const int* table; int gather; size_t a_t, w_e, w_t;
    DI bool get(int L, Unit& u) const { const int nT = __builtin_amdgcn_readfirstlane(tb[32]); if (L >= nT * 8) return false; int t, pn; grouped(xcd_remap(L, nT * 8), nT, 8, t, pn);
        int e = 0;
        for (int i = 1; i < 32; ++i) e = (tb[i] <= t) ? i : e;
        e = __builtin_amdgcn_readfirstlane(e); t = __builtin_amdgcn_readfirstlane(t); pn = __builtin_amdgcn_readfirstlane(pn);
        const int mt = __builtin_amdgcn_readfirstlane(t - tb[e]);
        if (gather) { u.A = A; u.gat = table + (size_t)e * T + mt * 256; } else { u.A = A + (size_t)t * a_t; u.gat = nullptr; }
        u.nvalid = __builtin_amdgcn_readfirstlane(min(256, cnt[e] - mt * 256));
        u.B = W + (size_t)e * w_e + (size_t)pn * w_t; u.m0 = t * 256; u.n0 = pn * 256; u.aux = e; return true; } };
struct SchedF1 { const bf16* CS; const bf16* U;
    DI bool get(int L, Unit& u) const { if (L >= 1024) return false; const int b = L >> 8, g = (L >> 6) & 3, pm = (L >> 4) & 3, pn = L & 15;
        u.A = CS + (size_t)pm * 256 * 512; u.B = U + ((size_t)b * SEQ + pn * 256) * D + g * 512; u.gat = nullptr; u.nvalid = 256; u.m0 = pm * 256; u.n0 = pn * 256; u.aux = b * 4 + g; return true; } };
struct SchedF2 { const bf16* ACS; const bf16* BT2;
    DI bool get(int L, Unit& u) const { if (L >= 512) return false; const int b = L >> 7, pm = (L >> 3) & 15, pn = L & 7;
        u.A = ACS + (size_t)pm * 256 * 8192; u.B = BT2 + ((size_t)b * D + pn * 256) * 8192; u.gat = nullptr; u.nvalid = 256; u.m0 = pm * 256; u.n0 = pn * 256; u.aux = b; return true; } };

DI void st_bf16x4(bf16* p, f32x4 v) { u32x2 w; w.x = pk2(v.x, v.y); w.y = pk2(v.z, v.w); *(u32x2*)p = w; }
struct EpiStoreBf16 { bf16* O; int ldc;
    DI void operator()(const Unit& u, int r, int c, f32x4 lo, f32x4 hi) const { bf16* p = O + (size_t)(u.m0 + r) * ldc + u.n0 + c; st_bf16x4(p, lo); st_bf16x4(p + 128, hi); } };
struct EpiResid { const float* x; float* t; const float* gate;
    DI void operator()(const Unit& u, int r, int c, f32x4 lo, f32x4 hi) const { const int row = u.m0 + r, b = row >> 12; const int col = u.n0 + c;
        const size_t o = (size_t)row * D + col; const float* g = gate + (size_t)b * MODW + col;
        *(f32x4*)(t + o) = *(const f32x4*)(x + o) * ALPHA + *(const f32x4*)g * lo;
        *(f32x4*)(t + o + 128) = *(const f32x4*)(x + o + 128) * ALPHA + *(const f32x4*)(g + 128) * hi; } };
struct EpiSwiglu { bf16* H;
    DI void operator()(const Unit& u, int r, int c, f32x4 lo, f32x4 hi) const { f32x4 h;
        h.x = silu_f(lo.x) * hi.x; h.y = silu_f(lo.y) * hi.y; h.z = silu_f(lo.z) * hi.z; h.w = silu_f(lo.w) * hi.w;
        st_bf16x4(H + (size_t)(u.m0 + r) * DE + (u.n0 >> 1) + c, h); } };
struct EpiF1 { bf16* BT2;
    DI void operator()(const Unit& u, int r, int c, f32x4 lo, f32x4 hi) const { const int b = u.aux >> 2, g = u.aux & 3, m = u.m0 + r, cs = m >> 9, cp = m & 511;
        bf16* p = BT2 + ((size_t)b * D + g * 512 + cp) * 8192 + cs * 4096 + u.n0 + c; st_bf16x4(p, lo); st_bf16x4(p + 128, hi); } };
struct EpiF2 { bf16* REZ;
    DI void operator()(const Unit& u, int r, int c, f32x4 lo, f32x4 hi) const { bf16* p = REZ + ((size_t)u.aux * SEQ + u.m0 + r) * D + u.n0 + c; st_bf16x4(p, lo); st_bf16x4(p + 128, hi); } };

DI void p0_mods(const float* c, const float* cctx, const float* ada_w, const float* ada_b, float* mods, LAS float* sl, int tid) {
    LAS float* red = sl + 5 * D;
    for (int i = tid; i < 5 * D; i += 512) { const float v = i < 4 * D ? c[i] : cctx[i - 4 * D]; sl[i] = silu_f(v); }
    __syncthreads();
    const int cq = tid & 127, ks = tid >> 7;
    for (int unit = blockIdx.x; unit < 192; unit += gridDim.x) {
        const int l = unit / 96, n = (unit % 96) * 128 + cq;
        const float* W = ada_w + (size_t)l * D * MODW + n;
        float a0 = 0.f, a1 = 0.f, a2 = 0.f, a3 = 0.f, a4 = 0.f;
#pragma unroll 8
        for (int k = ks * 512; k < ks * 512 + 512; ++k) { const float w = W[(size_t)k * MODW]; a0 += sl[k] * w; a1 += sl[D + k] * w; a2 += sl[2 * D + k] * w; a3 += sl[3 * D + k] * w; a4 += sl[4 * D + k] * w; }
        red[(ks * 5 + 0) * 128 + cq] = a0; red[(ks * 5 + 1) * 128 + cq] = a1; red[(ks * 5 + 2) * 128 + cq] = a2; red[(ks * 5 + 3) * 128 + cq] = a3; red[(ks * 5 + 4) * 128 + cq] = a4;
        __syncthreads();
        for (int i = tid; i < 640; i += 512) { const int r = i >> 7, q = i & 127, n2 = (unit % 96) * 128 + q;
            const float s = (red[(0 * 5 + r) * 128 + q] + red[(1 * 5 + r) * 128 + q]) + (red[(2 * 5 + r) * 128 + q] + red[(3 * 5 + r) * 128 + q]);
            mods[((size_t)l * 5 + r) * MODW + n2] = s + ada_b[(size_t)l * MODW + n2]; }
        __syncthreads();
    }
}
DI void tr_item(const float* W, int N, int Kd, int k0, int n0, bf16* WT, int drow0, LAS float* scr, int lane) {
#pragma unroll 8
    for (int i = 0; i < 32; ++i) { const int kk = 2 * i + (lane >> 5); scr[kk * 33 + (lane & 31)] = W[(size_t)(k0 + kk) * N + n0 + (lane & 31)]; }
    asm volatile("s_waitcnt lgkmcnt(0)" ::: "memory");
    const int c = lane & 7;
#pragma unroll
    for (int j = 0; j < 4; ++j) { const int n = (lane >> 3) + 8 * j; const LAS float* s = scr + (8 * c) * 33 + n;
        u32x4 o; o.x = pk2(s[0 * 33], s[1 * 33]); o.y = pk2(s[2 * 33], s[3 * 33]); o.z = pk2(s[4 * 33], s[5 * 33]); o.w = pk2(s[6 * 33], s[7 * 33]);
        *(u32x4*)(WT + (size_t)(drow0 + n) * Kd + k0 + 8 * c) = o; }
    asm volatile("s_waitcnt lgkmcnt(0)" ::: "memory");
}
DI void p0_weights(const float* w_in, const float* w_out, const float* w_f, const float* w_gate, const float* w_up, const float* w_down,
                   bf16* WIN, bf16* WO, bf16* WF, bf16* WGU, bf16* WD, LAS float* scr, int gw, int NGW, int lane) {
    constexpr int I_IN = 32 * 192, I_SQ = 32 * 64, I_E = 65536;
    constexpr int NIT = I_IN + 2 * I_SQ + 3 * I_E;
    for (int it = gw; it < NIT; it += NGW) {
        int r = it;
        if (r < I_IN) { const int kb = r / 192, nb = r % 192; tr_item(w_in, NMIX, D, kb * 64, nb * 32, WIN, nb * 32, scr, lane); continue; } r -= I_IN;
        if (r < I_SQ) { const int kb = r / 64, nb = r % 64; tr_item(w_out, D, D, kb * 64, nb * 32, WO, nb * 32, scr, lane); continue; } r -= I_SQ;
        if (r < I_SQ) { const int kb = r / 64, nb = r % 64; tr_item(w_f, D, D, kb * 64, nb * 32, WF, nb * 32, scr, lane); continue; } r -= I_SQ;
        if (r < 2 * I_E) { const int up = r >= I_E; if (up) r -= I_E; const int mat = r >> 10, rr = r & 1023, kb = rr >> 5, nb = rr & 31, n0 = nb * 32;
            tr_item((up ? w_up : w_gate) + (size_t)mat * D * DE, DE, D, kb * 64, n0, WGU + (size_t)mat * D * D, (n0 >> 7) * 256 + (n0 & 127) + (up ? 128 : 0), scr, lane); continue; } r -= 2 * I_E;
        { const int mat = r >> 10, rr = r & 1023, kb = rr >> 6, nb = rr & 63; tr_item(w_down + (size_t)mat * DE * D, D, DE, kb * 64, nb * 32, WD + (size_t)mat * D * DE, nb * 32, scr, lane); }
    }
}
DI void p0_dft(bf16* ACS, bf16* CS, int gtid, int GT) {
    for (int i = gtid; i < 4096 * 1024; i += GT) { const int j = i >> 10, k8 = (i & 1023) * 8; unsigned w[4];
#pragma unroll
        for (int e = 0; e < 4; ++e) { float v[2];
#pragma unroll
            for (int q = 0; q < 2; ++q) { const int kk = k8 + 2 * e + q; const int m = (j * (kk & 4095)) & 4095; const float ang = (float)m * (1.f / 2048.f); v[q] = (kk < 4096 ? cospif(ang) : -sinpif(ang)) * (1.f / 64.f); }
            w[e] = pk2(v[0], v[1]); }
        *(u32x4*)(ACS + (size_t)j * 8192 + k8) = (u32x4){w[0], w[1], w[2], w[3]}; }
    for (int i = gtid; i < 1024 * 64; i += GT) { const int rr = i >> 6, c8 = (i & 63) * 8, cs = rr >> 9, cp = rr & 511; unsigned w[4];
#pragma unroll
        for (int e = 0; e < 4; ++e) { float v[2];
#pragma unroll
            for (int q = 0; q < 2; ++q) { const int cc = c8 + 2 * e + q; const int m = (cc * cp) & 511; const float ang = (float)m * (1.f / 256.f); v[q] = (cs ? sinpif(ang) : cospif(ang)) * 0.04419417382415922f; }
            w[e] = pk2(v[0], v[1]); }
        *(u32x4*)(CS + (size_t)rr * 512 + c8) = (u32x4){w[0], w[1], w[2], w[3]}; }
}
DI void ln_mod_phase(const float* x, const float* ctx, const float* mods_l, int sh_chunk, bf16* U, int nrows, int gw, int NGW, int lane) {
    for (int row = gw; row < nrows; row += NGW) {
        const float* src = row < T ? x + (size_t)row * D : ctx + (size_t)(row - T) * D; const int rb = row < T ? (row >> 12) : 4;
        Row r; row_load(r, src, lane); row_ln(r);
        const float* mr = mods_l + (size_t)rb * MODW + sh_chunk * D;
        row_modulate(r, mr, mr + D, lane);
        row_store_bf16(r, U + (size_t)row * D, lane);
    }
}
DI void attn_simple(const bf16* P, const float* rpb, bf16* MIX, LAS float* scr, int gw, int NGW, int lane) {
    const float scale = 0.08838834764831845f;
    for (int item = gw; item < T * NH; item += NGW) {
        const int tok = item >> 3, h = item & 7, b = tok >> 12, l = tok & 4095, r = l >> 6, qc = l & 63;
        const int rs = min(max(r - 4, 0), 56), cs = min(max(qc - 8, 0), 48);
        { const unsigned w = *((const unsigned*)(P + (size_t)tok * NMIX + h * HD) + lane); scr[2 * lane] = bflo(w); scr[2 * lane + 1] = bfhi(w); }
        asm volatile("s_waitcnt lgkmcnt(0)" ::: "memory");
        float s[6];
#pragma unroll
        for (int i = 0; i < 6; ++i) {
            const int kk = lane + 64 * i; size_t krow; float bias = 0.f;
            if (kk < 128) { const int a = kk >> 4, j = kk & 15; krow = (size_t)b * SEQ + 64 * (rs + a) + cs + j; bias = rpb[(h * 15 + (rs + a - r + 7)) * 31 + (cs + j - qc + 15)]; }
            else krow = (size_t)T + b * CTXL + (kk - 128);
            const u32x4* kp = (const u32x4*)(P + krow * NMIX + D / 2 + h * HD);
            float acc = 0.f;
#pragma unroll 4
            for (int d8 = 0; d8 < 16; ++d8) { const u32x4 kv = kp[d8]; const LAS f32x4* qv = (const LAS f32x4*)scr + 2 * d8; const f32x4 q0 = qv[0], q1 = qv[1];
                acc += bflo(kv.x) * q0.x + bfhi(kv.x) * q0.y + bflo(kv.y) * q0.z + bfhi(kv.y) * q0.w + bflo(kv.z) * q1.x + bfhi(kv.z) * q1.y + bflo(kv.w) * q1.z + bfhi(kv.w) * q1.w; }
            s[i] = acc * scale + bias;
        }
        float m = s[0];
#pragma unroll
        for (int i = 1; i < 6; ++i) m = fmaxf(m, s[i]);
        m = wave_max(m); float sum = 0.f;
#pragma unroll
        for (int i = 0; i < 6; ++i) { s[i] = expf(s[i] - m); sum += s[i]; scr[128 + lane + 64 * i] = s[i]; }
        sum = wave_sum(sum);
        asm volatile("s_waitcnt lgkmcnt(0)" ::: "memory");
        float o0 = 0.f, o1 = 0.f;
        for (int kk = 0; kk < 384; ++kk) {
            size_t vrow; if (kk < 128) vrow = (size_t)b * SEQ + 64 * (rs + (kk >> 4)) + cs + (kk & 15); else vrow = (size_t)T + b * CTXL + (kk - 128);
            const unsigned w = *((const unsigned*)(P + vrow * NMIX + D + h * HD) + lane); const float p = scr[128 + kk];
            o0 += p * bflo(w); o1 += p * bfhi(w);
        }
        const float inv = 1.f / sum;
        *((unsigned*)(MIX + (size_t)tok * D + h * HD) + lane) = pk2(o0 * inv, o1 * inv);
        asm volatile("s_waitcnt lgkmcnt(0)" ::: "memory");
    }
}
DI void conv_phase(const bf16* P, const float* cw, bf16* MIX, int gtid, int GT) {
    for (int i = gtid; i < T * 128; i += GT) {
        const int tok = i >> 7, c8 = (i & 127) * 8, l = tok & 4095;
        const bf16* base = P + (size_t)tok * NMIX + 3072 + c8;
        const u32x4 gb = *(const u32x4*)base;
        float z[3][8];
#pragma unroll
        for (int j = 0; j < 3; ++j) { const int ll = l + j - 1; const bool ok = ll >= 0 && ll < SEQ;
            u32x4 gc = (u32x4){0u, 0u, 0u, 0u}, xi = gc;
            if (ok) { const bf16* pj = base + (ptrdiff_t)(j - 1) * NMIX; gc = *(const u32x4*)(pj + 1024); xi = *(const u32x4*)(pj + 2048); }
            z[j][0] = bflo(gc.x) * bflo(xi.x); z[j][1] = bfhi(gc.x) * bfhi(xi.x); z[j][2] = bflo(gc.y) * bflo(xi.y); z[j][3] = bfhi(gc.y) * bfhi(xi.y);
            z[j][4] = bflo(gc.z) * bflo(xi.z); z[j][5] = bfhi(gc.z) * bfhi(xi.z); z[j][6] = bflo(gc.w) * bflo(xi.w); z[j][7] = bfhi(gc.w) * bfhi(xi.w); }
        float gbf[8] = {bflo(gb.x), bfhi(gb.x), bflo(gb.y), bfhi(gb.y), bflo(gb.z), bfhi(gb.z), bflo(gb.w), bfhi(gb.w)};
        float o[8];
#pragma unroll
        for (int e = 0; e < 8; ++e) o[e] = gbf[e] * (cw[c8 + e] * z[0][e] + cw[1024 + c8 + e] * z[1][e] + cw[2048 + c8 + e] * z[2][e]);
        *(u32x4*)(MIX + (size_t)tok * D + 1024 + c8) = (u32x4){pk2(o[0], o[1]), pk2(o[2], o[3]), pk2(o[4], o[5]), pk2(o[6], o[7])};
    }
}
DI void ln_router_phase(const float* TB, const float* lng, const float* lnb, const float* mods_l, const float* rw, const float* rbias,
                        float* X1, bf16* U, unsigned* counts, int* table, unsigned* tokinfo, int gw, int NGW, int lane) {
    for (int row = gw; row < T; row += NGW) {
        Row r; row_load(r, TB + (size_t)row * D, lane); row_ln(r); row_affine(r, lng, lnb, lane);
        row_store(r, X1 + (size_t)row * D, lane);
        row_ln(r);
        const float* mr = mods_l + (size_t)(row >> 12) * MODW + 3 * D;
        row_modulate(r, mr, mr + D, lane);
        row_store_bf16(r, U + (size_t)row * D, lane);
        float lg[32];
#pragma unroll
        for (int e = 0; e < 32; ++e) lg[e] = 0.f;
#pragma unroll
        for (int j = 0; j < 8; ++j)
#pragma unroll
            for (int q = 0; q < 4; ++q) { const float uv = r.v[j][q]; const f32x4* wr = (const f32x4*)(rw + (size_t)(4 * lane + 256 * j + q) * NE);
#pragma unroll
                for (int e4 = 0; e4 < 8; ++e4) { const f32x4 w = wr[e4]; lg[4 * e4] += uv * w.x; lg[4 * e4 + 1] += uv * w.y; lg[4 * e4 + 2] += uv * w.z; lg[4 * e4 + 3] += uv * w.w; }
                asm volatile("" ::: "memory"); }
        float aff[32], bia[32];
#pragma unroll
        for (int e = 0; e < 32; ++e) { const float lgt = wave_sum(lg[e]); aff[e] = 1.f / (1.f + expf(-lgt)); bia[e] = aff[e] + rbias[e]; }
        float best = -1e30f; int grp = 0; float gv0 = 0.f, gv1 = 0.f, gv2 = 0.f, gv3 = 0.f, ga0 = 0.f, ga1 = 0.f, ga2 = 0.f, ga3 = 0.f;
#pragma unroll
        for (int g = 0; g < 8; ++g) { const float a = bia[4 * g], b = bia[4 * g + 1], c = bia[4 * g + 2], d = bia[4 * g + 3];
            const float h1 = fmaxf(a, b), l1 = fminf(a, b), h2 = fmaxf(c, d), l2 = fminf(c, d);
            const float sc = fmaxf(h1, h2) + fmaxf(fminf(h1, h2), fmaxf(l1, l2));
            if (sc > best) { best = sc; grp = g; gv0 = a; gv1 = b; gv2 = c; gv3 = d; ga0 = aff[4 * g]; ga1 = aff[4 * g + 1]; ga2 = aff[4 * g + 2]; ga3 = aff[4 * g + 3]; } }
        int i1 = 0; float v1 = gv0; if (gv1 > v1) { v1 = gv1; i1 = 1; } if (gv2 > v1) { v1 = gv2; i1 = 2; } if (gv3 > v1) { v1 = gv3; i1 = 3; }
        int i2 = -1; float v2 = -1e30f;
        if (i1 != 0 && gv0 > v2) { v2 = gv0; i2 = 0; } if (i1 != 1 && gv1 > v2) { v2 = gv1; i2 = 1; } if (i1 != 2 && gv2 > v2) { v2 = gv2; i2 = 2; } if (i1 != 3 && gv3 > v2) { v2 = gv3; i2 = 3; }
        const float a1 = i1 == 0 ? ga0 : i1 == 1 ? ga1 : i1 == 2 ? ga2 : ga3, a2 = i2 == 0 ? ga0 : i2 == 1 ? ga1 : i2 == 2 ? ga2 : ga3;
        const float w1 = a1 / (a1 + a2), w2 = a2 / (a1 + a2);
        const int e1 = grp * 4 + i1, e2 = grp * 4 + i2;
        if (lane == 0) {
            const unsigned p1 = __hip_atomic_fetch_add(counts + e1, 1u, __ATOMIC_RELAXED, __HIP_MEMORY_SCOPE_AGENT);
            const unsigned p2 = __hip_atomic_fetch_add(counts + e2, 1u, __ATOMIC_RELAXED, __HIP_MEMORY_SCOPE_AGENT);
            table[(size_t)e1 * T + p1] = row; table[(size_t)e2 * T + p2] = row;
            u32x4 ta; ta.x = (unsigned)e1; ta.y = (unsigned)e2; ta.z = p1; ta.w = p2; u32x4 tb2; tb2.x = __float_as_uint(w1); tb2.y = __float_as_uint(w2); tb2.z = 0u; tb2.w = 0u;
            *(u32x4*)(tokinfo + (size_t)row * 8) = ta; *(u32x4*)(tokinfo + (size_t)row * 8 + 4) = tb2;
        }
    }
}
DI void moe_prefix(const unsigned* counts, LAS int* cnt, LAS int* tb, int tid) {
    __syncthreads();
    if (tid < 32) cnt[tid] = (int)__hip_atomic_load(counts + tid, __ATOMIC_RELAXED, __HIP_MEMORY_SCOPE_AGENT);
    __syncthreads();
    if (tid == 0) { int a = 0; for (int e = 0; e < 32; ++e) { tb[e] = a; a += (cnt[e] + 255) >> 8; } tb[32] = a; }
    __syncthreads();
}
DI void combine_phase(const float* X1, const bf16* Y, const unsigned* tokinfo, const LAS int* tb, const float* mods_l, const float* lng, const float* lnb,
                      float* XO, const float* mods_next, bf16* U, int gw, int NGW, int lane) {
    for (int row = gw; row < T; row += NGW) {
        const u32x4 ta = *(const u32x4*)(tokinfo + (size_t)row * 8); const u32x4 tw = *(const u32x4*)(tokinfo + (size_t)row * 8 + 4);
        const size_t r0 = (size_t)tb[ta.x] * 256 + ta.z, r1 = (size_t)tb[ta.y] * 256 + ta.w; const float w0 = __uint_as_float(tw.x), w1 = __uint_as_float(tw.y);
        Row r; row_load(r, X1 + (size_t)row * D, lane);
        const u32x2* y0 = (const u32x2*)(Y + r0 * D) + lane; const u32x2* y1 = (const u32x2*)(Y + r1 * D) + lane;
        const f32x4* g2 = (const f32x4*)(mods_l + (size_t)(row >> 12) * MODW + 5 * D) + lane;
#pragma unroll
        for (int j = 0; j < 8; ++j) { const u32x2 a = y0[64 * j], b = y1[64 * j]; f32x4 f;
            f.x = w0 * bflo(a.x) + w1 * bflo(b.x); f.y = w0 * bfhi(a.x) + w1 * bfhi(b.x); f.z = w0 * bflo(a.y) + w1 * bflo(b.y); f.w = w0 * bfhi(a.y) + w1 * bfhi(b.y);
            r.v[j] = r.v[j] * ALPHA + g2[64 * j] * f; }
        row_ln(r); row_affine(r, lng, lnb, lane);
        row_store(r, XO + (size_t)row * D, lane);
        if (U) { row_ln(r); const float* mr = mods_next + (size_t)(row >> 12) * MODW; row_modulate(r, mr, mr + D, lane); row_store_bf16(r, U + (size_t)row * D, lane); }
    }
}

struct Args { const float* in[18]; float* out; unsigned char* ws; int ph_lo, ph_hi; };
__global__ void __launch_bounds__(512, 2) fwd(Args args) {
    extern __shared__ __attribute__((aligned(16))) unsigned char lds_raw[];
    LAS unsigned char* lds = (LAS unsigned char*)lds_raw;
    const int tid = threadIdx.x, lane = tid & 63, wave = __builtin_amdgcn_readfirstlane(tid >> 6);
    const int gw = blockIdx.x * 8 + wave, NGW = gridDim.x * 8, gtid = blockIdx.x * 512 + tid, GT = gridDim.x * 512;
    volatile LAS unsigned* LCTL = (volatile LAS unsigned*)(lds + LDSCTL_OFF);
    LAS int* l_cnt = (LAS int*)(lds + LDSCTL_OFF) + 16; LAS int* l_tb = (LAS int*)(lds + LDSCTL_OFF) + 48;
    for (int u = tid; u < (LDS_BYTES - LDSCTL_OFF) / 4; u += 512) ((LAS unsigned*)(lds + LDSCTL_OFF))[u] = 0u;
    __syncthreads();
    unsigned char* ws = args.ws;
    unsigned* ctl = (unsigned*)(ws + WS_CTL);
#define XIN ((const float*)args.in[0])
#define c_in args.in[1]
#define ctx args.in[2]
#define c_ctx args.in[3]
#define ada_w args.in[4]
#define ada_b args.in[5]
#define w_mix_in args.in[6]
#define rpb args.in[7]
#define conv_w args.in[8]
#define w_mix_out args.in[9]
#define w_fourier args.in[10]
#define router_w args.in[11]
#define router_b args.in[12]
#define w_gate args.in[13]
#define w_up args.in[14]
#define w_down args.in[15]
#define ln_g args.in[16]
#define ln_b args.in[17]
#define mods ((float*)(ws + WS_MODS))
#define tokinfo ((unsigned*)(ws + WS_TOKINFO))
#define table ((int*)(ws + WS_TABLE))
#define WIN ((bf16*)(ws + WS_WIN))
#define WO ((bf16*)(ws + WS_WO))
#define WF ((bf16*)(ws + WS_WF))
#define CSM ((bf16*)(ws + WS_CS))
#define ACS ((bf16*)(ws + WS_ACS))
#define U ((bf16*)(ws + WS_U))
#define P ((bf16*)(ws + WS_P))
#define YB ((bf16*)(ws + WS_P))
#define BT2 ((bf16*)(ws + WS_P))
#define MIX ((bf16*)(ws + WS_MIX))
#define REZ ((bf16*)(ws + WS_MIX))
#define HB ((bf16*)(ws + WS_H))
#define WGU ((bf16*)(ws + WS_WGU))
#define WD ((bf16*)(ws + WS_WD))
#define TB ((float*)(ws + WS_TB))
#define X1 ((float*)(ws + WS_X1))
#define X2 ((float*)(ws + WS_X2))
    XcdBarrier bar; bar.bar = ctl + CW_BAR; bar.x = 0; bar.st = nullptr;
    if (N_LAUNCHES != NPHASE) bar = xcd_barrier_post(ctl + CW_BAR, LCTL);
    const int lo = args.ph_lo, hi = args.ph_hi;
#ifndef PH_MASK
#define PH_MASK 0xffff
#endif
#define IN(k) ((((PH_MASK) >> (k)) & 1) && lo <= (k) && (k) < hi)
#define SEAM(k) do { if (IN(k) && IN((k) + 1)) xcd_barrier(bar); } while (0)

    if (IN(0)) {
        p0_mods(c_in, c_ctx, ada_w, ada_b, mods, (LAS float*)lds, tid);
        p0_weights(w_mix_in, w_mix_out, w_fourier, w_gate, w_up, w_down, WIN, WO, WF, WGU, WD, (LAS float*)(lds + wave * 16384), gw, NGW, lane);
        p0_dft(ACS, CSM, gtid, GT);
    }
    SEAM(0);
    if (IN(1)) ln_mod_phase(XIN, ctx, mods, 0, U, TALL, gw, NGW, lane);
    SEAM(1);
    if (IN(2)) { SchedInProj S{U, WIN}; EpiStoreBf16 E{P, NMIX}; gemm_pg8<false>(lds, S, E, D, D, D); }
    SEAM(2);
    if (IN(3)) { attn_simple(P, rpb, MIX, (LAS float*)(lds + wave * 4096), gw, NGW, lane); conv_phase(P, conv_w, MIX, gtid, GT); }
    SEAM(3);
    if (IN(4)) { SchedDense S{MIX, WO, 64, 8, (size_t)256 * D, (size_t)256 * D}; EpiResid E{XIN, TB, mods + 2 * D}; gemm_pg8<false>(lds, S, E, D, D, D); }
    SEAM(4);
    if (IN(5)) ln_router_phase(TB, ln_g, ln_b, mods, router_w, router_b, X1, U, ctl + CW_CNT, table, tokinfo, gw, NGW, lane);
    SEAM(5);
    if (IN(6)) { moe_prefix(ctl + CW_CNT, l_cnt, l_tb, tid); SchedMoe S{l_cnt, l_tb, U, WGU, table, 1, 0, (size_t)D * D, (size_t)256 * D}; EpiSwiglu E{HB}; gemm_pg8<true>(lds, S, E, D, D, D); }
    SEAM(6);
    if (IN(7)) { moe_prefix(ctl + CW_CNT, l_cnt, l_tb, tid); SchedMoe S{l_cnt, l_tb, HB, WD, table, 0, (size_t)256 * DE, (size_t)D * DE, (size_t)256 * DE}; EpiStoreBf16 E{YB, D}; gemm_pg8<false>(lds, S, E, DE, DE, DE); }
    SEAM(7);
    if (IN(8)) { moe_prefix(ctl + CW_CNT, l_cnt, l_tb, tid); combine_phase(X1, YB, tokinfo, l_tb, mods, ln_g + D, ln_b + D, X2, mods + 5 * MODW, U, gw, NGW, lane); }
    SEAM(8);
    if (IN(9)) { SchedF1 S{CSM, U}; EpiF1 E{BT2}; gemm_pg8<false>(lds, S, E, 512, D, 512); }
    SEAM(9);
    if (IN(10)) { SchedF2 S{ACS, BT2}; EpiF2 E{REZ}; gemm_pg8<false>(lds, S, E, 8192, 8192, 8192); }
    SEAM(10);
    if (IN(11)) { SchedDense S{REZ, WF, 64, 8, (size_t)256 * D, (size_t)256 * D}; EpiResid E{X2, TB, mods + 5 * MODW + 2 * D}; gemm_pg8<false>(lds, S, E, D, D, D); }
    SEAM(11);
    if (IN(12)) ln_router_phase(TB, ln_g + 2 * D, ln_b + 2 * D, mods + 5 * MODW, router_w, router_b, X1, U, ctl + CW_CNT + 32, table + (size_t)NE * T, tokinfo + (size_t)T * 8, gw, NGW, lane);
    SEAM(12);
    if (IN(13)) { moe_prefix(ctl + CW_CNT + 32, l_cnt, l_tb, tid); SchedMoe S{l_cnt, l_tb, U, WGU + (size_t)NE * D * D, table + (size_t)NE * T, 1, 0, (size_t)D * D, (size_t)256 * D}; EpiSwiglu E{HB}; gemm_pg8<true>(lds, S, E, D, D, D); }
    SEAM(13);
    if (IN(14)) { moe_prefix(ctl + CW_CNT + 32, l_cnt, l_tb, tid); SchedMoe S{l_cnt, l_tb, HB, WD + (size_t)NE * D * DE, table, 0, (size_t)256 * DE, (size_t)D * DE, (size_t)256 * DE}; EpiStoreBf16 E{YB, D}; gemm_pg8<false>(lds, S, E, DE, DE, DE); }
    SEAM(14);
    if (IN(15)) { moe_prefix(ctl + CW_CNT + 32, l_cnt, l_tb, tid); combine_phase(X1, YB, tokinfo + (size_t)T * 8, l_tb, mods + 5 * MODW, ln_g + 3 * D, ln_b + 3 * D, args.out, nullptr, nullptr, gw, NGW, lane); }
#undef IN
#undef SEAM
}

extern "C" void kernel_launch(void* const* d_in, const int* in_sizes, int n_in, void* d_out, int out_size, void* d_ws, size_t ws_size, hipStream_t stream) {
    static int grid = 0;
    if (grid == 0) {
        if (n_in != 18 || out_size != T * D || ws_size < WS_END) { fprintf(stderr, "kernel_launch: unexpected shapes (n_in %d, out %d, ws %zu)\n", n_in, out_size, ws_size); grid = -1; return; }
        int dev = 0, cus = 0, per_cu = 0;
        if (hipGetDevice(&dev) != hipSuccess || hipDeviceGetAttribute(&cus, hipDeviceAttributeMultiprocessorCount, dev) != hipSuccess) { grid = -1; return; }
        if (hipFuncSetAttribute((const void*)fwd, hipFuncAttributeMaxDynamicSharedMemorySize, LDS_BYTES) != hipSuccess) { fprintf(stderr, "kernel_launch: hipFuncSetAttribute failed\n"); grid = -1; return; }
        if (hipOccupancyMaxActiveBlocksPerMultiprocessor(&per_cu, (const void*)fwd, 512, LDS_BYTES) != hipSuccess || per_cu < 1) fprintf(stderr, "kernel_launch: occupancy query says %d\n", per_cu);
        (void)hipGetLastError();
        grid = cus;
    }
    if (grid < 0) return;
    (void)hipMemsetAsync((char*)d_ws + WS_CTL, 0, CTL_ZERO_BYTES, stream);
    Args a{};
    for (int i = 0; i < 18; ++i) a.in[i] = (const float*)d_in[i];
    a.out = (float*)d_out; a.ws = (unsigned char*)d_ws;
    if (N_LAUNCHES == 1) { a.ph_lo = 0; a.ph_hi = NPHASE; hipLaunchKernelGGL(fwd, dim3(grid), dim3(512), LDS_BYTES, stream, a); }
    else for (int p = 0; p < NPHASE; ++p) { a.ph_lo = p; a.ph_hi = p + 1; hipLaunchKernelGGL(fwd, dim3(grid), dim3(512), LDS_BYTES, stream, a); }
}
```

```cpp
#include <hip/hip_runtime.h>
#include <cstdio>
#include <cstdint>

#define DI __device__ __forceinline__
#define LAS __attribute__((address_space(3)))
typedef unsigned short bf16;
typedef float f32x4 __attribute__((ext_vector_type(4)));
typedef short bf16x8 __attribute__((ext_vector_type(8)));
typedef unsigned u32x4 __attribute__((ext_vector_type(4)));
typedef unsigned u32x2 __attribute__((ext_vector_type(2)));

constexpr int D = 2048, NB = 4, SEQ = 4096, T = NB * SEQ, CTXL = 256, TC = NB * CTXL, TALL = T + TC;
constexpr int NMIX = 6144, NE = 32, DE = 1024, NH = 8, HD = 128, MODW = 6 * D;
constexpr float ALPHA = 1.41421356237309515f;
constexpr float LN_EPS = 1e-6f;
constexpr int NPHASE = 16;
#ifndef MK_N_LAUNCHES
#define MK_N_LAUNCHES 1
#endif
constexpr int N_LAUNCHES = MK_N_LAUNCHES;

constexpr size_t MiB = 1u << 20;
constexpr size_t WS_CTL = 0, CTL_ZERO_BYTES = 64 * 1024;
constexpr size_t WS_MODS = 1 * MiB;
constexpr size_t WS_TOKINFO = 2 * MiB;
constexpr size_t WS_TABLE = 4 * MiB;
constexpr size_t WS_WIN = 8 * MiB, WS_WO = 32 * MiB, WS_WF = 40 * MiB, WS_CS = 48 * MiB, WS_ACS = 64 * MiB;
constexpr size_t WS_U = 128 * MiB;
constexpr size_t WS_P = 196 * MiB;
constexpr size_t WS_MIX = 400 * MiB;
constexpr size_t WS_TB = 464 * MiB, WS_X1 = 592 * MiB, WS_X2 = 720 * MiB;
constexpr size_t WS_H = 848 * MiB;
constexpr size_t WS_WGU = 928 * MiB;
constexpr size_t WS_WD = 1440 * MiB;
constexpr size_t WS_END = 1696 * MiB;
constexpr int CW_CNT = 64;
constexpr int CW_BAR = 1024;

constexpr int LDS_SCR = 131072;
constexpr int LDSCTL_OFF = LDS_SCR;
constexpr int LDS_BYTES = 147456;

DI float wave_sum(float v) {
#pragma unroll
    for (int o = 1; o < 64; o <<= 1) v += __shfl_xor(v, o);
    return v;
}
DI float wave_max(float v) {
#pragma unroll
    for (int o = 1; o < 64; o <<= 1) v = fmaxf(v, __shfl_xor(v, o));
    return v;
}
DI unsigned f2bf(float f) { unsigned u = __float_as_uint(f); return (u + 0x7fffu + ((u >> 16) & 1u)) >> 16; }
DI unsigned pk2(float lo, float hi) { return f2bf(lo) | (f2bf(hi) << 16); }
DI float bflo(unsigned w) { return __uint_as_float(w << 16); }
DI float bfhi(unsigned w) { return __uint_as_float(w & 0xffff0000u); }
DI float silu_f(float v) { return v / (1.f + expf(-v)); }

#define XB_TMO      128
#define XB_XCNT(j)  (256  + 64 * (j))
#define XB_XSUB(j)  (1280 + 64 * (j))
#define XB_XGEN(j)  (2304 + 64 * (j))
#define XB_TOP      3328
#define XB_TOPGEN   3392
#define XCD_BAR_WORDS 3456
#define XB_SPIN_CAP (1u << 18)
__device__ __forceinline__ unsigned xb_ld(unsigned* p)              { return __hip_atomic_load(p, __ATOMIC_RELAXED, __HIP_MEMORY_SCOPE_AGENT); }
__device__ __forceinline__ unsigned xb_add(unsigned* p, unsigned v) { return __hip_atomic_fetch_add(p, v, __ATOMIC_RELAXED, __HIP_MEMORY_SCOPE_AGENT); }
__device__ __forceinline__ unsigned xb_xcc_id() { return (unsigned)__builtin_amdgcn_s_getreg((3 << 11) | 20) & 0xFu; }
#define XB_SPIN(cond, bar) do { unsigned _sp = 0; while (cond) { __builtin_amdgcn_s_sleep(1); \
    if ((++_sp & 255u) == 0u) { if (xb_ld(&(bar)[XB_TMO])) break; if (_sp > XB_SPIN_CAP) { atomicAdd(&(bar)[XB_TMO], 1u); break; } } } } while (0)
struct XcdBarrier { unsigned* bar; unsigned x; volatile LAS unsigned* st; };
__device__ __forceinline__ XcdBarrier xcd_barrier_post(unsigned* bar, volatile LAS unsigned* st) {
    XcdBarrier b; b.bar = bar; b.x = xb_xcc_id(); b.st = st;
    if (threadIdx.x == 0) (void)xb_add(&bar[XB_XCNT(b.x)], 1u);
    return b;
}
__device__ __forceinline__ void xcd_barrier_complete(unsigned* bar, unsigned x, unsigned& nloc, unsigned& nx) {
    const unsigned G = gridDim.x * gridDim.y * gridDim.z;
    unsigned sum, cnt, mine, sp = 0u;
    for (;;) {
        sum = 0u; cnt = 0u; mine = 0u;
#pragma unroll
        for (unsigned j = 0; j < 16; ++j) { const unsigned c = xb_ld(&bar[XB_XCNT(j)]); sum += c; cnt += (c > 0u) ? 1u : 0u; mine = (j == x) ? c : mine; }
        if (sum == G) break;
        __builtin_amdgcn_s_sleep(1);
        if ((++sp & 255u) == 0u) { if (xb_ld(&bar[XB_TMO])) break; if (sp > XB_SPIN_CAP) { atomicAdd(&bar[XB_TMO], 1u); break; } }
    }
    nloc = mine > 0u ? mine : 1u; nx = cnt > 0u ? cnt : 1u;
}
__device__ __forceinline__ void xcd_barrier(const XcdBarrier& b) {
    asm volatile("s_waitcnt vmcnt(0)" ::: "memory");
    __syncthreads();
    if (threadIdx.x == 0) {
        unsigned* bar = b.bar;
        __builtin_amdgcn_s_waitcnt(0);
        unsigned nloc = b.st[0], nx = b.st[1];
        if (nloc == 0u) { xcd_barrier_complete(bar, b.x, nloc, nx); b.st[0] = nloc; b.st[1] = nx; }
        const unsigned old = xb_add(&bar[XB_XSUB(b.x)], 1u);
        const unsigned gen = old / nloc;
        if (old + 1u == (gen + 1u) * nloc) {
            __builtin_amdgcn_fence(__ATOMIC_RELEASE, "agent");
            asm volatile("s_waitcnt vmcnt(0)" ::: "memory");
            const unsigned og = xb_add(&bar[XB_TOP], 1u);
            const unsigned tg = og / nx;
            if (og + 1u == (tg + 1u) * nx) xb_add(&bar[XB_TOPGEN], 1u);
            else XB_SPIN(xb_ld(&bar[XB_TOPGEN]) == tg, bar);
            __builtin_amdgcn_fence(__ATOMIC_ACQUIRE, "agent");
            xb_add(&bar[XB_XGEN(b.x)], 1u);
            asm volatile("s_waitcnt vmcnt(0)" ::: "memory");
        } else {
            XB_SPIN(xb_ld(&bar[XB_XGEN(b.x)]) == gen, bar);
            __builtin_amdgcn_fence(__ATOMIC_ACQUIRE, "agent");
            asm volatile("s_waitcnt vmcnt(0)" ::: "memory");
        }
    }
    __syncthreads();
}

struct Row { f32x4 v[8]; };
DI void row_load(Row& r, const float* p, int lane) { const f32x4* q = (const f32x4*)p + lane;
#pragma unroll
    for (int j = 0; j < 8; ++j) r.v[j] = q[64 * j]; }
DI void row_store(const Row& r, float* p, int lane) { f32x4* q = (f32x4*)p + lane;
#pragma unroll
    for (int j = 0; j < 8; ++j) q[64 * j] = r.v[j]; }
DI void row_store_bf16(const Row& r, bf16* p, int lane) { u32x2* q = (u32x2*)p + lane;
#pragma unroll
    for (int j = 0; j < 8; ++j) { u32x2 w; w.x = pk2(r.v[j].x, r.v[j].y); w.y = pk2(r.v[j].z, r.v[j].w); q[64 * j] = w; } }
DI void row_ln(Row& r) {
    float s = 0.f;
#pragma unroll
    for (int j = 0; j < 8; ++j) s += (r.v[j].x + r.v[j].y) + (r.v[j].z + r.v[j].w);
    const float mean = wave_sum(s) * (1.f / D); float s2 = 0.f;
#pragma unroll
    for (int j = 0; j < 8; ++j) { r.v[j] = r.v[j] - mean; s2 += (r.v[j].x * r.v[j].x + r.v[j].y * r.v[j].y) + (r.v[j].z * r.v[j].z + r.v[j].w * r.v[j].w); }
    const float rstd = 1.f / sqrtf(wave_sum(s2) * (1.f / D) + LN_EPS);
#pragma unroll
    for (int j = 0; j < 8; ++j) r.v[j] = r.v[j] * rstd;
}
DI void row_affine(Row& r, const float* g, const float* b, int lane) {
    const f32x4* gq = (const f32x4*)g + lane; const f32x4* bq = (const f32x4*)b + lane;
#pragma unroll
    for (int j = 0; j < 8; ++j) r.v[j] = r.v[j] * gq[64 * j] + bq[64 * j];
}
DI void row_modulate(Row& r, const float* sh, const float* sc, int lane) {
    const f32x4* hq = (const f32x4*)sh + lane; const f32x4* cq = (const f32x4*)sc + lane;
#pragma unroll
    for (int j = 0; j < 8; ++j) r.v[j] = r.v[j] * (cq[64 * j] + 1.f) + hq[64 * j];
}

struct Unit { const bf16* A; const bf16* B; const int* gat; int nvalid; int m0, n0, aux; };

template <class Sched, class Epi>
DI void gemm_simple(const Sched& S, const Epi& E, const int lda, const int ldb, const int K) {
    const int tid = threadIdx.x, wid = tid >> 6, lane = tid & 63, fr = lane & 15, fq = lane >> 4;
    for (int L = blockIdx.x; ; L += gridDim.x) {
        Unit u; if (!S.get(L, u)) break;
        const bf16* arow[2];
#pragma unroll
        for (int m = 0; m < 2; ++m) { const int r = 32 * wid + 16 * m + fr; size_t grow = (size_t)r; if (u.gat) grow = (size_t)(r < u.nvalid ? u.gat[r] : 0); arow[m] = u.A + grow * lda + fq * 8; }
        for (int cc = 0; cc < 4; ++cc) {
            f32x4 acc[2][4];
#pragma unroll
            for (int m = 0; m < 2; ++m)
#pragma unroll
                for (int j = 0; j < 4; ++j) acc[m][j] = (f32x4){0.f, 0.f, 0.f, 0.f};
            const bf16* brow[4];
#pragma unroll
            for (int j = 0; j < 4; ++j) { const int col = (j >> 1) * 128 + cc * 32 + (j & 1) * 16 + fr; brow[j] = u.B + (size_t)col * ldb + fq * 8; }
            for (int k = 0; k < K; k += 32) {
                bf16x8 a[2], b[4];
#pragma unroll
                for (int m = 0; m < 2; ++m) a[m] = *(const bf16x8*)(arow[m] + k);
#pragma unroll
                for (int j = 0; j < 4; ++j) b[j] = *(const bf16x8*)(brow[j] + k);
#pragma unroll
                for (int m = 0; m < 2; ++m)
#pragma unroll
                    for (int j = 0; j < 4; ++j) acc[m][j] = __builtin_amdgcn_mfma_f32_16x16x32_bf16(b[j], a[m], acc[m][j], 0, 0, 0);
            }
#pragma unroll
            for (int m = 0; m < 2; ++m)
#pragma unroll
                for (int nn = 0; nn < 2; ++nn) E(u, 32 * wid + 16 * m + fr, cc * 32 + nn * 16 + 4 * fq, acc[m][nn], acc[m][nn + 2]);
        }
    }
}


namespace pg8 {
constexpr int BK = 64, HALF = 128, HTB = HALF * BK * 2, STAGE_BYTES = 8 * HTB;
DI int lds_byte(int r, int c) { const int st = (r >> 4) * 2 + (c >> 5), rr = r & 15, cc = c & 31, ob = rr * 64 + cc * 2; return st * 1024 + (ob ^ (((ob >> 9) & 1) << 5)); }
DI void stage_rc(int b, int& R, int& C) { const int st = b / 1024, sb = b % 1024, swz = sb ^ (((sb >> 9) & 1) << 5); R = (st >> 1) * 16 + swz / 64; C = (st & 1) * 32 + (swz % 64) / 2; }
}
template <bool GATHER, class Sched, class Epi>
DI void gemm_pg8(LAS unsigned char* lds, const Sched& S, const Epi& E, const int lda, const int ldb, const int K) {
    using namespace pg8;
    const int tid = threadIdx.x, wid = __builtin_amdgcn_readfirstlane(tid >> 6), lane = tid & 63, wr = wid >> 2, wc = wid & 3, fr = lane & 15, fq = lane >> 4;
    const int nt = K / BK, G = gridDim.x, cblk = blockIdx.x;
    unsigned voffB[2], vA[2][2];
#pragma unroll
    for (int i = 0; i < 2; ++i) { int R_, C_; stage_rc(tid * 16 + i * 8192, R_, C_); voffB[i] = (unsigned)(R_ * ldb + C_) * 2u; }
    const size_t kstep = (size_t)(BK * 2), hstepA = (size_t)HALF * lda * 2, hstepB = (size_t)HALF * ldb * 2;
    const unsigned ldsw = (unsigned)wid * 1024u;
    const int aoff = lds_byte(wr * 64 + fr, fq * 8), boff = lds_byte(wc * 32 + fr, fq * 8);
#define PG8_SA(b, h) (((b) * 2 + (h)) * HTB)
#define PG8_SB(b, h) ((4 + (b) * 2 + (h)) * HTB)
#define PG8_STAGE(bufoff, gbase, voff) do { _Pragma("unroll") for (int _i = 0; _i < 2; ++_i) \
        __builtin_amdgcn_global_load_lds((const unsigned*)((const char*)(gbase) + (voff)[_i]), (LAS unsigned*)(lds + (bufoff) + ldsw + _i * 8192), 16, 0, 0); } while (0)
#define PG8_STAGE_A(bufoff, gbase, h) do { if constexpr (GATHER) PG8_STAGE(bufoff, gbase, vA[h]); else PG8_STAGE(bufoff, (gbase) + (h) * hstepA, vA[0]); } while (0)
#define PG8_LDA(dst, b, h) do { _Pragma("unroll") for (int m = 0; m < 4; ++m) _Pragma("unroll") for (int k = 0; k < 2; ++k) dst[m][k] = *(const LAS bf16x8*)(lds + PG8_SA(b, h) + aoff + m * 2048 + k * 1024); } while (0)
#define PG8_LDB(dst, b, h) do { _Pragma("unroll") for (int n = 0; n < 2; ++n) _Pragma("unroll") for (int k = 0; k < 2; ++k) dst[n][k] = *(const LAS bf16x8*)(lds + PG8_SB(b, h) + boff + n * 2048 + k * 1024); } while (0)
#define PG8_MMA(ai, bj, At, Bt) do { __builtin_amdgcn_s_setprio(1); _Pragma("unroll") for (int m = 0; m < 4; ++m) _Pragma("unroll") for (int n = 0; n < 2; ++n) _Pragma("unroll") for (int k = 0; k < 2; ++k) \
        acc[ai][bj][m][n] = __builtin_amdgcn_mfma_f32_16x16x32_bf16(Bt[n][k], At[m][k], acc[ai][bj][m][n], 0, 0, 0); __builtin_amdgcn_s_setprio(0); } while (0)
#define PG8_WAIT_V(n) asm volatile("s_waitcnt vmcnt(" #n ")" ::: "memory")
#define PG8_WAIT_L(n) asm volatile("s_waitcnt lgkmcnt(" #n ")" ::: "memory")
#define PG8_BAR __builtin_amdgcn_s_barrier()
#define PG8_SCHED __builtin_amdgcn_sched_barrier(0)
#define PG8_SETV(dst, u) do { _Pragma("unroll") for (int _h = 0; _h < 2; ++_h) _Pragma("unroll") for (int _i = 0; _i < 2; ++_i) { int _R, _C; stage_rc(tid * 16 + _i * 8192, _R, _C); const int _r = _h * HALF + _R; \
        if constexpr (GATHER) { const int _g = _r < (u).nvalid ? (u).gat[_r] : 0; dst[_h][_i] = (unsigned)(_g * lda + _C) * 2u; } else dst[_h][_i] = (unsigned)(_R * lda + _C) * 2u; } } while (0)
    Unit cur, nxt; int ui = 0;
    if (!S.get(cblk, cur)) return;
    f32x4 acc[2][2][4][2];
#pragma unroll
    for (int a = 0; a < 2; ++a)
#pragma unroll
        for (int b = 0; b < 2; ++b)
#pragma unroll
            for (int m = 0; m < 4; ++m)
#pragma unroll
                for (int n = 0; n < 2; ++n) acc[a][b][m][n] = (f32x4){0.f, 0.f, 0.f, 0.f};
    bf16x8 At[4][2], B0[2][2], B1[2][2];
    const char* cA = (const char*)cur.A; const char* cB = (const char*)cur.B;
    PG8_SETV(vA, cur);
    PG8_STAGE(PG8_SB(0, 0), cB, voffB); PG8_STAGE(PG8_SB(0, 1), cB + hstepB, voffB); PG8_STAGE_A(PG8_SA(0, 0), cA, 0); PG8_STAGE_A(PG8_SA(0, 1), cA, 1);
    if (wr == 1) PG8_BAR;
    PG8_WAIT_V(2); PG8_BAR;
    PG8_STAGE(PG8_SB(1, 0), cB + kstep, voffB); PG8_STAGE_A(PG8_SA(1, 0), cA + kstep, 0); PG8_STAGE(PG8_SB(1, 1), cB + hstepB + kstep, voffB);
    PG8_WAIT_V(6); PG8_BAR;
    for (;;) {
        const bool has_next = S.get((ui + 1) * G + cblk, nxt);
        const char* nA = has_next ? (const char*)nxt.A : cA; const char* nB = has_next ? (const char*)nxt.B : cB;
        for (int t = 0; t < nt; t += 2) {
            const bool last = (t == nt - 2);
            const char* a1 = cA + (size_t)(t + 1) * kstep;
            const char* a2 = last ? nA : cA + (size_t)(t + 2) * kstep; const char* b2 = last ? nB : cB + (size_t)(t + 2) * kstep;
            const char* a3 = a2 + kstep; const char* b3 = b2 + kstep;
            PG8_LDB(B0, 0, 0); PG8_LDB(B1, 0, 1); PG8_SCHED; PG8_LDA(At, 0, 0); PG8_STAGE_A(PG8_SA(1, 1), a1, 1);
            PG8_WAIT_V(8); PG8_WAIT_L(0); PG8_BAR; PG8_MMA(0, 0, At, B0); PG8_MMA(0, 1, At, B1); PG8_BAR; PG8_SCHED;
            if constexpr (GATHER) { if (last && has_next) PG8_SETV(vA, nxt); }
            PG8_LDA(At, 0, 1); PG8_STAGE(PG8_SB(0, 0), b2, voffB); PG8_STAGE(PG8_SB(0, 1), b2 + hstepB, voffB); PG8_STAGE_A(PG8_SA(0, 0), a2, 0);
            PG8_WAIT_V(8); PG8_WAIT_L(0); PG8_BAR; PG8_MMA(1, 0, At, B0); PG8_MMA(1, 1, At, B1); PG8_BAR; PG8_SCHED;
            PG8_LDB(B0, 1, 0); PG8_LDB(B1, 1, 1); PG8_SCHED; PG8_LDA(At, 1, 0); PG8_STAGE_A(PG8_SA(0, 1), a2, 1);
            PG8_WAIT_V(8); PG8_WAIT_L(0); PG8_BAR; PG8_MMA(0, 0, At, B0); PG8_MMA(0, 1, At, B1); PG8_BAR; PG8_SCHED;
            PG8_LDA(At, 1, 1); PG8_STAGE(PG8_SB(1, 0), b3, voffB); PG8_STAGE(PG8_SB(1, 1), b3 + hstepB, voffB); PG8_STAGE_A(PG8_SA(1, 0), a3, 0);
            PG8_WAIT_V(8); PG8_WAIT_L(0); PG8_BAR; PG8_MMA(1, 0, At, B0); PG8_MMA(1, 1, At, B1); PG8_BAR; PG8_SCHED;
        }
        if (wr == 0) PG8_BAR;
#pragma unroll
        for (int ai = 0; ai < 2; ++ai)
#pragma unroll
            for (int m = 0; m < 4; ++m)
#pragma unroll
                for (int n = 0; n < 2; ++n) E(cur, ai * HALF + wr * 64 + m * 16 + fr, wc * 32 + n * 16 + 4 * fq, acc[ai][0][m][n], acc[ai][1][m][n]);
        if (!has_next) break;
#pragma unroll
        for (int a = 0; a < 2; ++a)
#pragma unroll
            for (int b = 0; b < 2; ++b)
#pragma unroll
                for (int m = 0; m < 4; ++m)
#pragma unroll
                    for (int n = 0; n < 2; ++n) acc[a][b][m][n] = (f32x4){0.f, 0.f, 0.f, 0.f};
        cur = nxt; cA = nA; cB = nB; ++ui;
        if (wr == 1) PG8_BAR;
    }
    PG8_WAIT_V(0);
    PG8_BAR;
#undef PG8_SA
#undef PG8_SB
#undef PG8_STAGE
#undef PG8_STAGE_A
#undef PG8_LDA
#undef PG8_LDB
#undef PG8_MMA
#undef PG8_WAIT_V
#undef PG8_WAIT_L
#undef PG8_BAR
#undef PG8_SCHED
#undef PG8_SETV
}

DI int xcd_remap(int L, int n) { const int q = n >> 3, r = n & 7, xcd = L & 7, off = L >> 3; return (xcd < r ? xcd * (q + 1) : r * (q + 1) + (xcd - r) * q) + off; }
DI void grouped(int wgid, int nM, int nN, int& pm, int& pn) { const int nig = 8 * nN, gid = wgid / nig, fm = gid * 8, gsz = min(nM - fm, 8); pm = fm + (wgid % nig) % gsz; pn = (wgid % nig) / gsz; }

struct SchedInProj { const bf16* U; const bf16* W;
    DI bool get(int L, Unit& u) const { int pm, pn;
        if (L >= 64 * 24 + 32) return false; const int w = xcd_remap(L, 64 * 24 + 32);
        if (w < 64 * 24) grouped(w, 64, 24, pm, pn); else { const int l2 = w - 64 * 24; pm = 64 + (l2 >> 3); pn = 4 + (l2 & 7); }
        u.A = U + (size_t)pm * 256 * D; u.B = W + (size_t)pn * 256 * D; u.gat = nullptr; u.nvalid = 256; u.m0 = pm * 256; u.n0 = pn * 256; u.aux = 0; return true; } };
struct SchedDense { const bf16* A; const bf16* B; int nM, nN; size_t a_t, b_t;
    DI bool get(int L, Unit& u) const { if (L >= nM * nN) return false; int pm, pn; grouped(xcd_remap(L, nM * nN), nM, nN, pm, pn);
        u.A = A + (size_t)pm * a_t; u.B = B + (size_t)pn * b_t; u.gat = nullptr; u.nvalid = 256; u.m0 = pm * 256; u.n0 = pn * 256; u.aux = 0; return true; } };
struct SchedMoe { const LAS int* cnt; const LAS int* tb; const bf16* A; const bf16* W; const int* table; int gather; size_t a_t, w_e, w_t;
    DI bool get(int L, Unit& u) const { const int nT = __builtin_amdgcn_readfirstlane(tb[32]); if (L >= nT * 8) return false; int t, pn; grouped(xcd_remap(L, nT * 8), nT, 8, t, pn);
        int e = 0;
        for (int i = 1; i < 32; ++i) e = (tb[i] <= t) ? i : e;
        e = __builtin_amdgcn_readfirstlane(e); t = __builtin_amdgcn_readfirstlane(t); pn = __builtin_amdgcn_readfirstlane(pn);
        const int mt = __builtin_amdgcn_readfirstlane(t - tb[e]);
        if (gather) { u.A = A; u.gat = table + (size_t)e * T + mt * 256; } else { u.A = A + (size_t)t * a_t; u.gat = nullptr; }
        u.nvalid = __builtin_amdgcn_readfirstlane(min(256, cnt[e] - mt * 256));
        u.B = W + (size_t)e * w_e + (size_t)pn * w_t; u.m0 = t * 256; u.n0 = pn * 256; u.aux = e; return true; } };
struct SchedF1 { const bf16* CS; const bf16* U;
    DI bool get(int L, Unit& u) const { if (L >= 1024) return false; const int b = L >> 8, g = (L >> 6) & 3, pm = (L >> 4) & 3, pn = L & 15;
        u.A = CS + (size_t)pm * 256 * 512; u.B = U + ((size_t)b * SEQ + pn * 256) * D + g * 512; u.gat = nullptr; u.nvalid = 256; u.m0 = pm * 256; u.n0 = pn * 256; u.aux = b * 4 + g; return true; } };
struct SchedF2 { const bf16* ACS; const bf16* BT2;
    DI bool get(int L, Unit& u) const { if (L >= 512) return false; const int b = L >> 7, pm = (L >> 3) & 15, pn = L & 7;
        u.A = ACS + (size_t)pm * 256 * 8192; u.B = BT2 + ((size_t)b * D + pn * 256) * 8192; u.gat = nullptr; u.nvalid = 256; u.m0 = pm * 256; u.n0 = pn * 256; u.aux = b; return true; } };

DI void st_bf16x4(bf16* p, f32x4 v) { u32x2 w; w.x = pk2(v.x, v.y); w.y = pk2(v.z, v.w); *(u32x2*)p = w; }
struct EpiStoreBf16 { bf16* O; int ldc;
    DI void operator()(const Unit& u, int r, int c, f32x4 lo, f32x4 hi) const { bf16* p = O + (size_t)(u.m0 + r) * ldc + u.n0 + c; st_bf16x4(p, lo); st_bf16x4(p + 128, hi); } };
struct EpiResid { const float* x; float* t; const float* gate;
    DI void operator()(const Unit& u, int r, int c, f32x4 lo, f32x4 hi) const { const int row = u.m0 + r, b = row >> 12; const int col = u.n0 + c;
        const size_t o = (size_t)row * D + col; const float* g = gate + (size_t)b * MODW + col;
        *(f32x4*)(t + o) = *(const f32x4*)(x + o) * ALPHA + *(const f32x4*)g * lo;
        *(f32x4*)(t + o + 128) = *(const f32x4*)(x + o + 128) * ALPHA + *(const f32x4*)(g + 128) * hi; } };
struct EpiSwiglu { bf16* H;
    DI void operator()(const Unit& u, int r, int c, f32x4 lo, f32x4 hi) const { f32x4 h;
        h.x = silu_f(lo.x) * hi.x; h.y = silu_f(lo.y) * hi.y; h.z = silu_f(lo.z) * hi.z; h.w = silu_f(lo.w) * hi.w;
        st_bf16x4(H + (size_t)(u.m0 + r) * DE + (u.n0 >> 1) + c, h); } };
struct EpiF1 { bf16* BT2;
    DI void operator()(const Unit& u, int r, int c, f32x4 lo, f32x4 hi) const { const int b = u.aux >> 2, g = u.aux & 3, m = u.m0 + r, cs = m >> 9, cp = m & 511;
        bf16* p = BT2 + ((size_t)b * D + g * 512 + cp) * 8192 + cs * 4096 + u.n0 + c; st_bf16x4(p, lo); st_bf16x4(p + 128, hi); } };
struct EpiF2 { bf16* REZ;
    DI void operator()(const Unit& u, int r, int c, f32x4 lo, f32x4 hi) const { bf16* p = REZ + ((size_t)u.aux * SEQ + u.m0 + r) * D + u.n0 + c; st_bf16x4(p, lo); st_bf16x4(p + 128, hi); } };

DI void p0_mods(const float* c, const float* cctx, const float* ada_w, const float* ada_b, float* mods, LAS float* sl, int tid) {
    LAS float* red = sl + 5 * D;
    for (int i = tid; i < 5 * D; i += 512) { const float v = i < 4 * D ? c[i] : cctx[i - 4 * D]; sl[i] = silu_f(v); }
    __syncthreads();
    const int cq = tid & 127, ks = tid >> 7;
    for (int unit = blockIdx.x; unit < 192; unit += gridDim.x) {
        const int l = unit / 96, n = (unit % 96) * 128 + cq;
        const float* W = ada_w + (size_t)l * D * MODW + n;
        float a0 = 0.f, a1 = 0.f, a2 = 0.f, a3 = 0.f, a4 = 0.f;
#pragma unroll 8
        for (int k = ks * 512; k < ks * 512 + 512; ++k) { const float w = W[(size_t)k * MODW]; a0 += sl[k] * w; a1 += sl[D + k] * w; a2 += sl[2 * D + k] * w; a3 += sl[3 * D + k] * w; a4 += sl[4 * D + k] * w; }
        red[(ks * 5 + 0) * 128 + cq] = a0; red[(ks * 5 + 1) * 128 + cq] = a1; red[(ks * 5 + 2) * 128 + cq] = a2; red[(ks * 5 + 3) * 128 + cq] = a3; red[(ks * 5 + 4) * 128 + cq] = a4;
        __syncthreads();
        for (int i = tid; i < 640; i += 512) { const int r = i >> 7, q = i & 127, n2 = (unit % 96) * 128 + q;
            const float s = (red[(0 * 5 + r) * 128 + q] + red[(1 * 5 + r) * 128 + q]) + (red[(2 * 5 + r) * 128 + q] + red[(3 * 5 + r) * 128 + q]);
            mods[((size_t)l * 5 + r) * MODW + n2] = s + ada_b[(size_t)l * MODW + n2]; }
        __syncthreads();
    }
}
DI void tr_item(const float* W, int N, int Kd, int k0, int n0, bf16* WT, int drow0, LAS float* scr, int lane) {
#pragma unroll 8
    for (int i = 0; i < 32; ++i) { const int kk = 2 * i + (lane >> 5); scr[kk * 33 + (lane & 31)] = W[(size_t)(k0 + kk) * N + n0 + (lane & 31)]; }
    asm volatile("s_waitcnt lgkmcnt(0)" ::: "memory");
    const int c = lane & 7;
#pragma unroll
    for (int j = 0; j < 4; ++j) { const int n = (lane >> 3) + 8 * j; const LAS float* s = scr + (8 * c) * 33 + n;
        u32x4 o; o.x = pk2(s[0 * 33], s[1 * 33]); o.y = pk2(s[2 * 33], s[3 * 33]); o.z = pk2(s[4 * 33], s[5 * 33]); o.w = pk2(s[6 * 33], s[7 * 33]);
        *(u32x4*)(WT + (size_t)(drow0 + n) * Kd + k0 + 8 * c) = o; }
    asm volatile("s_waitcnt lgkmcnt(0)" ::: "memory");
}
DI void p0_weights(const float* w_in, const float* w_out, const float* w_f, const float* w_gate, const float* w_up, const float* w_down,
                   bf16* WIN, bf16* WO, bf16* WF, bf16* WGU, bf16* WD, LAS float* scr, int gw, int NGW, int lane) {
    constexpr int I_IN = 32 * 192, I_SQ = 32 * 64, I_E = 65536;
    constexpr int NIT = I_IN + 2 * I_SQ + 3 * I_E;
    for (int it = gw; it < NIT; it += NGW) {
        int r = it;
        if (r < I_IN) { const int kb = r / 192, nb = r % 192; tr_item(w_in, NMIX, D, kb * 64, nb * 32, WIN, nb * 32, scr, lane); continue; } r -= I_IN;
        if (r < I_SQ) { const int kb = r / 64, nb = r % 64; tr_item(w_out, D, D, kb * 64, nb * 32, WO, nb * 32, scr, lane); continue; } r -= I_SQ;
        if (r < I_SQ) { const int kb = r / 64, nb = r % 64; tr_item(w_f, D, D, kb * 64, nb * 32, WF, nb * 32, scr, lane); continue; } r -= I_SQ;
        if (r < 2 * I_E) { const int up = r >= I_E; if (up) r -= I_E; const int mat = r >> 10, rr = r & 1023, kb = rr >> 5, nb = rr & 31, n0 = nb * 32;
            tr_item((up ? w_up : w_gate) + (size_t)mat * D * DE, DE, D, kb * 64, n0, WGU + (size_t)mat * D * D, (n0 >> 7) * 256 + (n0 & 127) + (up ? 128 : 0), scr, lane); continue; } r -= 2 * I_E;
        { const int mat = r >> 10, rr = r & 1023, kb = rr >> 6, nb = rr & 63; tr_item(w_down + (size_t)mat * DE * D, D, DE, kb * 64, nb * 32, WD + (size_t)mat * D * DE, nb * 32, scr, lane); }
    }
}
DI void p0_dft(bf16* ACS, bf16* CS, int gtid, int GT) {
    for (int i = gtid; i < 4096 * 1024; i += GT) { const int j = i >> 10, k8 = (i & 1023) * 8; unsigned w[4];
#pragma unroll
        for (int e = 0; e < 4; ++e) { float v[2];
#pragma unroll
            for (int q = 0; q < 2; ++q) { const int kk = k8 + 2 * e + q; const int m = (j * (kk & 4095)) & 4095; const float ang = (float)m * (1.f / 2048.f); v[q] = (kk < 4096 ? cospif(ang) : -sinpif(ang)) * (1.f / 64.f); }
            w[e] = pk2(v[0], v[1]); }
        *(u32x4*)(ACS + (size_t)j * 8192 + k8) = (u32x4){w[0], w[1], w[2], w[3]}; }
    for (int i = gtid; i < 1024 * 64; i += GT) { const int rr = i >> 6, c8 = (i & 63) * 8, cs = rr >> 9, cp = rr & 511; unsigned w[4];
#pragma unroll
        for (int e = 0; e < 4; ++e) { float v[2];
#pragma unroll
            for (int q = 0; q < 2; ++q) { const int cc = c8 + 2 * e + q; const int m = (cc * cp) & 511; const float ang = (float)m * (1.f / 256.f); v[q] = (cs ? sinpif(ang) : cospif(ang)) * 0.04419417382415922f; }
            w[e] = pk2(v[0], v[1]); }
        *(u32x4*)(CS + (size_t)rr * 512 + c8) = (u32x4){w[0], w[1], w[2], w[3]}; }
}
DI void ln_mod_phase(const float* x, const float* ctx, const float* mods_l, int sh_chunk, bf16* U, int nrows, int gw, int NGW, int lane) {
    for (int row = gw; row < nrows; row += NGW) {
        const float* src = row < T ? x + (size_t)row * D : ctx + (size_t)(row - T) * D; const int rb = row < T ? (row >> 12) : 4;
        Row r; row_load(r, src, lane); row_ln(r);
        const float* mr = mods_l + (size_t)rb * MODW + sh_chunk * D;
        row_modulate(r, mr, mr + D, lane);
        row_store_bf16(r, U + (size_t)row * D, lane);
    }
}
DI void attn_simple(const bf16* P, const float* rpb, bf16* MIX, LAS float* scr, int gw, int NGW, int lane) {
    const float scale = 0.08838834764831845f;
    for (int item = gw; item < T * NH; item += NGW) {
        const int tok = item >> 3, h = item & 7, b = tok >> 12, l = tok & 4095, r = l >> 6, qc = l & 63;
        const int rs = min(max(r - 4, 0), 56), cs = min(max(qc - 8, 0), 48);
        { const unsigned w = *((const unsigned*)(P + (size_t)tok * NMIX + h * HD) + lane); scr[2 * lane] = bflo(w); scr[2 * lane + 1] = bfhi(w); }
        asm volatile("s_waitcnt lgkmcnt(0)" ::: "memory");
        float s[6];
#pragma unroll
        for (int i = 0; i < 6; ++i) {
            const int kk = lane + 64 * i; size_t krow; float bias = 0.f;
            if (kk < 128) { const int a = kk >> 4, j = kk & 15; krow = (size_t)b * SEQ + 64 * (rs + a) + cs + j; bias = rpb[(h * 15 + (rs + a - r + 7)) * 31 + (cs + j - qc + 15)]; }
            else krow = (size_t)T + b * CTXL + (kk - 128);
            const u32x4* kp = (const u32x4*)(P + krow * NMIX + D / 2 + h * HD);
            float acc = 0.f;
#pragma unroll 4
            for (int d8 = 0; d8 < 16; ++d8) { const u32x4 kv = kp[d8]; const LAS f32x4* qv = (const LAS f32x4*)scr + 2 * d8; const f32x4 q0 = qv[0], q1 = qv[1];
                acc += bflo(kv.x) * q0.x + bfhi(kv.x) * q0.y + bflo(kv.y) * q0.z + bfhi(kv.y) * q0.w + bflo(kv.z) * q1.x + bfhi(kv.z) * q1.y + bflo(kv.w) * q1.z + bfhi(kv.w) * q1.w; }
            s[i] = acc * scale + bias;
        }
        float m = s[0];
#pragma unroll
        for (int i = 1; i < 6; ++i) m = fmaxf(m, s[i]);
        m = wave_max(m); float sum = 0.f;
#pragma unroll
        for (int i = 0; i < 6; ++i) { s[i] = expf(s[i] - m); sum += s[i]; scr[128 + lane + 64 * i] = s[i]; }
        sum = wave_sum(sum);
        asm volatile("s_waitcnt lgkmcnt(0)" ::: "memory");
        float o0 = 0.f, o1 = 0.f;
        for (int kk = 0; kk < 384; ++kk) {
            size_t vrow; if (kk < 128) vrow = (size_t)b * SEQ + 64 * (rs + (kk >> 4)) + cs + (kk & 15); else vrow = (size_t)T + b * CTXL + (kk - 128);
            const unsigned w = *((const unsigned*)(P + vrow * NMIX + D + h * HD) + lane); const float p = scr[128 + kk];
            o0 += p * bflo(w); o1 += p * bfhi(w);
        }
        const float inv = 1.f / sum;
        *((unsigned*)(MIX + (size_t)tok * D + h * HD) + lane) = pk2(o0 * inv, o1 * inv);
        asm volatile("s_waitcnt lgkmcnt(0)" ::: "memory");
    }
}

constexpr int ATT_RS = 288, ATT_TILE = 64 * ATT_RS, ATT_BUF = 2 * ATT_TILE;
typedef short s16x4 __attribute__((ext_vector_type(4)));
struct AttState { f32x4 sc[32]; unsigned pk[32][2]; f32x4 o[8]; u32x4 stg[4]; bf16x8 qf[4]; float inv; unsigned g_off, w_off, ka_off, va_off; };
struct AttCtx { const bf16* P; LAS unsigned char* lds; const LAS float* lrpb; int b, r, rs, hp, hs, c0, qc, csq, quad; };
template <int STEP> DI void att_load(AttState& S, const AttCtx& C) {
    constexpr int ti = STEP % 12; const int colb = (STEP < 12 ? 1024 : 2048) + C.hp * 256;
    const size_t tok0 = ti < 8 ? (size_t)C.b * SEQ + 64 * (C.rs + ti) : (size_t)T + C.b * CTXL + (ti - 8) * 64;
    const char* ub = (const char*)(C.P + tok0 * NMIX + colb);
#pragma unroll
    for (int k = 0; k < 4; ++k) S.stg[k] = *(const u32x4*)(ub + (size_t)(32 * (k & 1)) * NMIX * 2 + (k >> 1) * 256 + S.g_off);
}
template <int BUFI> DI void att_write(AttState& S, const AttCtx& C) {
#pragma unroll
    for (int k = 0; k < 4; ++k) *(LAS u32x4*)(C.lds + BUFI * ATT_BUF + (k >> 1) * ATT_TILE + 32 * (k & 1) * ATT_RS + S.w_off) = S.stg[k];
}
template <int STEP> DI void att_step(AttState& S, const AttCtx& C) {
    const float scale = 0.08838834764831845f;
    asm volatile("" : "+v"(S.g_off), "+v"(S.w_off), "+v"(S.ka_off), "+v"(S.va_off));
    if constexpr (STEP + 1 < 24) att_load<STEP + 1>(S, C);
    constexpr int bo = (STEP & 1) * ATT_BUF;
    if constexpr (STEP < 12) {
        constexpr int ti = STEP;
        if constexpr (ti < 8) {
            const int aidx = C.rs + ti - C.r + 7;
            const LAS float* brow = C.lrpb + C.hs * 465 + aidx * 31;
#pragma unroll
            for (int t = 0; t < 2; ++t) { const int krow0 = C.c0 + 16 * t; f32x4 acc = (f32x4){0.f, 0.f, 0.f, 0.f};
                const LAS unsigned char* ka = C.lds + bo + krow0 * ATT_RS + S.ka_off;
#pragma unroll
                for (int s4 = 0; s4 < 4; ++s4) acc = __builtin_amdgcn_mfma_f32_16x16x32_bf16(*(const LAS bf16x8*)(ka + s4 * 64), S.qf[s4], acc, 0, 0, 0);
#pragma unroll
                for (int i = 0; i < 4; ++i) { const int kcol = krow0 + C.quad * 4 + i; const bool ok = kcol >= C.csq && kcol < C.csq + 16; const int bi = min(max(kcol - C.qc + 15, 0), 30);
                    const float bias = brow[bi]; S.sc[ti * 2 + t][i] = ok ? acc[i] * scale + bias : -1e30f; } }
        } else {
#pragma unroll
            for (int t = 0; t < 4; ++t) { f32x4 acc = (f32x4){0.f, 0.f, 0.f, 0.f};
                const LAS unsigned char* ka = C.lds + bo + 16 * t * ATT_RS + S.ka_off;
#pragma unroll
                for (int s4 = 0; s4 < 4; ++s4) acc = __builtin_amdgcn_mfma_f32_16x16x32_bf16(*(const LAS bf16x8*)(ka + s4 * 64), S.qf[s4], acc, 0, 0, 0);
                S.sc[16 + (ti - 8) * 4 + t] = acc * scale; }
        }
    } else {
        if constexpr (STEP == 12) {
            float m = -1e30f;
#pragma unroll
            for (int sl = 0; sl < 32; ++sl) m = fmaxf(fmaxf(m, fmaxf(S.sc[sl][0], S.sc[sl][1])), fmaxf(S.sc[sl][2], S.sc[sl][3]));
            m = fmaxf(m, __shfl_xor(m, 16)); m = fmaxf(m, __shfl_xor(m, 32));
            float sum = 0.f;
#pragma unroll
            for (int sl = 0; sl < 32; ++sl) { const float e0 = __expf(S.sc[sl][0] - m), e1 = __expf(S.sc[sl][1] - m), e2 = __expf(S.sc[sl][2] - m), e3 = __expf(S.sc[sl][3] - m);
                sum += (e0 + e1) + (e2 + e3); S.pk[sl][0] = pk2(e0, e1); S.pk[sl][1] = pk2(e2, e3); }
            sum += __shfl_xor(sum, 16); sum += __shfl_xor(sum, 32); S.inv = 1.f / sum;
#pragma unroll
            for (int dt = 0; dt < 8; ++dt) S.o[dt] = (f32x4){0.f, 0.f, 0.f, 0.f};
        }
        constexpr int ti = STEP - 12; constexpr int nks = ti < 8 ? 1 : 2;
#pragma unroll
        for (int kk = 0; kk < nks; ++kk) {
            const int sa = ti < 8 ? ti * 2 : 16 + (ti - 8) * 4 + 2 * kk; const int rb = ti < 8 ? C.c0 : 32 * kk;
            const u32x4 pw = (u32x4){S.pk[sa][0], S.pk[sa][1], S.pk[sa + 1][0], S.pk[sa + 1][1]}; const bf16x8 pf = __builtin_bit_cast(bf16x8, pw);
            const LAS unsigned char* va = C.lds + bo + rb * ATT_RS + S.va_off;
#pragma unroll
            for (int dt = 0; dt < 8; ++dt) { const s16x4 v1 = __builtin_amdgcn_ds_read_tr16_b64_v4i16((LAS s16x4*)(va + dt * 32)); const s16x4 v2 = __builtin_amdgcn_ds_read_tr16_b64_v4i16((LAS s16x4*)(va + 16 * ATT_RS + dt * 32));
                const bf16x8 vf = __builtin_shufflevector(v1, v2, 0, 1, 2, 3, 4, 5, 6, 7); S.o[dt] = __builtin_amdgcn_mfma_f32_16x16x32_bf16(vf, pf, S.o[dt], 0, 0, 0); }
        }
    }
    if constexpr (STEP + 1 < 24) att_write<(STEP + 1) & 1>(S, C);
    __syncthreads();
}
DI void attn_phase(const bf16* P, const float* rpb, bf16* MIX, LAS unsigned char* lds, LAS float* lrpb) {
    const int tid = threadIdx.x, wid = __builtin_amdgcn_readfirstlane(tid >> 6), lane = tid & 63, hs = wid >> 2, j = wid & 3, lq = lane & 15, quad = lane >> 4;
    const int srow = tid >> 4, sch = tid & 15;
    AttState S; AttCtx C;
    C.P = P; C.lds = lds; C.lrpb = lrpb; C.hs = hs; C.quad = quad;
    C.c0 = (j == 0) ? 0 : (j == 1) ? 8 : (j == 2) ? 24 : 32;
    C.qc = 16 * j + lq; C.csq = min(max(C.qc - 8, 0), 48);
    S.g_off = (unsigned)(srow * NMIX + sch * 8) * 2u;
    S.w_off = (unsigned)(srow * ATT_RS + sch * 16);
    S.ka_off = (unsigned)(hs * ATT_TILE + lq * ATT_RS + quad * 16);
    S.va_off = (unsigned)(hs * ATT_TILE + (4 * quad + (lq >> 2)) * ATT_RS + 8 * (lq & 3));
    for (int unit = blockIdx.x; unit < 1024; unit += gridDim.x) {
        const int r = unit & 63, hp = (unit >> 6) & 3, b = unit >> 8, h = 2 * hp + hs;
        C.r = r; C.hp = hp; C.b = b; C.rs = min(max(r - 4, 0), 56);
        __syncthreads();
        for (int i = tid; i < 930; i += 512) lrpb[i] = rpb[(size_t)hp * 930 + i];
        const size_t tq = (size_t)b * SEQ + 64 * r + C.qc;
#pragma unroll
        for (int s4 = 0; s4 < 4; ++s4) S.qf[s4] = *(const bf16x8*)(P + tq * NMIX + h * HD + s4 * 32 + quad * 8);
        att_load<0>(S, C); att_write<0>(S, C); __syncthreads();
        att_step<0>(S, C); att_step<1>(S, C); att_step<2>(S, C); att_step<3>(S, C); att_step<4>(S, C); att_step<5>(S, C); att_step<6>(S, C); att_step<7>(S, C);
        att_step<8>(S, C); att_step<9>(S, C); att_step<10>(S, C); att_step<11>(S, C); att_step<12>(S, C); att_step<13>(S, C); att_step<14>(S, C); att_step<15>(S, C);
        att_step<16>(S, C); att_step<17>(S, C); att_step<18>(S, C); att_step<19>(S, C); att_step<20>(S, C); att_step<21>(S, C); att_step<22>(S, C); att_step<23>(S, C);
        bf16* op = MIX + tq * D + h * HD + quad * 4;
#pragma unroll
        for (int dt = 0; dt < 8; ++dt) st_bf16x4(op + dt * 16, S.o[dt] * S.inv);
    }
}

DI void conv_phase(const bf16* P, const float* cw, bf16* MIX, int gtid, int GT) {
    for (int i = gtid; i < T * 128; i += GT) {
        const int tok = i >> 7, c8 = (i & 127) * 8, l = tok & 4095;
        const bf16* base = P + (size_t)tok * NMIX + 3072 + c8;
        const u32x4 gb = *(const u32x4*)base;
        float z[3][8];
#pragma unroll
        for (int j = 0; j < 3; ++j) { const int ll = l + j - 1; const bool ok = ll >= 0 && ll < SEQ;
            u32x4 gc = (u32x4){0u, 0u, 0u, 0u}, xi = gc;
            if (ok) { const bf16* pj = base + (ptrdiff_t)(j - 1) * NMIX; gc = *(const u32x4*)(pj + 1024); xi = *(const u32x4*)(pj + 2048); }
            z[j][0] = bflo(gc.x) * bflo(xi.x); z[j][1] = bfhi(gc.x) * bfhi(xi.x); z[j][2] = bflo(gc.y) * bflo(xi.y); z[j][3] = bfhi(gc.y) * bfhi(xi.y);
            z[j][4] = bflo(gc.z) * bflo(xi.z); z[j][5] = bfhi(gc.z) * bfhi(xi.z); z[j][6] = bflo(gc.w) * bflo(xi.w); z[j][7] = bfhi(gc.w) * bfhi(xi.w); }
        float gbf[8] = {bflo(gb.x), bfhi(gb.x), bflo(gb.y), bfhi(gb.y), bflo(gb.z), bfhi(gb.z), bflo(gb.w), bfhi(gb.w)};
        float o[8];
#pragma unroll
        for (int e = 0; e < 8; ++e) o[e] = gbf[e] * (cw[c8 + e] * z[0][e] + cw[1024 + c8 + e] * z[1][e] + cw[2048 + c8 + e] * z[2][e]);
        *(u32x4*)(MIX + (size_t)tok * D + 1024 + c8) = (u32x4){pk2(o[0], o[1]), pk2(o[2], o[3]), pk2(o[4], o[5]), pk2(o[6], o[7])};
    }
}
DI void ln_router_phase(const float* TB, const float* lng, const float* lnb, const float* mods_l, const float* rw, const float* rbias,
                        float* X1, bf16* U, unsigned* counts, int* table, unsigned* tokinfo, int gw, int NGW, int lane) {
    for (int row = gw; row < T; row += NGW) {
        Row r; row_load(r, TB + (size_t)row * D, lane); row_ln(r); row_affine(r, lng, lnb, lane);
        row_store(r, X1 + (size_t)row * D, lane);
        row_ln(r);
        const float* mr = mods_l + (size_t)(row >> 12) * MODW + 3 * D;
        row_modulate(r, mr, mr + D, lane);
        row_store_bf16(r, U + (size_t)row * D, lane);
        float lg[32];
#pragma unroll
        for (int e = 0; e < 32; ++e) lg[e] = 0.f;
        const float* wj = rw + (size_t)(4 * lane) * NE;
#pragma unroll
        for (int j = 0; j < 8; ++j) {
            asm volatile("" : "+v"(wj));
#pragma unroll
            for (int q = 0; q < 4; ++q) { const float uv = r.v[j][q]; const f32x4* wr = (const f32x4*)(wj + q * NE);
#pragma unroll
                for (int e4 = 0; e4 < 8; ++e4) { const f32x4 w = wr[e4]; lg[4 * e4] += uv * w.x; lg[4 * e4 + 1] += uv * w.y; lg[4 * e4 + 2] += uv * w.z; lg[4 * e4 + 3] += uv * w.w; }
                asm volatile("" ::: "memory"); }
            wj += 256 * NE; }
        float aff[32], bia[32];
#pragma unroll
        for (int e = 0; e < 32; ++e) { const float lgt = wave_sum(lg[e]); aff[e] = 1.f / (1.f + expf(-lgt)); bia[e] = aff[e] + rbias[e]; }
        float best = -1e30f; int grp = 0; float gv0 = 0.f, gv1 = 0.f, gv2 = 0.f, gv3 = 0.f, ga0 = 0.f, ga1 = 0.f, ga2 = 0.f, ga3 = 0.f;
#pragma unroll
        for (int g = 0; g < 8; ++g) { const float a = bia[4 * g], b = bia[4 * g + 1], c = bia[4 * g + 2], d = bia[4 * g + 3];
            const float h1 = fmaxf(a, b), l1 = fminf(a, b), h2 = fmaxf(c, d), l2 = fminf(c, d);
            const float sc = fmaxf(h1, h2) + fmaxf(fminf(h1, h2), fmaxf(l1, l2));
            if (sc > best) { best = sc; grp = g; gv0 = a; gv1 = b; gv2 = c; gv3 = d; ga0 = aff[4 * g]; ga1 = aff[4 * g + 1]; ga2 = aff[4 * g + 2]; ga3 = aff[4 * g + 3]; } }
        int i1 = 0; float v1 = gv0; if (gv1 > v1) { v1 = gv1; i1 = 1; } if (gv2 > v1) { v1 = gv2; i1 = 2; } if (gv3 > v1) { v1 = gv3; i1 = 3; }
        int i2 = -1; float v2 = -1e30f;
        if (i1 != 0 && gv0 > v2) { v2 = gv0; i2 = 0; } if (i1 != 1 && gv1 > v2) { v2 = gv1; i2 = 1; } if (i1 != 2 && gv2 > v2) { v2 = gv2; i2 = 2; } if (i1 != 3 && gv3 > v2) { v2 = gv3; i2 = 3; }
        const float a1 = i1 == 0 ? ga0 : i1 == 1 ? ga1 : i1 == 2 ? ga2 : ga3, a2 = i2 == 0 ? ga0 : i2 == 1 ? ga1 : i2 == 2 ? ga2 : ga3;
        const float w1 = a1 / (a1 + a2), w2 = a2 / (a1 + a2);
        const int e1 = grp * 4 + i1, e2 = grp * 4 + i2;
        if (lane == 0) {
            const unsigned p1 = __hip_atomic_fetch_add(counts + e1, 1u, __ATOMIC_RELAXED, __HIP_MEMORY_SCOPE_AGENT);
            const unsigned p2 = __hip_atomic_fetch_add(counts + e2, 1u, __ATOMIC_RELAXED, __HIP_MEMORY_SCOPE_AGENT);
            table[(size_t)e1 * T + p1] = row; table[(size_t)e2 * T + p2] = row;
            u32x4 ta; ta.x = (unsigned)e1; ta.y = (unsigned)e2; ta.z = p1; ta.w = p2; u32x4 tb2; tb2.x = __float_as_uint(w1); tb2.y = __float_as_uint(w2); tb2.z = 0u; tb2.w = 0u;
            *(u32x4*)(tokinfo + (size_t)row * 8) = ta; *(u32x4*)(tokinfo + (size_t)row * 8 + 4) = tb2;
        }
    }
}
DI void moe_prefix(const unsigned* counts, LAS int* cnt, LAS int* tb, int tid) {
    __syncthreads();
    if (tid < 32) cnt[tid] = (int)__hip_atomic_load(counts + tid, __ATOMIC_RELAXED, __HIP_MEMORY_SCOPE_AGENT);
    __syncthreads();
    if (tid == 0) { int a = 0; for (int e = 0; e < 32; ++e) { tb[e] = a; a += (cnt[e] + 255) >> 8; } tb[32] = a; }
    __syncthreads();
}
DI void combine_phase(const float* X1, const bf16* Y, const unsigned* tokinfo, const LAS int* tb, const float* mods_l, const float* lng, const float* lnb,
                      float* XO, const float* mods_next, bf16* U, int gw, int NGW, int lane) {
    for (int row = gw; row < T; row += NGW) {
        const u32x4 ta = *(const u32x4*)(tokinfo + (size_t)row * 8); const u32x4 tw = *(const u32x4*)(tokinfo + (size_t)row * 8 + 4);
        const size_t r0 = (size_t)tb[ta.x] * 256 + ta.z, r1 = (size_t)tb[ta.y] * 256 + ta.w; const float w0 = __uint_as_float(tw.x), w1 = __uint_as_float(tw.y);
        Row r; row_load(r, X1 + (size_t)row * D, lane);
        const u32x2* y0 = (const u32x2*)(Y + r0 * D) + lane; const u32x2* y1 = (const u32x2*)(Y + r1 * D) + lane;
        const f32x4* g2 = (const f32x4*)(mods_l + (size_t)(row >> 12) * MODW + 5 * D) + lane;
#pragma unroll
        for (int j = 0; j < 8; ++j) { const u32x2 a = y0[64 * j], b = y1[64 * j]; f32x4 f;
            f.x = w0 * bflo(a.x) + w1 * bflo(b.x); f.y = w0 * bfhi(a.x) + w1 * bfhi(b.x); f.z = w0 * bflo(a.y) + w1 * bflo(b.y); f.w = w0 * bfhi(a.y) + w1 * bfhi(b.y);
            r.v[j] = r.v[j] * ALPHA + g2[64 * j] * f; }
        row_ln(r); row_affine(r, lng, lnb, lane);
        row_store(r, XO + (size_t)row * D, lane);
        if (U) { row_ln(r); const float* mr = mods_next + (size_t)(row >> 12) * MODW; row_modulate(r, mr, mr + D, lane); row_store_bf16(r, U + (size_t)row * D, lane); }
    }
}

struct Args { const float* in[18]; float* out; unsigned char* ws; int ph_lo, ph_hi; };
__global__ void __launch_bounds__(512, 2) fwd(Args args) {
    extern __shared__ __attribute__((aligned(16))) unsigned char lds_raw[];
    LAS unsigned char* lds = (LAS unsigned char*)lds_raw;
#define PH_IDS int tid = threadIdx.x; asm volatile("" : "+v"(tid)); const int lane = tid & 63, wave = __builtin_amdgcn_readfirstlane(tid >> 6); \
    const int gw = blockIdx.x * 8 + wave, NGW = gridDim.x * 8, gtid = blockIdx.x * 512 + tid, GT = gridDim.x * 512; (void)lane; (void)gw; (void)NGW; (void)gtid; (void)GT;
    volatile LAS unsigned* LCTL = (volatile LAS unsigned*)(lds + LDSCTL_OFF);
    LAS int* l_cnt = (LAS int*)(lds + LDSCTL_OFF) + 16; LAS int* l_tb = (LAS int*)(lds + LDSCTL_OFF) + 48;
    for (int u = threadIdx.x; u < (LDS_BYTES - LDSCTL_OFF) / 4; u += 512) ((LAS unsigned*)(lds + LDSCTL_OFF))[u] = 0u;
    __syncthreads();
    unsigned char* ws = args.ws;
    unsigned* ctl = (unsigned*)(ws + WS_CTL);
#define XIN ((const float*)args.in[0])
#define c_in args.in[1]
#define ctx args.in[2]
#define c_ctx args.in[3]
#define ada_w args.in[4]
#define ada_b args.in[5]
#define w_mix_in args.in[6]
#define rpb args.in[7]
#define conv_w args.in[8]
#define w_mix_out args.in[9]
#define w_fourier args.in[10]
#define router_w args.in[11]
#define router_b args.in[12]
#define w_gate args.in[13]
#define w_up args.in[14]
#define w_down args.in[15]
#define ln_g args.in[16]
#define ln_b args.in[17]
#define mods ((float*)(ws + WS_MODS))
#define tokinfo ((unsigned*)(ws + WS_TOKINFO))
#define table ((int*)(ws + WS_TABLE))
#define WIN ((bf16*)(ws + WS_WIN))
#define WO ((bf16*)(ws + WS_WO))
#define WF ((bf16*)(ws + WS_WF))
#define CSM ((bf16*)(ws + WS_CS))
#define ACS ((bf16*)(ws + WS_ACS))
#define U ((bf16*)(ws + WS_U))
#define P ((bf16*)(ws + WS_P))
#define YB ((bf16*)(ws + WS_P))
#define BT2 ((bf16*)(ws + WS_P))
#define MIX ((bf16*)(ws + WS_MIX))
#define REZ ((bf16*)(ws + WS_MIX))
#define HB ((bf16*)(ws + WS_H))
#define WGU ((bf16*)(ws + WS_WGU))
#define WD ((bf16*)(ws + WS_WD))
#define TB ((float*)(ws + WS_TB))
#define X1 ((float*)(ws + WS_X1))
#define X2 ((float*)(ws + WS_X2))
    XcdBarrier bar; bar.bar = ctl + CW_BAR; bar.x = 0; bar.st = nullptr;
    if (N_LAUNCHES != NPHASE) bar = xcd_barrier_post(ctl + CW_BAR, LCTL);
    const int lo = args.ph_lo, hi = args.ph_hi;
#ifndef PH_MASK
#define PH_MASK 0xffff
#endif
#define IN(k) ((((PH_MASK) >> (k)) & 1) && lo <= (k) && (k) < hi)
#define SEAM(k) do { if (IN(k) && IN((k) + 1)) xcd_barrier(bar); } while (0)

    if (IN(0)) { PH_IDS
        p0_mods(c_in, c_ctx, ada_w, ada_b, mods, (LAS float*)lds, tid);
        p0_weights(w_mix_in, w_mix_out, w_fourier, w_gate, w_up, w_down, WIN, WO, WF, WGU, WD, (LAS float*)(lds + wave * 16384), gw, NGW, lane);
        p0_dft(ACS, CSM, gtid, GT);
    }
    SEAM(0);
    if (IN(1)) { PH_IDS ln_mod_phase(XIN, ctx, mods, 0, U, TALL, gw, NGW, lane); }
    SEAM(1);
    if (IN(2)) { SchedInProj S{U, WIN}; EpiStoreBf16 E{P, NMIX}; gemm_pg8<false>(lds, S, E, D, D, D); }
    SEAM(2);
    if (IN(3)) { PH_IDS attn_phase(P, rpb, MIX, lds, (LAS float*)(lds + LDSCTL_OFF + 1024)); conv_phase(P, conv_w, MIX, gtid, GT); }
    SEAM(3);
    if (IN(4)) { SchedDense S{MIX, WO, 64, 8, (size_t)256 * D, (size_t)256 * D}; EpiResid E{XIN, TB, mods + 2 * D}; gemm_pg8<false>(lds, S, E, D, D, D); }
    SEAM(4);
    if (IN(5)) { PH_IDS ln_router_phase(TB, ln_g, ln_b, mods, router_w, router_b, X1, U, ctl + CW_CNT, table, tokinfo, gw, NGW, lane); }
    SEAM(5);
    if (IN(6)) { PH_IDS moe_prefix(ctl + CW_CNT, l_cnt, l_tb, tid); SchedMoe S{l_cnt, l_tb, U, WGU, table, 1, 0, (size_t)D * D, (size_t)256 * D}; EpiSwiglu E{HB}; gemm_pg8<true>(lds, S, E, D, D, D); }
    SEAM(6);
    if (IN(7)) { PH_IDS moe_prefix(ctl + CW_CNT, l_cnt, l_tb, tid); SchedMoe S{l_cnt, l_tb, HB, WD, table, 0, (size_t)256 * DE, (size_t)D * DE, (size_t)256 * DE}; EpiStoreBf16 E{YB, D}; gemm_pg8<false>(lds, S, E, DE, DE, DE); }
    SEAM(7);
    if (IN(8)) { PH_IDS moe_prefix(ctl + CW_CNT, l_cnt, l_tb, tid); combine_phase(X1, YB, tokinfo, l_tb, mods, ln_g + D, ln_b + D, X2, mods + 5 * MODW, U, gw, NGW, lane); }
    SEAM(8);
    if (IN(9)) { SchedF1 S{CSM, U}; EpiF1 E{BT2}; gemm_pg8<false>(lds, S, E, 512, D, 512); }
    SEAM(9);
    if (IN(10)) { SchedF2 S{ACS, BT2}; EpiF2 E{REZ}; gemm_pg8<false>(lds, S, E, 8192, 8192, 8192); }
    SEAM(10);
    if (IN(11)) { SchedDense S{REZ, WF, 64, 8, (size_t)256 * D, (size_t)256 * D}; EpiResid E{X2, TB, mods + 5 * MODW + 2 * D}; gemm_pg8<false>(lds, S, E, D, D, D); }
    SEAM(11);
    if (IN(12)) { PH_IDS ln_router_phase(TB, ln_g + 2 * D, ln_b + 2 * D, mods + 5 * MODW, router_w, router_b, X1, U, ctl + CW_CNT + 32, table + (size_t)NE * T, tokinfo + (size_t)T * 8, gw, NGW, lane); }
    SEAM(12);
    if (IN(13)) { PH_IDS moe_prefix(ctl + CW_CNT + 32, l_cnt, l_tb, tid); SchedMoe S{l_cnt, l_tb, U, WGU + (size_t)NE * D * D, table + (size_t)NE * T, 1, 0, (size_t)D * D, (size_t)256 * D}; EpiSwiglu E{HB}; gemm_pg8<true>(lds, S, E, D, D, D); }
    SEAM(13);
    if (IN(14)) { PH_IDS moe_prefix(ctl + CW_CNT + 32, l_cnt, l_tb, tid); SchedMoe S{l_cnt, l_tb, HB, WD + (size_t)NE * D * DE, table, 0, (size_t)256 * DE, (size_t)D * DE, (size_t)256 * DE}; EpiStoreBf16 E{YB, D}; gemm_pg8<false>(lds, S, E, DE, DE, DE); }
    SEAM(14);
    if (IN(15)) { PH_IDS moe_prefix(ctl + CW_CNT + 32, l_cnt, l_tb, tid); combine_phase(X1, YB, tokinfo + (size_t)T * 8, l_tb, mods + 5 * MODW, ln_g + 3 * D, ln_b + 3 * D, args.out, nullptr, nullptr, gw, NGW, lane); }
#undef IN
#undef SEAM
}

extern "C" void kernel_launch(void* const* d_in, const int* in_sizes, int n_in, void* d_out, int out_size, void* d_ws, size_t ws_size, hipStream_t stream) {
    static int grid = 0;
    if (grid == 0) {
        if (n_in != 18 || out_size != T * D || ws_size < WS_END) { fprintf(stderr, "kernel_launch: unexpected shapes (n_in %d, out %d, ws %zu)\n", n_in, out_size, ws_size); grid = -1; return; }
        int dev = 0, cus = 0, per_cu = 0;
        if (hipGetDevice(&dev) != hipSuccess || hipDeviceGetAttribute(&cus, hipDeviceAttributeMultiprocessorCount, dev) != hipSuccess) { grid = -1; return; }
        if (hipFuncSetAttribute((const void*)fwd, hipFuncAttributeMaxDynamicSharedMemorySize, LDS_BYTES) != hipSuccess) { fprintf(stderr, "kernel_launch: hipFuncSetAttribute failed\n"); grid = -1; return; }
        if (hipOccupancyMaxActiveBlocksPerMultiprocessor(&per_cu, (const void*)fwd, 512, LDS_BYTES) != hipSuccess || per_cu < 1) fprintf(stderr, "kernel_launch: occupancy query says %d\n", per_cu);
        (void)hipGetLastError();
        grid = cus;
    }
    if (grid < 0) return;
    (void)hipMemsetAsync((char*)d_ws + WS_CTL, 0, CTL_ZERO_BYTES, stream);
    Args a{};
    for (int i = 0; i < 18; ++i) a.in[i] = (const float*)d_in[i];
    a.out = (float*)d_out; a.ws = (unsigned char*)d_ws;
    if (N_LAUNCHES == 1) { a.ph_lo = 0; a.ph_hi = NPHASE; hipLaunchKernelGGL(fwd, dim3(grid), dim3(512), LDS_BYTES, stream, a); }
    else for (int p = 0; p < NPHASE; ++p) { a.ph_lo = p; a.ph_hi = p + 1; hipLaunchKernelGGL(fwd, dim3(grid), dim3(512), LDS_BYTES, stream, a); }
}
```

```cpp
#include <hip/hip_runtime.h>
#include <cstdio>
#include <cstdint>

#define DI __device__ __forceinline__
#define LAS __attribute__((address_space(3)))
typedef unsigned short bf16;
typedef float f32x4 __attribute__((ext_vector_type(4)));
typedef short bf16x8 __attribute__((ext_vector_type(8)));
typedef unsigned u32x4 __attribute__((ext_vector_type(4)));
typedef unsigned u32x2 __attribute__((ext_vector_type(2)));

constexpr int D = 2048, NB = 4, SEQ = 4096, T = NB * SEQ, CTXL = 256, TC = NB * CTXL, TALL = T + TC;
constexpr int NMIX = 6144, NE = 32, DE = 1024, NH = 8, HD = 128, MODW = 6 * D;
constexpr float ALPHA = 1.41421356237309515f;
constexpr float LN_EPS = 1e-6f;
constexpr int NPHASE = 16;
#ifndef MK_N_LAUNCHES
#define MK_N_LAUNCHES 1
#endif
constexpr int N_LAUNCHES = MK_N_LAUNCHES;

constexpr size_t MiB = 1u << 20;
constexpr size_t WS_CTL = 0, CTL_ZERO_BYTES = 64 * 1024;
constexpr size_t WS_MODS = 1 * MiB;
constexpr size_t WS_TOKINFO = 2 * MiB;
constexpr size_t WS_TABLE = 4 * MiB;
constexpr size_t WS_WIN = 8 * MiB, WS_WO = 32 * MiB, WS_WF = 40 * MiB, WS_CS = 48 * MiB, WS_ACS = 64 * MiB;
constexpr size_t WS_U = 128 * MiB;
constexpr size_t WS_P = 196 * MiB;
constexpr size_t WS_MIX = 400 * MiB;
constexpr size_t WS_TB = 464 * MiB, WS_X1 = 592 * MiB, WS_X2 = 720 * MiB;
constexpr size_t WS_H = 848 * MiB;
constexpr size_t WS_WGU = 928 * MiB;
constexpr size_t WS_WD = 1440 * MiB;
constexpr size_t WS_END = 1696 * MiB;
constexpr int CW_CNT = 64;
constexpr int CW_BAR = 1024;

constexpr int LDS_SCR = 133120;
constexpr int LDSCTL_OFF = LDS_SCR;
constexpr int LDS_BYTES = 147456;

DI float wave_sum(float v) {
#pragma unroll
    for (int o = 1; o < 64; o <<= 1) v += __shfl_xor(v, o);
    return v;
}
DI float wave_max(float v) {
#pragma unroll
    for (int o = 1; o < 64; o <<= 1) v = fmaxf(v, __shfl_xor(v, o));
    return v;
}
DI unsigned f2bf(float f) { unsigned u = __float_as_uint(f); return (u + 0x7fffu + ((u >> 16) & 1u)) >> 16; }
DI unsigned pk2(float lo, float hi) { return f2bf(lo) | (f2bf(hi) << 16); }
DI float bflo(unsigned w) { return __uint_as_float(w << 16); }
DI float bfhi(unsigned w) { return __uint_as_float(w & 0xffff0000u); }
DI float silu_f(float v) { return v / (1.f + expf(-v)); }

#define XB_TMO      128
#define XB_XCNT(j)  (256  + 64 * (j))
#define XB_XSUB(j)  (1280 + 64 * (j))
#define XB_XGEN(j)  (2304 + 64 * (j))
#define XB_TOP      3328
#define XB_TOPGEN   3392
#define XCD_BAR_WORDS 3456
#define XB_SPIN_CAP (1u << 18)
__device__ __forceinline__ unsigned xb_ld(unsigned* p)              { return __hip_atomic_load(p, __ATOMIC_RELAXED, __HIP_MEMORY_SCOPE_AGENT); }
__device__ __forceinline__ unsigned xb_add(unsigned* p, unsigned v) { return __hip_atomic_fetch_add(p, v, __ATOMIC_RELAXED, __HIP_MEMORY_SCOPE_AGENT); }
__device__ __forceinline__ unsigned xb_xcc_id() { return (unsigned)__builtin_amdgcn_s_getreg((3 << 11) | 20) & 0xFu; }
#define XB_SPIN(cond, bar) do { unsigned _sp = 0; while (cond) { __builtin_amdgcn_s_sleep(1); \
    if ((++_sp & 255u) == 0u) { if (xb_ld(&(bar)[XB_TMO])) break; if (_sp > XB_SPIN_CAP) { atomicAdd(&(bar)[XB_TMO], 1u); break; } } } } while (0)
struct XcdBarrier { unsigned* bar; unsigned x; volatile LAS unsigned* st; };
__device__ __forceinline__ XcdBarrier xcd_barrier_post(unsigned* bar, volatile LAS unsigned* st) {
    XcdBarrier b; b.bar = bar; b.x = xb_xcc_id(); b.st = st;
    if (threadIdx.x == 0) (void)xb_add(&bar[XB_XCNT(b.x)], 1u);
    return b;
}
__device__ __forceinline__ void xcd_barrier_complete(unsigned* bar, unsigned x, unsigned& nloc, unsigned& nx) {
    const unsigned G = gridDim.x * gridDim.y * gridDim.z;
    unsigned sum, cnt, mine, sp = 0u;
    for (;;) {
        sum = 0u; cnt = 0u; mine = 0u;
#pragma unroll
        for (unsigned j = 0; j < 16; ++j) { const unsigned c = xb_ld(&bar[XB_XCNT(j)]); sum += c; cnt += (c > 0u) ? 1u : 0u; mine = (j == x) ? c : mine; }
        if (sum == G) break;
        __builtin_amdgcn_s_sleep(1);
        if ((++sp & 255u) == 0u) { if (xb_ld(&bar[XB_TMO])) break; if (sp > XB_SPIN_CAP) { atomicAdd(&bar[XB_TMO], 1u); break; } }
    }
    nloc = mine > 0u ? mine : 1u; nx = cnt > 0u ? cnt : 1u;
}
__device__ __forceinline__ void xcd_barrier(const XcdBarrier& b) {
    asm volatile("s_waitcnt vmcnt(0)" ::: "memory");
    __syncthreads();
    if (threadIdx.x == 0) {
        unsigned* bar = b.bar;
        __builtin_amdgcn_s_waitcnt(0);
        unsigned nloc = b.st[0], nx = b.st[1];
        if (nloc == 0u) { xcd_barrier_complete(bar, b.x, nloc, nx); b.st[0] = nloc; b.st[1] = nx; }
        const unsigned old = xb_add(&bar[XB_XSUB(b.x)], 1u);
        const unsigned gen = old / nloc;
        if (old + 1u == (gen + 1u) * nloc) {
            __builtin_amdgcn_fence(__ATOMIC_RELEASE, "agent");
            asm volatile("s_waitcnt vmcnt(0)" ::: "memory");
            const unsigned og = xb_add(&bar[XB_TOP], 1u);
            const unsigned tg = og / nx;
            if (og + 1u == (tg + 1u) * nx) xb_add(&bar[XB_TOPGEN], 1u);
            else XB_SPIN(xb_ld(&bar[XB_TOPGEN]) == tg, bar);
            __builtin_amdgcn_fence(__ATOMIC_ACQUIRE, "agent");
            xb_add(&bar[XB_XGEN(b.x)], 1u);
            asm volatile("s_waitcnt vmcnt(0)" ::: "memory");
        } else {
            XB_SPIN(xb_ld(&bar[XB_XGEN(b.x)]) == gen, bar);
            __builtin_amdgcn_fence(__ATOMIC_ACQUIRE, "agent");
            asm volatile("s_waitcnt vmcnt(0)" ::: "memory");
        }
    }
    __syncthreads();
}

struct Row { f32x4 v[8]; };
DI void row_load(Row& r, const float* p, int lane) { const f32x4* q = (const f32x4*)p + lane;
#pragma unroll
    for (int j = 0; j < 8; ++j) r.v[j] = q[64 * j]; }
DI void row_store(const Row& r, float* p, int lane) { f32x4* q = (f32x4*)p + lane;
#pragma unroll
    for (int j = 0; j < 8; ++j) q[64 * j] = r.v[j]; }
DI void row_store_bf16(const Row& r, bf16* p, int lane) { u32x2* q = (u32x2*)p + lane;
#pragma unroll
    for (int j = 0; j < 8; ++j) { u32x2 w; w.x = pk2(r.v[j].x, r.v[j].y); w.y = pk2(r.v[j].z, r.v[j].w); q[64 * j] = w; } }
DI void row_ln(Row& r) {
    float s = 0.f;
#pragma unroll
    for (int j = 0; j < 8; ++j) s += (r.v[j].x + r.v[j].y) + (r.v[j].z + r.v[j].w);
    const float mean = wave_sum(s) * (1.f / D); float s2 = 0.f;
#pragma unroll
    for (int j = 0; j < 8; ++j) { r.v[j] = r.v[j] - mean; s2 += (r.v[j].x * r.v[j].x + r.v[j].y * r.v[j].y) + (r.v[j].z * r.v[j].z + r.v[j].w * r.v[j].w); }
    const float rstd = 1.f / sqrtf(wave_sum(s2) * (1.f / D) + LN_EPS);
#pragma unroll
    for (int j = 0; j < 8; ++j) r.v[j] = r.v[j] * rstd;
}
DI void row_affine(Row& r, const float* g, const float* b, int lane) {
    const f32x4* gq = (const f32x4*)g + lane; const f32x4* bq = (const f32x4*)b + lane;
#pragma unroll
    for (int j = 0; j < 8; ++j) r.v[j] = r.v[j] * gq[64 * j] + bq[64 * j];
}
DI void row_modulate(Row& r, const float* sh, const float* sc, int lane) {
    const f32x4* hq = (const f32x4*)sh + lane; const f32x4* cq = (const f32x4*)sc + lane;
#pragma unroll
    for (int j = 0; j < 8; ++j) r.v[j] = r.v[j] * (cq[64 * j] + 1.f) + hq[64 * j];
}

struct Unit { const bf16* A; const bf16* B; const int* gat; int nvalid; int m0, n0, aux; };

template <class Sched, class Epi>
DI void gemm_simple(const Sched& S, const Epi& E, const int lda, const int ldb, const int K) {
    const int tid = threadIdx.x, wid = tid >> 6, lane = tid & 63, fr = lane & 15, fq = lane >> 4;
    for (int L = blockIdx.x; ; L += gridDim.x) {
        Unit u; if (!S.get(L, u)) break;
        const bf16* arow[2];
#pragma unroll
        for (int m = 0; m < 2; ++m) { const int r = 32 * wid + 16 * m + fr; size_t grow = (size_t)r; if (u.gat) grow = (size_t)(r < u.nvalid ? u.gat[r] : 0); arow[m] = u.A + grow * lda + fq * 8; }
        for (int cc = 0; cc < 4; ++cc) {
            f32x4 acc[2][4];
#pragma unroll
            for (int m = 0; m < 2; ++m)
#pragma unroll
                for (int j = 0; j < 4; ++j) acc[m][j] = (f32x4){0.f, 0.f, 0.f, 0.f};
            const bf16* brow[4];
#pragma unroll
            for (int j = 0; j < 4; ++j) { const int col = (j >> 1) * 128 + cc * 32 + (j & 1) * 16 + fr; brow[j] = u.B + (size_t)col * ldb + fq * 8; }
            for (int k = 0; k < K; k += 32) {
                bf16x8 a[2], b[4];
#pragma unroll
                for (int m = 0; m < 2; ++m) a[m] = *(const bf16x8*)(arow[m] + k);
#pragma unroll
                for (int j = 0; j < 4; ++j) b[j] = *(const bf16x8*)(brow[j] + k);
#pragma unroll
                for (int m = 0; m < 2; ++m)
#pragma unroll
                    for (int j = 0; j < 4; ++j) acc[m][j] = __builtin_amdgcn_mfma_f32_16x16x32_bf16(b[j], a[m], acc[m][j], 0, 0, 0);
            }
#pragma unroll
            for (int m = 0; m < 2; ++m)
#pragma unroll
                for (int nn = 0; nn < 2; ++nn) E(u, 32 * wid + 16 * m + fr, cc * 32 + nn * 16 + 4 * fq, acc[m][nn], acc[m][nn + 2]);
        }
    }
}


namespace pg8 {
constexpr int BK = 64, HALF = 128, HTB = HALF * BK * 2, STAGE_BYTES = 8 * HTB;
DI int lds_byte(int r, int c) { const int st = (r >> 4) * 2 + (c >> 5), rr = r & 15, cc = c & 31, ob = rr * 64 + cc * 2; return st * 1024 + (ob ^ (((ob >> 9) & 1) << 5)); }
DI void stage_rc(int b, int& R, int& C) { const int st = b / 1024, sb = b % 1024, swz = sb ^ (((sb >> 9) & 1) << 5); R = (st >> 1) * 16 + swz / 64; C = (st & 1) * 32 + (swz % 64) / 2; }
}
template <bool GATHER, class Sched, class Epi>
DI void gemm_pg8(LAS unsigned char* lds, const Sched& S, const Epi& E, const int lda, const int ldb, const int K) {
    using namespace pg8;
    const int tid = threadIdx.x, wid = __builtin_amdgcn_readfirstlane(tid >> 6), lane = tid & 63, wr = wid >> 2, wc = wid & 3, fr = lane & 15, fq = lane >> 4;
    const int nt = K / BK, G = gridDim.x, cblk = blockIdx.x;
    unsigned voffB[2], vA[2][2];
#pragma unroll
    for (int i = 0; i < 2; ++i) { int R_, C_; stage_rc(tid * 16 + i * 8192, R_, C_); voffB[i] = (unsigned)(R_ * ldb + C_) * 2u; }
    const size_t kstep = (size_t)(BK * 2), hstepA = (size_t)HALF * lda * 2, hstepB = (size_t)HALF * ldb * 2;
    const unsigned ldsw = (unsigned)wid * 1024u;
    const int aoff = lds_byte(wr * 64 + fr, fq * 8), boff = lds_byte(wc * 32 + fr, fq * 8);
#define PG8_SA(b, h) (((b) * 2 + (h)) * HTB)
#define PG8_SB(b, h) ((4 + (b) * 2 + (h)) * HTB)
#define PG8_STAGE(bufoff, gbase, voff) do { _Pragma("unroll") for (int _i = 0; _i < 2; ++_i) \
        __builtin_amdgcn_global_load_lds((const unsigned*)((const char*)(gbase) + (voff)[_i]), (LAS unsigned*)(lds + (bufoff) + ldsw + _i * 8192), 16, 0, 0); } while (0)
#define PG8_STAGE_A(bufoff, gbase, h) do { if constexpr (GATHER) PG8_STAGE(bufoff, gbase, vA[h]); else PG8_STAGE(bufoff, (gbase) + (h) * hstepA, vA[0]); } while (0)
#define PG8_LDA(dst, b, h) do { _Pragma("unroll") for (int m = 0; m < 4; ++m) _Pragma("unroll") for (int k = 0; k < 2; ++k) dst[m][k] = *(const LAS bf16x8*)(lds + PG8_SA(b, h) + aoff + m * 2048 + k * 1024); } while (0)
#define PG8_LDB(dst, b, h) do { _Pragma("unroll") for (int n = 0; n < 2; ++n) _Pragma("unroll") for (int k = 0; k < 2; ++k) dst[n][k] = *(const LAS bf16x8*)(lds + PG8_SB(b, h) + boff + n * 2048 + k * 1024); } while (0)
#define PG8_MMA(ai, bj, At, Bt) do { __builtin_amdgcn_s_setprio(1); _Pragma("unroll") for (int m = 0; m < 4; ++m) _Pragma("unroll") for (int n = 0; n < 2; ++n) _Pragma("unroll") for (int k = 0; k < 2; ++k) \
        acc[ai][bj][m][n] = __builtin_amdgcn_mfma_f32_16x16x32_bf16(Bt[n][k], At[m][k], acc[ai][bj][m][n], 0, 0, 0); __builtin_amdgcn_s_setprio(0); } while (0)
#define PG8_WAIT_V(n) asm volatile("s_waitcnt vmcnt(" #n ")" ::: "memory")
#define PG8_WAIT_L(n) asm volatile("s_waitcnt lgkmcnt(" #n ")" ::: "memory")
#define PG8_BAR __builtin_amdgcn_s_barrier()
#define PG8_SCHED __builtin_amdgcn_sched_barrier(0)
#define PG8_SETV(dst, u) do { _Pragma("unroll") for (int _h = 0; _h < 2; ++_h) _Pragma("unroll") for (int _i = 0; _i < 2; ++_i) { int _R, _C; stage_rc(tid * 16 + _i * 8192, _R, _C); const int _r = _h * HALF + _R; \
        if constexpr (GATHER) { const int _g = _r < (u).nvalid ? (u).gat[_r] : 0; dst[_h][_i] = (unsigned)(_g * lda + _C) * 2u; } else dst[_h][_i] = (unsigned)(_R * lda + _C) * 2u; } } while (0)
    Unit cur, nxt; int ui = 0;
    if (!S.get(cblk, cur)) return;
    f32x4 acc[2][2][4][2];
#pragma unroll
    for (int a = 0; a < 2; ++a)
#pragma unroll
        for (int b = 0; b < 2; ++b)
#pragma unroll
            for (int m = 0; m < 4; ++m)
#pragma unroll
                for (int n = 0; n < 2; ++n) acc[a][b][m][n] = (f32x4){0.f, 0.f, 0.f, 0.f};
    bf16x8 At[4][2], B0[2][2], B1[2][2];
    const char* cA = (const char*)cur.A; const char* cB = (const char*)cur.B;
    PG8_SETV(vA, cur);
    PG8_STAGE(PG8_SB(0, 0), cB, voffB); PG8_STAGE(PG8_SB(0, 1), cB + hstepB, voffB); PG8_STAGE_A(PG8_SA(0, 0), cA, 0); PG8_STAGE_A(PG8_SA(0, 1), cA, 1);
    if (wr == 1) PG8_BAR;
    PG8_WAIT_V(2); PG8_BAR;
    PG8_STAGE(PG8_SB(1, 0), cB + kstep, voffB); PG8_STAGE_A(PG8_SA(1, 0), cA + kstep, 0); PG8_STAGE(PG8_SB(1, 1), cB + hstepB + kstep, voffB);
    PG8_WAIT_V(6); PG8_BAR;
    for (;;) {
        const bool has_next = S.get((ui + 1) * G + cblk, nxt);
        const char* nA = has_next ? (const char*)nxt.A : cA; const char* nB = has_next ? (const char*)nxt.B : cB;
        for (int t = 0; t < nt; t += 2) {
            const bool last = (t == nt - 2);
            const char* a1 = cA + (size_t)(t + 1) * kstep;
            const char* a2 = last ? nA : cA + (size_t)(t + 2) * kstep; const char* b2 = last ? nB : cB + (size_t)(t + 2) * kstep;
            const char* a3 = a2 + kstep; const char* b3 = b2 + kstep;
            PG8_LDB(B0, 0, 0); PG8_LDB(B1, 0, 1); PG8_SCHED; PG8_LDA(At, 0, 0); PG8_STAGE_A(PG8_SA(1, 1), a1, 1);
            PG8_WAIT_V(8); PG8_WAIT_L(0); PG8_BAR; PG8_MMA(0, 0, At, B0); PG8_MMA(0, 1, At, B1); PG8_BAR; PG8_SCHED;
            if constexpr (GATHER) { if (last && has_next) PG8_SETV(vA, nxt); }
            PG8_LDA(At, 0, 1); PG8_STAGE(PG8_SB(0, 0), b2, voffB); PG8_STAGE(PG8_SB(0, 1), b2 + hstepB, voffB); PG8_STAGE_A(PG8_SA(0, 0), a2, 0);
            PG8_WAIT_V(8); PG8_WAIT_L(0); PG8_BAR; PG8_MMA(1, 0, At, B0); PG8_MMA(1, 1, At, B1); PG8_BAR; PG8_SCHED;
            PG8_LDB(B0, 1, 0); PG8_LDB(B1, 1, 1); PG8_SCHED; PG8_LDA(At, 1, 0); PG8_STAGE_A(PG8_SA(0, 1), a2, 1);
            PG8_WAIT_V(8); PG8_WAIT_L(0); PG8_BAR; PG8_MMA(0, 0, At, B0); PG8_MMA(0, 1, At, B1); PG8_BAR; PG8_SCHED;
            PG8_LDA(At, 1, 1); PG8_STAGE(PG8_SB(1, 0), b3, voffB); PG8_STAGE(PG8_SB(1, 1), b3 + hstepB, voffB); PG8_STAGE_A(PG8_SA(1, 0), a3, 0);
            PG8_WAIT_V(8); PG8_WAIT_L(0); PG8_BAR; PG8_MMA(1, 0, At, B0); PG8_MMA(1, 1, At, B1); PG8_BAR; PG8_SCHED;
        }
        if (wr == 0) PG8_BAR;
#pragma unroll
        for (int ai = 0; ai < 2; ++ai)
#pragma unroll
            for (int m = 0; m < 4; ++m)
#pragma unroll
                for (int n = 0; n < 2; ++n) E(cur, ai * HALF + wr * 64 + m * 16 + fr, wc * 32 + n * 16 + 4 * fq, acc[ai][0][m][n], acc[ai][1][m][n]);
        if (!has_next) break;
#pragma unroll
        for (int a = 0; a < 2; ++a)
#pragma unroll
            for (int b = 0; b < 2; ++b)
#pragma unroll
                for (int m = 0; m < 4; ++m)
#pragma unroll
                    for (int n = 0; n < 2; ++n) acc[a][b][m][n] = (f32x4){0.f, 0.f, 0.f, 0.f};
        cur = nxt; cA = nA; cB = nB; ++ui;
        if (wr == 1) PG8_BAR;
    }
    PG8_WAIT_V(0);
    PG8_BAR;
#undef PG8_SA
#undef PG8_SB
#undef PG8_STAGE
#undef PG8_STAGE_A
#undef PG8_LDA
#undef PG8_LDB
#undef PG8_MMA
#undef PG8_WAIT_V
#undef PG8_WAIT_L
#undef PG8_BAR
#undef PG8_SCHED
#undef PG8_SETV
}

DI int xcd_remap(int L, int n) { const int q = n >> 3, r = n & 7, xcd = L & 7, off = L >> 3; return (xcd < r ? xcd * (q + 1) : r * (q + 1) + (xcd - r) * q) + off; }
DI void grouped(int wgid, int nM, int nN, int& pm, int& pn) { const int nig = 8 * nN, gid = wgid / nig, fm = gid * 8, gsz = min(nM - fm, 8); pm = fm + (wgid % nig) % gsz; pn = (wgid % nig) / gsz; }

struct SchedInProj { const bf16* U; const bf16* W;
    DI bool get(int L, Unit& u) const { int pm, pn;
        if (L >= 64 * 24 + 32) return false; const int w = xcd_remap(L, 64 * 24 + 32);
        if (w < 64 * 24) grouped(w, 64, 24, pm, pn); else { const int l2 = w - 64 * 24; pm = 64 + (l2 >> 3); pn = 4 + (l2 & 7); }
        u.A = U + (size_t)pm * 256 * D; u.B = W + (size_t)pn * 256 * D; u.gat = nullptr; u.nvalid = 256; u.m0 = pm * 256; u.n0 = pn * 256; u.aux = 0; return true; } };
struct SchedDense { const bf16* A; const bf16* B; int nM, nN; size_t a_t, b_t;
    DI bool get(int L, Unit& u) const { if (L >= nM * nN) return false; int pm, pn; grouped(xcd_remap(L, nM * nN), nM, nN, pm, pn);
        u.A = A + (size_t)pm * a_t; u.B = B + (size_t)pn * b_t; u.gat = nullptr; u.nvalid = 256; u.m0 = pm * 256; u.n0 = pn * 256; u.aux = 0; return true; } };
struct SchedMoe { const LAS int* cnt; const LAS int* tb; const bf16* A; const bf16* W; const int* table; int gather; size_t a_t, w_e, w_t;
    DI bool get(int L, Unit& u) const { const int nT = __builtin_amdgcn_readfirstlane(tb[32]); if (L >= nT * 8) return false; int t, pn; grouped(xcd_remap(L, nT * 8), nT, 8, t, pn);
        int e = 0;
        for (int i = 1; i < 32; ++i) e = (tb[i] <= t) ? i : e;
        e = __builtin_amdgcn_readfirstlane(e); t = __builtin_amdgcn_readfirstlane(t); pn = __builtin_amdgcn_readfirstlane(pn);
        const int mt = __builtin_amdgcn_readfirstlane(t - tb[e]);
        if (gather) { u.A = A; u.gat = table + (size_t)e * T + mt * 256; } else { u.A = A + (size_t)t * a_t; u.gat = nullptr; }
        u.nvalid = __builtin_amdgcn_readfirstlane(min(256, cnt[e] - mt * 256));
        u.B = W + (size_t)e * w_e + (size_t)pn * w_t; u.m0 = t * 256; u.n0 = pn * 256; u.aux = e; return true; } };
struct SchedF1 { const bf16* CS; const bf16* U;
    DI bool get(int L, Unit& u) const { if (L >= 1024) return false; const int b = L >> 8, g = (L >> 6) & 3, pm = (L >> 4) & 3, pn = L & 15;
        u.A = CS + (size_t)pm * 256 * 512; u.B = U + ((size_t)b * SEQ + pn * 256) * D + g * 512; u.gat = nullptr; u.nvalid = 256; u.m0 = pm * 256; u.n0 = pn * 256; u.aux = b * 4 + g; return true; } };
struct SchedF2 { const bf16* ACS; const bf16* BT2;
    DI bool get(int L, Unit& u) const { if (L >= 512) return false; const int b = L >> 7, pm = (L >> 3) & 15, pn = L & 7;
        u.A = ACS + (size_t)pm * 256 * 8192; u.B = BT2 + ((size_t)b * D + pn * 256) * 8192; u.gat = nullptr; u.nvalid = 256; u.m0 = pm * 256; u.n0 = pn * 256; u.aux = b; return true; } };

DI void st_bf16x4(bf16* p, f32x4 v) { u32x2 w; w.x = pk2(v.x, v.y); w.y = pk2(v.z, v.w); *(u32x2*)p = w; }
struct EpiStoreBf16 { bf16* O; int ldc;
    DI void operator()(const Unit& u, int r, int c, f32x4 lo, f32x4 hi) const { bf16* p = O + (size_t)(u.m0 + r) * ldc + u.n0 + c; st_bf16x4(p, lo); st_bf16x4(p + 128, hi); } };
struct EpiResid { const float* x; float* t; const float* gate;
    DI void operator()(const Unit& u, int r, int c, f32x4 lo, f32x4 hi) const { const int row = u.m0 + r, b = row >> 12; const int col = u.n0 + c;
        const size_t o = (size_t)row * D + col; const float* g = gate + (size_t)b * MODW + col;
        *(f32x4*)(t + o) = *(const f32x4*)(x + o) * ALPHA + *(const f32x4*)g * lo;
        *(f32x4*)(t + o + 128) = *(const f32x4*)(x + o + 128) * ALPHA + *(const f32x4*)(g + 128) * hi; } };
struct EpiSwiglu { bf16* H;
    DI void operator()(const Unit& u, int r, int c, f32x4 lo, f32x4 hi) const { f32x4 h;
        h.x = silu_f(lo.x) * hi.x; h.y = silu_f(lo.y) * hi.y; h.z = silu_f(lo.z) * hi.z; h.w = silu_f(lo.w) * hi.w;
        st_bf16x4(H + (size_t)(u.m0 + r) * DE + (u.n0 >> 1) + c, h); } };
struct EpiF1 { bf16* BT2;
    DI void operator()(const Unit& u, int r, int c, f32x4 lo, f32x4 hi) const { const int b = u.aux >> 2, g = u.aux & 3, m = u.m0 + r, cs = m >> 9, cp = m & 511;
        bf16* p = BT2 + ((size_t)b * D + g * 512 + cp) * 8192 + cs * 4096 + u.n0 + c; st_bf16x4(p, lo); st_bf16x4(p + 128, hi); } };
struct EpiF2 { bf16* REZ;
    DI void operator()(const Unit& u, int r, int c, f32x4 lo, f32x4 hi) const { bf16* p = REZ + ((size_t)u.aux * SEQ + u.m0 + r) * D + u.n0 + c; st_bf16x4(p, lo); st_bf16x4(p + 128, hi); } };

DI void p0_mods(const float* c, const float* cctx, const float* ada_w, const float* ada_b, float* mods, LAS float* sl, int tid) {
    LAS float* red = sl + 5 * D;
    for (int i = tid; i < 5 * D; i += 512) { const float v = i < 4 * D ? c[i] : cctx[i - 4 * D]; sl[i] = silu_f(v); }
    __syncthreads();
    const int cq = tid & 127, ks = tid >> 7;
    for (int unit = blockIdx.x; unit < 192; unit += gridDim.x) {
        const int l = unit / 96, n = (unit % 96) * 128 + cq;
        const float* W = ada_w + (size_t)l * D * MODW + n;
        float a0 = 0.f, a1 = 0.f, a2 = 0.f, a3 = 0.f, a4 = 0.f;
#pragma unroll 8
        for (int k = ks * 512; k < ks * 512 + 512; ++k) { const float w = W[(size_t)k * MODW]; a0 += sl[k] * w; a1 += sl[D + k] * w; a2 += sl[2 * D + k] * w; a3 += sl[3 * D + k] * w; a4 += sl[4 * D + k] * w; }
        red[(ks * 5 + 0) * 128 + cq] = a0; red[(ks * 5 + 1) * 128 + cq] = a1; red[(ks * 5 + 2) * 128 + cq] = a2; red[(ks * 5 + 3) * 128 + cq] = a3; red[(ks * 5 + 4) * 128 + cq] = a4;
        __syncthreads();
        for (int i = tid; i < 640; i += 512) { const int r = i >> 7, q = i & 127, n2 = (unit % 96) * 128 + q;
            const float s = (red[(0 * 5 + r) * 128 + q] + red[(1 * 5 + r) * 128 + q]) + (red[(2 * 5 + r) * 128 + q] + red[(3 * 5 + r) * 128 + q]);
            mods[((size_t)l * 5 + r) * MODW + n2] = s + ada_b[(size_t)l * MODW + n2]; }
        __syncthreads();
    }
}
DI void tr_item(const float* W, int N, int Kd, int k0, int n0, bf16* WT, int drow0, LAS unsigned char* scr, int lane) {
    const int ng = lane & 15, kl = lane >> 4;
    f32x4 v[2][8];
    const float* src = W + (size_t)(k0 + 16 * kl) * N + n0 + 4 * ng;
#pragma unroll
    for (int pp = 0; pp < 2; ++pp)
#pragma unroll
        for (int i = 0; i < 8; ++i) v[pp][i] = *(const f32x4*)(src + (size_t)(8 * pp + i) * N);
#pragma unroll
    for (int pp = 0; pp < 2; ++pp)
#pragma unroll
        for (int c = 0; c < 4; ++c) { u32x4 o; o.x = pk2(v[pp][0][c], v[pp][1][c]); o.y = pk2(v[pp][2][c], v[pp][3][c]); o.z = pk2(v[pp][4][c], v[pp][5][c]); o.w = pk2(v[pp][6][c], v[pp][7][c]);
            *(LAS u32x4*)(scr + (4 * ng + c) * 144 + (16 * kl + 8 * pp) * 2) = o; }
    asm volatile("s_waitcnt lgkmcnt(0)" ::: "memory");
#pragma unroll
    for (int j = 0; j < 8; ++j) { const int row = (lane >> 3) + 8 * j, ch = lane & 7;
        const u32x4 o = *(const LAS u32x4*)(scr + row * 144 + ch * 16);
        *(u32x4*)(WT + (size_t)(drow0 + row) * Kd + k0 + 8 * ch) = o; }
    asm volatile("s_waitcnt lgkmcnt(0)" ::: "memory");
}
DI void p0_weights(const float* w_in, const float* w_out, const float* w_f, const float* w_gate, const float* w_up, const float* w_down,
                   bf16* WIN, bf16* WO, bf16* WF, bf16* WGU, bf16* WD, LAS unsigned char* scr, int gw, int NGW, int lane) {
    constexpr int I_IN = 32 * 96, I_SQ = 32 * 32, I_E = 64 * 512;
    constexpr int NIT = I_IN + 2 * I_SQ + 3 * I_E;
    for (int it = gw; it < NIT; it += NGW) {
        int r = it;
        if (r < I_IN) { const int kb = r / 96, nb = r % 96; tr_item(w_in, NMIX, D, kb * 64, nb * 64, WIN, nb * 64, scr, lane); continue; } r -= I_IN;
        if (r < I_SQ) { const int kb = r >> 5, nb = r & 31; tr_item(w_out, D, D, kb * 64, nb * 64, WO, nb * 64, scr, lane); continue; } r -= I_SQ;
        if (r < I_SQ) { const int kb = r >> 5, nb = r & 31; tr_item(w_f, D, D, kb * 64, nb * 64, WF, nb * 64, scr, lane); continue; } r -= I_SQ;
        if (r < 2 * I_E) { const int up = r >= I_E; if (up) r -= I_E; const int mat = r >> 9, rr = r & 511, kb = rr >> 4, nb = rr & 15, n0 = nb * 64;
            tr_item((up ? w_up : w_gate) + (size_t)mat * D * DE, DE, D, kb * 64, n0, WGU + (size_t)mat * D * D, (n0 >> 7) * 256 + (n0 & 127) + (up ? 128 : 0), scr, lane); continue; } r -= 2 * I_E;
        { const int mat = r >> 9, rr = r & 511, kb = rr >> 5, nb = rr & 31; tr_item(w_down + (size_t)mat * DE * D, D, DE, kb * 64, nb * 64, WD + (size_t)mat * D * DE, nb * 64, scr, lane); }
    }
}
DI void p0_dft(bf16* ACS, bf16* CS, int gtid, int GT) {
    for (int i = gtid; i < 4096 * 1024; i += GT) { const int j = i >> 10, k8 = (i & 1023) * 8; unsigned w[4];
#pragma unroll
        for (int e = 0; e < 4; ++e) { float v[2];
#pragma unroll
            for (int q = 0; q < 2; ++q) { const int kk = k8 + 2 * e + q; const int m = (j * (kk & 4095)) & 4095; const float ang = (float)m * (1.f / 2048.f); v[q] = (kk < 4096 ? cospif(ang) : -sinpif(ang)) * (1.f / 64.f); }
            w[e] = pk2(v[0], v[1]); }
        *(u32x4*)(ACS + (size_t)j * 8192 + k8) = (u32x4){w[0], w[1], w[2], w[3]}; }
    for (int i = gtid; i < 1024 * 64; i += GT) { const int rr = i >> 6, c8 = (i & 63) * 8, cs = rr >> 9, cp = rr & 511; unsigned w[4];
#pragma unroll
        for (int e = 0; e < 4; ++e) { float v[2];
#pragma unroll
            for (int q = 0; q < 2; ++q) { const int cc = c8 + 2 * e + q; const int m = (cc * cp) & 511; const float ang = (float)m * (1.f / 256.f); v[q] = (cs ? sinpif(ang) : cospif(ang)) * 0.04419417382415922f; }
            w[e] = pk2(v[0], v[1]); }
        *(u32x4*)(CS + (size_t)rr * 512 + c8) = (u32x4){w[0], w[1], w[2], w[3]}; }
}
DI void ln_mod_phase(const float* x, const float* ctx, const float* mods_l, int sh_chunk, bf16* U, int nrows, int gw, int NGW, int lane) {
    for (int row = gw; row < nrows; row += NGW) {
        const float* src = row < T ? x + (size_t)row * D : ctx + (size_t)(row - T) * D; const int rb = row < T ? (row >> 12) : 4;
        Row r; row_load(r, src, lane); row_ln(r);
        const float* mr = mods_l + (size_t)rb * MODW + sh_chunk * D;
        row_modulate(r, mr, mr + D, lane);
        row_store_bf16(r, U + (size_t)row * D, lane);
    }
}
DI void attn_simple(const bf16* P, const float* rpb, bf16* MIX, LAS float* scr, int gw, int NGW, int lane) {
    const float scale = 0.08838834764831845f;
    for (int item = gw; item < T * NH; item += NGW) {
        const int tok = item >> 3, h = item & 7, b = tok >> 12, l = tok & 4095, r = l >> 6, qc = l & 63;
        const int rs = min(max(r - 4, 0), 56), cs = min(max(qc - 8, 0), 48);
        { const unsigned w = *((const unsigned*)(P + (size_t)tok * NMIX + h * HD) + lane); scr[2 * lane] = bflo(w); scr[2 * lane + 1] = bfhi(w); }
        asm volatile("s_waitcnt lgkmcnt(0)" ::: "memory");
        float s[6];
#pragma unroll
        for (int i = 0; i < 6; ++i) {
            const int kk = lane + 64 * i; size_t krow; float bias = 0.f;
            if (kk < 128) { const int a = kk >> 4, j = kk & 15; krow = (size_t)b * SEQ + 64 * (rs + a) + cs + j; bias = rpb[(h * 15 + (rs + a - r + 7)) * 31 + (cs + j - qc + 15)]; }
            else krow = (size_t)T + b * CTXL + (kk - 128);
            const u32x4* kp = (const u32x4*)(P + krow * NMIX + D / 2 + h * HD);
            float acc = 0.f;
#pragma unroll 4
            for (int d8 = 0; d8 < 16; ++d8) { const u32x4 kv = kp[d8]; const LAS f32x4* qv = (const LAS f32x4*)scr + 2 * d8; const f32x4 q0 = qv[0], q1 = qv[1];
                acc += bflo(kv.x) * q0.x + bfhi(kv.x) * q0.y + bflo(kv.y) * q0.z + bfhi(kv.y) * q0.w + bflo(kv.z) * q1.x + bfhi(kv.z) * q1.y + bflo(kv.w) * q1.z + bfhi(kv.w) * q1.w; }
            s[i] = acc * scale + bias;
        }
        float m = s[0];
#pragma unroll
        for (int i = 1; i < 6; ++i) m = fmaxf(m, s[i]);
        m = wave_max(m); float sum = 0.f;
#pragma unroll
        for (int i = 0; i < 6; ++i) { s[i] = expf(s[i] - m); sum += s[i]; scr[128 + lane + 64 * i] = s[i]; }
        sum = wave_sum(sum);
        asm volatile("s_waitcnt lgkmcnt(0)" ::: "memory");
        float o0 = 0.f, o1 = 0.f;
        for (int kk = 0; kk < 384; ++kk) {
            size_t vrow; if (kk < 128) vrow = (size_t)b * SEQ + 64 * (rs + (kk >> 4)) + cs + (kk & 15); else vrow = (size_t)T + b * CTXL + (kk - 128);
            const unsigned w = *((const unsigned*)(P + vrow * NMIX + D + h * HD) + lane); const float p = scr[128 + kk];
            o0 += p * bflo(w); o1 += p * bfhi(w);
        }
        const float inv = 1.f / sum;
        *((unsigned*)(MIX + (size_t)tok * D + h * HD) + lane) = pk2(o0 * inv, o1 * inv);
        asm volatile("s_waitcnt lgkmcnt(0)" ::: "memory");
    }
}

constexpr int ATT_RS = 288, ATT_TILE = 64 * ATT_RS, ATT_BUF = 2 * ATT_TILE;
typedef short s16x4 __attribute__((ext_vector_type(4)));
struct AttState { f32x4 sc[32]; unsigned pk[32][2]; f32x4 o[8]; u32x4 stg[4]; bf16x8 qf[4]; float inv; unsigned g_off, w_off, ka_off, va_off; };
struct AttCtx { const bf16* P; LAS unsigned char* lds; const LAS float* lrpb; int b, r, rs, hp, hs, c0, qc, csq, quad; };
template <int STEP> DI void att_load(AttState& S, const AttCtx& C) {
    constexpr int ti = STEP % 12; const int colb = (STEP < 12 ? 1024 : 2048) + C.hp * 256;
    const size_t tok0 = ti < 8 ? (size_t)C.b * SEQ + 64 * (C.rs + ti) : (size_t)T + C.b * CTXL + (ti - 8) * 64;
    const char* ub = (const char*)(C.P + tok0 * NMIX + colb);
#pragma unroll
    for (int k = 0; k < 4; ++k) S.stg[k] = *(const u32x4*)(ub + (size_t)(32 * (k & 1)) * NMIX * 2 + (k >> 1) * 256 + S.g_off);
}
template <int BUFI> DI void att_write(AttState& S, const AttCtx& C) {
#pragma unroll
    for (int k = 0; k < 4; ++k) *(LAS u32x4*)(C.lds + BUFI * ATT_BUF + (k >> 1) * ATT_TILE + 32 * (k & 1) * ATT_RS + S.w_off) = S.stg[k];
}
template <int STEP> DI void att_step(AttState& S, const AttCtx& C) {
    const float scale = 0.08838834764831845f;
    asm volatile("" : "+v"(S.g_off), "+v"(S.w_off), "+v"(S.ka_off), "+v"(S.va_off));
    if constexpr (STEP + 1 < 24) att_load<STEP + 1>(S, C);
    constexpr int bo = (STEP & 1) * ATT_BUF;
    if constexpr (STEP < 12) {
        constexpr int ti = STEP;
        if constexpr (ti < 8) {
            const int aidx = C.rs + ti - C.r + 7;
            const LAS float* brow = C.lrpb + C.hs * 465 + aidx * 31;
#pragma unroll
            for (int t = 0; t < 2; ++t) { const int krow0 = C.c0 + 16 * t; f32x4 acc = (f32x4){0.f, 0.f, 0.f, 0.f};
                const LAS unsigned char* ka = C.lds + bo + krow0 * ATT_RS + S.ka_off;
#pragma unroll
                for (int s4 = 0; s4 < 4; ++s4) acc = __builtin_amdgcn_mfma_f32_16x16x32_bf16(*(const LAS bf16x8*)(ka + s4 * 64), S.qf[s4], acc, 0, 0, 0);
#pragma unroll
                for (int i = 0; i < 4; ++i) { const int kcol = krow0 + C.quad * 4 + i; const bool ok = kcol >= C.csq && kcol < C.csq + 16; const int bi = min(max(kcol - C.qc + 15, 0), 30);
                    const float bias = brow[bi]; S.sc[ti * 2 + t][i] = ok ? acc[i] * scale + bias : -1e30f; } }
        } else {
#pragma unroll
            for (int t = 0; t < 4; ++t) { f32x4 acc = (f32x4){0.f, 0.f, 0.f, 0.f};
                const LAS unsigned char* ka = C.lds + bo + 16 * t * ATT_RS + S.ka_off;
#pragma unroll
                for (int s4 = 0; s4 < 4; ++s4) acc = __builtin_amdgcn_mfma_f32_16x16x32_bf16(*(const LAS bf16x8*)(ka + s4 * 64), S.qf[s4], acc, 0, 0, 0);
                S.sc[16 + (ti - 8) * 4 + t] = acc * scale; }
        }
    } else {
        if constexpr (STEP == 12) {
            float m = -1e30f;
#pragma unroll
            for (int sl = 0; sl < 32; ++sl) m = fmaxf(fmaxf(m, fmaxf(S.sc[sl][0], S.sc[sl][1])), fmaxf(S.sc[sl][2], S.sc[sl][3]));
            m = fmaxf(m, __shfl_xor(m, 16)); m = fmaxf(m, __shfl_xor(m, 32));
            float sum = 0.f;
#pragma unroll
            for (int sl = 0; sl < 32; ++sl) { const float e0 = __expf(S.sc[sl][0] - m), e1 = __expf(S.sc[sl][1] - m), e2 = __expf(S.sc[sl][2] - m), e3 = __expf(S.sc[sl][3] - m);
                sum += (e0 + e1) + (e2 + e3); S.pk[sl][0] = pk2(e0, e1); S.pk[sl][1] = pk2(e2, e3); }
            sum += __shfl_xor(sum, 16); sum += __shfl_xor(sum, 32); S.inv = 1.f / sum;
#pragma unroll
            for (int dt = 0; dt < 8; ++dt) S.o[dt] = (f32x4){0.f, 0.f, 0.f, 0.f};
        }
        constexpr int ti = STEP - 12; constexpr int nks = ti < 8 ? 1 : 2;
#pragma unroll
        for (int kk = 0; kk < nks; ++kk) {
            const int sa = ti < 8 ? ti * 2 : 16 + (ti - 8) * 4 + 2 * kk; const int rb = ti < 8 ? C.c0 : 32 * kk;
            const u32x4 pw = (u32x4){S.pk[sa][0], S.pk[sa][1], S.pk[sa + 1][0], S.pk[sa + 1][1]}; const bf16x8 pf = __builtin_bit_cast(bf16x8, pw);
            const LAS unsigned char* va = C.lds + bo + rb * ATT_RS + S.va_off;
#pragma unroll
            for (int dt = 0; dt < 8; ++dt) { const s16x4 v1 = __builtin_amdgcn_ds_read_tr16_b64_v4i16((LAS s16x4*)(va + dt * 32)); const s16x4 v2 = __builtin_amdgcn_ds_read_tr16_b64_v4i16((LAS s16x4*)(va + 16 * ATT_RS + dt * 32));
                const bf16x8 vf = __builtin_shufflevector(v1, v2, 0, 1, 2, 3, 4, 5, 6, 7); S.o[dt] = __builtin_amdgcn_mfma_f32_16x16x32_bf16(vf, pf, S.o[dt], 0, 0, 0); }
        }
    }
    if constexpr (STEP + 1 < 24) att_write<(STEP + 1) & 1>(S, C);
    __syncthreads();
}
DI void attn_phase(const bf16* P, const float* rpb, bf16* MIX, LAS unsigned char* lds, LAS float* lrpb) {
    const int tid = threadIdx.x, wid = __builtin_amdgcn_readfirstlane(tid >> 6), lane = tid & 63, hs = wid >> 2, j = wid & 3, lq = lane & 15, quad = lane >> 4;
    const int srow = tid >> 4, sch = tid & 15;
    AttState S; AttCtx C;
    C.P = P; C.lds = lds; C.lrpb = lrpb; C.hs = hs; C.quad = quad;
    C.c0 = (j == 0) ? 0 : (j == 1) ? 8 : (j == 2) ? 24 : 32;
    C.qc = 16 * j + lq; C.csq = min(max(C.qc - 8, 0), 48);
    S.g_off = (unsigned)(srow * NMIX + sch * 8) * 2u;
    S.w_off = (unsigned)(srow * ATT_RS + sch * 16);
    S.ka_off = (unsigned)(hs * ATT_TILE + lq * ATT_RS + quad * 16);
    S.va_off = (unsigned)(hs * ATT_TILE + (4 * quad + (lq >> 2)) * ATT_RS + 8 * (lq & 3));
    for (int unit = blockIdx.x; unit < 1024; unit += gridDim.x) {
        const int r = unit & 63, hp = (unit >> 6) & 3, b = unit >> 8, h = 2 * hp + hs;
        C.r = r; C.hp = hp; C.b = b; C.rs = min(max(r - 4, 0), 56);
        __syncthreads();
        for (int i = tid; i < 930; i += 512) lrpb[i] = rpb[(size_t)hp * 930 + i];
        const size_t tq = (size_t)b * SEQ + 64 * r + C.qc;
#pragma unroll
        for (int s4 = 0; s4 < 4; ++s4) S.qf[s4] = *(const bf16x8*)(P + tq * NMIX + h * HD + s4 * 32 + quad * 8);
        att_load<0>(S, C); att_write<0>(S, C); __syncthreads();
        att_step<0>(S, C); att_step<1>(S, C); att_step<2>(S, C); att_step<3>(S, C); att_step<4>(S, C); att_step<5>(S, C); att_step<6>(S, C); att_step<7>(S, C);
        att_step<8>(S, C); att_step<9>(S, C); att_step<10>(S, C); att_step<11>(S, C); att_step<12>(S, C); att_step<13>(S, C); att_step<14>(S, C); att_step<15>(S, C);
        att_step<16>(S, C); att_step<17>(S, C); att_step<18>(S, C); att_step<19>(S, C); att_step<20>(S, C); att_step<21>(S, C); att_step<22>(S, C); att_step<23>(S, C);
        bf16* op = MIX + tq * D + h * HD + quad * 4;
#pragma unroll
        for (int dt = 0; dt < 8; ++dt) st_bf16x4(op + dt * 16, S.o[dt] * S.inv);
    }
}

DI void conv_phase(const bf16* P, const float* cw, bf16* MIX, int gtid, int GT) {
    for (int i = gtid; i < T * 128; i += GT) {
        const int tok = i >> 7, c8 = (i & 127) * 8, l = tok & 4095;
        const bf16* base = P + (size_t)tok * NMIX + 3072 + c8;
        const u32x4 gb = *(const u32x4*)base;
        float z[3][8];
#pragma unroll
        for (int j = 0; j < 3; ++j) { const int ll = l + j - 1; const bool ok = ll >= 0 && ll < SEQ;
            u32x4 gc = (u32x4){0u, 0u, 0u, 0u}, xi = gc;
            if (ok) { const bf16* pj = base + (ptrdiff_t)(j - 1) * NMIX; gc = *(const u32x4*)(pj + 1024); xi = *(const u32x4*)(pj + 2048); }
            z[j][0] = bflo(gc.x) * bflo(xi.x); z[j][1] = bfhi(gc.x) * bfhi(xi.x); z[j][2] = bflo(gc.y) * bflo(xi.y); z[j][3] = bfhi(gc.y) * bfhi(xi.y);
            z[j][4] = bflo(gc.z) * bflo(xi.z); z[j][5] = bfhi(gc.z) * bfhi(xi.z); z[j][6] = bflo(gc.w) * bflo(xi.w); z[j][7] = bfhi(gc.w) * bfhi(xi.w); }
        float gbf[8] = {bflo(gb.x), bfhi(gb.x), bflo(gb.y), bfhi(gb.y), bflo(gb.z), bfhi(gb.z), bflo(gb.w), bfhi(gb.w)};
        float o[8];
#pragma unroll
        for (int e = 0; e < 8; ++e) o[e] = gbf[e] * (cw[c8 + e] * z[0][e] + cw[1024 + c8 + e] * z[1][e] + cw[2048 + c8 + e] * z[2][e]);
        *(u32x4*)(MIX + (size_t)tok * D + 1024 + c8) = (u32x4){pk2(o[0], o[1]), pk2(o[2], o[3]), pk2(o[4], o[5]), pk2(o[6], o[7])};
    }
}
constexpr int RT_RS = 4112, RT_IMG = 16 * RT_RS;
DI void split_bf16(const float* w8, bf16x8& hi, bf16x8& lo) {
    unsigned h[4], l[4];
#pragma unroll
    for (int p = 0; p < 4; ++p) { const unsigned a = f2bf(w8[2 * p]), b = f2bf(w8[2 * p + 1]); h[p] = a | (b << 16);
        l[p] = pk2(w8[2 * p] - __uint_as_float(a << 16), w8[2 * p + 1] - __uint_as_float(b << 16)); }
    hi = __builtin_bit_cast(bf16x8, (u32x4){h[0], h[1], h[2], h[3]}); lo = __builtin_bit_cast(bf16x8, (u32x4){l[0], l[1], l[2], l[3]});
}
DI void ln_router_phase(const float* TBp, const float* lng, const float* lnb, const float* mods_l, const float* rw, const float* rbias,
                        float* X1p, bf16* Up, unsigned* counts, int* tablep, unsigned* tokinfop, LAS unsigned char* lds) {
    const int tid = threadIdx.x, wave = __builtin_amdgcn_readfirstlane(tid >> 6), lane = tid & 63, fr = lane & 15, fq = lane >> 4;
    bf16x8 bh[8][2], bl[8][2];
#pragma unroll
    for (int ks = 0; ks < 8; ++ks)
#pragma unroll
        for (int nt = 0; nt < 2; ++nt) { float w8[8];
#pragma unroll
            for (int j = 0; j < 8; ++j) w8[j] = rw[(size_t)(256 * wave + 32 * ks + 8 * fq + j) * NE + nt * 16 + fr];
            split_bf16(w8, bh[ks][nt], bl[ks][nt]); }
    LAS float* part = (LAS float*)lds; LAS float* lgs = (LAS float*)(lds + 16384);
    for (int rg = blockIdx.x; rg < T / 16; rg += gridDim.x) {
        __syncthreads();
#pragma unroll 1
        for (int rr = 0; rr < 2; ++rr) {
            const int lr = 2 * wave + rr, row = rg * 16 + lr;
            Row r; row_load(r, TBp + (size_t)row * D, lane); row_ln(r); row_affine(r, lng, lnb, lane);
            row_store(r, X1p + (size_t)row * D, lane);
            row_ln(r);
            const float* mr = mods_l + (size_t)(row >> 12) * MODW + 3 * D;
            row_modulate(r, mr, mr + D, lane);
            u32x2* uq = (u32x2*)(Up + (size_t)row * D) + lane;
#pragma unroll
            for (int j = 0; j < 8; ++j) { const unsigned a = f2bf(r.v[j].x), b = f2bf(r.v[j].y), c = f2bf(r.v[j].z), d = f2bf(r.v[j].w);
                u32x2 hi; hi.x = a | (b << 16); hi.y = c | (d << 16); uq[64 * j] = hi;
                u32x2 lo; lo.x = pk2(r.v[j].x - __uint_as_float(a << 16), r.v[j].y - __uint_as_float(b << 16)); lo.y = pk2(r.v[j].z - __uint_as_float(c << 16), r.v[j].w - __uint_as_float(d << 16));
                *(LAS u32x2*)(lds + lr * RT_RS + (4 * lane + 256 * j) * 2) = hi; *(LAS u32x2*)(lds + RT_IMG + lr * RT_RS + (4 * lane + 256 * j) * 2) = lo; }
        }
        __syncthreads();
        f32x4 acc[2]; acc[0] = (f32x4){0.f, 0.f, 0.f, 0.f}; acc[1] = acc[0];
        const LAS unsigned char* ap = lds + fr * RT_RS + (256 * wave + 8 * fq) * 2;
#pragma unroll
        for (int ks = 0; ks < 8; ++ks) { const bf16x8 ah = *(const LAS bf16x8*)(ap + ks * 64), al = *(const LAS bf16x8*)(ap + RT_IMG + ks * 64);
#pragma unroll
            for (int nt = 0; nt < 2; ++nt) { acc[nt] = __builtin_amdgcn_mfma_f32_16x16x32_bf16(ah, bh[ks][nt], acc[nt], 0, 0, 0); acc[nt] = __builtin_amdgcn_mfma_f32_16x16x32_bf16(ah, bl[ks][nt], acc[nt], 0, 0, 0);
                acc[nt] = __builtin_amdgcn_mfma_f32_16x16x32_bf16(al, bh[ks][nt], acc[nt], 0, 0, 0); } }
        __syncthreads();
#pragma unroll
        for (int nt = 0; nt < 2; ++nt)
#pragma unroll
            for (int i = 0; i < 4; ++i) part[(wave * 16 + fq * 4 + i) * 32 + nt * 16 + fr] = acc[nt][i];
        __syncthreads();
        { const int r16 = tid >> 5, e = tid & 31; float sacc = 0.f;
#pragma unroll
            for (int w = 0; w < 8; ++w) sacc += part[(w * 16 + r16) * 32 + e];
            lgs[r16 * 32 + e] = sacc; }
        __syncthreads();
        if (tid < 16) {
            const int row = rg * 16 + tid; const LAS float* lg = lgs + tid * 32;
            float best = -1e30f; int grp = 0;
            for (int g = 0; g < 8; ++g) { float v[4];
#pragma unroll
                for (int i = 0; i < 4; ++i) v[i] = 1.f / (1.f + expf(-lg[4 * g + i])) + rbias[4 * g + i];
                const float h1 = fmaxf(v[0], v[1]), l1 = fminf(v[0], v[1]), h2 = fmaxf(v[2], v[3]), l2 = fminf(v[2], v[3]);
                const float scg = fmaxf(h1, h2) + fmaxf(fminf(h1, h2), fmaxf(l1, l2));
                if (scg > best) { best = scg; grp = g; } }
            float ga[4], gv[4];
#pragma unroll
            for (int i = 0; i < 4; ++i) { ga[i] = 1.f / (1.f + expf(-lg[4 * grp + i])); gv[i] = ga[i] + rbias[4 * grp + i]; }
            int i1 = 0; float v1 = gv[0]; if (gv[1] > v1) { v1 = gv[1]; i1 = 1; } if (gv[2] > v1) { v1 = gv[2]; i1 = 2; } if (gv[3] > v1) { v1 = gv[3]; i1 = 3; }
            int i2 = -1; float v2 = -1e30f;
            if (i1 != 0 && gv[0] > v2) { v2 = gv[0]; i2 = 0; } if (i1 != 1 && gv[1] > v2) { v2 = gv[1]; i2 = 1; } if (i1 != 2 && gv[2] > v2) { v2 = gv[2]; i2 = 2; } if (i1 != 3 && gv[3] > v2) { v2 = gv[3]; i2 = 3; }
            const float a1 = i1 == 0 ? ga[0] : i1 == 1 ? ga[1] : i1 == 2 ? ga[2] : ga[3], a2 = i2 == 0 ? ga[0] : i2 == 1 ? ga[1] : i2 == 2 ? ga[2] : ga[3];
            const float w1 = a1 / (a1 + a2), w2 = a2 / (a1 + a2);
            const int e1 = grp * 4 + i1, e2 = grp * 4 + i2;
            const unsigned p1 = __hip_atomic_fetch_add(counts + e1, 1u, __ATOMIC_RELAXED, __HIP_MEMORY_SCOPE_AGENT);
            const unsigned p2 = __hip_atomic_fetch_add(counts + e2, 1u, __ATOMIC_RELAXED, __HIP_MEMORY_SCOPE_AGENT);
            tablep[(size_t)e1 * T + p1] = row; tablep[(size_t)e2 * T + p2] = row;
            u32x4 ta; ta.x = (unsigned)e1; ta.y = (unsigned)e2; ta.z = p1; ta.w = p2; u32x4 tb2; tb2.x = __float_as_uint(w1); tb2.y = __float_as_uint(w2); tb2.z = 0u; tb2.w = 0u;
            *(u32x4*)(tokinfop + (size_t)row * 8) = ta; *(u32x4*)(tokinfop + (size_t)row * 8 + 4) = tb2;
        }
    }
}
DI void moe_prefix(const unsigned* counts, LAS int* cnt, LAS int* tb, int tid) {
    __syncthreads();
    if (tid < 32) cnt[tid] = (int)__hip_atomic_load(counts + tid, __ATOMIC_RELAXED, __HIP_MEMORY_SCOPE_AGENT);
    __syncthreads();
    if (tid == 0) { int a = 0; for (int e = 0; e < 32; ++e) { tb[e] = a; a += (cnt[e] + 255) >> 8; } tb[32] = a; }
    __syncthreads();
}
DI void combine_phase(const float* X1, const bf16* Y, const unsigned* tokinfo, const LAS int* tb, const float* mods_l, const float* lng, const float* lnb,
                      float* XO, const float* mods_next, bf16* U, int gw, int NGW, int lane) {
    for (int row = gw; row < T; row += NGW) {
        const u32x4 ta = *(const u32x4*)(tokinfo + (size_t)row * 8); const u32x4 tw = *(const u32x4*)(tokinfo + (size_t)row * 8 + 4);
        const size_t r0 = (size_t)tb[ta.x] * 256 + ta.z, r1 = (size_t)tb[ta.y] * 256 + ta.w; const float w0 = __uint_as_float(tw.x), w1 = __uint_as_float(tw.y);
        Row r; row_load(r, X1 + (size_t)row * D, lane);
        const u32x2* y0 = (const u32x2*)(Y + r0 * D) + lane; const u32x2* y1 = (const u32x2*)(Y + r1 * D) + lane;
        const f32x4* g2 = (const f32x4*)(mods_l + (size_t)(row >> 12) * MODW + 5 * D) + lane;
#pragma unroll
        for (int j = 0; j < 8; ++j) { const u32x2 a = y0[64 * j], b = y1[64 * j]; f32x4 f;
            f.x = w0 * bflo(a.x) + w1 * bflo(b.x); f.y = w0 * bfhi(a.x) + w1 * bfhi(b.x); f.z = w0 * bflo(a.y) + w1 * bflo(b.y); f.w = w0 * bfhi(a.y) + w1 * bfhi(b.y);
            r.v[j] = r.v[j] * ALPHA + g2[64 * j] * f; }
        row_ln(r); row_affine(r, lng, lnb, lane);
        row_store(r, XO + (size_t)row * D, lane);
        if (U) { row_ln(r); const float* mr = mods_next + (size_t)(row >> 12) * MODW; row_modulate(r, mr, mr + D, lane); row_store_bf16(r, U + (size_t)row * D, lane); }
    }
}

struct Args { const float* in[18]; float* out; unsigned char* ws; int ph_lo, ph_hi; };
__global__ void __launch_bounds__(512, 2) fwd(Args args) {
    extern __shared__ __attribute__((aligned(16))) unsigned char lds_raw[];
    LAS unsigned char* lds = (LAS unsigned char*)lds_raw;
#define PH_IDS int tid = threadIdx.x; asm volatile("" : "+v"(tid)); const int lane = tid & 63, wave = __builtin_amdgcn_readfirstlane(tid >> 6); \
    const int gw = blockIdx.x * 8 + wave, NGW = gridDim.x * 8, gtid = blockIdx.x * 512 + tid, GT = gridDim.x * 512; (void)lane; (void)gw; (void)NGW; (void)gtid; (void)GT;
    volatile LAS unsigned* LCTL = (volatile LAS unsigned*)(lds + LDSCTL_OFF);
    LAS int* l_cnt = (LAS int*)(lds + LDSCTL_OFF) + 16; LAS int* l_tb = (LAS int*)(lds + LDSCTL_OFF) + 48;
    for (int u = threadIdx.x; u < (LDS_BYTES - LDSCTL_OFF) / 4; u += 512) ((LAS unsigned*)(lds + LDSCTL_OFF))[u] = 0u;
    __syncthreads();
    unsigned char* ws = args.ws;
    unsigned* ctl = (unsigned*)(ws + WS_CTL);
#define XIN ((const float*)args.in[0])
#define c_in args.in[1]
#define ctx args.in[2]
#define c_ctx args.in[3]
#define ada_w args.in[4]
#define ada_b args.in[5]
#define w_mix_in args.in[6]
#define rpb args.in[7]
#define conv_w args.in[8]
#define w_mix_out args.in[9]
#define w_fourier args.in[10]
#define router_w args.in[11]
#define router_b args.in[12]
#define w_gate args.in[13]
#define w_up args.in[14]
#define w_down args.in[15]
#define ln_g args.in[16]
#define ln_b args.in[17]
#define mods ((float*)(ws + WS_MODS))
#define tokinfo ((unsigned*)(ws + WS_TOKINFO))
#define table ((int*)(ws + WS_TABLE))
#define WIN ((bf16*)(ws + WS_WIN))
#define WO ((bf16*)(ws + WS_WO))
#define WF ((bf16*)(ws + WS_WF))
#define CSM ((bf16*)(ws + WS_CS))
#define ACS ((bf16*)(ws + WS_ACS))
#define U ((bf16*)(ws + WS_U))
#define P ((bf16*)(ws + WS_P))
#define YB ((bf16*)(ws + WS_P))
#define BT2 ((bf16*)(ws + WS_P))
#define MIX ((bf16*)(ws + WS_MIX))
#define REZ ((bf16*)(ws + WS_MIX))
#define HB ((bf16*)(ws + WS_H))
#define WGU ((bf16*)(ws + WS_WGU))
#define WD ((bf16*)(ws + WS_WD))
#define TB ((float*)(ws + WS_TB))
#define X1 ((float*)(ws + WS_X1))
#define X2 ((float*)(ws + WS_X2))
    XcdBarrier bar; bar.bar = ctl + CW_BAR; bar.x = 0; bar.st = nullptr;
    if (N_LAUNCHES != NPHASE) bar = xcd_barrier_post(ctl + CW_BAR, LCTL);
    const int lo = args.ph_lo, hi = args.ph_hi;
#ifndef DUP_MASK
#define DUP_MASK 0x0000
#endif
#define RUN(k, ...) do { __VA_ARGS__ if constexpr ((((DUP_MASK) >> (k)) & 1) != 0) { __VA_ARGS__ } } while (0)
#ifndef PH_MASK
#define PH_MASK 0xffff
#endif
#define IN(k) ((((PH_MASK) >> (k)) & 1) && lo <= (k) && (k) < hi)
#define SEAM(k) do { if (IN(k) && IN((k) + 1)) xcd_barrier(bar); } while (0)

    RUN(0, if (IN(0)) { PH_IDS
        p0_mods(c_in, c_ctx, ada_w, ada_b, mods, (LAS float*)lds, tid);
        p0_weights(w_mix_in, w_mix_out, w_fourier, w_gate, w_up, w_down, WIN, WO, WF, WGU, WD, lds + wave * 16384, gw, NGW, lane);
        p0_dft(ACS, CSM, gtid, GT);
    });
    SEAM(0);
    RUN(1, if (IN(1)) { PH_IDS ln_mod_phase(XIN, ctx, mods, 0, U, TALL, gw, NGW, lane); });
    SEAM(1);
    RUN(2, if (IN(2)) { SchedInProj S{U, WIN}; EpiStoreBf16 E{P, NMIX}; gemm_pg8<false>(lds, S, E, D, D, D); });
    SEAM(2);
    RUN(3, if (IN(3)) { PH_IDS attn_phase(P, rpb, MIX, lds, (LAS float*)(lds + LDSCTL_OFF + 1024)); conv_phase(P, conv_w, MIX, gtid, GT); });
    SEAM(3);
    RUN(4, if (IN(4)) { SchedDense S{MIX, WO, 64, 8, (size_t)256 * D, (size_t)256 * D}; EpiResid E{XIN, TB, mods + 2 * D}; gemm_pg8<false>(lds, S, E, D, D, D); });
    SEAM(4);
    RUN(5, if (IN(5)) { PH_IDS ln_router_phase(TB, ln_g, ln_b, mods, router_w, router_b, X1, U, ctl + CW_CNT, table, tokinfo, lds); });
    SEAM(5);
    RUN(6, if (IN(6)) { PH_IDS moe_prefix(ctl + CW_CNT, l_cnt, l_tb, tid); SchedMoe S{l_cnt, l_tb, U, WGU, table, 1, 0, (size_t)D * D, (size_t)256 * D}; EpiSwiglu E{HB}; gemm_pg8<true>(lds, S, E, D, D, D); });
    SEAM(6);
    RUN(7, if (IN(7)) { PH_IDS moe_prefix(ctl + CW_CNT, l_cnt, l_tb, tid); SchedMoe S{l_cnt, l_tb, HB, WD, table, 0, (size_t)256 * DE, (size_t)D * DE, (size_t)256 * DE}; EpiStoreBf16 E{YB, D}; gemm_pg8<false>(lds, S, E, DE, DE, DE); });
    SEAM(7);
    RUN(8, if (IN(8)) { PH_IDS moe_prefix(ctl + CW_CNT, l_cnt, l_tb, tid); combine_phase(X1, YB, tokinfo, l_tb, mods, ln_g + D, ln_b + D, X2, mods + 5 * MODW, U, gw, NGW, lane); });
    SEAM(8);
    RUN(9, if (IN(9)) { SchedF1 S{CSM, U}; EpiF1 E{BT2}; gemm_pg8<false>(lds, S, E, 512, D, 512); });
    SEAM(9);
    RUN(10, if (IN(10)) { SchedF2 S{ACS, BT2}; EpiF2 E{REZ}; gemm_pg8<false>(lds, S, E, 8192, 8192, 8192); });
    SEAM(10);
    RUN(11, if (IN(11)) { SchedDense S{REZ, WF, 64, 8, (size_t)256 * D, (size_t)256 * D}; EpiResid E{X2, TB, mods + 5 * MODW + 2 * D}; gemm_pg8<false>(lds, S, E, D, D, D); });
    SEAM(11);
    RUN(12, if (IN(12)) { PH_IDS ln_router_phase(TB, ln_g + 2 * D, ln_b + 2 * D, mods + 5 * MODW, router_w, router_b, X1, U, ctl + CW_CNT + 32, table + (size_t)NE * T, tokinfo + (size_t)T * 8, lds); });
    SEAM(12);
    RUN(13, if (IN(13)) { PH_IDS moe_prefix(ctl + CW_CNT + 32, l_cnt, l_tb, tid); SchedMoe S{l_cnt, l_tb, U, WGU + (size_t)NE * D * D, table + (size_t)NE * T, 1, 0, (size_t)D * D, (size_t)256 * D}; EpiSwiglu E{HB}; gemm_pg8<true>(lds, S, E, D, D, D); });
    SEAM(13);
    RUN(14, if (IN(14)) { PH_IDS moe_prefix(ctl + CW_CNT + 32, l_cnt, l_tb, tid); SchedMoe S{l_cnt, l_tb, HB, WD + (size_t)NE * D * DE, table, 0, (size_t)256 * DE, (size_t)D * DE, (size_t)256 * DE}; EpiStoreBf16 E{YB, D}; gemm_pg8<false>(lds, S, E, DE, DE, DE); });
    SEAM(14);
    RUN(15, if (IN(15)) { PH_IDS moe_prefix(ctl + CW_CNT + 32, l_cnt, l_tb, tid); combine_phase(X1, YB, tokinfo + (size_t)T * 8, l_tb, mods + 5 * MODW, ln_g + 3 * D, ln_b + 3 * D, args.out, nullptr, nullptr, gw, NGW, lane); });
#undef IN
#undef SEAM
}

extern "C" void kernel_launch(void* const* d_in, const int* in_sizes, int n_in, void* d_out, int out_size, void* d_ws, size_t ws_size, hipStream_t stream) {
    static int grid = 0;
    if (grid == 0) {
        if (n_in != 18 || out_size != T * D || ws_size < WS_END) { fprintf(stderr, "kernel_launch: unexpected shapes (n_in %d, out %d, ws %zu)\n", n_in, out_size, ws_size); grid = -1; return; }
        int dev = 0, cus = 0, per_cu = 0;
        if (hipGetDevice(&dev) != hipSuccess || hipDeviceGetAttribute(&cus, hipDeviceAttributeMultiprocessorCount, dev) != hipSuccess) { grid = -1; return; }
        if (hipFuncSetAttribute((const void*)fwd, hipFuncAttributeMaxDynamicSharedMemorySize, LDS_BYTES) != hipSuccess) { fprintf(stderr, "kernel_launch: hipFuncSetAttribute failed\n"); grid = -1; return; }
        if (hipOccupancyMaxActiveBlocksPerMultiprocessor(&per_cu, (const void*)fwd, 512, LDS_BYTES) != hipSuccess || per_cu < 1) fprintf(stderr, "kernel_launch: occupancy query says %d\n", per_cu);
        (void)hipGetLastError();
        grid = cus;
    }
    if (grid < 0) return;
    (void)hipMemsetAsync((char*)d_ws + WS_CTL, 0, CTL_ZERO_BYTES, stream);
    Args a{};
    for (int i = 0; i < 18; ++i) a.in[i] = (const float*)d_in[i];
    a.out = (float*)d_out; a.ws = (unsigned char*)d_ws;
    if (N_LAUNCHES == 1) { a.ph_lo = 0; a.ph_hi = NPHASE; hipLaunchKernelGGL(fwd, dim3(grid), dim3(512), LDS_BYTES, stream, a); }
    else for (int p = 0; p < NPHASE; ++p) { a.ph_lo = p; a.ph_hi = p + 1; hipLaunchKernelGGL(fwd, dim3(grid), dim3(512), LDS_BYTES, stream, a); }
}
```

```cpp
#include <hip/hip_runtime.h>
#include <cstdio>
#include <cstdint>

#define DI __device__ __forceinline__
#define LAS __attribute__((address_space(3)))
typedef unsigned short bf16;
typedef float f32x4 __attribute__((ext_vector_type(4)));
typedef short bf16x8 __attribute__((ext_vector_type(8)));
typedef unsigned u32x4 __attribute__((ext_vector_type(4)));
typedef unsigned u32x2 __attribute__((ext_vector_type(2)));

constexpr int D = 2048, NB = 4, SEQ = 4096, T = NB * SEQ, CTXL = 256, TC = NB * CTXL, TALL = T + TC;
constexpr int NMIX = 6144, NE = 32, DE = 1024, NH = 8, HD = 128, MODW = 6 * D;
constexpr float ALPHA = 1.41421356237309515f;
constexpr float LN_EPS = 1e-6f;
constexpr int NPHASE = 16;
#ifndef MK_N_LAUNCHES
#define MK_N_LAUNCHES 1
#endif
constexpr int N_LAUNCHES = MK_N_LAUNCHES;

constexpr size_t MiB = 1u << 20;
constexpr size_t WS_CTL = 0, CTL_ZERO_BYTES = 64 * 1024;
constexpr size_t WS_MODS = 1 * MiB;
constexpr size_t WS_TOKINFO = 2 * MiB;
constexpr size_t WS_TABLE = 4 * MiB;
constexpr size_t WS_WIN = 8 * MiB, WS_WO = 32 * MiB, WS_WF = 40 * MiB, WS_CS = 48 * MiB, WS_ACS = 64 * MiB;
constexpr size_t WS_U = 128 * MiB;
constexpr size_t WS_P = 196 * MiB;
constexpr size_t WS_MIX = 400 * MiB;
constexpr size_t WS_TB = 464 * MiB, WS_X1 = 592 * MiB, WS_X2 = 720 * MiB;
constexpr size_t WS_H = 848 * MiB;
constexpr size_t WS_WGU = 928 * MiB;
constexpr size_t WS_WD = 1440 * MiB;
constexpr size_t WS_END = 1696 * MiB;
constexpr int CW_CNT = 64;
constexpr int CW_BAR = 1024;

constexpr int LDS_SCR = 133120;
constexpr int LDSCTL_OFF = LDS_SCR;
constexpr int LDS_BYTES = 147456;

template <int CTRL> DI float dpp_f(float v) { return __builtin_bit_cast(float, __builtin_amdgcn_mov_dpp(__builtin_bit_cast(int, v), CTRL, 0xF, 0xF, true)); }
DI float wave_sum(float v) {
    v += dpp_f<0xB1>(v); v += dpp_f<0x4E>(v); v += dpp_f<0x141>(v); v += dpp_f<0x140>(v);
    const int iv = __builtin_bit_cast(int, v);
    const float r0 = __builtin_bit_cast(float, __builtin_amdgcn_readlane(iv, 0)), r1 = __builtin_bit_cast(float, __builtin_amdgcn_readlane(iv, 16)),
                r2 = __builtin_bit_cast(float, __builtin_amdgcn_readlane(iv, 32)), r3 = __builtin_bit_cast(float, __builtin_amdgcn_readlane(iv, 48));
    return (r0 + r1) + (r2 + r3);
}
DI float wave_max(float v) {
    v = fmaxf(v, dpp_f<0xB1>(v)); v = fmaxf(v, dpp_f<0x4E>(v)); v = fmaxf(v, dpp_f<0x141>(v)); v = fmaxf(v, dpp_f<0x140>(v));
    const int iv = __builtin_bit_cast(int, v);
    const float r0 = __builtin_bit_cast(float, __builtin_amdgcn_readlane(iv, 0)), r1 = __builtin_bit_cast(float, __builtin_amdgcn_readlane(iv, 16)),
                r2 = __builtin_bit_cast(float, __builtin_amdgcn_readlane(iv, 32)), r3 = __builtin_bit_cast(float, __builtin_amdgcn_readlane(iv, 48));
    return fmaxf(fmaxf(r0, r1), fmaxf(r2, r3));
}
DI unsigned f2bf(float f) { unsigned u = __float_as_uint(f); return (u + 0x7fffu + ((u >> 16) & 1u)) >> 16; }
DI unsigned pk2(float lo, float hi) { return f2bf(lo) | (f2bf(hi) << 16); }
DI float bflo(unsigned w) { return __uint_as_float(w << 16); }
DI float bfhi(unsigned w) { return __uint_as_float(w & 0xffff0000u); }
DI float silu_f(float v) { return v / (1.f + expf(-v)); }

#define XB_TMO      128
#define XB_XCNT(j)  (256  + 64 * (j))
#define XB_XSUB(j)  (1280 + 64 * (j))
#define XB_XGEN(j)  (2304 + 64 * (j))
#define XB_TOP      3328
#define XB_TOPGEN   3392
#define XCD_BAR_WORDS 3456
#define XB_SPIN_CAP (1u << 18)
__device__ __forceinline__ unsigned xb_ld(unsigned* p)              { return __hip_atomic_load(p, __ATOMIC_RELAXED, __HIP_MEMORY_SCOPE_AGENT); }
__device__ __forceinline__ unsigned xb_add(unsigned* p, unsigned v) { return __hip_atomic_fetch_add(p, v, __ATOMIC_RELAXED, __HIP_MEMORY_SCOPE_AGENT); }
__device__ __forceinline__ unsigned xb_xcc_id() { return (unsigned)__builtin_amdgcn_s_getreg((3 << 11) | 20) & 0xFu; }
#define XB_SPIN(cond, bar) do { unsigned _sp = 0; while (cond) { __builtin_amdgcn_s_sleep(1); \
    if ((++_sp & 255u) == 0u) { if (xb_ld(&(bar)[XB_TMO])) break; if (_sp > XB_SPIN_CAP) { atomicAdd(&(bar)[XB_TMO], 1u); break; } } } } while (0)
struct XcdBarrier { unsigned* bar; unsigned x; volatile LAS unsigned* st; };
__device__ __forceinline__ XcdBarrier xcd_barrier_post(unsigned* bar, volatile LAS unsigned* st) {
    XcdBarrier b; b.bar = bar; b.x = xb_xcc_id(); b.st = st;
    if (threadIdx.x == 0) (void)xb_add(&bar[XB_XCNT(b.x)], 1u);
    return b;
}
__device__ __forceinline__ void xcd_barrier_complete(unsigned* bar, unsigned x, unsigned& nloc, unsigned& nx) {
    const unsigned G = gridDim.x * gridDim.y * gridDim.z;
    unsigned sum, cnt, mine, sp = 0u;
    for (;;) {
        sum = 0u; cnt = 0u; mine = 0u;
#pragma unroll
        for (unsigned j = 0; j < 16; ++j) { const unsigned c = xb_ld(&bar[XB_XCNT(j)]); sum += c; cnt += (c > 0u) ? 1u : 0u; mine = (j == x) ? c : mine; }
        if (sum == G) break;
        __builtin_amdgcn_s_sleep(1);
        if ((++sp & 255u) == 0u) { if (xb_ld(&bar[XB_TMO])) break; if (sp > XB_SPIN_CAP) { atomicAdd(&bar[XB_TMO], 1u); break; } }
    }
    nloc = mine > 0u ? mine : 1u; nx = cnt > 0u ? cnt : 1u;
}
__device__ __forceinline__ void xcd_barrier(const XcdBarrier& b) {
    asm volatile("s_waitcnt vmcnt(0)" ::: "memory");
    __syncthreads();
    if (threadIdx.x == 0) {
        unsigned* bar = b.bar;
        __builtin_amdgcn_s_waitcnt(0);
        unsigned nloc = b.st[0], nx = b.st[1];
        if (nloc == 0u) { xcd_barrier_complete(bar, b.x, nloc, nx); b.st[0] = nloc; b.st[1] = nx; }
        const unsigned old = xb_add(&bar[XB_XSUB(b.x)], 1u);
        const unsigned gen = old / nloc;
        if (old + 1u == (gen + 1u) * nloc) {
            __builtin_amdgcn_fence(__ATOMIC_RELEASE, "agent");
            asm volatile("s_waitcnt vmcnt(0)" ::: "memory");
            const unsigned og = xb_add(&bar[XB_TOP], 1u);
            const unsigned tg = og / nx;
            if (og + 1u == (tg + 1u) * nx) xb_add(&bar[XB_TOPGEN], 1u);
            else XB_SPIN(xb_ld(&bar[XB_TOPGEN]) == tg, bar);
            __builtin_amdgcn_fence(__ATOMIC_ACQUIRE, "agent");
            xb_add(&bar[XB_XGEN(b.x)], 1u);
            asm volatile("s_waitcnt vmcnt(0)" ::: "memory");
        } else {
            XB_SPIN(xb_ld(&bar[XB_XGEN(b.x)]) == gen, bar);
            __builtin_amdgcn_fence(__ATOMIC_ACQUIRE, "agent");
            asm volatile("s_waitcnt vmcnt(0)" ::: "memory");
        }
    }
    __syncthreads();
}

struct Row { f32x4 v[8]; };
DI void row_load(Row& r, const float* p, int lane) { const f32x4* q = (const f32x4*)p + lane;
#pragma unroll
    for (int j = 0; j < 8; ++j) r.v[j] = q[64 * j]; }
DI void row_store(const Row& r, float* p, int lane) { f32x4* q = (f32x4*)p + lane;
#pragma unroll
    for (int j = 0; j < 8; ++j) q[64 * j] = r.v[j]; }
DI void row_store_bf16(const Row& r, bf16* p, int lane) { u32x2* q = (u32x2*)p + lane;
#pragma unroll
    for (int j = 0; j < 8; ++j) { u32x2 w; w.x = pk2(r.v[j].x, r.v[j].y); w.y = pk2(r.v[j].z, r.v[j].w); q[64 * j] = w; } }
DI void row_ln(Row& r) {
    float s = 0.f;
#pragma unroll
    for (int j = 0; j < 8; ++j) s += (r.v[j].x + r.v[j].y) + (r.v[j].z + r.v[j].w);
    const float mean = wave_sum(s) * (1.f / D); float s2 = 0.f;
#pragma unroll
    for (int j = 0; j < 8; ++j) { r.v[j] = r.v[j] - mean; s2 += (r.v[j].x * r.v[j].x + r.v[j].y * r.v[j].y) + (r.v[j].z * r.v[j].z + r.v[j].w * r.v[j].w); }
    const float rstd = 1.f / sqrtf(wave_sum(s2) * (1.f / D) + LN_EPS);
#pragma unroll
    for (int j = 0; j < 8; ++j) r.v[j] = r.v[j] * rstd;
}
DI void row_affine(Row& r, const float* g, const float* b, int lane) {
    const f32x4* gq = (const f32x4*)g + lane; const f32x4* bq = (const f32x4*)b + lane;
#pragma unroll
    for (int j = 0; j < 8; ++j) r.v[j] = r.v[j] * gq[64 * j] + bq[64 * j];
}
DI void row_modulate(Row& r, const float* sh, const float* sc, int lane) {
    const f32x4* hq = (const f32x4*)sh + lane; const f32x4* cq = (const f32x4*)sc + lane;
#pragma unroll
    for (int j = 0; j < 8; ++j) r.v[j] = r.v[j] * (cq[64 * j] + 1.f) + hq[64 * j];
}

struct Unit { const bf16* A; const bf16* B; const int* gat; int nvalid; int m0, n0, aux; };

template <class Sched, class Epi>
DI void gemm_simple(const Sched& S, const Epi& E, const int lda, const int ldb, const int K) {
    const int tid = threadIdx.x, wid = tid >> 6, lane = tid & 63, fr = lane & 15, fq = lane >> 4;
    for (int L = blockIdx.x; ; L += gridDim.x) {
        Unit u; if (!S.get(L, u)) break;
        const bf16* arow[2];
#pragma unroll
        for (int m = 0; m < 2; ++m) { const int r = 32 * wid + 16 * m + fr; size_t grow = (size_t)r; if (u.gat) grow = (size_t)(r < u.nvalid ? u.gat[r] : 0); arow[m] = u.A + grow * lda + fq * 8; }
        for (int cc = 0; cc < 4; ++cc) {
            f32x4 acc[2][4];
#pragma unroll
            for (int m = 0; m < 2; ++m)
#pragma unroll
                for (int j = 0; j < 4; ++j) acc[m][j] = (f32x4){0.f, 0.f, 0.f, 0.f};
            const bf16* brow[4];
#pragma unroll
            for (int j = 0; j < 4; ++j) { const int col = (j >> 1) * 128 + cc * 32 + (j & 1) * 16 + fr; brow[j] = u.B + (size_t)col * ldb + fq * 8; }
            for (int k = 0; k < K; k += 32) {
                bf16x8 a[2], b[4];
#pragma unroll
                for (int m = 0; m < 2; ++m) a[m] = *(const bf16x8*)(arow[m] + k);
#pragma unroll
                for (int j = 0; j < 4; ++j) b[j] = *(const bf16x8*)(brow[j] + k);
#pragma unroll
                for (int m = 0; m < 2; ++m)
#pragma unroll
                    for (int j = 0; j < 4; ++j) acc[m][j] = __builtin_amdgcn_mfma_f32_16x16x32_bf16(b[j], a[m], acc[m][j], 0, 0, 0);
            }
#pragma unroll
            for (int m = 0; m < 2; ++m)
#pragma unroll
                for (int nn = 0; nn < 2; ++nn) E(u, 32 * wid + 16 * m + fr, cc * 32 + nn * 16 + 4 * fq, acc[m][nn], acc[m][nn + 2]);
        }
    }
}


namespace pg8 {
constexpr int BK = 64, HALF = 128, HTB = HALF * BK * 2, STAGE_BYTES = 8 * HTB;
DI int lds_byte(int r, int c) { const int st = (r >> 4) * 2 + (c >> 5), rr = r & 15, cc = c & 31, ob = rr * 64 + cc * 2; return st * 1024 + (ob ^ (((ob >> 9) & 1) << 5)); }
DI void stage_rc(int b, int& R, int& C) { const int st = b / 1024, sb = b % 1024, swz = sb ^ (((sb >> 9) & 1) << 5); R = (st >> 1) * 16 + swz / 64; C = (st & 1) * 32 + (swz % 64) / 2; }
}
template <bool GATHER, class Sched, class Epi>
DI void gemm_pg8(LAS unsigned char* lds, const Sched& S, const Epi& E, const int lda, const int ldb, const int K) {
    using namespace pg8;
    const int tid = threadIdx.x, wid = __builtin_amdgcn_readfirstlane(tid >> 6), lane = tid & 63, wr = wid >> 2, wc = wid & 3, fr = lane & 15, fq = lane >> 4;
    const int nt = K / BK, G = gridDim.x, cblk = blockIdx.x;
    unsigned voffB[2], vA[2][2];
#pragma unroll
    for (int i = 0; i < 2; ++i) { int R_, C_; stage_rc(tid * 16 + i * 8192, R_, C_); voffB[i] = (unsigned)(R_ * ldb + C_) * 2u; }
    const size_t kstep = (size_t)(BK * 2), hstepA = (size_t)HALF * lda * 2, hstepB = (size_t)HALF * ldb * 2;
    const unsigned ldsw = (unsigned)wid * 1024u;
    const int aoff = lds_byte(wr * 64 + fr, fq * 8), boff = lds_byte(wc * 32 + fr, fq * 8);
#define PG8_SA(b, h) (((b) * 2 + (h)) * HTB)
#define PG8_SB(b, h) ((4 + (b) * 2 + (h)) * HTB)
#define PG8_STAGE(bufoff, gbase, voff) do { _Pragma("unroll") for (int _i = 0; _i < 2; ++_i) \
        __builtin_amdgcn_global_load_lds((const unsigned*)((const char*)(gbase) + (voff)[_i]), (LAS unsigned*)(lds + (bufoff) + ldsw + _i * 8192), 16, 0, 0); } while (0)
#define PG8_STAGE_A(bufoff, gbase, h) do { if constexpr (GATHER) PG8_STAGE(bufoff, gbase, vA[h]); else PG8_STAGE(bufoff, (gbase) + (h) * hstepA, vA[0]); } while (0)
#define PG8_LDA(dst, b, h) do { _Pragma("unroll") for (int m = 0; m < 4; ++m) _Pragma("unroll") for (int k = 0; k < 2; ++k) dst[m][k] = *(const LAS bf16x8*)(lds + PG8_SA(b, h) + aoff + m * 2048 + k * 1024); } while (0)
#define PG8_LDB(dst, b, h) do { _Pragma("unroll") for (int n = 0; n < 2; ++n) _Pragma("unroll") for (int k = 0; k < 2; ++k) dst[n][k] = *(const LAS bf16x8*)(lds + PG8_SB(b, h) + boff + n * 2048 + k * 1024); } while (0)
#define PG8_MMA(ai, bj, At, Bt) do { __builtin_amdgcn_s_setprio(1); _Pragma("unroll") for (int m = 0; m < 4; ++m) _Pragma("unroll") for (int n = 0; n < 2; ++n) _Pragma("unroll") for (int k = 0; k < 2; ++k) \
        acc[ai][bj][m][n] = __builtin_amdgcn_mfma_f32_16x16x32_bf16(Bt[n][k], At[m][k], acc[ai][bj][m][n], 0, 0, 0); __builtin_amdgcn_s_setprio(0); } while (0)
#define PG8_WAIT_V(n) asm volatile("s_waitcnt vmcnt(" #n ")" ::: "memory")
#define PG8_WAIT_L(n) asm volatile("s_waitcnt lgkmcnt(" #n ")" ::: "memory")
#define PG8_BAR __builtin_amdgcn_s_barrier()
#define PG8_SCHED __builtin_amdgcn_sched_barrier(0)
#define PG8_SETV(dst, u) do { _Pragma("unroll") for (int _h = 0; _h < 2; ++_h) _Pragma("unroll") for (int _i = 0; _i < 2; ++_i) { int _R, _C; stage_rc(tid * 16 + _i * 8192, _R, _C); const int _r = _h * HALF + _R; \
        if constexpr (GATHER) { const int _g = _r < (u).nvalid ? (u).gat[_r] : 0; dst[_h][_i] = (unsigned)(_g * lda + _C) * 2u; } else dst[_h][_i] = (unsigned)(_R * lda + _C) * 2u; } } while (0)
    Unit cur, nxt; int ui = 0;
    if (!S.get(cblk, cur)) return;
    f32x4 acc[2][2][4][2];
#pragma unroll
    for (int a = 0; a < 2; ++a)
#pragma unroll
        for (int b = 0; b < 2; ++b)
#pragma unroll
            for (int m = 0; m < 4; ++m)
#pragma unroll
                for (int n = 0; n < 2; ++n) acc[a][b][m][n] = (f32x4){0.f, 0.f, 0.f, 0.f};
    bf16x8 At[4][2], B0[2][2], B1[2][2];
    const char* cA = (const char*)cur.A; const char* cB = (const char*)cur.B;
    PG8_SETV(vA, cur);
    PG8_STAGE(PG8_SB(0, 0), cB, voffB); PG8_STAGE(PG8_SB(0, 1), cB + hstepB, voffB); PG8_STAGE_A(PG8_SA(0, 0), cA, 0); PG8_STAGE_A(PG8_SA(0, 1), cA, 1);
    if (wr == 1) PG8_BAR;
    PG8_WAIT_V(2); PG8_BAR;
    PG8_STAGE(PG8_SB(1, 0), cB + kstep, voffB); PG8_STAGE_A(PG8_SA(1, 0), cA + kstep, 0); PG8_STAGE(PG8_SB(1, 1), cB + hstepB + kstep, voffB);
    PG8_WAIT_V(6); PG8_BAR;
    for (;;) {
        const bool has_next = S.get((ui + 1) * G + cblk, nxt);
        const char* nA = has_next ? (const char*)nxt.A : cA; const char* nB = has_next ? (const char*)nxt.B : cB;
        for (int t = 0; t < nt; t += 2) {
            const bool last = (t == nt - 2);
            const char* a1 = cA + (size_t)(t + 1) * kstep;
            const char* a2 = last ? nA : cA + (size_t)(t + 2) * kstep; const char* b2 = last ? nB : cB + (size_t)(t + 2) * kstep;
            const char* a3 = a2 + kstep; const char* b3 = b2 + kstep;
            PG8_LDB(B0, 0, 0); PG8_LDB(B1, 0, 1); PG8_SCHED; PG8_LDA(At, 0, 0); PG8_STAGE_A(PG8_SA(1, 1), a1, 1);
            PG8_WAIT_V(8); PG8_WAIT_L(0); PG8_BAR; PG8_MMA(0, 0, At, B0); PG8_MMA(0, 1, At, B1); PG8_BAR; PG8_SCHED;
            if constexpr (GATHER) { if (last && has_next) PG8_SETV(vA, nxt); }
            PG8_LDA(At, 0, 1); PG8_STAGE(PG8_SB(0, 0), b2, voffB); PG8_STAGE(PG8_SB(0, 1), b2 + hstepB, voffB); PG8_STAGE_A(PG8_SA(0, 0), a2, 0);
            PG8_WAIT_V(8); PG8_WAIT_L(0); PG8_BAR; PG8_MMA(1, 0, At, B0); PG8_MMA(1, 1, At, B1); PG8_BAR; PG8_SCHED;
            PG8_LDB(B0, 1, 0); PG8_LDB(B1, 1, 1); PG8_SCHED; PG8_LDA(At, 1, 0); PG8_STAGE_A(PG8_SA(0, 1), a2, 1);
            PG8_WAIT_V(8); PG8_WAIT_L(0); PG8_BAR; PG8_MMA(0, 0, At, B0); PG8_MMA(0, 1, At, B1); PG8_BAR; PG8_SCHED;
            PG8_LDA(At, 1, 1); PG8_STAGE(PG8_SB(1, 0), b3, voffB); PG8_STAGE(PG8_SB(1, 1), b3 + hstepB, voffB); PG8_STAGE_A(PG8_SA(1, 0), a3, 0);
            PG8_WAIT_V(8); PG8_WAIT_L(0); PG8_BAR; PG8_MMA(1, 0, At, B0); PG8_MMA(1, 1, At, B1); PG8_BAR; PG8_SCHED;
        }
        if (wr == 0) PG8_BAR;
#pragma unroll
        for (int ai = 0; ai < 2; ++ai)
#pragma unroll
            for (int m = 0; m < 4; ++m)
#pragma unroll
                for (int n = 0; n < 2; ++n) E(cur, ai * HALF + wr * 64 + m * 16 + fr, wc * 32 + n * 16 + 4 * fq, acc[ai][0][m][n], acc[ai][1][m][n]);
        if (!has_next) break;
#pragma unroll
        for (int a = 0; a < 2; ++a)
#pragma unroll
            for (int b = 0; b < 2; ++b)
#pragma unroll
                for (int m = 0; m < 4; ++m)
#pragma unroll
                    for (int n = 0; n < 2; ++n) acc[a][b][m][n] = (f32x4){0.f, 0.f, 0.f, 0.f};
        cur = nxt; cA = nA; cB = nB; ++ui;
        if (wr == 1) PG8_BAR;
    }
    PG8_WAIT_V(0);
    PG8_BAR;
#undef PG8_SA
#undef PG8_SB
#undef PG8_STAGE
#undef PG8_STAGE_A
#undef PG8_LDA
#undef PG8_LDB
#undef PG8_MMA
#undef PG8_WAIT_V
#undef PG8_WAIT_L
#undef PG8_BAR
#undef PG8_SCHED
#undef PG8_SETV
}

DI int xcd_remap(int L, int n) { const int q = n >> 3, r = n & 7, xcd = L & 7, off = L >> 3; return (xcd < r ? xcd * (q + 1) : r * (q + 1) + (xcd - r) * q) + off; }
DI void grouped(int wgid, int nM, int nN, int& pm, int& pn) { const int nig = 8 * nN, gid = wgid / nig, fm = gid * 8, gsz = min(nM - fm, 8); pm = fm + (wgid % nig) % gsz; pn = (wgid % nig) / gsz; }

struct SchedInProj { const bf16* U; const bf16* W;
    DI bool get(int L, Unit& u) const { int pm, pn;
        if (L >= 64 * 24 + 32) return false; const int w = xcd_remap(L, 64 * 24 + 32);
        if (w < 64 * 24) grouped(w, 64, 24, pm, pn); else { const int l2 = w - 64 * 24; pm = 64 + (l2 >> 3); pn = 4 + (l2 & 7); }
        u.A = U + (size_t)pm * 256 * D; u.B = W + (size_t)pn * 256 * D; u.gat = nullptr; u.nvalid = 256; u.m0 = pm * 256; u.n0 = pn * 256; u.aux = 0; return true; } };
struct SchedDense { const bf16* A; const bf16* B; int nM, nN; size_t a_t, b_t;
    DI bool get(int L, Unit& u) const { if (L >= nM * nN) return false; int pm, pn; grouped(xcd_remap(L, nM * nN), nM, nN, pm, pn);
        u.A = A + (size_t)pm * a_t; u.B = B + (size_t)pn * b_t; u.gat = nullptr; u.nvalid = 256; u.m0 = pm * 256; u.n0 = pn * 256; u.aux = 0; return true; } };
struct SchedMoe { const LAS int* cnt; const LAS int* tb; const bf16* A; const bf16* W; const int* table; int gather; size_t a_t, w_e, w_t;
    DI bool get(int L, Unit& u) const { const int nT = __builtin_amdgcn_readfirstlane(tb[32]); if (L >= nT * 8) return false; int t, pn; grouped(xcd_remap(L, nT * 8), nT, 8, t, pn);
        int e = 0;
        for (int i = 1; i < 32; ++i) e = (tb[i] <= t) ? i : e;
        e = __builtin_amdgcn_readfirstlane(e); t = __builtin_amdgcn_readfirstlane(t); pn = __builtin_amdgcn_readfirstlane(pn);
        const int mt = __builtin_amdgcn_readfirstlane(t - tb[e]);
        if (gather) { u.A = A; u.gat = table + (size_t)e * T + mt * 256; } else { u.A = A + (size_t)t * a_t; u.gat = nullptr; }
        u.nvalid = __builtin_amdgcn_readfirstlane(min(256, cnt[e] - mt * 256));
        u.B = W + (size_t)e * w_e + (size_t)pn * w_t; u.m0 = t * 256; u.n0 = pn * 256; u.aux = e; return true; } };
struct SchedF1 { const bf16* CS; const bf16* U;
    DI bool get(int L, Unit& u) const { if (L >= 1024) return false; const int b = L >> 8, g = (L >> 6) & 3, pm = (L >> 4) & 3, pn = L & 15;
        u.A = CS + (size_t)pm * 256 * 512; u.B = U + ((size_t)b * SEQ + pn * 256) * D + g * 512; u.gat = nullptr; u.nvalid = 256; u.m0 = pm * 256; u.n0 = pn * 256; u.aux = b * 4 + g; return true; } };
struct SchedF2 { const bf16* ACS; const bf16* BT2;
    DI bool get(int L, Unit& u) const { if (L >= 512) return false; const int b = L >> 7, pm = (L >> 3) & 15, pn = L & 7;
        u.A = ACS + (size_t)pm * 256 * 8192; u.B = BT2 + ((size_t)b * D + pn * 256) * 8192; u.gat = nullptr; u.nvalid = 256; u.m0 = pm * 256; u.n0 = pn * 256; u.aux = b; return true; } };

DI void st_bf16x4(bf16* p, f32x4 v) { u32x2 w; w.x = pk2(v.x, v.y); w.y = pk2(v.z, v.w); *(u32x2*)p = w; }
struct EpiStoreBf16 { bf16* O; int ldc;
    DI void operator()(const Unit& u, int r, int c, f32x4 lo, f32x4 hi) const { bf16* p = O + (size_t)(u.m0 + r) * ldc + u.n0 + c; st_bf16x4(p, lo); st_bf16x4(p + 128, hi); } };
struct EpiResid { const float* x; float* t; const float* gate;
    DI void operator()(const Unit& u, int r, int c, f32x4 lo, f32x4 hi) const { const int row = u.m0 + r, b = row >> 12; const int col = u.n0 + c;
        const size_t o = (size_t)row * D + col; const float* g = gate + (size_t)b * MODW + col;
        *(f32x4*)(t + o) = *(const f32x4*)(x + o) * ALPHA + *(const f32x4*)g * lo;
        *(f32x4*)(t + o + 128) = *(const f32x4*)(x + o + 128) * ALPHA + *(const f32x4*)(g + 128) * hi; } };
struct EpiSwiglu { bf16* H;
    DI void operator()(const Unit& u, int r, int c, f32x4 lo, f32x4 hi) const { f32x4 h;
        h.x = silu_f(lo.x) * hi.x; h.y = silu_f(lo.y) * hi.y; h.z = silu_f(lo.z) * hi.z; h.w = silu_f(lo.w) * hi.w;
        st_bf16x4(H + (size_t)(u.m0 + r) * DE + (u.n0 >> 1) + c, h); } };
struct EpiF1 { bf16* BT2;
    DI void operator()(const Unit& u, int r, int c, f32x4 lo, f32x4 hi) const { const int b = u.aux >> 2, g = u.aux & 3, m = u.m0 + r, cs = m >> 9, cp = m & 511;
        bf16* p = BT2 + ((size_t)b * D + g * 512 + cp) * 8192 + cs * 4096 + u.n0 + c; st_bf16x4(p, lo); st_bf16x4(p + 128, hi); } };
struct EpiF2 { bf16* REZ;
    DI void operator()(const Unit& u, int r, int c, f32x4 lo, f32x4 hi) const { bf16* p = REZ + ((size_t)u.aux * SEQ + u.m0 + r) * D + u.n0 + c; st_bf16x4(p, lo); st_bf16x4(p + 128, hi); } };

DI void p0_mods(const float* c, const float* cctx, const float* ada_w, const float* ada_b, float* mods, LAS float* sl, int tid) {
    LAS float* red = sl + 5 * D;
    for (int i = tid; i < 5 * D; i += 512) { const float v = i < 4 * D ? c[i] : cctx[i - 4 * D]; sl[i] = silu_f(v); }
    __syncthreads();
    const int cq = tid & 127, ks = tid >> 7;
    for (int unit = blockIdx.x; unit < 192; unit += gridDim.x) {
        const int l = unit / 96, n = (unit % 96) * 128 + cq;
        const float* W = ada_w + (size_t)l * D * MODW + n;
        float a0 = 0.f, a1 = 0.f, a2 = 0.f, a3 = 0.f, a4 = 0.f;
#pragma unroll 8
        for (int k = ks * 512; k < ks * 512 + 512; ++k) { const float w = W[(size_t)k * MODW]; a0 += sl[k] * w; a1 += sl[D + k] * w; a2 += sl[2 * D + k] * w; a3 += sl[3 * D + k] * w; a4 += sl[4 * D + k] * w; }
        red[(ks * 5 + 0) * 128 + cq] = a0; red[(ks * 5 + 1) * 128 + cq] = a1; red[(ks * 5 + 2) * 128 + cq] = a2; red[(ks * 5 + 3) * 128 + cq] = a3; red[(ks * 5 + 4) * 128 + cq] = a4;
        __syncthreads();
        for (int i = tid; i < 640; i += 512) { const int r = i >> 7, q = i & 127, n2 = (unit % 96) * 128 + q;
            const float s = (red[(0 * 5 + r) * 128 + q] + red[(1 * 5 + r) * 128 + q]) + (red[(2 * 5 + r) * 128 + q] + red[(3 * 5 + r) * 128 + q]);
            mods[((size_t)l * 5 + r) * MODW + n2] = s + ada_b[(size_t)l * MODW + n2]; }
        __syncthreads();
    }
}
DI void tr_item(const float* W, int N, int Kd, int k0, int n0, bf16* WT, int drow0, LAS unsigned char* scr, int lane) {
    const int ng = lane & 15, kl = lane >> 4;
    f32x4 v[2][8];
    const float* src = W + (size_t)(k0 + 16 * kl) * N + n0 + 4 * ng;
#pragma unroll
    for (int pp = 0; pp < 2; ++pp)
#pragma unroll
        for (int i = 0; i < 8; ++i) v[pp][i] = *(const f32x4*)(src + (size_t)(8 * pp + i) * N);
#pragma unroll
    for (int pp = 0; pp < 2; ++pp)
#pragma unroll
        for (int c = 0; c < 4; ++c) { u32x4 o; o.x = pk2(v[pp][0][c], v[pp][1][c]); o.y = pk2(v[pp][2][c], v[pp][3][c]); o.z = pk2(v[pp][4][c], v[pp][5][c]); o.w = pk2(v[pp][6][c], v[pp][7][c]);
            *(LAS u32x4*)(scr + (4 * ng + c) * 144 + (16 * kl + 8 * pp) * 2) = o; }
    asm volatile("s_waitcnt lgkmcnt(0)" ::: "memory");
#pragma unroll
    for (int j = 0; j < 8; ++j) { const int row = (lane >> 3) + 8 * j, ch = lane & 7;
        const u32x4 o = *(const LAS u32x4*)(scr + row * 144 + ch * 16);
        *(u32x4*)(WT + (size_t)(drow0 + row) * Kd + k0 + 8 * ch) = o; }
    asm volatile("s_waitcnt lgkmcnt(0)" ::: "memory");
}
DI void p0_weights(const float* w_in, const float* w_out, const float* w_f, const float* w_gate, const float* w_up, const float* w_down,
                   bf16* WIN, bf16* WO, bf16* WF, bf16* WGU, bf16* WD, LAS unsigned char* scr, int gw, int NGW, int lane) {
    constexpr int I_IN = 32 * 96, I_SQ = 32 * 32, I_E = 64 * 512;
    constexpr int NIT = I_IN + 2 * I_SQ + 3 * I_E;
    for (int it = gw; it < NIT; it += NGW) {
        int r = it;
        if (r < I_IN) { const int kb = r / 96, nb = r % 96; tr_item(w_in, NMIX, D, kb * 64, nb * 64, WIN, nb * 64, scr, lane); continue; } r -= I_IN;
        if (r < I_SQ) { const int kb = r >> 5, nb = r & 31; tr_item(w_out, D, D, kb * 64, nb * 64, WO, nb * 64, scr, lane); continue; } r -= I_SQ;
        if (r < I_SQ) { const int kb = r >> 5, nb = r & 31; tr_item(w_f, D, D, kb * 64, nb * 64, WF, nb * 64, scr, lane); continue; } r -= I_SQ;
        if (r < 2 * I_E) { const int up = r >= I_E; if (up) r -= I_E; const int mat = r >> 9, rr = r & 511, kb = rr >> 4, nb = rr & 15, n0 = nb * 64;
            tr_item((up ? w_up : w_gate) + (size_t)mat * D * DE, DE, D, kb * 64, n0, WGU + (size_t)mat * D * D, (n0 >> 7) * 256 + (n0 & 127) + (up ? 128 : 0), scr, lane); continue; } r -= 2 * I_E;
        { const int mat = r >> 9, rr = r & 511, kb = rr >> 5, nb = rr & 31; tr_item(w_down + (size_t)mat * DE * D, D, DE, kb * 64, nb * 64, WD + (size_t)mat * D * DE, nb * 64, scr, lane); }
    }
}
DI void p0_dft(bf16* ACS, bf16* CS, int gtid, int GT) {
    for (int i = gtid; i < 4096 * 1024; i += GT) { const int j = i >> 10, k8 = (i & 1023) * 8; unsigned w[4];
#pragma unroll
        for (int e = 0; e < 4; ++e) { float v[2];
#pragma unroll
            for (int q = 0; q < 2; ++q) { const int kk = k8 + 2 * e + q; const int m = (j * (kk & 4095)) & 4095; const float ang = (float)m * (1.f / 2048.f); v[q] = (kk < 4096 ? cospif(ang) : -sinpif(ang)) * (1.f / 64.f); }
            w[e] = pk2(v[0], v[1]); }
        *(u32x4*)(ACS + (size_t)j * 8192 + k8) = (u32x4){w[0], w[1], w[2], w[3]}; }
    for (int i = gtid; i < 1024 * 64; i += GT) { const int rr = i >> 6, c8 = (i & 63) * 8, cs = rr >> 9, cp = rr & 511; unsigned w[4];
#pragma unroll
        for (int e = 0; e < 4; ++e) { float v[2];
#pragma unroll
            for (int q = 0; q < 2; ++q) { const int cc = c8 + 2 * e + q; const int m = (cc * cp) & 511; const float ang = (float)m * (1.f / 256.f); v[q] = (cs ? sinpif(ang) : cospif(ang)) * 0.04419417382415922f; }
            w[e] = pk2(v[0], v[1]); }
        *(u32x4*)(CS + (size_t)rr * 512 + c8) = (u32x4){w[0], w[1], w[2], w[3]}; }
}
DI void ln_mod_phase(const float* x, const float* ctx, const float* mods_l, int sh_chunk, bf16* U, int nrows, int gw, int NGW, int lane) {
    int row = gw; if (row >= nrows) return;
    Row cur; row_load(cur, row < T ? x + (size_t)row * D : ctx + (size_t)(row - T) * D, lane);
    for (; row < nrows; row += NGW) {
        const int nr = row + NGW < nrows ? row + NGW : row;
        Row nxt; row_load(nxt, nr < T ? x + (size_t)nr * D : ctx + (size_t)(nr - T) * D, lane);
        const int rb = row < T ? (row >> 12) : 4;
        row_ln(cur);
        const float* mr = mods_l + (size_t)rb * MODW + sh_chunk * D;
        row_modulate(cur, mr, mr + D, lane);
        row_store_bf16(cur, U + (size_t)row * D, lane);
        cur = nxt;
    }
}
DI void attn_simple(const bf16* P, const float* rpb, bf16* MIX, LAS float* scr, int gw, int NGW, int lane) {
    const float scale = 0.08838834764831845f;
    for (int item = gw; item < T * NH; item += NGW) {
        const int tok = item >> 3, h = item & 7, b = tok >> 12, l = tok & 4095, r = l >> 6, qc = l & 63;
        const int rs = min(max(r - 4, 0), 56), cs = min(max(qc - 8, 0), 48);
        { const unsigned w = *((const unsigned*)(P + (size_t)tok * NMIX + h * HD) + lane); scr[2 * lane] = bflo(w); scr[2 * lane + 1] = bfhi(w); }
        asm volatile("s_waitcnt lgkmcnt(0)" ::: "memory");
        float s[6];
#pragma unroll
        for (int i = 0; i < 6; ++i) {
            const int kk = lane + 64 * i; size_t krow; float bias = 0.f;
            if (kk < 128) { const int a = kk >> 4, j = kk & 15; krow = (size_t)b * SEQ + 64 * (rs + a) + cs + j; bias = rpb[(h * 15 + (rs + a - r + 7)) * 31 + (cs + j - qc + 15)]; }
            else krow = (size_t)T + b * CTXL + (kk - 128);
            const u32x4* kp = (const u32x4*)(P + krow * NMIX + D / 2 + h * HD);
            float acc = 0.f;
#pragma unroll 4
            for (int d8 = 0; d8 < 16; ++d8) { const u32x4 kv = kp[d8]; const LAS f32x4* qv = (const LAS f32x4*)scr + 2 * d8; const f32x4 q0 = qv[0], q1 = qv[1];
                acc += bflo(kv.x) * q0.x + bfhi(kv.x) * q0.y + bflo(kv.y) * q0.z + bfhi(kv.y) * q0.w + bflo(kv.z) * q1.x + bfhi(kv.z) * q1.y + bflo(kv.w) * q1.z + bfhi(kv.w) * q1.w; }
            s[i] = acc * scale + bias;
        }
        float m = s[0];
#pragma unroll
        for (int i = 1; i < 6; ++i) m = fmaxf(m, s[i]);
        m = wave_max(m); float sum = 0.f;
#pragma unroll
        for (int i = 0; i < 6; ++i) { s[i] = expf(s[i] - m); sum += s[i]; scr[128 + lane + 64 * i] = s[i]; }
        sum = wave_sum(sum);
        asm volatile("s_waitcnt lgkmcnt(0)" ::: "memory");
        float o0 = 0.f, o1 = 0.f;
        for (int kk = 0; kk < 384; ++kk) {
            size_t vrow; if (kk < 128) vrow = (size_t)b * SEQ + 64 * (rs + (kk >> 4)) + cs + (kk & 15); else vrow = (size_t)T + b * CTXL + (kk - 128);
            const unsigned w = *((const unsigned*)(P + vrow * NMIX + D + h * HD) + lane); const float p = scr[128 + kk];
            o0 += p * bflo(w); o1 += p * bfhi(w);
        }
        const float inv = 1.f / sum;
        *((unsigned*)(MIX + (size_t)tok * D + h * HD) + lane) = pk2(o0 * inv, o1 * inv);
        asm volatile("s_waitcnt lgkmcnt(0)" ::: "memory");
    }
}

constexpr int ATT_RS = 288, ATT_TILE = 64 * ATT_RS, ATT_BUF = 2 * ATT_TILE;
typedef short s16x4 __attribute__((ext_vector_type(4)));
struct AttState { f32x4 sc[32]; unsigned pk[32][2]; f32x4 o[8]; u32x4 stg[4]; bf16x8 qf[4]; float inv; unsigned g_off, w_off, ka_off, va_off; };
struct AttCtx { const bf16* P; LAS unsigned char* lds; const LAS float* lrpb; int b, r, rs, hp, hs, c0, qc, csq, quad; };
template <int STEP> DI void att_load(AttState& S, const AttCtx& C) {
    constexpr int ti = STEP % 12; const int colb = (STEP < 12 ? 1024 : 2048) + C.hp * 256;
    const size_t tok0 = ti < 8 ? (size_t)C.b * SEQ + 64 * (C.rs + ti) : (size_t)T + C.b * CTXL + (ti - 8) * 64;
    const char* ub = (const char*)(C.P + tok0 * NMIX + colb);
#pragma unroll
    for (int k = 0; k < 4; ++k) S.stg[k] = *(const u32x4*)(ub + (size_t)(32 * (k & 1)) * NMIX * 2 + (k >> 1) * 256 + S.g_off);
}
template <int BUFI> DI void att_write(AttState& S, const AttCtx& C) {
#pragma unroll
    for (int k = 0; k < 4; ++k) *(LAS u32x4*)(C.lds + BUFI * ATT_BUF + (k >> 1) * ATT_TILE + 32 * (k & 1) * ATT_RS + S.w_off) = S.stg[k];
}
template <int STEP> DI void att_step(AttState& S, const AttCtx& C) {
    const float scale = 0.08838834764831845f;
    asm volatile("" : "+v"(S.g_off), "+v"(S.w_off), "+v"(S.ka_off), "+v"(S.va_off));
    if constexpr (STEP + 1 < 24) att_load<STEP + 1>(S, C);
    constexpr int bo = (STEP & 1) * ATT_BUF;
    if constexpr (STEP < 12) {
        constexpr int ti = STEP;
        if constexpr (ti < 8) {
            const int aidx = C.rs + ti - C.r + 7;
            const LAS float* brow = C.lrpb + C.hs * 465 + aidx * 31;
#pragma unroll
            for (int t = 0; t < 2; ++t) { const int krow0 = C.c0 + 16 * t; f32x4 acc = (f32x4){0.f, 0.f, 0.f, 0.f};
                const LAS unsigned char* ka = C.lds + bo + krow0 * ATT_RS + S.ka_off;
#pragma unroll
                for (int s4 = 0; s4 < 4; ++s4) acc = __builtin_amdgcn_mfma_f32_16x16x32_bf16(*(const LAS bf16x8*)(ka + s4 * 64), S.qf[s4], acc, 0, 0, 0);
#pragma unroll
                for (int i = 0; i < 4; ++i) { const int kcol = krow0 + C.quad * 4 + i; const bool ok = kcol >= C.csq && kcol < C.csq + 16; const int bi = min(max(kcol - C.qc + 15, 0), 30);
                    const float bias = brow[bi]; S.sc[ti * 2 + t][i] = ok ? acc[i] * scale + bias : -1e30f; } }
        } else {
#pragma unroll
            for (int t = 0; t < 4; ++t) { f32x4 acc = (f32x4){0.f, 0.f, 0.f, 0.f};
                const LAS unsigned char* ka = C.lds + bo + 16 * t * ATT_RS + S.ka_off;
#pragma unroll
                for (int s4 = 0; s4 < 4; ++s4) acc = __builtin_amdgcn_mfma_f32_16x16x32_bf16(*(const LAS bf16x8*)(ka + s4 * 64), S.qf[s4], acc, 0, 0, 0);
                S.sc[16 + (ti - 8) * 4 + t] = acc * scale; }
        }
    } else {
        if constexpr (STEP == 12) {
            float m = -1e30f;
#pragma unroll
            for (int sl = 0; sl < 32; ++sl) m = fmaxf(fmaxf(m, fmaxf(S.sc[sl][0], S.sc[sl][1])), fmaxf(S.sc[sl][2], S.sc[sl][3]));
            m = fmaxf(m, __shfl_xor(m, 16)); m = fmaxf(m, __shfl_xor(m, 32));
            float sum = 0.f;
#pragma unroll
            for (int sl = 0; sl < 32; ++sl) { const float e0 = __expf(S.sc[sl][0] - m), e1 = __expf(S.sc[sl][1] - m), e2 = __expf(S.sc[sl][2] - m), e3 = __expf(S.sc[sl][3] - m);
                sum += (e0 + e1) + (e2 + e3); S.pk[sl][0] = pk2(e0, e1); S.pk[sl][1] = pk2(e2, e3); }
            sum += __shfl_xor(sum, 16); sum += __shfl_xor(sum, 32); S.inv = 1.f / sum;
#pragma unroll
            for (int dt = 0; dt < 8; ++dt) S.o[dt] = (f32x4){0.f, 0.f, 0.f, 0.f};
        }
        constexpr int ti = STEP - 12; constexpr int nks = ti < 8 ? 1 : 2;
#pragma unroll
        for (int kk = 0; kk < nks; ++kk) {
            const int sa = ti < 8 ? ti * 2 : 16 + (ti - 8) * 4 + 2 * kk; const int rb = ti < 8 ? C.c0 : 32 * kk;
            const u32x4 pw = (u32x4){S.pk[sa][0], S.pk[sa][1], S.pk[sa + 1][0], S.pk[sa + 1][1]}; const bf16x8 pf = __builtin_bit_cast(bf16x8, pw);
            const LAS unsigned char* va = C.lds + bo + rb * ATT_RS + S.va_off;
#pragma unroll
            for (int dt = 0; dt < 8; ++dt) { const s16x4 v1 = __builtin_amdgcn_ds_read_tr16_b64_v4i16((LAS s16x4*)(va + dt * 32)); const s16x4 v2 = __builtin_amdgcn_ds_read_tr16_b64_v4i16((LAS s16x4*)(va + 16 * ATT_RS + dt * 32));
                const bf16x8 vf = __builtin_shufflevector(v1, v2, 0, 1, 2, 3, 4, 5, 6, 7); S.o[dt] = __builtin_amdgcn_mfma_f32_16x16x32_bf16(vf, pf, S.o[dt], 0, 0, 0); }
        }
    }
    if constexpr (STEP + 1 < 24) att_write<(STEP + 1) & 1>(S, C);
    __syncthreads();
}
DI void attn_phase(const bf16* P, const float* rpb, bf16* MIX, LAS unsigned char* lds, LAS float* lrpb) {
    const int tid = threadIdx.x, wid = __builtin_amdgcn_readfirstlane(tid >> 6), lane = tid & 63, hs = wid >> 2, j = wid & 3, lq = lane & 15, quad = lane >> 4;
    const int srow = tid >> 4, sch = tid & 15;
    AttState S; AttCtx C;
    C.P = P; C.lds = lds; C.lrpb = lrpb; C.hs = hs; C.quad = quad;
    C.c0 = (j == 0) ? 0 : (j == 1) ? 8 : (j == 2) ? 24 : 32;
    C.qc = 16 * j + lq; C.csq = min(max(C.qc - 8, 0), 48);
    S.g_off = (unsigned)(srow * NMIX + sch * 8) * 2u;
    S.w_off = (unsigned)(srow * ATT_RS + sch * 16);
    S.ka_off = (unsigned)(hs * ATT_TILE + lq * ATT_RS + quad * 16);
    S.va_off = (unsigned)(hs * ATT_TILE + (4 * quad + (lq >> 2)) * ATT_RS + 8 * (lq & 3));
    for (int unit = blockIdx.x; unit < 1024; unit += gridDim.x) {
        const int r = unit & 63, hp = (unit >> 6) & 3, b = unit >> 8, h = 2 * hp + hs;
        C.r = r; C.hp = hp; C.b = b; C.rs = min(max(r - 4, 0), 56);
        __syncthreads();
        for (int i = tid; i < 930; i += 512) lrpb[i] = rpb[(size_t)hp * 930 + i];
        const size_t tq = (size_t)b * SEQ + 64 * r + C.qc;
#pragma unroll
        for (int s4 = 0; s4 < 4; ++s4) S.qf[s4] = *(const bf16x8*)(P + tq * NMIX + h * HD + s4 * 32 + quad * 8);
        att_load<0>(S, C); att_write<0>(S, C); __syncthreads();
        att_step<0>(S, C); att_step<1>(S, C); att_step<2>(S, C); att_step<3>(S, C); att_step<4>(S, C); att_step<5>(S, C); att_step<6>(S, C); att_step<7>(S, C);
        att_step<8>(S, C); att_step<9>(S, C); att_step<10>(S, C); att_step<11>(S, C); att_step<12>(S, C); att_step<13>(S, C); att_step<14>(S, C); att_step<15>(S, C);
        att_step<16>(S, C); att_step<17>(S, C); att_step<18>(S, C); att_step<19>(S, C); att_step<20>(S, C); att_step<21>(S, C); att_step<22>(S, C); att_step<23>(S, C);
        bf16* op = MIX + tq * D + h * HD + quad * 4;
#pragma unroll
        for (int dt = 0; dt < 8; ++dt) st_bf16x4(op + dt * 16, S.o[dt] * S.inv);
    }
}

DI void conv_phase(const bf16* P, const float* cw, bf16* MIX, int gtid, int GT) {
    for (int i = gtid; i < T * 128; i += GT) {
        const int tok = i >> 7, c8 = (i & 127) * 8, l = tok & 4095;
        const bf16* base = P + (size_t)tok * NMIX + 3072 + c8;
        const u32x4 gb = *(const u32x4*)base;
        float z[3][8];
#pragma unroll
        for (int j = 0; j < 3; ++j) { const int ll = l + j - 1; const bool ok = ll >= 0 && ll < SEQ;
            u32x4 gc = (u32x4){0u, 0u, 0u, 0u}, xi = gc;
            if (ok) { const bf16* pj = base + (ptrdiff_t)(j - 1) * NMIX; gc = *(const u32x4*)(pj + 1024); xi = *(const u32x4*)(pj + 2048); }
            z[j][0] = bflo(gc.x) * bflo(xi.x); z[j][1] = bfhi(gc.x) * bfhi(xi.x); z[j][2] = bflo(gc.y) * bflo(xi.y); z[j][3] = bfhi(gc.y) * bfhi(xi.y);
            z[j][4] = bflo(gc.z) * bflo(xi.z); z[j][5] = bfhi(gc.z) * bfhi(xi.z); z[j][6] = bflo(gc.w) * bflo(xi.w); z[j][7] = bfhi(gc.w) * bfhi(xi.w); }
        float gbf[8] = {bflo(gb.x), bfhi(gb.x), bflo(gb.y), bfhi(gb.y), bflo(gb.z), bfhi(gb.z), bflo(gb.w), bfhi(gb.w)};
        float o[8];
#pragma unroll
        for (int e = 0; e < 8; ++e) o[e] = gbf[e] * (cw[c8 + e] * z[0][e] + cw[1024 + c8 + e] * z[1][e] + cw[2048 + c8 + e] * z[2][e]);
        *(u32x4*)(MIX + (size_t)tok * D + 1024 + c8) = (u32x4){pk2(o[0], o[1]), pk2(o[2], o[3]), pk2(o[4], o[5]), pk2(o[6], o[7])};
    }
}
constexpr int RT_RS = 4112, RT_IMG = 16 * RT_RS;
DI void split_bf16(const float* w8, bf16x8& hi, bf16x8& lo) {
    unsigned h[4], l[4];
#pragma unroll
    for (int p = 0; p < 4; ++p) { const unsigned a = f2bf(w8[2 * p]), b = f2bf(w8[2 * p + 1]); h[p] = a | (b << 16);
        l[p] = pk2(w8[2 * p] - __uint_as_float(a << 16), w8[2 * p + 1] - __uint_as_float(b << 16)); }
    hi = __builtin_bit_cast(bf16x8, (u32x4){h[0], h[1], h[2], h[3]}); lo = __builtin_bit_cast(bf16x8, (u32x4){l[0], l[1], l[2], l[3]});
}
DI void ln_router_phase(const float* TBp, const float* lng, const float* lnb, const float* mods_l, const float* rw, const float* rbias,
                        float* X1p, bf16* Up, unsigned* counts, int* tablep, unsigned* tokinfop, LAS unsigned char* lds) {
    const int tid = threadIdx.x, wave = __builtin_amdgcn_readfirstlane(tid >> 6), lane = tid & 63, fr = lane & 15, fq = lane >> 4;
    bf16x8 bh[8][2], bl[8][2];
#pragma unroll
    for (int ks = 0; ks < 8; ++ks)
#pragma unroll
        for (int nt = 0; nt < 2; ++nt) { float w8[8];
#pragma unroll
            for (int j = 0; j < 8; ++j) w8[j] = rw[(size_t)(256 * wave + 32 * ks + 8 * fq + j) * NE + nt * 16 + fr];
            split_bf16(w8, bh[ks][nt], bl[ks][nt]); }
    LAS float* part = (LAS float*)lds; LAS float* lgs = (LAS float*)(lds + 16384);
    for (int rg = blockIdx.x; rg < T / 16; rg += gridDim.x) {
        __syncthreads();
#pragma unroll 1
        for (int rr = 0; rr < 2; ++rr) {
            const int lr = 2 * wave + rr, row = rg * 16 + lr;
            Row r; row_load(r, TBp + (size_t)row * D, lane); row_ln(r); row_affine(r, lng, lnb, lane);
            row_store(r, X1p + (size_t)row * D, lane);
            row_ln(r);
            const float* mr = mods_l + (size_t)(row >> 12) * MODW + 3 * D;
            row_modulate(r, mr, mr + D, lane);
            u32x2* uq = (u32x2*)(Up + (size_t)row * D) + lane;
#pragma unroll
            for (int j = 0; j < 8; ++j) { const unsigned a = f2bf(r.v[j].x), b = f2bf(r.v[j].y), c = f2bf(r.v[j].z), d = f2bf(r.v[j].w);
                u32x2 hi; hi.x = a | (b << 16); hi.y = c | (d << 16); uq[64 * j] = hi;
                u32x2 lo; lo.x = pk2(r.v[j].x - __uint_as_float(a << 16), r.v[j].y - __uint_as_float(b << 16)); lo.y = pk2(r.v[j].z - __uint_as_float(c << 16), r.v[j].w - __uint_as_float(d << 16));
                *(LAS u32x2*)(lds + lr * RT_RS + (4 * lane + 256 * j) * 2) = hi; *(LAS u32x2*)(lds + RT_IMG + lr * RT_RS + (4 * lane + 256 * j) * 2) = lo; }
        }
        __syncthreads();
        f32x4 acc[2]; acc[0] = (f32x4){0.f, 0.f, 0.f, 0.f}; acc[1] = acc[0];
        const LAS unsigned char* ap = lds + fr * RT_RS + (256 * wave + 8 * fq) * 2;
#pragma unroll
        for (int ks = 0; ks < 8; ++ks) { const bf16x8 ah = *(const LAS bf16x8*)(ap + ks * 64), al = *(const LAS bf16x8*)(ap + RT_IMG + ks * 64);
#pragma unroll
            for (int nt = 0; nt < 2; ++nt) { acc[nt] = __builtin_amdgcn_mfma_f32_16x16x32_bf16(ah, bh[ks][nt], acc[nt], 0, 0, 0); acc[nt] = __builtin_amdgcn_mfma_f32_16x16x32_bf16(ah, bl[ks][nt], acc[nt], 0, 0, 0);
                acc[nt] = __builtin_amdgcn_mfma_f32_16x16x32_bf16(al, bh[ks][nt], acc[nt], 0, 0, 0); } }
        __syncthreads();
#pragma unroll
        for (int nt = 0; nt < 2; ++nt)
#pragma unroll
            for (int i = 0; i < 4; ++i) part[(wave * 16 + fq * 4 + i) * 32 + nt * 16 + fr] = acc[nt][i];
        __syncthreads();
        { const int r16 = tid >> 5, e = tid & 31; float sacc = 0.f;
#pragma unroll
            for (int w = 0; w < 8; ++w) sacc += part[(w * 16 + r16) * 32 + e];
            const float af = 1.f / (1.f + expf(-sacc)); const float bi = af + rbias[e];
            lgs[r16 * 32 + e] = af; lgs[512 + r16 * 32 + e] = bi;
            const float b1 = dpp_f<0xB1>(bi), b2 = dpp_f<0x4E>(bi), b3 = dpp_f<0x1B>(bi);
            const float hi1 = fmaxf(bi, b1), lo1 = fminf(bi, b1), hi2 = fmaxf(b2, b3), lo2 = fminf(b2, b3);
            const float scg = fmaxf(hi1, hi2) + fmaxf(fminf(hi1, hi2), fmaxf(lo1, lo2));
            if ((e & 3) == 0) lgs[1024 + r16 * 8 + (e >> 2)] = scg; }
        __syncthreads();
        if (tid < 16) {
            const int row = rg * 16 + tid; const LAS float* gs = lgs + 1024 + tid * 8;
            float best = -1e30f; int grp = 0;
#pragma unroll
            for (int g = 0; g < 8; ++g) { const float scg = gs[g]; if (scg > best) { best = scg; grp = g; } }
            float ga[4], gv[4];
#pragma unroll
            for (int i = 0; i < 4; ++i) { ga[i] = lgs[tid * 32 + 4 * grp + i]; gv[i] = lgs[512 + tid * 32 + 4 * grp + i]; }
            int i1 = 0; float v1 = gv[0]; if (gv[1] > v1) { v1 = gv[1]; i1 = 1; } if (gv[2] > v1) { v1 = gv[2]; i1 = 2; } if (gv[3] > v1) { v1 = gv[3]; i1 = 3; }
            int i2 = -1; float v2 = -1e30f;
            if (i1 != 0 && gv[0] > v2) { v2 = gv[0]; i2 = 0; } if (i1 != 1 && gv[1] > v2) { v2 = gv[1]; i2 = 1; } if (i1 != 2 && gv[2] > v2) { v2 = gv[2]; i2 = 2; } if (i1 != 3 && gv[3] > v2) { v2 = gv[3]; i2 = 3; }
            const float a1 = i1 == 0 ? ga[0] : i1 == 1 ? ga[1] : i1 == 2 ? ga[2] : ga[3], a2 = i2 == 0 ? ga[0] : i2 == 1 ? ga[1] : i2 == 2 ? ga[2] : ga[3];
            const float w1 = a1 / (a1 + a2), w2 = a2 / (a1 + a2);
            const int e1 = grp * 4 + i1, e2 = grp * 4 + i2;
            const unsigned p1 = __hip_atomic_fetch_add(counts + e1, 1u, __ATOMIC_RELAXED, __HIP_MEMORY_SCOPE_AGENT);
            const unsigned p2 = __hip_atomic_fetch_add(counts + e2, 1u, __ATOMIC_RELAXED, __HIP_MEMORY_SCOPE_AGENT);
            tablep[(size_t)e1 * T + p1] = row; tablep[(size_t)e2 * T + p2] = row;
            u32x4 ta; ta.x = (unsigned)e1; ta.y = (unsigned)e2; ta.z = p1; ta.w = p2; u32x4 tb2; tb2.x = __float_as_uint(w1); tb2.y = __float_as_uint(w2); tb2.z = 0u; tb2.w = 0u;
            *(u32x4*)(tokinfop + (size_t)row * 8) = ta; *(u32x4*)(tokinfop + (size_t)row * 8 + 4) = tb2;
        }
    }
}
DI void moe_prefix(const unsigned* counts, LAS int* cnt, LAS int* tb, int tid) {
    __syncthreads();
    if (tid < 32) cnt[tid] = (int)__hip_atomic_load(counts + tid, __ATOMIC_RELAXED, __HIP_MEMORY_SCOPE_AGENT);
    __syncthreads();
    if (tid == 0) { int a = 0; for (int e = 0; e < 32; ++e) { tb[e] = a; a += (cnt[e] + 255) >> 8; } tb[32] = a; }
    __syncthreads();
}
DI void combine_phase(const float* X1, const bf16* Y, const unsigned* tokinfo, const LAS int* tb, const float* mods_l, const float* lng, const float* lnb,
                      float* XO, const float* mods_next, bf16* U, int gw, int NGW, int lane) {
    if (gw >= T) return;
    u32x4 ta = *(const u32x4*)(tokinfo + (size_t)gw * 8), tw = *(const u32x4*)(tokinfo + (size_t)gw * 8 + 4);
    for (int row = gw; row < T; row += NGW) {
        const int nr = row + NGW < T ? row + NGW : row;
        const u32x4 tan = *(const u32x4*)(tokinfo + (size_t)nr * 8), twn = *(const u32x4*)(tokinfo + (size_t)nr * 8 + 4);
        const int e0 = __builtin_amdgcn_readfirstlane((int)ta.x), e1 = __builtin_amdgcn_readfirstlane((int)ta.y);
        const size_t r0 = (size_t)(__builtin_amdgcn_readfirstlane(tb[e0]) * 256 + __builtin_amdgcn_readfirstlane((int)ta.z)), r1 = (size_t)(__builtin_amdgcn_readfirstlane(tb[e1]) * 256 + __builtin_amdgcn_readfirstlane((int)ta.w));
        const float w0 = __uint_as_float(tw.x), w1 = __uint_as_float(tw.y);
        Row r; row_load(r, X1 + (size_t)row * D, lane);
        const u32x2* y0 = (const u32x2*)(Y + r0 * D) + lane; const u32x2* y1 = (const u32x2*)(Y + r1 * D) + lane;
        const f32x4* g2 = (const f32x4*)(mods_l + (size_t)(row >> 12) * MODW + 5 * D) + lane;
#pragma unroll
        for (int j = 0; j < 8; ++j) { const u32x2 a = y0[64 * j], b = y1[64 * j]; f32x4 f;
            f.x = w0 * bflo(a.x) + w1 * bflo(b.x); f.y = w0 * bfhi(a.x) + w1 * bfhi(b.x); f.z = w0 * bflo(a.y) + w1 * bflo(b.y); f.w = w0 * bfhi(a.y) + w1 * bfhi(b.y);
            r.v[j] = r.v[j] * ALPHA + g2[64 * j] * f; }
        row_ln(r); row_affine(r, lng, lnb, lane);
        row_store(r, XO + (size_t)row * D, lane);
        if (U) { row_ln(r); const float* mr = mods_next + (size_t)(row >> 12) * MODW; row_modulate(r, mr, mr + D, lane); row_store_bf16(r, U + (size_t)row * D, lane); }
        ta = tan; tw = twn;
    }
}

struct Args { const float* in[18]; float* out; unsigned char* ws; int ph_lo, ph_hi; };
__global__ void __launch_bounds__(512, 2) fwd(Args args) {
    extern __shared__ __attribute__((aligned(16))) unsigned char lds_raw[];
    LAS unsigned char* lds = (LAS unsigned char*)lds_raw;
#define PH_IDS int tid = threadIdx.x; asm volatile("" : "+v"(tid)); const int lane = tid & 63, wave = __builtin_amdgcn_readfirstlane(tid >> 6); \
    const int gw = blockIdx.x * 8 + wave, NGW = gridDim.x * 8, gtid = blockIdx.x * 512 + tid, GT = gridDim.x * 512; (void)lane; (void)gw; (void)NGW; (void)gtid; (void)GT;
    volatile LAS unsigned* LCTL = (volatile LAS unsigned*)(lds + LDSCTL_OFF);
    LAS int* l_cnt = (LAS int*)(lds + LDSCTL_OFF) + 16; LAS int* l_tb = (LAS int*)(lds + LDSCTL_OFF) + 48;
    for (int u = threadIdx.x; u < (LDS_BYTES - LDSCTL_OFF) / 4; u += 512) ((LAS unsigned*)(lds + LDSCTL_OFF))[u] = 0u;
    __syncthreads();
    unsigned char* ws = args.ws;
    unsigned* ctl = (unsigned*)(ws + WS_CTL);
#define XIN ((const float*)args.in[0])
#define c_in args.in[1]
#define ctx args.in[2]
#define c_ctx args.in[3]
#define ada_w args.in[4]
#define ada_b args.in[5]
#define w_mix_in args.in[6]
#define rpb args.in[7]
#define conv_w args.in[8]
#define w_mix_out args.in[9]
#define w_fourier args.in[10]
#define router_w args.in[11]
#define router_b args.in[12]
#define w_gate args.in[13]
#define w_up args.in[14]
#define w_down args.in[15]
#define ln_g args.in[16]
#define ln_b args.in[17]
#define mods ((float*)(ws + WS_MODS))
#define tokinfo ((unsigned*)(ws + WS_TOKINFO))
#define table ((int*)(ws + WS_TABLE))
#define WIN ((bf16*)(ws + WS_WIN))
#define WO ((bf16*)(ws + WS_WO))
#define WF ((bf16*)(ws + WS_WF))
#define CSM ((bf16*)(ws + WS_CS))
#define ACS ((bf16*)(ws + WS_ACS))
#define U ((bf16*)(ws + WS_U))
#define P ((bf16*)(ws + WS_P))
#define YB ((bf16*)(ws + WS_P))
#define BT2 ((bf16*)(ws + WS_P))
#define MIX ((bf16*)(ws + WS_MIX))
#define REZ ((bf16*)(ws + WS_MIX))
#define HB ((bf16*)(ws + WS_H))
#define WGU ((bf16*)(ws + WS_WGU))
#define WD ((bf16*)(ws + WS_WD))
#define TB ((float*)(ws + WS_TB))
#define X1 ((float*)(ws + WS_X1))
#define X2 ((float*)(ws + WS_X2))
    XcdBarrier bar; bar.bar = ctl + CW_BAR; bar.x = 0; bar.st = nullptr;
    if (N_LAUNCHES != NPHASE) bar = xcd_barrier_post(ctl + CW_BAR, LCTL);
    const int lo = args.ph_lo, hi = args.ph_hi;
#ifndef DUP_MASK
#define DUP_MASK 0x0000
#endif
#define RUN(k, ...) do { __VA_ARGS__ if constexpr ((((DUP_MASK) >> (k)) & 1) != 0) { __VA_ARGS__ } } while (0)
#ifndef PH_MASK
#define PH_MASK 0xffff
#endif
#define IN(k) ((((PH_MASK) >> (k)) & 1) && lo <= (k) && (k) < hi)
#define SEAM(k) do { if (IN(k) && IN((k) + 1)) xcd_barrier(bar); } while (0)

    RUN(0, if (IN(0)) { PH_IDS
        p0_mods(c_in, c_ctx, ada_w, ada_b, mods, (LAS float*)lds, tid);
        p0_weights(w_mix_in, w_mix_out, w_fourier, w_gate, w_up, w_down, WIN, WO, WF, WGU, WD, lds + wave * 16384, gw, NGW, lane);
        p0_dft(ACS, CSM, gtid, GT);
    });
    SEAM(0);
    RUN(1, if (IN(1)) { PH_IDS ln_mod_phase(XIN, ctx, mods, 0, U, TALL, gw, NGW, lane); });
    SEAM(1);
    RUN(2, if (IN(2)) { SchedInProj S{U, WIN}; EpiStoreBf16 E{P, NMIX}; gemm_pg8<false>(lds, S, E, D, D, D); });
    SEAM(2);
    RUN(3, if (IN(3)) { PH_IDS attn_phase(P, rpb, MIX, lds, (LAS float*)(lds + LDSCTL_OFF + 1024)); conv_phase(P, conv_w, MIX, gtid, GT); });
    SEAM(3);
    RUN(4, if (IN(4)) { SchedDense S{MIX, WO, 64, 8, (size_t)256 * D, (size_t)256 * D}; EpiResid E{XIN, TB, mods + 2 * D}; gemm_pg8<false>(lds, S, E, D, D, D); });
    SEAM(4);
    RUN(5, if (IN(5)) { PH_IDS ln_router_phase(TB, ln_g, ln_b, mods, router_w, router_b, X1, U, ctl + CW_CNT, table, tokinfo, lds); });
    SEAM(5);
    RUN(6, if (IN(6)) { PH_IDS moe_prefix(ctl + CW_CNT, l_cnt, l_tb, tid); SchedMoe S{l_cnt, l_tb, U, WGU, table, 1, 0, (size_t)D * D, (size_t)256 * D}; EpiSwiglu E{HB}; gemm_pg8<true>(lds, S, E, D, D, D); });
    SEAM(6);
    RUN(7, if (IN(7)) { PH_IDS moe_prefix(ctl + CW_CNT, l_cnt, l_tb, tid); SchedMoe S{l_cnt, l_tb, HB, WD, table, 0, (size_t)256 * DE, (size_t)D * DE, (size_t)256 * DE}; EpiStoreBf16 E{YB, D}; gemm_pg8<false>(lds, S, E, DE, DE, DE); });
    SEAM(7);
    RUN(8, if (IN(8)) { PH_IDS moe_prefix(ctl + CW_CNT, l_cnt, l_tb, tid); combine_phase(X1, YB, tokinfo, l_tb, mods, ln_g + D, ln_b + D, X2, mods + 5 * MODW, U, gw, NGW, lane); });
    SEAM(8);
    RUN(9, if (IN(9)) { SchedF1 S{CSM, U}; EpiF1 E{BT2}; gemm_pg8<false>(lds, S, E, 512, D, 512); });
    SEAM(9);
    RUN(10, if (IN(10)) { SchedF2 S{ACS, BT2}; EpiF2 E{REZ}; gemm_pg8<false>(lds, S, E, 8192, 8192, 8192); });
    SEAM(10);
    RUN(11, if (IN(11)) { SchedDense S{REZ, WF, 64, 8, (size_t)256 * D, (size_t)256 * D}; EpiResid E{X2, TB, mods + 5 * MODW + 2 * D}; gemm_pg8<false>(lds, S, E, D, D, D); });
    SEAM(11);
    RUN(12, if (IN(12)) { PH_IDS ln_router_phase(TB, ln_g + 2 * D, ln_b + 2 * D, mods + 5 * MODW, router_w, router_b, X1, U, ctl + CW_CNT + 32, table + (size_t)NE * T, tokinfo + (size_t)T * 8, lds); });
    SEAM(12);
    RUN(13, if (IN(13)) { PH_IDS moe_prefix(ctl + CW_CNT + 32, l_cnt, l_tb, tid); SchedMoe S{l_cnt, l_tb, U, WGU + (size_t)NE * D * D, table + (size_t)NE * T, 1, 0, (size_t)D * D, (size_t)256 * D}; EpiSwiglu E{HB}; gemm_pg8<true>(lds, S, E, D, D, D); });
    SEAM(13);
    RUN(14, if (IN(14)) { PH_IDS moe_prefix(ctl + CW_CNT + 32, l_cnt, l_tb, tid); SchedMoe S{l_cnt, l_tb, HB, WD + (size_t)NE * D * DE, table, 0, (size_t)256 * DE, (size_t)D * DE, (size_t)256 * DE}; EpiStoreBf16 E{YB, D}; gemm_pg8<false>(lds, S, E, DE, DE, DE); });
    SEAM(14);
    RUN(15, if (IN(15)) { PH_IDS moe_prefix(ctl + CW_CNT + 32, l_cnt, l_tb, tid); combine_phase(X1, YB, tokinfo + (size_t)T * 8, l_tb, mods + 5 * MODW, ln_g + 3 * D, ln_b + 3 * D, args.out, nullptr, nullptr, gw, NGW, lane); });
#undef IN
#undef SEAM
}

extern "C" void kernel_launch(void* const* d_in, const int* in_sizes, int n_in, void* d_out, int out_size, void* d_ws, size_t ws_size, hipStream_t stream) {
    static int grid = 0;
    if (grid == 0) {
        if (n_in != 18 || out_size != T * D || ws_size < WS_END) { fprintf(stderr, "kernel_launch: unexpected shapes (n_in %d, out %d, ws %zu)\n", n_in, out_size, ws_size); grid = -1; return; }
        int dev = 0, cus = 0, per_cu = 0;
        if (hipGetDevice(&dev) != hipSuccess || hipDeviceGetAttribute(&cus, hipDeviceAttributeMultiprocessorCount, dev) != hipSuccess) { grid = -1; return; }
        if (hipFuncSetAttribute((const void*)fwd, hipFuncAttributeMaxDynamicSharedMemorySize, LDS_BYTES) != hipSuccess) { fprintf(stderr, "kernel_launch: hipFuncSetAttribute failed\n"); grid = -1; return; }
        if (hipOccupancyMaxActiveBlocksPerMultiprocessor(&per_cu, (const void*)fwd, 512, LDS_BYTES) != hipSuccess || per_cu < 1) fprintf(stderr, "kernel_launch: occupancy query says %d\n", per_cu);
        (void)hipGetLastError();
        grid = cus;
    }
    if (grid < 0) return;
    (void)hipMemsetAsync((char*)d_ws + WS_CTL, 0, CTL_ZERO_BYTES, stream);
    Args a{};
    for (int i = 0; i < 18; ++i) a.in[i] = (const float*)d_in[i];
    a.out = (float*)d_out; a.ws = (unsigned char*)d_ws;
    if (N_LAUNCHES == 1) { a.ph_lo = 0; a.ph_hi = NPHASE; hipLaunchKernelGGL(fwd, dim3(grid), dim3(512), LDS_BYTES, stream, a); }
    else for (int p = 0; p < NPHASE; ++p) { a.ph_lo = p; a.ph_hi = p + 1; hipLaunchKernelGGL(fwd, dim3(grid), dim3(512), LDS_BYTES, stream, a); }
}
```

```cpp
#include <hip/hip_runtime.h>
#include <cstdio>
#include <cstdint>

#define DI __device__ __forceinline__
#define LAS __attribute__((address_space(3)))
typedef unsigned short bf16;
typedef float f32x4 __attribute__((ext_vector_type(4)));
typedef short bf16x8 __attribute__((ext_vector_type(8)));
typedef unsigned u32x4 __attribute__((ext_vector_type(4)));
typedef unsigned u32x2 __attribute__((ext_vector_type(2)));

constexpr int D = 2048, NB = 4, SEQ = 4096, T = NB * SEQ, CTXL = 256, TC = NB * CTXL, TALL = T + TC;
constexpr int NMIX = 6144, NE = 32, DE = 1024, NH = 8, HD = 128, MODW = 6 * D;
constexpr float ALPHA = 1.41421356237309515f;
constexpr float LN_EPS = 1e-6f;
constexpr int NPHASE = 17;
#ifndef MK_N_LAUNCHES
#define MK_N_LAUNCHES 1
#endif
constexpr int N_LAUNCHES = MK_N_LAUNCHES;

constexpr size_t MiB = 1u << 20;
constexpr size_t WS_CTL = 0, CTL_ZERO_BYTES = 64 * 1024;
constexpr size_t WS_MODS = 1 * MiB;
constexpr size_t WS_TOKINFO = 2 * MiB;
constexpr size_t WS_TABLE = 4 * MiB;
constexpr size_t WS_WIN = 8 * MiB, WS_WO = 32 * MiB, WS_WF = 40 * MiB, WS_CS = 48 * MiB, WS_ACS = 64 * MiB;
constexpr size_t WS_U = 128 * MiB;
constexpr size_t WS_P = 196 * MiB;
constexpr size_t WS_MIX = 400 * MiB;
constexpr size_t WS_TB = 464 * MiB, WS_X1 = 592 * MiB, WS_X2 = 720 * MiB;
constexpr size_t WS_H = 848 * MiB;
constexpr size_t WS_WGU = 928 * MiB;
constexpr size_t WS_WD = 1440 * MiB;
constexpr size_t WS_END = 1696 * MiB;
constexpr int CW_CNT = 64;
constexpr int CW_BAR = 1024;

constexpr int LDS_SCR = 133120;
constexpr int LDSCTL_OFF = LDS_SCR;
constexpr int LDS_BYTES = 147456;

template <int CTRL> DI float dpp_f(float v) { return __builtin_bit_cast(float, __builtin_amdgcn_mov_dpp(__builtin_bit_cast(int, v), CTRL, 0xF, 0xF, true)); }
DI float wave_sum(float v) {
    v += dpp_f<0xB1>(v); v += dpp_f<0x4E>(v); v += dpp_f<0x141>(v); v += dpp_f<0x140>(v);
    const int iv = __builtin_bit_cast(int, v);
    const float r0 = __builtin_bit_cast(float, __builtin_amdgcn_readlane(iv, 0)), r1 = __builtin_bit_cast(float, __builtin_amdgcn_readlane(iv, 16)),
                r2 = __builtin_bit_cast(float, __builtin_amdgcn_readlane(iv, 32)), r3 = __builtin_bit_cast(float, __builtin_amdgcn_readlane(iv, 48));
    return (r0 + r1) + (r2 + r3);
}
DI float wave_max(float v) {
    v = fmaxf(v, dpp_f<0xB1>(v)); v = fmaxf(v, dpp_f<0x4E>(v)); v = fmaxf(v, dpp_f<0x141>(v)); v = fmaxf(v, dpp_f<0x140>(v));
    const int iv = __builtin_bit_cast(int, v);
    const float r0 = __builtin_bit_cast(float, __builtin_amdgcn_readlane(iv, 0)), r1 = __builtin_bit_cast(float, __builtin_amdgcn_readlane(iv, 16)),
                r2 = __builtin_bit_cast(float, __builtin_amdgcn_readlane(iv, 32)), r3 = __builtin_bit_cast(float, __builtin_amdgcn_readlane(iv, 48));
    return fmaxf(fmaxf(r0, r1), fmaxf(r2, r3));
}
DI unsigned f2bf(float f) { unsigned u = __float_as_uint(f); return (u + 0x7fffu + ((u >> 16) & 1u)) >> 16; }
DI unsigned pk2(float lo, float hi) { return f2bf(lo) | (f2bf(hi) << 16); }
DI float bflo(unsigned w) { return __uint_as_float(w << 16); }
DI float bfhi(unsigned w) { return __uint_as_float(w & 0xffff0000u); }
DI float silu_f(float v) { return v / (1.f + expf(-v)); }

#define XB_TMO      128
#define XB_XCNT(j)  (256  + 64 * (j))
#define XB_XSUB(j)  (1280 + 64 * (j))
#define XB_XGEN(j)  (2304 + 64 * (j))
#define XB_TOP      3328
#define XB_TOPGEN   3392
#define XCD_BAR_WORDS 3456
#define XB_SPIN_CAP (1u << 18)
__device__ __forceinline__ unsigned xb_ld(unsigned* p)              { return __hip_atomic_load(p, __ATOMIC_RELAXED, __HIP_MEMORY_SCOPE_AGENT); }
__device__ __forceinline__ unsigned xb_add(unsigned* p, unsigned v) { return __hip_atomic_fetch_add(p, v, __ATOMIC_RELAXED, __HIP_MEMORY_SCOPE_AGENT); }
__device__ __forceinline__ unsigned xb_xcc_id() { return (unsigned)__builtin_amdgcn_s_getreg((3 << 11) | 20) & 0xFu; }
#define XB_SPIN(cond, bar) do { unsigned _sp = 0; while (cond) { __builtin_amdgcn_s_sleep(1); \
    if ((++_sp & 255u) == 0u) { if (xb_ld(&(bar)[XB_TMO])) break; if (_sp > XB_SPIN_CAP) { atomicAdd(&(bar)[XB_TMO], 1u); break; } } } } while (0)
struct XcdBarrier { unsigned* bar; unsigned x; volatile LAS unsigned* st; };
__device__ __forceinline__ XcdBarrier xcd_barrier_post(unsigned* bar, volatile LAS unsigned* st) {
    XcdBarrier b; b.bar = bar; b.x = xb_xcc_id(); b.st = st;
    if (threadIdx.x == 0) (void)xb_add(&bar[XB_XCNT(b.x)], 1u);
    return b;
}
__device__ __forceinline__ void xcd_barrier_complete(unsigned* bar, unsigned x, unsigned& nloc, unsigned& nx) {
    const unsigned G = gridDim.x * gridDim.y * gridDim.z;
    unsigned sum, cnt, mine, sp = 0u;
    for (;;) {
        sum = 0u; cnt = 0u; mine = 0u;
#pragma unroll
        for (unsigned j = 0; j < 16; ++j) { const unsigned c = xb_ld(&bar[XB_XCNT(j)]); sum += c; cnt += (c > 0u) ? 1u : 0u; mine = (j == x) ? c : mine; }
        if (sum == G) break;
        __builtin_amdgcn_s_sleep(1);
        if ((++sp & 255u) == 0u) { if (xb_ld(&bar[XB_TMO])) break; if (sp > XB_SPIN_CAP) { atomicAdd(&bar[XB_TMO], 1u); break; } }
    }
    nloc = mine > 0u ? mine : 1u; nx = cnt > 0u ? cnt : 1u;
}
__device__ __forceinline__ void xcd_barrier(const XcdBarrier& b) {
    asm volatile("s_waitcnt vmcnt(0)" ::: "memory");
    __syncthreads();
    if (threadIdx.x == 0) {
        unsigned* bar = b.bar;
        __builtin_amdgcn_s_waitcnt(0);
        unsigned nloc = b.st[0], nx = b.st[1];
        if (nloc == 0u) { xcd_barrier_complete(bar, b.x, nloc, nx); b.st[0] = nloc; b.st[1] = nx; }
        const unsigned old = xb_add(&bar[XB_XSUB(b.x)], 1u);
        const unsigned gen = old / nloc;
        if (old + 1u == (gen + 1u) * nloc) {
            __builtin_amdgcn_fence(__ATOMIC_RELEASE, "agent");
            asm volatile("s_waitcnt vmcnt(0)" ::: "memory");
            const unsigned og = xb_add(&bar[XB_TOP], 1u);
            const unsigned tg = og / nx;
            if (og + 1u == (tg + 1u) * nx) xb_add(&bar[XB_TOPGEN], 1u);
            else XB_SPIN(xb_ld(&bar[XB_TOPGEN]) == tg, bar);
            __builtin_amdgcn_fence(__ATOMIC_ACQUIRE, "agent");
            xb_add(&bar[XB_XGEN(b.x)], 1u);
            asm volatile("s_waitcnt vmcnt(0)" ::: "memory");
        } else {
            XB_SPIN(xb_ld(&bar[XB_XGEN(b.x)]) == gen, bar);
            __builtin_amdgcn_fence(__ATOMIC_ACQUIRE, "agent");
            asm volatile("s_waitcnt vmcnt(0)" ::: "memory");
        }
    }
    __syncthreads();
}

struct Row { f32x4 v[8]; };
DI void row_load(Row& r, const float* p, int lane) { const f32x4* q = (const f32x4*)p + lane;
#pragma unroll
    for (int j = 0; j < 8; ++j) r.v[j] = q[64 * j]; }
DI void row_store(const Row& r, float* p, int lane) { f32x4* q = (f32x4*)p + lane;
#pragma unroll
    for (int j = 0; j < 8; ++j) q[64 * j] = r.v[j]; }
DI void row_store_bf16(const Row& r, bf16* p, int lane) { u32x2* q = (u32x2*)p + lane;
#pragma unroll
    for (int j = 0; j < 8; ++j) { u32x2 w; w.x = pk2(r.v[j].x, r.v[j].y); w.y = pk2(r.v[j].z, r.v[j].w); q[64 * j] = w; } }
DI void row_ln(Row& r) {
    float s = 0.f;
#pragma unroll
    for (int j = 0; j < 8; ++j) s += (r.v[j].x + r.v[j].y) + (r.v[j].z + r.v[j].w);
    const float mean = wave_sum(s) * (1.f / D); float s2 = 0.f;
#pragma unroll
    for (int j = 0; j < 8; ++j) { r.v[j] = r.v[j] - mean; s2 += (r.v[j].x * r.v[j].x + r.v[j].y * r.v[j].y) + (r.v[j].z * r.v[j].z + r.v[j].w * r.v[j].w); }
    const float rstd = 1.f / sqrtf(wave_sum(s2) * (1.f / D) + LN_EPS);
#pragma unroll
    for (int j = 0; j < 8; ++j) r.v[j] = r.v[j] * rstd;
}
DI void row_affine(Row& r, const float* g, const float* b, int lane) {
    const f32x4* gq = (const f32x4*)g + lane; const f32x4* bq = (const f32x4*)b + lane;
#pragma unroll
    for (int j = 0; j < 8; ++j) r.v[j] = r.v[j] * gq[64 * j] + bq[64 * j];
}
DI void row_modulate(Row& r, const float* sh, const float* sc, int lane) {
    const f32x4* hq = (const f32x4*)sh + lane; const f32x4* cq = (const f32x4*)sc + lane;
#pragma unroll
    for (int j = 0; j < 8; ++j) r.v[j] = r.v[j] * (cq[64 * j] + 1.f) + hq[64 * j];
}

struct Unit { const bf16* A; const bf16* B; const int* gat; int nvalid; int m0, n0, aux; };

template <class Sched, class Epi>
DI void gemm_simple(const Sched& S, const Epi& E, const int lda, const int ldb, const int K) {
    const int tid = threadIdx.x, wid = tid >> 6, lane = tid & 63, fr = lane & 15, fq = lane >> 4;
    for (int L = blockIdx.x; ; L += gridDim.x) {
        Unit u; if (!S.get(L, u)) break;
        const bf16* arow[2];
#pragma unroll
        for (int m = 0; m < 2; ++m) { const int r = 32 * wid + 16 * m + fr; size_t grow = (size_t)r; if (u.gat) grow = (size_t)(r < u.nvalid ? u.gat[r] : 0); arow[m] = u.A + grow * lda + fq * 8; }
        for (int cc = 0; cc < 4; ++cc) {
            f32x4 acc[2][4];
#pragma unroll
            for (int m = 0; m < 2; ++m)
#pragma unroll
                for (int j = 0; j < 4; ++j) acc[m][j] = (f32x4){0.f, 0.f, 0.f, 0.f};
            const bf16* brow[4];
#pragma unroll
            for (int j = 0; j < 4; ++j) { const int col = (j >> 1) * 128 + cc * 32 + (j & 1) * 16 + fr; brow[j] = u.B + (size_t)col * ldb + fq * 8; }
            for (int k = 0; k < K; k += 32) {
                bf16x8 a[2], b[4];
#pragma unroll
                for (int m = 0; m < 2; ++m) a[m] = *(const bf16x8*)(arow[m] + k);
#pragma unroll
                for (int j = 0; j < 4; ++j) b[j] = *(const bf16x8*)(brow[j] + k);
#pragma unroll
                for (int m = 0; m < 2; ++m)
#pragma unroll
                    for (int j = 0; j < 4; ++j) acc[m][j] = __builtin_amdgcn_mfma_f32_16x16x32_bf16(b[j], a[m], acc[m][j], 0, 0, 0);
            }
#pragma unroll
            for (int m = 0; m < 2; ++m)
#pragma unroll
                for (int nn = 0; nn < 2; ++nn) E(u, 32 * wid + 16 * m + fr, cc * 32 + nn * 16 + 4 * fq, acc[m][nn], acc[m][nn + 2]);
        }
    }
}


namespace pg8 {
constexpr int BK = 64, HALF = 128, HTB = HALF * BK * 2, STAGE_BYTES = 8 * HTB;
DI int lds_byte(int r, int c) { const int st = (r >> 4) * 2 + (c >> 5), rr = r & 15, cc = c & 31, ob = rr * 64 + cc * 2; return st * 1024 + (ob ^ (((ob >> 9) & 1) << 5)); }
DI void stage_rc(int b, int& R, int& C) { const int st = b / 1024, sb = b % 1024, swz = sb ^ (((sb >> 9) & 1) << 5); R = (st >> 1) * 16 + swz / 64; C = (st & 1) * 32 + (swz % 64) / 2; }
}
template <bool GATHER, class Sched, class Epi>
DI void gemm_pg8(LAS unsigned char* lds, const Sched& S, const Epi& E, const int lda, const int ldb, const int K) {
    using namespace pg8;
    const int tid = threadIdx.x, wid = __builtin_amdgcn_readfirstlane(tid >> 6), lane = tid & 63, wr = wid >> 2, wc = wid & 3, fr = lane & 15, fq = lane >> 4;
    const int nt = K / BK, G = gridDim.x, cblk = blockIdx.x;
    unsigned voffB[2], vA[2][2];
#pragma unroll
    for (int i = 0; i < 2; ++i) { int R_, C_; stage_rc(tid * 16 + i * 8192, R_, C_); voffB[i] = (unsigned)(R_ * ldb + C_) * 2u; }
    const size_t kstep = (size_t)(BK * 2), hstepA = (size_t)HALF * lda * 2, hstepB = (size_t)HALF * ldb * 2;
    const unsigned ldsw = (unsigned)wid * 1024u;
    const int aoff = lds_byte(wr * 64 + fr, fq * 8), boff = lds_byte(wc * 32 + fr, fq * 8);
#define PG8_SA(b, h) (((b) * 2 + (h)) * HTB)
#define PG8_SB(b, h) ((4 + (b) * 2 + (h)) * HTB)
#define PG8_STAGE(bufoff, gbase, voff) do { _Pragma("unroll") for (int _i = 0; _i < 2; ++_i) \
        __builtin_amdgcn_global_load_lds((const unsigned*)((const char*)(gbase) + (voff)[_i]), (LAS unsigned*)(lds + (bufoff) + ldsw + _i * 8192), 16, 0, 0); } while (0)
#define PG8_STAGE_A(bufoff, gbase, h) do { if constexpr (GATHER) PG8_STAGE(bufoff, gbase, vA[h]); else PG8_STAGE(bufoff, (gbase) + (h) * hstepA, vA[0]); } while (0)
#define PG8_LDA(dst, b, h) do { _Pragma("unroll") for (int m = 0; m < 4; ++m) _Pragma("unroll") for (int k = 0; k < 2; ++k) dst[m][k] = *(const LAS bf16x8*)(lds + PG8_SA(b, h) + aoff + m * 2048 + k * 1024); } while (0)
#define PG8_LDB(dst, b, h) do { _Pragma("unroll") for (int n = 0; n < 2; ++n) _Pragma("unroll") for (int k = 0; k < 2; ++k) dst[n][k] = *(const LAS bf16x8*)(lds + PG8_SB(b, h) + boff + n * 2048 + k * 1024); } while (0)
#define PG8_MMA(ai, bj, At, Bt) do { __builtin_amdgcn_s_setprio(1); _Pragma("unroll") for (int m = 0; m < 4; ++m) _Pragma("unroll") for (int n = 0; n < 2; ++n) _Pragma("unroll") for (int k = 0; k < 2; ++k) \
        acc[ai][bj][m][n] = __builtin_amdgcn_mfma_f32_16x16x32_bf16(Bt[n][k], At[m][k], acc[ai][bj][m][n], 0, 0, 0); __builtin_amdgcn_s_setprio(0); } while (0)
#define PG8_WAIT_V(n) asm volatile("s_waitcnt vmcnt(" #n ")" ::: "memory")
#define PG8_WAIT_L(n) asm volatile("s_waitcnt lgkmcnt(" #n ")" ::: "memory")
#define PG8_BAR __builtin_amdgcn_s_barrier()
#define PG8_SCHED __builtin_amdgcn_sched_barrier(0)
#define PG8_SETV(dst, u) do { _Pragma("unroll") for (int _h = 0; _h < 2; ++_h) _Pragma("unroll") for (int _i = 0; _i < 2; ++_i) { int _R, _C; stage_rc(tid * 16 + _i * 8192, _R, _C); const int _r = _h * HALF + _R; \
        if constexpr (GATHER) { const int _g = _r < (u).nvalid ? (u).gat[_r] : 0; dst[_h][_i] = (unsigned)(_g * lda + _C) * 2u; } else dst[_h][_i] = (unsigned)(_R * lda + _C) * 2u; } } while (0)
    Unit cur, nxt; int ui = 0;
    if (!S.get(cblk, cur)) return;
    f32x4 acc[2][2][4][2];
#pragma unroll
    for (int a = 0; a < 2; ++a)
#pragma unroll
        for (int b = 0; b < 2; ++b)
#pragma unroll
            for (int m = 0; m < 4; ++m)
#pragma unroll
                for (int n = 0; n < 2; ++n) acc[a][b][m][n] = (f32x4){0.f, 0.f, 0.f, 0.f};
    bf16x8 At[4][2], B0[2][2], B1[2][2];
    const char* cA = (const char*)cur.A; const char* cB = (const char*)cur.B;
    PG8_SETV(vA, cur);
    PG8_STAGE(PG8_SB(0, 0), cB, voffB); PG8_STAGE(PG8_SB(0, 1), cB + hstepB, voffB); PG8_STAGE_A(PG8_SA(0, 0), cA, 0); PG8_STAGE_A(PG8_SA(0, 1), cA, 1);
    if (wr == 1) PG8_BAR;
    PG8_WAIT_V(2); PG8_BAR;
    PG8_STAGE(PG8_SB(1, 0), cB + kstep, voffB); PG8_STAGE_A(PG8_SA(1, 0), cA + kstep, 0); PG8_STAGE(PG8_SB(1, 1), cB + hstepB + kstep, voffB);
    PG8_WAIT_V(6); PG8_BAR;
    for (;;) {
        const bool has_next = S.get((ui + 1) * G + cblk, nxt);
        const char* nA = has_next ? (const char*)nxt.A : cA; const char* nB = has_next ? (const char*)nxt.B : cB;
        for (int t = 0; t < nt; t += 2) {
            const bool last = (t == nt - 2);
            const char* a1 = cA + (size_t)(t + 1) * kstep;
            const char* a2 = last ? nA : cA + (size_t)(t + 2) * kstep; const char* b2 = last ? nB : cB + (size_t)(t + 2) * kstep;
            const char* a3 = a2 + kstep; const char* b3 = b2 + kstep;
            PG8_LDB(B0, 0, 0); PG8_LDB(B1, 0, 1); PG8_SCHED; PG8_LDA(At, 0, 0); PG8_STAGE_A(PG8_SA(1, 1), a1, 1);
            PG8_WAIT_V(8); PG8_WAIT_L(0); PG8_BAR; PG8_MMA(0, 0, At, B0); PG8_MMA(0, 1, At, B1); PG8_BAR; PG8_SCHED;
            if constexpr (GATHER) { if (last && has_next) PG8_SETV(vA, nxt); }
            PG8_LDA(At, 0, 1); PG8_STAGE(PG8_SB(0, 0), b2, voffB); PG8_STAGE(PG8_SB(0, 1), b2 + hstepB, voffB); PG8_STAGE_A(PG8_SA(0, 0), a2, 0);
            PG8_WAIT_V(8); PG8_WAIT_L(0); PG8_BAR; PG8_MMA(1, 0, At, B0); PG8_MMA(1, 1, At, B1); PG8_BAR; PG8_SCHED;
            PG8_LDB(B0, 1, 0); PG8_LDB(B1, 1, 1); PG8_SCHED; PG8_LDA(At, 1, 0); PG8_STAGE_A(PG8_SA(0, 1), a2, 1);
            PG8_WAIT_V(8); PG8_WAIT_L(0); PG8_BAR; PG8_MMA(0, 0, At, B0); PG8_MMA(0, 1, At, B1); PG8_BAR; PG8_SCHED;
            PG8_LDA(At, 1, 1); PG8_STAGE(PG8_SB(1, 0), b3, voffB); PG8_STAGE(PG8_SB(1, 1), b3 + hstepB, voffB); PG8_STAGE_A(PG8_SA(1, 0), a3, 0);
            PG8_WAIT_V(8); PG8_WAIT_L(0); PG8_BAR; PG8_MMA(1, 0, At, B0); PG8_MMA(1, 1, At, B1); PG8_BAR; PG8_SCHED;
        }
        if (wr == 0) PG8_BAR;
#pragma unroll
        for (int ai = 0; ai < 2; ++ai)
#pragma unroll
            for (int m = 0; m < 4; ++m)
#pragma unroll
                for (int n = 0; n < 2; ++n) E(cur, ai * HALF + wr * 64 + m * 16 + fr, wc * 32 + n * 16 + 4 * fq, acc[ai][0][m][n], acc[ai][1][m][n]);
        if (!has_next) break;
#pragma unroll
        for (int a = 0; a < 2; ++a)
#pragma unroll
            for (int b = 0; b < 2; ++b)
#pragma unroll
                for (int m = 0; m < 4; ++m)
#pragma unroll
                    for (int n = 0; n < 2; ++n) acc[a][b][m][n] = (f32x4){0.f, 0.f, 0.f, 0.f};
        cur = nxt; cA = nA; cB = nB; ++ui;
        if (wr == 1) PG8_BAR;
    }
    PG8_WAIT_V(0);
    PG8_BAR;
#undef PG8_SA
#undef PG8_SB
#undef PG8_STAGE
#undef PG8_STAGE_A
#undef PG8_LDA
#undef PG8_LDB
#undef PG8_MMA
#undef PG8_WAIT_V
#undef PG8_WAIT_L
#undef PG8_BAR
#undef PG8_SCHED
#undef PG8_SETV
}

DI int xcd_remap(int L, int n) { const int q = n >> 3, r = n & 7, xcd = L & 7, off = L >> 3; return (xcd < r ? xcd * (q + 1) : r * (q + 1) + (xcd - r) * q) + off; }
DI void grouped(int wgid, int nM, int nN, int& pm, int& pn) { const int nig = 8 * nN, gid = wgid / nig, fm = gid * 8, gsz = min(nM - fm, 8); pm = fm + (wgid % nig) % gsz; pn = (wgid % nig) / gsz; }

struct SchedInProj { const bf16* U; const bf16* W;
    DI bool get(int L, Unit& u) const { int pm, pn;
        if (L >= 64 * 24 + 32) return false; const int w = xcd_remap(L, 64 * 24 + 32);
        if (w < 64 * 24) grouped(w, 64, 24, pm, pn); else { const int l2 = w - 64 * 24; pm = 64 + (l2 >> 3); pn = 4 + (l2 & 7); }
        u.A = U + (size_t)pm * 256 * D; u.B = W + (size_t)pn * 256 * D; u.gat = nullptr; u.nvalid = 256; u.m0 = pm * 256; u.n0 = pn * 256; u.aux = 0; return true; } };
struct SchedDense { const bf16* A; const bf16* B; int nM, nN; size_t a_t, b_t;
    DI bool get(int L, Unit& u) const { if (L >= nM * nN) return false; int pm, pn; grouped(xcd_remap(L, nM * nN), nM, nN, pm, pn);
        u.A = A + (size_t)pm * a_t; u.B = B + (size_t)pn * b_t; u.gat = nullptr; u.nvalid = 256; u.m0 = pm * 256; u.n0 = pn * 256; u.aux = 0; return true; } };
struct SchedMoe { const LAS int* cnt; const LAS int* tb; const bf16* A; const bf16* W; const int* table; int gather; size_t a_t, w_e, w_t;
    DI bool get(int L, Unit& u) const { const int nT = __builtin_amdgcn_readfirstlane(tb[32]); if (L >= nT * 8) return false; int t, pn; grouped(xcd_remap(L, nT * 8), nT, 8, t, pn);
        int e = 0;
        for (int i = 1; i < 32; ++i) e = (tb[i] <= t) ? i : e;
        e = __builtin_amdgcn_readfirstlane(e); t = __builtin_amdgcn_readfirstlane(t); pn = __builtin_amdgcn_readfirstlane(pn);
        const int mt = __builtin_amdgcn_readfirstlane(t - tb[e]);
        if (gather) { u.A = A; u.gat = table + (size_t)e * T + mt * 256; } else { u.A = A + (size_t)t * a_t; u.gat = nullptr; }
        u.nvalid = __builtin_amdgcn_readfirstlane(min(256, cnt[e] - mt * 256));
        u.B = W + (size_t)e * w_e + (size_t)pn * w_t; u.m0 = t * 256; u.n0 = pn * 256; u.aux = e; return true; } };
struct SchedChan { const bf16* PCAT; const bf16* CSB;
    DI bool get(int L, Unit& u) const { if (L >= 512) return false; int pm, q; grouped(xcd_remap(L, 512), 64, 8, pm, q); const int g = q >> 1, pn = q & 1;
        u.A = PCAT + (size_t)pm * 256 * 4096 + g * 1024; u.B = CSB + (size_t)pn * 256 * 1024; u.gat = nullptr; u.nvalid = 256; u.m0 = pm * 256; u.n0 = g * 512 + pn * 256; u.aux = g; return true; } };

DI void st_bf16x4(bf16* p, f32x4 v) { u32x2 w; w.x = pk2(v.x, v.y); w.y = pk2(v.z, v.w); *(u32x2*)p = w; }
struct EpiStoreBf16 { bf16* O; int ldc;
    DI void operator()(const Unit& u, int r, int c, f32x4 lo, f32x4 hi) const { bf16* p = O + (size_t)(u.m0 + r) * ldc + u.n0 + c; st_bf16x4(p, lo); st_bf16x4(p + 128, hi); } };
struct EpiResid { const float* x; float* t; const float* gate;
    DI void operator()(const Unit& u, int r, int c, f32x4 lo, f32x4 hi) const { const int row = u.m0 + r, b = row >> 12; const int col = u.n0 + c;
        const size_t o = (size_t)row * D + col; const float* g = gate + (size_t)b * MODW + col;
        *(f32x4*)(t + o) = *(const f32x4*)(x + o) * ALPHA + *(const f32x4*)g * lo;
        *(f32x4*)(t + o + 128) = *(const f32x4*)(x + o + 128) * ALPHA + *(const f32x4*)(g + 128) * hi; } };
struct EpiSwiglu { bf16* H;
    DI void operator()(const Unit& u, int r, int c, f32x4 lo, f32x4 hi) const { f32x4 h;
        h.x = silu_f(lo.x) * hi.x; h.y = silu_f(lo.y) * hi.y; h.z = silu_f(lo.z) * hi.z; h.w = silu_f(lo.w) * hi.w;
        st_bf16x4(H + (size_t)(u.m0 + r) * DE + (u.n0 >> 1) + c, h); } };
DI void p0_mods(const float* c, const float* cctx, const float* ada_w, const float* ada_b, float* mods, LAS float* sl, int tid) {
    LAS float* red = sl + 5 * D;
    for (int i = tid; i < 5 * D; i += 512) { const float v = i < 4 * D ? c[i] : cctx[i - 4 * D]; sl[i] = silu_f(v); }
    __syncthreads();
    const int cq = tid & 127, ks = tid >> 7;
    for (int unit = blockIdx.x; unit < 192; unit += gridDim.x) {
        const int l = unit / 96, n = (unit % 96) * 128 + cq;
        const float* W = ada_w + (size_t)l * D * MODW + n;
        float a0 = 0.f, a1 = 0.f, a2 = 0.f, a3 = 0.f, a4 = 0.f;
#pragma unroll 8
        for (int k = ks * 512; k < ks * 512 + 512; ++k) { const float w = W[(size_t)k * MODW]; a0 += sl[k] * w; a1 += sl[D + k] * w; a2 += sl[2 * D + k] * w; a3 += sl[3 * D + k] * w; a4 += sl[4 * D + k] * w; }
        red[(ks * 5 + 0) * 128 + cq] = a0; red[(ks * 5 + 1) * 128 + cq] = a1; red[(ks * 5 + 2) * 128 + cq] = a2; red[(ks * 5 + 3) * 128 + cq] = a3; red[(ks * 5 + 4) * 128 + cq] = a4;
        __syncthreads();
        for (int i = tid; i < 640; i += 512) { const int r = i >> 7, q = i & 127, n2 = (unit % 96) * 128 + q;
            const float s = (red[(0 * 5 + r) * 128 + q] + red[(1 * 5 + r) * 128 + q]) + (red[(2 * 5 + r) * 128 + q] + red[(3 * 5 + r) * 128 + q]);
            mods[((size_t)l * 5 + r) * MODW + n2] = s + ada_b[(size_t)l * MODW + n2]; }
        __syncthreads();
    }
}
DI void tr_item(const float* W, int N, int Kd, int k0, int n0, bf16* WT, int drow0, LAS unsigned char* scr, int lane) {
    const int ng = lane & 15, kl = lane >> 4;
    f32x4 v[2][8];
    const float* src = W + (size_t)(k0 + 16 * kl) * N + n0 + 4 * ng;
#pragma unroll
    for (int pp = 0; pp < 2; ++pp)
#pragma unroll
        for (int i = 0; i < 8; ++i) v[pp][i] = *(const f32x4*)(src + (size_t)(8 * pp + i) * N);
#pragma unroll
    for (int pp = 0; pp < 2; ++pp)
#pragma unroll
        for (int c = 0; c < 4; ++c) { u32x4 o; o.x = pk2(v[pp][0][c], v[pp][1][c]); o.y = pk2(v[pp][2][c], v[pp][3][c]); o.z = pk2(v[pp][4][c], v[pp][5][c]); o.w = pk2(v[pp][6][c], v[pp][7][c]);
            *(LAS u32x4*)(scr + (4 * ng + c) * 144 + (16 * kl + 8 * pp) * 2) = o; }
    asm volatile("s_waitcnt lgkmcnt(0)" ::: "memory");
#pragma unroll
    for (int j = 0; j < 8; ++j) { const int row = (lane >> 3) + 8 * j, ch = lane & 7;
        const u32x4 o = *(const LAS u32x4*)(scr + row * 144 + ch * 16);
        *(u32x4*)(WT + (size_t)(drow0 + row) * Kd + k0 + 8 * ch) = o; }
    asm volatile("s_waitcnt lgkmcnt(0)" ::: "memory");
}
DI void p0_weights(const float* w_in, const float* w_out, const float* w_f, const float* w_gate, const float* w_up, const float* w_down,
                   bf16* WIN, bf16* WO, bf16* WF, bf16* WGU, bf16* WD, LAS unsigned char* scr, int gw, int NGW, int lane) {
    constexpr int I_IN = 32 * 96, I_SQ = 32 * 32, I_E = 64 * 512;
    constexpr int NIT = I_IN + 2 * I_SQ + 3 * I_E;
    for (int it = gw; it < NIT; it += NGW) {
        int r = it;
        if (r < I_IN) { const int kb = r / 96, nb = r % 96; tr_item(w_in, NMIX, D, kb * 64, nb * 64, WIN, nb * 64, scr, lane); continue; } r -= I_IN;
        if (r < I_SQ) { const int kb = r >> 5, nb = r & 31; tr_item(w_out, D, D, kb * 64, nb * 64, WO, nb * 64, scr, lane); continue; } r -= I_SQ;
        if (r < I_SQ) { const int kb = r >> 5, nb = r & 31; tr_item(w_f, D, D, kb * 64, nb * 64, WF, nb * 64, scr, lane); continue; } r -= I_SQ;
        if (r < 2 * I_E) { const int up = r >= I_E; if (up) r -= I_E; const int mat = r >> 9, rr = r & 511, kb = rr >> 4, nb = rr & 15, n0 = nb * 64;
            tr_item((up ? w_up : w_gate) + (size_t)mat * D * DE, DE, D, kb * 64, n0, WGU + (size_t)mat * D * D, (n0 >> 7) * 256 + (n0 & 127) + (up ? 128 : 0), scr, lane); continue; } r -= 2 * I_E;
        { const int mat = r >> 9, rr = r & 511, kb = rr >> 5, nb = rr & 31; tr_item(w_down + (size_t)mat * DE * D, D, DE, kb * 64, nb * 64, WD + (size_t)mat * D * DE, nb * 64, scr, lane); }
    }
}
DI void p0_dft(bf16* CSB, int gtid, int GT) {
    for (int i = gtid; i < 512 * 128; i += GT) { const int cp = i >> 7, k8 = (i & 127) * 8; unsigned w[4];
#pragma unroll
        for (int e = 0; e < 4; ++e) { float v[2];
#pragma unroll
            for (int q = 0; q < 2; ++q) { const int kk = k8 + 2 * e + q; const int m = (cp * (kk & 511)) & 511; const float ang = (float)m * (1.f / 256.f); v[q] = (kk < 512 ? cospif(ang) : sinpif(ang)) * 0.04419417382415922f; }
            w[e] = pk2(v[0], v[1]); }
        *(u32x4*)(CSB + (size_t)cp * 1024 + k8) = (u32x4){w[0], w[1], w[2], w[3]}; }
}
DI void ln_mod_phase(const float* x, const float* ctx, const float* mods_l, int sh_chunk, bf16* U, int nrows, int gw, int NGW, int lane) {
    int row = gw; if (row >= nrows) return;
    Row cur; row_load(cur, row < T ? x + (size_t)row * D : ctx + (size_t)(row - T) * D, lane);
    for (; row < nrows; row += NGW) {
        const int nr = row + NGW < nrows ? row + NGW : row;
        Row nxt; row_load(nxt, nr < T ? x + (size_t)nr * D : ctx + (size_t)(nr - T) * D, lane);
        const int rb = row < T ? (row >> 12) : 4;
        row_ln(cur);
        const float* mr = mods_l + (size_t)rb * MODW + sh_chunk * D;
        row_modulate(cur, mr, mr + D, lane);
        row_store_bf16(cur, U + (size_t)row * D, lane);
        cur = nxt;
    }
}
DI void attn_simple(const bf16* P, const float* rpb, bf16* MIX, LAS float* scr, int gw, int NGW, int lane) {
    const float scale = 0.08838834764831845f;
    for (int item = gw; item < T * NH; item += NGW) {
        const int tok = item >> 3, h = item & 7, b = tok >> 12, l = tok & 4095, r = l >> 6, qc = l & 63;
        const int rs = min(max(r - 4, 0), 56), cs = min(max(qc - 8, 0), 48);
        { const unsigned w = *((const unsigned*)(P + (size_t)tok * NMIX + h * HD) + lane); scr[2 * lane] = bflo(w); scr[2 * lane + 1] = bfhi(w); }
        asm volatile("s_waitcnt lgkmcnt(0)" ::: "memory");
        float s[6];
#pragma unroll
        for (int i = 0; i < 6; ++i) {
            const int kk = lane + 64 * i; size_t krow; float bias = 0.f;
            if (kk < 128) { const int a = kk >> 4, j = kk & 15; krow = (size_t)b * SEQ + 64 * (rs + a) + cs + j; bias = rpb[(h * 15 + (rs + a - r + 7)) * 31 + (cs + j - qc + 15)]; }
            else krow = (size_t)T + b * CTXL + (kk - 128);
            const u32x4* kp = (const u32x4*)(P + krow * NMIX + D / 2 + h * HD);
            float acc = 0.f;
#pragma unroll 4
            for (int d8 = 0; d8 < 16; ++d8) { const u32x4 kv = kp[d8]; const LAS f32x4* qv = (const LAS f32x4*)scr + 2 * d8; const f32x4 q0 = qv[0], q1 = qv[1];
                acc += bflo(kv.x) * q0.x + bfhi(kv.x) * q0.y + bflo(kv.y) * q0.z + bfhi(kv.y) * q0.w + bflo(kv.z) * q1.x + bfhi(kv.z) * q1.y + bflo(kv.w) * q1.z + bfhi(kv.w) * q1.w; }
            s[i] = acc * scale + bias;
        }
        float m = s[0];
#pragma unroll
        for (int i = 1; i < 6; ++i) m = fmaxf(m, s[i]);
        m = wave_max(m); float sum = 0.f;
#pragma unroll
        for (int i = 0; i < 6; ++i) { s[i] = expf(s[i] - m); sum += s[i]; scr[128 + lane + 64 * i] = s[i]; }
        sum = wave_sum(sum);
        asm volatile("s_waitcnt lgkmcnt(0)" ::: "memory");
        float o0 = 0.f, o1 = 0.f;
        for (int kk = 0; kk < 384; ++kk) {
            size_t vrow; if (kk < 128) vrow = (size_t)b * SEQ + 64 * (rs + (kk >> 4)) + cs + (kk & 15); else vrow = (size_t)T + b * CTXL + (kk - 128);
            const unsigned w = *((const unsigned*)(P + vrow * NMIX + D + h * HD) + lane); const float p = scr[128 + kk];
            o0 += p * bflo(w); o1 += p * bfhi(w);
        }
        const float inv = 1.f / sum;
        *((unsigned*)(MIX + (size_t)tok * D + h * HD) + lane) = pk2(o0 * inv, o1 * inv);
        asm volatile("s_waitcnt lgkmcnt(0)" ::: "memory");
    }
}

constexpr int ATT_RS = 288, ATT_TILE = 64 * ATT_RS, ATT_BUF = 2 * ATT_TILE;
typedef short s16x4 __attribute__((ext_vector_type(4)));
struct AttState { f32x4 sc[32]; unsigned pk[32][2]; f32x4 o[8]; u32x4 stg[4]; bf16x8 qf[4]; float inv; unsigned g_off, w_off, ka_off, va_off; };
struct AttCtx { const bf16* P; LAS unsigned char* lds; const LAS float* lrpb; int b, r, rs, hp, hs, c0, qc, csq, quad; };
template <int STEP> DI void att_load(AttState& S, const AttCtx& C) {
    constexpr int ti = STEP % 12; const int colb = (STEP < 12 ? 1024 : 2048) + C.hp * 256;
    const size_t tok0 = ti < 8 ? (size_t)C.b * SEQ + 64 * (C.rs + ti) : (size_t)T + C.b * CTXL + (ti - 8) * 64;
    const char* ub = (const char*)(C.P + tok0 * NMIX + colb);
#pragma unroll
    for (int k = 0; k < 4; ++k) S.stg[k] = *(const u32x4*)(ub + (size_t)(32 * (k & 1)) * NMIX * 2 + (k >> 1) * 256 + S.g_off);
}
template <int BUFI> DI void att_write(AttState& S, const AttCtx& C) {
#pragma unroll
    for (int k = 0; k < 4; ++k) *(LAS u32x4*)(C.lds + BUFI * ATT_BUF + (k >> 1) * ATT_TILE + 32 * (k & 1) * ATT_RS + S.w_off) = S.stg[k];
}
template <int STEP> DI void att_step(AttState& S, const AttCtx& C) {
    const float scale = 0.08838834764831845f;
    asm volatile("" : "+v"(S.g_off), "+v"(S.w_off), "+v"(S.ka_off), "+v"(S.va_off));
    if constexpr (STEP + 1 < 24) att_load<STEP + 1>(S, C);
    constexpr int bo = (STEP & 1) * ATT_BUF;
    if constexpr (STEP < 12) {
        constexpr int ti = STEP;
        if constexpr (ti < 8) {
            const int aidx = C.rs + ti - C.r + 7;
            const LAS float* brow = C.lrpb + C.hs * 465 + aidx * 31;
#pragma unroll
            for (int t = 0; t < 2; ++t) { const int krow0 = C.c0 + 16 * t; f32x4 acc = (f32x4){0.f, 0.f, 0.f, 0.f};
                const LAS unsigned char* ka = C.lds + bo + krow0 * ATT_RS + S.ka_off;
#pragma unroll
                for (int s4 = 0; s4 < 4; ++s4) acc = __builtin_amdgcn_mfma_f32_16x16x32_bf16(*(const LAS bf16x8*)(ka + s4 * 64), S.qf[s4], acc, 0, 0, 0);
#pragma unroll
                for (int i = 0; i < 4; ++i) { const int kcol = krow0 + C.quad * 4 + i; const bool ok = kcol >= C.csq && kcol < C.csq + 16; const int bi = min(max(kcol - C.qc + 15, 0), 30);
                    const float bias = brow[bi]; S.sc[ti * 2 + t][i] = ok ? acc[i] * scale + bias : -1e30f; } }
        } else {
#pragma unroll
            for (int t = 0; t < 4; ++t) { f32x4 acc = (f32x4){0.f, 0.f, 0.f, 0.f};
                const LAS unsigned char* ka = C.lds + bo + 16 * t * ATT_RS + S.ka_off;
#pragma unroll
                for (int s4 = 0; s4 < 4; ++s4) acc = __builtin_amdgcn_mfma_f32_16x16x32_bf16(*(const LAS bf16x8*)(ka + s4 * 64), S.qf[s4], acc, 0, 0, 0);
                S.sc[16 + (ti - 8) * 4 + t] = acc * scale; }
        }
    } else {
        if constexpr (STEP == 12) {
            float m = -1e30f;
#pragma unroll
            for (int sl = 0; sl < 32; ++sl) m = fmaxf(fmaxf(m, fmaxf(S.sc[sl][0], S.sc[sl][1])), fmaxf(S.sc[sl][2], S.sc[sl][3]));
            m = fmaxf(m, __shfl_xor(m, 16)); m = fmaxf(m, __shfl_xor(m, 32));
            float sum = 0.f;
#pragma unroll
            for (int sl = 0; sl < 32; ++sl) { const float e0 = __expf(S.sc[sl][0] - m), e1 = __expf(S.sc[sl][1] - m), e2 = __expf(S.sc[sl][2] - m), e3 = __expf(S.sc[sl][3] - m);
                sum += (e0 + e1) + (e2 + e3); S.pk[sl][0] = pk2(e0, e1); S.pk[sl][1] = pk2(e2, e3); }
            sum += __shfl_xor(sum, 16); sum += __shfl_xor(sum, 32); S.inv = 1.f / sum;
#pragma unroll
            for (int dt = 0; dt < 8; ++dt) S.o[dt] = (f32x4){0.f, 0.f, 0.f, 0.f};
        }
        constexpr int ti = STEP - 12; constexpr int nks = ti < 8 ? 1 : 2;
#pragma unroll
        for (int kk = 0; kk < nks; ++kk) {
            const int sa = ti < 8 ? ti * 2 : 16 + (ti - 8) * 4 + 2 * kk; const int rb = ti < 8 ? C.c0 : 32 * kk;
            const u32x4 pw = (u32x4){S.pk[sa][0], S.pk[sa][1], S.pk[sa + 1][0], S.pk[sa + 1][1]}; const bf16x8 pf = __builtin_bit_cast(bf16x8, pw);
            const LAS unsigned char* va = C.lds + bo + rb * ATT_RS + S.va_off;
#pragma unroll
            for (int dt = 0; dt < 8; ++dt) { const s16x4 v1 = __builtin_amdgcn_ds_read_tr16_b64_v4i16((LAS s16x4*)(va + dt * 32)); const s16x4 v2 = __builtin_amdgcn_ds_read_tr16_b64_v4i16((LAS s16x4*)(va + 16 * ATT_RS + dt * 32));
                const bf16x8 vf = __builtin_shufflevector(v1, v2, 0, 1, 2, 3, 4, 5, 6, 7); S.o[dt] = __builtin_amdgcn_mfma_f32_16x16x32_bf16(vf, pf, S.o[dt], 0, 0, 0); }
        }
    }
    if constexpr (STEP + 1 < 24) att_write<(STEP + 1) & 1>(S, C);
    __syncthreads();
}
DI void attn_phase(const bf16* P, const float* rpb, bf16* MIX, LAS unsigned char* lds, LAS float* lrpb) {
    const int tid = threadIdx.x, wid = __builtin_amdgcn_readfirstlane(tid >> 6), lane = tid & 63, hs = wid >> 2, j = wid & 3, lq = lane & 15, quad = lane >> 4;
    const int srow = tid >> 4, sch = tid & 15;
    AttState S; AttCtx C;
    C.P = P; C.lds = lds; C.lrpb = lrpb; C.hs = hs; C.quad = quad;
    C.c0 = (j == 0) ? 0 : (j == 1) ? 8 : (j == 2) ? 24 : 32;
    C.qc = 16 * j + lq; C.csq = min(max(C.qc - 8, 0), 48);
    S.g_off = (unsigned)(srow * NMIX + sch * 8) * 2u;
    S.w_off = (unsigned)(srow * ATT_RS + sch * 16);
    S.ka_off = (unsigned)(hs * ATT_TILE + lq * ATT_RS + quad * 16);
    S.va_off = (unsigned)(hs * ATT_TILE + (4 * quad + (lq >> 2)) * ATT_RS + 8 * (lq & 3));
    for (int unit = blockIdx.x; unit < 1024; unit += gridDim.x) {
        const int r = unit & 63, hp = (unit >> 6) & 3, b = unit >> 8, h = 2 * hp + hs;
        C.r = r; C.hp = hp; C.b = b; C.rs = min(max(r - 4, 0), 56);
        __syncthreads();
        for (int i = tid; i < 930; i += 512) lrpb[i] = rpb[(size_t)hp * 930 + i];
        const size_t tq = (size_t)b * SEQ + 64 * r + C.qc;
#pragma unroll
        for (int s4 = 0; s4 < 4; ++s4) S.qf[s4] = *(const bf16x8*)(P + tq * NMIX + h * HD + s4 * 32 + quad * 8);
        att_load<0>(S, C); att_write<0>(S, C); __syncthreads();
        att_step<0>(S, C); att_step<1>(S, C); att_step<2>(S, C); att_step<3>(S, C); att_step<4>(S, C); att_step<5>(S, C); att_step<6>(S, C); att_step<7>(S, C);
        att_step<8>(S, C); att_step<9>(S, C); att_step<10>(S, C); att_step<11>(S, C); att_step<12>(S, C); att_step<13>(S, C); att_step<14>(S, C); att_step<15>(S, C);
        att_step<16>(S, C); att_step<17>(S, C); att_step<18>(S, C); att_step<19>(S, C); att_step<20>(S, C); att_step<21>(S, C); att_step<22>(S, C); att_step<23>(S, C);
        bf16* op = MIX + tq * D + h * HD + quad * 4;
#pragma unroll
        for (int dt = 0; dt < 8; ++dt) st_bf16x4(op + dt * 16, S.o[dt] * S.inv);
    }
}


constexpr int FF_RS = 544;
DI bf16x8 fft_frag(int kind  , int k, int s, int kq) {
    unsigned w[4];
#pragma unroll
    for (int p = 0; p < 4; ++p) { float v[2];
#pragma unroll
        for (int q = 0; q < 2; ++q) { const int j = 2 * p + q; const int jj = 32 * s + (j < 4 ? 4 * kq + j : 16 + 4 * kq + (j - 4)); const float ang = (float)((k * jj) & 63) * (1.f / 32.f);
            v[q] = (kind == 0 ? cospif(ang) : kind == 1 ? -sinpif(ang) : sinpif(ang)) * 0.125f; }
        w[p] = pk2(v[0], v[1]); }
    return __builtin_bit_cast(bf16x8, (u32x4){w[0], w[1], w[2], w[3]});
}
DI bf16x8 fft_tr(const LAS unsigned char* p) { const s16x4 v1 = __builtin_amdgcn_ds_read_tr16_b64_v4i16((LAS s16x4*)p), v2 = __builtin_amdgcn_ds_read_tr16_b64_v4i16((LAS s16x4*)(p + 16 * FF_RS));
    return __builtin_shufflevector(v1, v2, 0, 1, 2, 3, 4, 5, 6, 7); }
DI void fft1_phase(const bf16* Up, bf16* YP, LAS unsigned char* lds) {
    const int tid = threadIdx.x, wave = __builtin_amdgcn_readfirstlane(tid >> 6), lane = tid & 63, ml = lane & 15, quad = lane >> 4;
    bf16x8 Ff[8][2];
#pragma unroll
    for (int mt = 0; mt < 8; ++mt)
#pragma unroll
        for (int s2 = 0; s2 < 2; ++s2) Ff[mt][s2] = fft_frag(mt < 4 ? 0 : 1, (16 * mt + ml) & 63, s2, quad);
    LAS float* tw = (LAS float*)(lds + 64 * FF_RS);
    const unsigned va_off = (unsigned)((4 * quad + (ml >> 2)) * FF_RS + 8 * (ml & 3) + 64 * wave);
    for (int unit = blockIdx.x; unit < 2048; unit += gridDim.x) {
        const int b = unit >> 9, j2 = (unit >> 3) & 63, c0 = (unit & 7) * 256;
        __syncthreads();
#pragma unroll
        for (int q = 0; q < 4; ++q) { const int j1 = (tid >> 5) + 16 * q;
            *(LAS u32x4*)(lds + j1 * FF_RS + (tid & 31) * 16) = *(const u32x4*)(Up + ((size_t)b * SEQ + 64 * j1 + j2) * D + c0 + (tid & 31) * 8); }
        if (tid < 64) { const float ang = (float)(j2 * tid) * (1.f / 2048.f); tw[2 * tid] = cospif(ang); tw[2 * tid + 1] = sinpif(ang); }
        __syncthreads();
        float cth4[4], sth4[4];
#pragma unroll
        for (int mp = 0; mp < 4; ++mp) { cth4[mp] = tw[2 * (16 * mp + ml)]; sth4[mp] = tw[2 * (16 * mp + ml) + 1]; }
        asm volatile("s_waitcnt lgkmcnt(0)" : "+v"(cth4[0]), "+v"(cth4[1]), "+v"(cth4[2]), "+v"(cth4[3]), "+v"(sth4[0]), "+v"(sth4[1]), "+v"(sth4[2]), "+v"(sth4[3]) :: "memory");
        f32x4 acc[8][2];
#pragma unroll
        for (int mt = 0; mt < 8; ++mt) { acc[mt][0] = (f32x4){0.f, 0.f, 0.f, 0.f}; acc[mt][1] = acc[mt][0]; }
#pragma unroll
        for (int s2 = 0; s2 < 2; ++s2)
#pragma unroll
            for (int nt = 0; nt < 2; ++nt) { const bf16x8 zf = fft_tr(lds + va_off + 32 * s2 * FF_RS + 32 * nt);
#pragma unroll
                for (int mt = 0; mt < 8; ++mt) acc[mt][nt] = __builtin_amdgcn_mfma_f32_16x16x32_bf16(zf, Ff[mt][s2], acc[mt][nt], 0, 0, 0); }
#pragma unroll
        for (int mp = 0; mp < 4; ++mp) { const int k1 = 16 * mp + ml; const float cth = cth4[mp], sth = sth4[mp];
            bf16* dr = YP + ((((size_t)b * 64 + k1) * 2) * 64 + j2) * D + c0 + 32 * wave + 4 * quad;
#pragma unroll
            for (int nt = 0; nt < 2; ++nt) { const f32x4 yr = acc[mp][nt], yi = acc[mp + 4][nt];
                st_bf16x4(dr + 16 * nt, yr * cth + yi * sth); st_bf16x4(dr + (size_t)64 * D + 16 * nt, yi * cth - yr * sth); } }
    }
}
DI void fft2_phase(const bf16* YP, bf16* PCAT, LAS unsigned char* lds) {
    const int tid = threadIdx.x, wave = __builtin_amdgcn_readfirstlane(tid >> 6), lane = tid & 63, ml = lane & 15, quad = lane >> 4;
    bf16x8 Cf[4][2], Sf[4][2], Nf[4][2];
#pragma unroll
    for (int mt = 0; mt < 4; ++mt)
#pragma unroll
        for (int s2 = 0; s2 < 2; ++s2) { Cf[mt][s2] = fft_frag(0, 16 * mt + ml, s2, quad); Nf[mt][s2] = fft_frag(1, 16 * mt + ml, s2, quad); Sf[mt][s2] = fft_frag(2, 16 * mt + ml, s2, quad); }
    const unsigned va_off = (unsigned)((4 * quad + (ml >> 2)) * FF_RS + 8 * (ml & 3) + 64 * wave);
    for (int unit = blockIdx.x; unit < 2048; unit += gridDim.x) {
        const int b = unit >> 9, k1 = (unit >> 3) & 63, cc = unit & 7, c0 = cc * 256;
        __syncthreads();
#pragma unroll
        for (int q = 0; q < 8; ++q) { const int kr = (tid >> 5) + 16 * q;
            *(LAS u32x4*)(lds + kr * FF_RS + (tid & 31) * 16) = *(const u32x4*)(YP + (((size_t)b * 64 + k1) * 128 + kr) * D + c0 + (tid & 31) * 8); }
        __syncthreads();
        f32x4 acc[8][2];
#pragma unroll
        for (int mt = 0; mt < 8; ++mt) { acc[mt][0] = (f32x4){0.f, 0.f, 0.f, 0.f}; acc[mt][1] = acc[mt][0]; }
#pragma unroll
        for (int s4 = 0; s4 < 4; ++s4)
#pragma unroll
            for (int nt = 0; nt < 2; ++nt) { const bf16x8 yf = fft_tr(lds + va_off + 32 * s4 * FF_RS + 32 * nt);
#pragma unroll
                for (int mt = 0; mt < 4; ++mt) {
                    if (s4 < 2) { acc[mt][nt] = __builtin_amdgcn_mfma_f32_16x16x32_bf16(yf, Cf[mt][s4], acc[mt][nt], 0, 0, 0); acc[mt + 4][nt] = __builtin_amdgcn_mfma_f32_16x16x32_bf16(yf, Nf[mt][s4], acc[mt + 4][nt], 0, 0, 0); }
                    else { acc[mt][nt] = __builtin_amdgcn_mfma_f32_16x16x32_bf16(yf, Sf[mt][s4 - 2], acc[mt][nt], 0, 0, 0); acc[mt + 4][nt] = __builtin_amdgcn_mfma_f32_16x16x32_bf16(yf, Cf[mt][s4 - 2], acc[mt + 4][nt], 0, 0, 0); } } }
        const int g = cc >> 1, cp0 = (cc & 1) * 256 + 32 * wave + 4 * quad;
#pragma unroll
        for (int mt = 0; mt < 8; ++mt) { const int part = mt >> 2, k2 = 16 * (mt & 3) + ml;
            bf16* dp = PCAT + ((size_t)b * SEQ + k1 + 64 * k2) * 4096 + g * 1024 + part * 512 + cp0;
            st_bf16x4(dp, acc[mt][0]); st_bf16x4(dp + 16, acc[mt][1]); }
    }
}

DI void conv_phase(const bf16* P, const float* cw, bf16* MIX, int gtid, int GT) {
    for (int i = gtid; i < T * 128; i += GT) {
        const int tok = i >> 7, c8 = (i & 127) * 8, l = tok & 4095;
        const bf16* base = P + (size_t)tok * NMIX + 3072 + c8;
        const u32x4 gb = *(const u32x4*)base;
        float z[3][8];
#pragma unroll
        for (int j = 0; j < 3; ++j) { const int ll = l + j - 1; const bool ok = ll >= 0 && ll < SEQ;
            u32x4 gc = (u32x4){0u, 0u, 0u, 0u}, xi = gc;
            if (ok) { const bf16* pj = base + (ptrdiff_t)(j - 1) * NMIX; gc = *(const u32x4*)(pj + 1024); xi = *(const u32x4*)(pj + 2048); }
            z[j][0] = bflo(gc.x) * bflo(xi.x); z[j][1] = bfhi(gc.x) * bfhi(xi.x); z[j][2] = bflo(gc.y) * bflo(xi.y); z[j][3] = bfhi(gc.y) * bfhi(xi.y);
            z[j][4] = bflo(gc.z) * bflo(xi.z); z[j][5] = bfhi(gc.z) * bfhi(xi.z); z[j][6] = bflo(gc.w) * bflo(xi.w); z[j][7] = bfhi(gc.w) * bfhi(xi.w); }
        float gbf[8] = {bflo(gb.x), bfhi(gb.x), bflo(gb.y), bfhi(gb.y), bflo(gb.z), bfhi(gb.z), bflo(gb.w), bfhi(gb.w)};
        float o[8];
#pragma unroll
        for (int e = 0; e < 8; ++e) o[e] = gbf[e] * (cw[c8 + e] * z[0][e] + cw[1024 + c8 + e] * z[1][e] + cw[2048 + c8 + e] * z[2][e]);
        *(u32x4*)(MIX + (size_t)tok * D + 1024 + c8) = (u32x4){pk2(o[0], o[1]), pk2(o[2], o[3]), pk2(o[4], o[5]), pk2(o[6], o[7])};
    }
}
constexpr int RT_RS = 4112, RT_IMG = 16 * RT_RS;
DI void split_bf16(const float* w8, bf16x8& hi, bf16x8& lo) {
    unsigned h[4], l[4];
#pragma unroll
    for (int p = 0; p < 4; ++p) { const unsigned a = f2bf(w8[2 * p]), b = f2bf(w8[2 * p + 1]); h[p] = a | (b << 16);
        l[p] = pk2(w8[2 * p] - __uint_as_float(a << 16), w8[2 * p + 1] - __uint_as_float(b << 16)); }
    hi = __builtin_bit_cast(bf16x8, (u32x4){h[0], h[1], h[2], h[3]}); lo = __builtin_bit_cast(bf16x8, (u32x4){l[0], l[1], l[2], l[3]});
}
DI void ln_router_phase(const float* TBp, const float* lng, const float* lnb, const float* mods_l, const float* rw, const float* rbias,
                        float* X1p, bf16* Up, unsigned* counts, int* tablep, unsigned* tokinfop, LAS unsigned char* lds) {
    const int tid = threadIdx.x, wave = __builtin_amdgcn_readfirstlane(tid >> 6), lane = tid & 63, fr = lane & 15, fq = lane >> 4;
    bf16x8 bh[8][2], bl[8][2];
#pragma unroll
    for (int ks = 0; ks < 8; ++ks)
#pragma unroll
        for (int nt = 0; nt < 2; ++nt) { float w8[8];
#pragma unroll
            for (int j = 0; j < 8; ++j) w8[j] = rw[(size_t)(256 * wave + 32 * ks + 8 * fq + j) * NE + nt * 16 + fr];
            split_bf16(w8, bh[ks][nt], bl[ks][nt]); }
    LAS float* part = (LAS float*)lds; LAS float* lgs = (LAS float*)(lds + 16384);
    for (int rg = blockIdx.x; rg < T / 16; rg += gridDim.x) {
        __syncthreads();
#pragma unroll 1
        for (int rr = 0; rr < 2; ++rr) {
            const int lr = 2 * wave + rr, row = rg * 16 + lr;
            Row r; row_load(r, TBp + (size_t)row * D, lane); row_ln(r); row_affine(r, lng, lnb, lane);
            row_store(r, X1p + (size_t)row * D, lane);
            row_ln(r);
            const float* mr = mods_l + (size_t)(row >> 12) * MODW + 3 * D;
            row_modulate(r, mr, mr + D, lane);
            u32x2* uq = (u32x2*)(Up + (size_t)row * D) + lane;
#pragma unroll
            for (int j = 0; j < 8; ++j) { const unsigned a = f2bf(r.v[j].x), b = f2bf(r.v[j].y), c = f2bf(r.v[j].z), d = f2bf(r.v[j].w);
                u32x2 hi; hi.x = a | (b << 16); hi.y = c | (d << 16); uq[64 * j] = hi;
                u32x2 lo; lo.x = pk2(r.v[j].x - __uint_as_float(a << 16), r.v[j].y - __uint_as_float(b << 16)); lo.y = pk2(r.v[j].z - __uint_as_float(c << 16), r.v[j].w - __uint_as_float(d << 16));
                *(LAS u32x2*)(lds + lr * RT_RS + (4 * lane + 256 * j) * 2) = hi; *(LAS u32x2*)(lds + RT_IMG + lr * RT_RS + (4 * lane + 256 * j) * 2) = lo; }
        }
        __syncthreads();
        f32x4 acc[2]; acc[0] = (f32x4){0.f, 0.f, 0.f, 0.f}; acc[1] = acc[0];
        const LAS unsigned char* ap = lds + fr * RT_RS + (256 * wave + 8 * fq) * 2;
#pragma unroll
        for (int ks = 0; ks < 8; ++ks) { const bf16x8 ah = *(const LAS bf16x8*)(ap + ks * 64), al = *(const LAS bf16x8*)(ap + RT_IMG + ks * 64);
#pragma unroll
            for (int nt = 0; nt < 2; ++nt) { acc[nt] = __builtin_amdgcn_mfma_f32_16x16x32_bf16(ah, bh[ks][nt], acc[nt], 0, 0, 0); acc[nt] = __builtin_amdgcn_mfma_f32_16x16x32_bf16(ah, bl[ks][nt], acc[nt], 0, 0, 0);
                acc[nt] = __builtin_amdgcn_mfma_f32_16x16x32_bf16(al, bh[ks][nt], acc[nt], 0, 0, 0); } }
        __syncthreads();
#pragma unroll
        for (int nt = 0; nt < 2; ++nt)
#pragma unroll
            for (int i = 0; i < 4; ++i) part[(wave * 16 + fq * 4 + i) * 32 + nt * 16 + fr] = acc[nt][i];
        __syncthreads();
        { const int r16 = tid >> 5, e = tid & 31; float sacc = 0.f;
#pragma unroll
            for (int w = 0; w < 8; ++w) sacc += part[(w * 16 + r16) * 32 + e];
            const float af = 1.f / (1.f + expf(-sacc)); const float bi = af + rbias[e];
            lgs[r16 * 32 + e] = af; lgs[512 + r16 * 32 + e] = bi;
            const float b1 = dpp_f<0xB1>(bi), b2 = dpp_f<0x4E>(bi), b3 = dpp_f<0x1B>(bi);
            const float hi1 = fmaxf(bi, b1), lo1 = fminf(bi, b1), hi2 = fmaxf(b2, b3), lo2 = fminf(b2, b3);
            const float scg = fmaxf(hi1, hi2) + fmaxf(fminf(hi1, hi2), fmaxf(lo1, lo2));
            if ((e & 3) == 0) lgs[1024 + r16 * 8 + (e >> 2)] = scg; }
        __syncthreads();
        if (tid < 16) {
            const int row = rg * 16 + tid; const LAS float* gs = lgs + 1024 + tid * 8;
            float best = -1e30f; int grp = 0;
#pragma unroll
            for (int g = 0; g < 8; ++g) { const float scg = gs[g]; if (scg > best) { best = scg; grp = g; } }
            float ga[4], gv[4];
#pragma unroll
            for (int i = 0; i < 4; ++i) { ga[i] = lgs[tid * 32 + 4 * grp + i]; gv[i] = lgs[512 + tid * 32 + 4 * grp + i]; }
            int i1 = 0; float v1 = gv[0]; if (gv[1] > v1) { v1 = gv[1]; i1 = 1; } if (gv[2] > v1) { v1 = gv[2]; i1 = 2; } if (gv[3] > v1) { v1 = gv[3]; i1 = 3; }
            int i2 = -1; float v2 = -1e30f;
            if (i1 != 0 && gv[0] > v2) { v2 = gv[0]; i2 = 0; } if (i1 != 1 && gv[1] > v2) { v2 = gv[1]; i2 = 1; } if (i1 != 2 && gv[2] > v2) { v2 = gv[2]; i2 = 2; } if (i1 != 3 && gv[3] > v2) { v2 = gv[3]; i2 = 3; }
            const float a1 = i1 == 0 ? ga[0] : i1 == 1 ? ga[1] : i1 == 2 ? ga[2] : ga[3], a2 = i2 == 0 ? ga[0] : i2 == 1 ? ga[1] : i2 == 2 ? ga[2] : ga[3];
            const float w1 = a1 / (a1 + a2), w2 = a2 / (a1 + a2);
            const int e1 = grp * 4 + i1, e2 = grp * 4 + i2;
            const unsigned p1 = __hip_atomic_fetch_add(counts + e1, 1u, __ATOMIC_RELAXED, __HIP_MEMORY_SCOPE_AGENT);
            const unsigned p2 = __hip_atomic_fetch_add(counts + e2, 1u, __ATOMIC_RELAXED, __HIP_MEMORY_SCOPE_AGENT);
            tablep[(size_t)e1 * T + p1] = row; tablep[(size_t)e2 * T + p2] = row;
            u32x4 ta; ta.x = (unsigned)e1; ta.y = (unsigned)e2; ta.z = p1; ta.w = p2; u32x4 tb2; tb2.x = __float_as_uint(w1); tb2.y = __float_as_uint(w2); tb2.z = 0u; tb2.w = 0u;
            *(u32x4*)(tokinfop + (size_t)row * 8) = ta; *(u32x4*)(tokinfop + (size_t)row * 8 + 4) = tb2;
        }
    }
}
DI void moe_prefix(const unsigned* counts, LAS int* cnt, LAS int* tb, int tid) {
    __syncthreads();
    if (tid < 32) cnt[tid] = (int)__hip_atomic_load(counts + tid, __ATOMIC_RELAXED, __HIP_MEMORY_SCOPE_AGENT);
    __syncthreads();
    if (tid == 0) { int a = 0; for (int e = 0; e < 32; ++e) { tb[e] = a; a += (cnt[e] + 255) >> 8; } tb[32] = a; }
    __syncthreads();
}
DI void combine_phase(const float* X1, const bf16* Y, const unsigned* tokinfo, const LAS int* tb, const float* mods_l, const float* lng, const float* lnb,
                      float* XO, const float* mods_next, bf16* U, int gw, int NGW, int lane) {
    if (gw >= T) return;
    u32x4 ta = *(const u32x4*)(tokinfo + (size_t)gw * 8), tw = *(const u32x4*)(tokinfo + (size_t)gw * 8 + 4);
    for (int row = gw; row < T; row += NGW) {
        const int nr = row + NGW < T ? row + NGW : row;
        const u32x4 tan = *(const u32x4*)(tokinfo + (size_t)nr * 8), twn = *(const u32x4*)(tokinfo + (size_t)nr * 8 + 4);
        const int e0 = __builtin_amdgcn_readfirstlane((int)ta.x), e1 = __builtin_amdgcn_readfirstlane((int)ta.y);
        const size_t r0 = (size_t)(__builtin_amdgcn_readfirstlane(tb[e0]) * 256 + __builtin_amdgcn_readfirstlane((int)ta.z)), r1 = (size_t)(__builtin_amdgcn_readfirstlane(tb[e1]) * 256 + __builtin_amdgcn_readfirstlane((int)ta.w));
        const float w0 = __uint_as_float(tw.x), w1 = __uint_as_float(tw.y);
        Row r; row_load(r, X1 + (size_t)row * D, lane);
        const u32x2* y0 = (const u32x2*)(Y + r0 * D) + lane; const u32x2* y1 = (const u32x2*)(Y + r1 * D) + lane;
        const f32x4* g2 = (const f32x4*)(mods_l + (size_t)(row >> 12) * MODW + 5 * D) + lane;
#pragma unroll
        for (int j = 0; j < 8; ++j) { const u32x2 a = y0[64 * j], b = y1[64 * j]; f32x4 f;
            f.x = w0 * bflo(a.x) + w1 * bflo(b.x); f.y = w0 * bfhi(a.x) + w1 * bfhi(b.x); f.z = w0 * bflo(a.y) + w1 * bflo(b.y); f.w = w0 * bfhi(a.y) + w1 * bfhi(b.y);
            r.v[j] = r.v[j] * ALPHA + g2[64 * j] * f; }
        row_ln(r); row_affine(r, lng, lnb, lane);
        row_store(r, XO + (size_t)row * D, lane);
        if (U) { row_ln(r); const float* mr = mods_next + (size_t)(row >> 12) * MODW; row_modulate(r, mr, mr + D, lane); row_store_bf16(r, U + (size_t)row * D, lane); }
        ta = tan; tw = twn;
    }
}

struct Args { const float* in[18]; float* out; unsigned char* ws; int ph_lo, ph_hi; };
__global__ void __launch_bounds__(512, 2) fwd(Args args) {
    extern __shared__ __attribute__((aligned(16))) unsigned char lds_raw[];
    LAS unsigned char* lds = (LAS unsigned char*)lds_raw;
#define PH_IDS int tid = threadIdx.x; asm volatile("" : "+v"(tid)); const int lane = tid & 63, wave = __builtin_amdgcn_readfirstlane(tid >> 6); \
    const int gw = blockIdx.x * 8 + wave, NGW = gridDim.x * 8, gtid = blockIdx.x * 512 + tid, GT = gridDim.x * 512; (void)lane; (void)gw; (void)NGW; (void)gtid; (void)GT;
    volatile LAS unsigned* LCTL = (volatile LAS unsigned*)(lds + LDSCTL_OFF);
    LAS int* l_cnt = (LAS int*)(lds + LDSCTL_OFF) + 16; LAS int* l_tb = (LAS int*)(lds + LDSCTL_OFF) + 48;
    for (int u = threadIdx.x; u < (LDS_BYTES - LDSCTL_OFF) / 4; u += 512) ((LAS unsigned*)(lds + LDSCTL_OFF))[u] = 0u;
    __syncthreads();
    unsigned char* ws = args.ws;
    unsigned* ctl = (unsigned*)(ws + WS_CTL);
#define XIN ((const float*)args.in[0])
#define c_in args.in[1]
#define ctx args.in[2]
#define c_ctx args.in[3]
#define ada_w args.in[4]
#define ada_b args.in[5]
#define w_mix_in args.in[6]
#define rpb args.in[7]
#define conv_w args.in[8]
#define w_mix_out args.in[9]
#define w_fourier args.in[10]
#define router_w args.in[11]
#define router_b args.in[12]
#define w_gate args.in[13]
#define w_up args.in[14]
#define w_down args.in[15]
#define ln_g args.in[16]
#define ln_b args.in[17]
#define mods ((float*)(ws + WS_MODS))
#define tokinfo ((unsigned*)(ws + WS_TOKINFO))
#define table ((int*)(ws + WS_TABLE))
#define WIN ((bf16*)(ws + WS_WIN))
#define WO ((bf16*)(ws + WS_WO))
#define WF ((bf16*)(ws + WS_WF))
#define CSM ((bf16*)(ws + WS_CS))
#define U ((bf16*)(ws + WS_U))
#define P ((bf16*)(ws + WS_P))
#define YB ((bf16*)(ws + WS_P))
#define YPB ((bf16*)(ws + WS_P))
#define PCATB ((bf16*)(ws + WS_TB))
#define MIX ((bf16*)(ws + WS_MIX))
#define REZ ((bf16*)(ws + WS_MIX))
#define HB ((bf16*)(ws + WS_H))
#define WGU ((bf16*)(ws + WS_WGU))
#define WD ((bf16*)(ws + WS_WD))
#define TB ((float*)(ws + WS_TB))
#define X1 ((float*)(ws + WS_X1))
#define X2 ((float*)(ws + WS_X2))
    XcdBarrier bar; bar.bar = ctl + CW_BAR; bar.x = 0; bar.st = nullptr;
    if (N_LAUNCHES != NPHASE) bar = xcd_barrier_post(ctl + CW_BAR, LCTL);
    const int lo = args.ph_lo, hi = args.ph_hi;
#ifndef DUP_MASK
#define DUP_MASK 0x0000
#endif
#define RUN(k, ...) do { __VA_ARGS__ if constexpr ((((DUP_MASK) >> (k)) & 1) != 0) { __VA_ARGS__ } } while (0)
#ifndef PH_MASK
#define PH_MASK 0x1ffff
#endif
#define IN(k) ((((PH_MASK) >> (k)) & 1) && lo <= (k) && (k) < hi)
#define SEAM(k) do { if (IN(k) && IN((k) + 1)) xcd_barrier(bar); } while (0)

    RUN(0, if (IN(0)) { PH_IDS
        p0_mods(c_in, c_ctx, ada_w, ada_b, mods, (LAS float*)lds, tid);
        p0_weights(w_mix_in, w_mix_out, w_fourier, w_gate, w_up, w_down, WIN, WO, WF, WGU, WD, lds + wave * 16384, gw, NGW, lane);
        p0_dft(CSM, gtid, GT);
    });
    SEAM(0);
    RUN(1, if (IN(1)) { PH_IDS ln_mod_phase(XIN, ctx, mods, 0, U, TALL, gw, NGW, lane); });
    SEAM(1);
    RUN(2, if (IN(2)) { SchedInProj S{U, WIN}; EpiStoreBf16 E{P, NMIX}; gemm_pg8<false>(lds, S, E, D, D, D); });
    SEAM(2);
    RUN(3, if (IN(3)) { PH_IDS attn_phase(P, rpb, MIX, lds, (LAS float*)(lds + LDSCTL_OFF + 1024)); conv_phase(P, conv_w, MIX, gtid, GT); });
    SEAM(3);
    RUN(4, if (IN(4)) { SchedDense S{MIX, WO, 64, 8, (size_t)256 * D, (size_t)256 * D}; EpiResid E{XIN, TB, mods + 2 * D}; gemm_pg8<false>(lds, S, E, D, D, D); });
    SEAM(4);
    RUN(5, if (IN(5)) { PH_IDS ln_router_phase(TB, ln_g, ln_b, mods, router_w, router_b, X1, U, ctl + CW_CNT, table, tokinfo, lds); });
    SEAM(5);
    RUN(6, if (IN(6)) { PH_IDS moe_prefix(ctl + CW_CNT, l_cnt, l_tb, tid); SchedMoe S{l_cnt, l_tb, U, WGU, table, 1, 0, (size_t)D * D, (size_t)256 * D}; EpiSwiglu E{HB}; gemm_pg8<true>(lds, S, E, D, D, D); });
    SEAM(6);
    RUN(7, if (IN(7)) { PH_IDS moe_prefix(ctl + CW_CNT, l_cnt, l_tb, tid); SchedMoe S{l_cnt, l_tb, HB, WD, table, 0, (size_t)256 * DE, (size_t)D * DE, (size_t)256 * DE}; EpiStoreBf16 E{YB, D}; gemm_pg8<false>(lds, S, E, DE, DE, DE); });
    SEAM(7);
    RUN(8, if (IN(8)) { PH_IDS moe_prefix(ctl + CW_CNT, l_cnt, l_tb, tid); combine_phase(X1, YB, tokinfo, l_tb, mods, ln_g + D, ln_b + D, X2, mods + 5 * MODW, U, gw, NGW, lane); });
    SEAM(8);
    RUN(9, if (IN(9)) { fft1_phase(U, YPB, lds); });
    SEAM(9);
    RUN(10, if (IN(10)) { fft2_phase(YPB, PCATB, lds); });
    SEAM(10);
    RUN(11, if (IN(11)) { SchedChan S{PCATB, CSM}; EpiStoreBf16 E{REZ, D}; gemm_pg8<false>(lds, S, E, 4096, 1024, 1024); });
    SEAM(11);
    RUN(12, if (IN(12)) { SchedDense S{REZ, WF, 64, 8, (size_t)256 * D, (size_t)256 * D}; EpiResid E{X2, TB, mods + 5 * MODW + 2 * D}; gemm_pg8<false>(lds, S, E, D, D, D); });
    SEAM(12);
    RUN(13, if (IN(13)) { PH_IDS ln_router_phase(TB, ln_g + 2 * D, ln_b + 2 * D, mods + 5 * MODW, router_w, router_b, X1, U, ctl + CW_CNT + 32, table + (size_t)NE * T, tokinfo + (size_t)T * 8, lds); });
    SEAM(13);
    RUN(14, if (IN(14)) { PH_IDS moe_prefix(ctl + CW_CNT + 32, l_cnt, l_tb, tid); SchedMoe S{l_cnt, l_tb, U, WGU + (size_t)NE * D * D, table + (size_t)NE * T, 1, 0, (size_t)D * D, (size_t)256 * D}; EpiSwiglu E{HB}; gemm_pg8<true>(lds, S, E, D, D, D); });
    SEAM(14);
    RUN(15, if (IN(15)) { PH_IDS moe_prefix(ctl + CW_CNT + 32, l_cnt, l_tb, tid); SchedMoe S{l_cnt, l_tb, HB, WD + (size_t)NE * D * DE, table, 0, (size_t)256 * DE, (size_t)D * DE, (size_t)256 * DE}; EpiStoreBf16 E{YB, D}; gemm_pg8<false>(lds, S, E, DE, DE, DE); });
    SEAM(15);
    RUN(16, if (IN(16)) { PH_IDS moe_prefix(ctl + CW_CNT + 32, l_cnt, l_tb, tid); combine_phase(X1, YB, tokinfo + (size_t)T * 8, l_tb, mods + 5 * MODW, ln_g + 3 * D, ln_b + 3 * D, args.out, nullptr, nullptr, gw, NGW, lane); });
#undef IN
#undef SEAM
}

extern "C" void kernel_launch(void* const* d_in, const int* in_sizes, int n_in, void* d_out, int out_size, void* d_ws, size_t ws_size, hipStream_t stream) {
    static int grid = 0;
    if (grid == 0) {
        if (n_in != 18 || out_size != T * D || ws_size < WS_END) { fprintf(stderr, "kernel_launch: unexpected shapes (n_in %d, out %d, ws %zu)\n", n_in, out_size, ws_size); grid = -1; return; }
        int dev = 0, cus = 0, per_cu = 0;
        if (hipGetDevice(&dev) != hipSuccess || hipDeviceGetAttribute(&cus, hipDeviceAttributeMultiprocessorCount, dev) != hipSuccess) { grid = -1; return; }
        if (hipFuncSetAttribute((const void*)fwd, hipFuncAttributeMaxDynamicSharedMemorySize, LDS_BYTES) != hipSuccess) { fprintf(stderr, "kernel_launch: hipFuncSetAttribute failed\n"); grid = -1; return; }
        if (hipOccupancyMaxActiveBlocksPerMultiprocessor(&per_cu, (const void*)fwd, 512, LDS_BYTES) != hipSuccess || per_cu < 1) fprintf(stderr, "kernel_launch: occupancy query says %d\n", per_cu);
        (void)hipGetLastError();
        grid = cus;
    }
    if (grid < 0) return;
    (void)hipMemsetAsync((char*)d_ws + WS_CTL, 0, CTL_ZERO_BYTES, stream);
    Args a{};
    for (int i = 0; i < 18; ++i) a.in[i] = (const float*)d_in[i];
    a.out = (float*)d_out; a.ws = (unsigned char*)d_ws;
    if (N_LAUNCHES == 1) { a.ph_lo = 0; a.ph_hi = NPHASE; hipLaunchKernelGGL(fwd, dim3(grid), dim3(512), LDS_BYTES, stream, a); }
    else for (int p = 0; p < NPHASE; ++p) { a.ph_lo = p; a.ph_hi = p + 1; hipLaunchKernelGGL(fwd, dim3(grid), dim3(512), LDS_BYTES, stream, a); }
}
```

```cpp
#include <hip/hip_runtime.h>
#include <cstdio>
#include <cstdint>

#define DI __device__ __forceinline__
#define LAS __attribute__((address_space(3)))
typedef unsigned short bf16;
typedef float f32x4 __attribute__((ext_vector_type(4)));
typedef short bf16x8 __attribute__((ext_vector_type(8)));
typedef unsigned u32x4 __attribute__((ext_vector_type(4)));
typedef unsigned u32x2 __attribute__((ext_vector_type(2)));

constexpr int D = 2048, NB = 4, SEQ = 4096, T = NB * SEQ, CTXL = 256, TC = NB * CTXL, TALL = T + TC;
constexpr int NMIX = 6144, NE = 32, DE = 1024, NH = 8, HD = 128, MODW = 6 * D;
constexpr float ALPHA = 1.41421356237309515f;
constexpr float LN_EPS = 1e-6f;
constexpr int NPHASE = 17;
#ifndef MK_N_LAUNCHES
#define MK_N_LAUNCHES 1
#endif
constexpr int N_LAUNCHES = MK_N_LAUNCHES;

constexpr size_t MiB = 1u << 20;
constexpr size_t WS_CTL = 0, CTL_ZERO_BYTES = 64 * 1024;
constexpr size_t WS_MODS = 1 * MiB;
constexpr size_t WS_TOKINFO = 2 * MiB;
constexpr size_t WS_TABLE = 4 * MiB;
constexpr size_t WS_WIN = 8 * MiB, WS_WO = 32 * MiB, WS_WF = 40 * MiB, WS_CS = 48 * MiB, WS_ACS = 64 * MiB;
constexpr size_t WS_U = 128 * MiB;
constexpr size_t WS_P = 196 * MiB;
constexpr size_t WS_MIX = 400 * MiB;
constexpr size_t WS_TB = 464 * MiB, WS_X1 = 592 * MiB, WS_X2 = 720 * MiB;
constexpr size_t WS_H = 848 * MiB;
constexpr size_t WS_WGU = 928 * MiB;
constexpr size_t WS_WD = 1440 * MiB;
constexpr size_t WS_END = 1696 * MiB;
constexpr int CW_CNT = 64;
constexpr int CW_BAR = 1024;

constexpr int LDS_SCR = 133120;
constexpr int LDSCTL_OFF = LDS_SCR;
constexpr int LDS_BYTES = 147456;

template <int CTRL> DI float dpp_f(float v) { return __builtin_bit_cast(float, __builtin_amdgcn_mov_dpp(__builtin_bit_cast(int, v), CTRL, 0xF, 0xF, true)); }
DI float wave_sum(float v) {
    v += dpp_f<0xB1>(v); v += dpp_f<0x4E>(v); v += dpp_f<0x141>(v); v += dpp_f<0x140>(v);
    const int iv = __builtin_bit_cast(int, v);
    const float r0 = __builtin_bit_cast(float, __builtin_amdgcn_readlane(iv, 0)), r1 = __builtin_bit_cast(float, __builtin_amdgcn_readlane(iv, 16)),
                r2 = __builtin_bit_cast(float, __builtin_amdgcn_readlane(iv, 32)), r3 = __builtin_bit_cast(float, __builtin_amdgcn_readlane(iv, 48));
    return (r0 + r1) + (r2 + r3);
}
DI float wave_max(float v) {
    v = fmaxf(v, dpp_f<0xB1>(v)); v = fmaxf(v, dpp_f<0x4E>(v)); v = fmaxf(v, dpp_f<0x141>(v)); v = fmaxf(v, dpp_f<0x140>(v));
    const int iv = __builtin_bit_cast(int, v);
    const float r0 = __builtin_bit_cast(float, __builtin_amdgcn_readlane(iv, 0)), r1 = __builtin_bit_cast(float, __builtin_amdgcn_readlane(iv, 16)),
                r2 = __builtin_bit_cast(float, __builtin_amdgcn_readlane(iv, 32)), r3 = __builtin_bit_cast(float, __builtin_amdgcn_readlane(iv, 48));
    return fmaxf(fmaxf(r0, r1), fmaxf(r2, r3));
}
DI unsigned f2bf(float f) { unsigned u = __float_as_uint(f); return (u + 0x7fffu + ((u >> 16) & 1u)) >> 16; }
DI unsigned pk2(float lo, float hi) { return f2bf(lo) | (f2bf(hi) << 16); }
DI float bflo(unsigned w) { return __uint_as_float(w << 16); }
DI float bfhi(unsigned w) { return __uint_as_float(w & 0xffff0000u); }
DI float silu_f(float v) { return v / (1.f + expf(-v)); }

#define XB_TMO      128
#define XB_XCNT(j)  (256  + 64 * (j))
#define XB_XSUB(j)  (1280 + 64 * (j))
#define XB_XGEN(j)  (2304 + 64 * (j))
#define XB_TOP      3328
#define XB_TOPGEN   3392
#define XCD_BAR_WORDS 3456
#define XB_SPIN_CAP (1u << 18)
__device__ __forceinline__ unsigned xb_ld(unsigned* p)              { return __hip_atomic_load(p, __ATOMIC_RELAXED, __HIP_MEMORY_SCOPE_AGENT); }
__device__ __forceinline__ unsigned xb_add(unsigned* p, unsigned v) { return __hip_atomic_fetch_add(p, v, __ATOMIC_RELAXED, __HIP_MEMORY_SCOPE_AGENT); }
__device__ __forceinline__ unsigned xb_xcc_id() { return (unsigned)__builtin_amdgcn_s_getreg((3 << 11) | 20) & 0xFu; }
#define XB_SPIN(cond, bar) do { unsigned _sp = 0; while (cond) { __builtin_amdgcn_s_sleep(1); \
    if ((++_sp & 255u) == 0u) { if (xb_ld(&(bar)[XB_TMO])) break; if (_sp > XB_SPIN_CAP) { atomicAdd(&(bar)[XB_TMO], 1u); break; } } } } while (0)
struct XcdBarrier { unsigned* bar; unsigned x; volatile LAS unsigned* st; };
__device__ __forceinline__ XcdBarrier xcd_barrier_post(unsigned* bar, volatile LAS unsigned* st) {
    XcdBarrier b; b.bar = bar; b.x = xb_xcc_id(); b.st = st;
    if (threadIdx.x == 0) (void)xb_add(&bar[XB_XCNT(b.x)], 1u);
    return b;
}
__device__ __forceinline__ void xcd_barrier_complete(unsigned* bar, unsigned x, unsigned& nloc, unsigned& nx) {
    const unsigned G = gridDim.x * gridDim.y * gridDim.z;
    unsigned sum, cnt, mine, sp = 0u;
    for (;;) {
        sum = 0u; cnt = 0u; mine = 0u;
#pragma unroll
        for (unsigned j = 0; j < 16; ++j) { const unsigned c = xb_ld(&bar[XB_XCNT(j)]); sum += c; cnt += (c > 0u) ? 1u : 0u; mine = (j == x) ? c : mine; }
        if (sum == G) break;
        __builtin_amdgcn_s_sleep(1);
        if ((++sp & 255u) == 0u) { if (xb_ld(&bar[XB_TMO])) break; if (sp > XB_SPIN_CAP) { atomicAdd(&bar[XB_TMO], 1u); break; } }
    }
    nloc = mine > 0u ? mine : 1u; nx = cnt > 0u ? cnt : 1u;
}
__device__ __forceinline__ void xcd_barrier(const XcdBarrier& b) {
    asm volatile("s_waitcnt vmcnt(0)" ::: "memory");
    __syncthreads();
    if (threadIdx.x == 0) {
        unsigned* bar = b.bar;
        __builtin_amdgcn_s_waitcnt(0);
        unsigned nloc = b.st[0], nx = b.st[1];
        if (nloc == 0u) { xcd_barrier_complete(bar, b.x, nloc, nx); b.st[0] = nloc; b.st[1] = nx; }
        const unsigned old = xb_add(&bar[XB_XSUB(b.x)], 1u);
        const unsigned gen = old / nloc;
        if (old + 1u == (gen + 1u) * nloc) {
            __builtin_amdgcn_fence(__ATOMIC_RELEASE, "agent");
            asm volatile("s_waitcnt vmcnt(0)" ::: "memory");
            const unsigned og = xb_add(&bar[XB_TOP], 1u);
            const unsigned tg = og / nx;
            if (og + 1u == (tg + 1u) * nx) xb_add(&bar[XB_TOPGEN], 1u);
            else XB_SPIN(xb_ld(&bar[XB_TOPGEN]) == tg, bar);
            __builtin_amdgcn_fence(__ATOMIC_ACQUIRE, "agent");
            xb_add(&bar[XB_XGEN(b.x)], 1u);
            asm volatile("s_waitcnt vmcnt(0)" ::: "memory");
        } else {
            XB_SPIN(xb_ld(&bar[XB_XGEN(b.x)]) == gen, bar);
            __builtin_amdgcn_fence(__ATOMIC_ACQUIRE, "agent");
            asm volatile("s_waitcnt vmcnt(0)" ::: "memory");
        }
    }
    __syncthreads();
}

struct Row { f32x4 v[8]; };
DI void row_load(Row& r, const float* p, int lane) { const f32x4* q = (const f32x4*)p + lane;
#pragma unroll
    for (int j = 0; j < 8; ++j) r.v[j] = q[64 * j]; }
DI void row_store(const Row& r, float* p, int lane) { f32x4* q = (f32x4*)p + lane;
#pragma unroll
    for (int j = 0; j < 8; ++j) q[64 * j] = r.v[j]; }
DI void row_store_bf16(const Row& r, bf16* p, int lane) { u32x2* q = (u32x2*)p + lane;
#pragma unroll
    for (int j = 0; j < 8; ++j) { u32x2 w; w.x = pk2(r.v[j].x, r.v[j].y); w.y = pk2(r.v[j].z, r.v[j].w); q[64 * j] = w; } }
DI void row_ln(Row& r) {
    float s = 0.f;
#pragma unroll
    for (int j = 0; j < 8; ++j) s += (r.v[j].x + r.v[j].y) + (r.v[j].z + r.v[j].w);
    const float mean = wave_sum(s) * (1.f / D); float s2 = 0.f;
#pragma unroll
    for (int j = 0; j < 8; ++j) { r.v[j] = r.v[j] - mean; s2 += (r.v[j].x * r.v[j].x + r.v[j].y * r.v[j].y) + (r.v[j].z * r.v[j].z + r.v[j].w * r.v[j].w); }
    const float rstd = 1.f / sqrtf(wave_sum(s2) * (1.f / D) + LN_EPS);
#pragma unroll
    for (int j = 0; j < 8; ++j) r.v[j] = r.v[j] * rstd;
}
DI void row_affine(Row& r, const float* g, const float* b, int lane) {
    const f32x4* gq = (const f32x4*)g + lane; const f32x4* bq = (const f32x4*)b + lane;
#pragma unroll
    for (int j = 0; j < 8; ++j) r.v[j] = r.v[j] * gq[64 * j] + bq[64 * j];
}
DI void row_modulate(Row& r, const float* sh, const float* sc, int lane) {
    const f32x4* hq = (const f32x4*)sh + lane; const f32x4* cq = (const f32x4*)sc + lane;
#pragma unroll
    for (int j = 0; j < 8; ++j) r.v[j] = r.v[j] * (cq[64 * j] + 1.f) + hq[64 * j];
}

struct Unit { const bf16* A; const bf16* B; const int* gat; int nvalid; int m0, n0, aux; };

template <class Sched, class Epi>
DI void gemm_simple(const Sched& S, const Epi& E, const int lda, const int ldb, const int K) {
    const int tid = threadIdx.x, wid = tid >> 6, lane = tid & 63, fr = lane & 15, fq = lane >> 4;
    for (int L = blockIdx.x; ; L += gridDim.x) {
        Unit u; if (!S.get(L, u)) break;
        const bf16* arow[2];
#pragma unroll
        for (int m = 0; m < 2; ++m) { const int r = 32 * wid + 16 * m + fr; size_t grow = (size_t)r; if (u.gat) grow = (size_t)(r < u.nvalid ? u.gat[r] : 0); arow[m] = u.A + grow * lda + fq * 8; }
        for (int cc = 0; cc < 4; ++cc) {
            f32x4 acc[2][4];
#pragma unroll
            for (int m = 0; m < 2; ++m)
#pragma unroll
                for (int j = 0; j < 4; ++j) acc[m][j] = (f32x4){0.f, 0.f, 0.f, 0.f};
            const bf16* brow[4];
#pragma unroll
            for (int j = 0; j < 4; ++j) { const int col = (j >> 1) * 128 + cc * 32 + (j & 1) * 16 + fr; brow[j] = u.B + (size_t)col * ldb + fq * 8; }
            for (int k = 0; k < K; k += 32) {
                bf16x8 a[2], b[4];
#pragma unroll
                for (int m = 0; m < 2; ++m) a[m] = *(const bf16x8*)(arow[m] + k);
#pragma unroll
                for (int j = 0; j < 4; ++j) b[j] = *(const bf16x8*)(brow[j] + k);
#pragma unroll
                for (int m = 0; m < 2; ++m)
#pragma unroll
                    for (int j = 0; j < 4; ++j) acc[m][j] = __builtin_amdgcn_mfma_f32_16x16x32_bf16(b[j], a[m], acc[m][j], 0, 0, 0);
            }
#pragma unroll
            for (int m = 0; m < 2; ++m)
#pragma unroll
                for (int nn = 0; nn < 2; ++nn) E(u, 32 * wid + 16 * m + fr, cc * 32 + nn * 16 + 4 * fq, acc[m][nn], acc[m][nn + 2]);
        }
    }
}


namespace pg8 {
constexpr int BK = 64, HALF = 128, HTB = HALF * BK * 2, STAGE_BYTES = 8 * HTB;
DI int lds_byte(int r, int c) { const int st = (r >> 4) * 2 + (c >> 5), rr = r & 15, cc = c & 31, ob = rr * 64 + cc * 2; return st * 1024 + (ob ^ (((ob >> 9) & 1) << 5)); }
DI void stage_rc(int b, int& R, int& C) { const int st = b / 1024, sb = b % 1024, swz = sb ^ (((sb >> 9) & 1) << 5); R = (st >> 1) * 16 + swz / 64; C = (st & 1) * 32 + (swz % 64) / 2; }
}
template <bool GATHER, class Sched, class Epi>
DI void gemm_pg8(LAS unsigned char* lds, const Sched& S, const Epi& E, const int lda, const int ldb, const int K) {
    using namespace pg8;
    const int tid = threadIdx.x, wid = __builtin_amdgcn_readfirstlane(tid >> 6), lane = tid & 63, wr = wid >> 2, wc = wid & 3, fr = lane & 15, fq = lane >> 4;
    const int nt = K / BK, G = gridDim.x, cblk = blockIdx.x;
    unsigned voffB[2], vA[2][2];
#pragma unroll
    for (int i = 0; i < 2; ++i) { int R_, C_; stage_rc(tid * 16 + i * 8192, R_, C_); voffB[i] = (unsigned)(R_ * ldb + C_) * 2u; }
    const size_t kstep = (size_t)(BK * 2), hstepA = (size_t)HALF * lda * 2, hstepB = (size_t)HALF * ldb * 2;
    const unsigned ldsw = (unsigned)wid * 1024u;
    const int aoff = lds_byte(wr * 64 + fr, fq * 8), boff = lds_byte(wc * 32 + fr, fq * 8);
#define PG8_SA(b, h) (((b) * 2 + (h)) * HTB)
#define PG8_SB(b, h) ((4 + (b) * 2 + (h)) * HTB)
#define PG8_STAGE(bufoff, gbase, voff) do { _Pragma("unroll") for (int _i = 0; _i < 2; ++_i) \
        __builtin_amdgcn_global_load_lds((const unsigned*)((const char*)(gbase) + (voff)[_i]), (LAS unsigned*)(lds + (bufoff) + ldsw + _i * 8192), 16, 0, 0); } while (0)
#define PG8_STAGE_A(bufoff, gbase, h) do { if constexpr (GATHER) PG8_STAGE(bufoff, gbase, vA[h]); else PG8_STAGE(bufoff, (gbase) + (h) * hstepA, vA[0]); } while (0)
#define PG8_LDA(dst, b, h) do { _Pragma("unroll") for (int m = 0; m < 4; ++m) _Pragma("unroll") for (int k = 0; k < 2; ++k) dst[m][k] = *(const LAS bf16x8*)(lds + PG8_SA(b, h) + aoff + m * 2048 + k * 1024); } while (0)
#define PG8_LDB(dst, b, h) do { _Pragma("unroll") for (int n = 0; n < 2; ++n) _Pragma("unroll") for (int k = 0; k < 2; ++k) dst[n][k] = *(const LAS bf16x8*)(lds + PG8_SB(b, h) + boff + n * 2048 + k * 1024); } while (0)
#define PG8_MMA(ai, bj, At, Bt) do { __builtin_amdgcn_s_setprio(1); _Pragma("unroll") for (int m = 0; m < 4; ++m) _Pragma("unroll") for (int n = 0; n < 2; ++n) _Pragma("unroll") for (int k = 0; k < 2; ++k) \
        acc[ai][bj][m][n] = __builtin_amdgcn_mfma_f32_16x16x32_bf16(Bt[n][k], At[m][k], acc[ai][bj][m][n], 0, 0, 0); __builtin_amdgcn_s_setprio(0); } while (0)
#define PG8_WAIT_V(n) asm volatile("s_waitcnt vmcnt(" #n ")" ::: "memory")
#define PG8_WAIT_L(n) asm volatile("s_waitcnt lgkmcnt(" #n ")" ::: "memory")
#define PG8_BAR __builtin_amdgcn_s_barrier()
#define PG8_SCHED __builtin_amdgcn_sched_barrier(0)
#define PG8_SETV(dst, u) do { _Pragma("unroll") for (int _h = 0; _h < 2; ++_h) _Pragma("unroll") for (int _i = 0; _i < 2; ++_i) { int _R, _C; stage_rc(tid * 16 + _i * 8192, _R, _C); const int _r = _h * HALF + _R; \
        if constexpr (GATHER) { const int _g = _r < (u).nvalid ? (u).gat[_r] : 0; dst[_h][_i] = (unsigned)(_g * lda + _C) * 2u; } else dst[_h][_i] = (unsigned)(_R * lda + _C) * 2u; } } while (0)
    Unit cur, nxt; int ui = 0;
    if (!S.get(cblk, cur)) return;
    f32x4 acc[2][2][4][2];
#pragma unroll
    for (int a = 0; a < 2; ++a)
#pragma unroll
        for (int b = 0; b < 2; ++b)
#pragma unroll
            for (int m = 0; m < 4; ++m)
#pragma unroll
                for (int n = 0; n < 2; ++n) acc[a][b][m][n] = (f32x4){0.f, 0.f, 0.f, 0.f};
    bf16x8 At[4][2], B0[2][2], B1[2][2];
    const char* cA = (const char*)cur.A; const char* cB = (const char*)cur.B;
    PG8_SETV(vA, cur);
    PG8_STAGE(PG8_SB(0, 0), cB, voffB); PG8_STAGE(PG8_SB(0, 1), cB + hstepB, voffB); PG8_STAGE_A(PG8_SA(0, 0), cA, 0); PG8_STAGE_A(PG8_SA(0, 1), cA, 1);
    if (wr == 1) PG8_BAR;
    PG8_WAIT_V(2); PG8_BAR;
    PG8_STAGE(PG8_SB(1, 0), cB + kstep, voffB); PG8_STAGE_A(PG8_SA(1, 0), cA + kstep, 0); PG8_STAGE(PG8_SB(1, 1), cB + hstepB + kstep, voffB);
    PG8_WAIT_V(6); PG8_BAR;
    for (;;) {
        const bool has_next = S.get((ui + 1) * G + cblk, nxt);
        const char* nA = has_next ? (const char*)nxt.A : cA; const char* nB = has_next ? (const char*)nxt.B : cB;
        for (int t = 0; t < nt; t += 2) {
            const bool last = (t == nt - 2);
            const char* a1 = cA + (size_t)(t + 1) * kstep;
            const char* a2 = last ? nA : cA + (size_t)(t + 2) * kstep; const char* b2 = last ? nB : cB + (size_t)(t + 2) * kstep;
            const char* a3 = a2 + kstep; const char* b3 = b2 + kstep;
            PG8_LDB(B0, 0, 0); PG8_LDB(B1, 0, 1); PG8_SCHED; PG8_LDA(At, 0, 0); PG8_STAGE_A(PG8_SA(1, 1), a1, 1);
            PG8_WAIT_V(8); PG8_WAIT_L(0); PG8_BAR; PG8_MMA(0, 0, At, B0); PG8_MMA(0, 1, At, B1); PG8_BAR; PG8_SCHED;
            if constexpr (GATHER) { if (last && has_next) PG8_SETV(vA, nxt); }
            PG8_LDA(At, 0, 1); PG8_STAGE(PG8_SB(0, 0), b2, voffB); PG8_STAGE(PG8_SB(0, 1), b2 + hstepB, voffB); PG8_STAGE_A(PG8_SA(0, 0), a2, 0);
            PG8_WAIT_V(8); PG8_WAIT_L(0); PG8_BAR; PG8_MMA(1, 0, At, B0); PG8_MMA(1, 1, At, B1); PG8_BAR; PG8_SCHED;
            PG8_LDB(B0, 1, 0); PG8_LDB(B1, 1, 1); PG8_SCHED; PG8_LDA(At, 1, 0); PG8_STAGE_A(PG8_SA(0, 1), a2, 1);
            PG8_WAIT_V(8); PG8_WAIT_L(0); PG8_BAR; PG8_MMA(0, 0, At, B0); PG8_MMA(0, 1, At, B1); PG8_BAR; PG8_SCHED;
            PG8_LDA(At, 1, 1); PG8_STAGE(PG8_SB(1, 0), b3, voffB); PG8_STAGE(PG8_SB(1, 1), b3 + hstepB, voffB); PG8_STAGE_A(PG8_SA(1, 0), a3, 0);
            PG8_WAIT_V(8); PG8_WAIT_L(0); PG8_BAR; PG8_MMA(1, 0, At, B0); PG8_MMA(1, 1, At, B1); PG8_BAR; PG8_SCHED;
        }
        if (wr == 0) PG8_BAR;
#pragma unroll
        for (int ai = 0; ai < 2; ++ai)
#pragma unroll
            for (int m = 0; m < 4; ++m)
#pragma unroll
                for (int n = 0; n < 2; ++n) E(cur, ai * HALF + wr * 64 + m * 16 + fr, wc * 32 + n * 16 + 4 * fq, acc[ai][0][m][n], acc[ai][1][m][n]);
        if (!has_next) break;
#pragma unroll
        for (int a = 0; a < 2; ++a)
#pragma unroll
            for (int b = 0; b < 2; ++b)
#pragma unroll
                for (int m = 0; m < 4; ++m)
#pragma unroll
                    for (int n = 0; n < 2; ++n) acc[a][b][m][n] = (f32x4){0.f, 0.f, 0.f, 0.f};
        cur = nxt; cA = nA; cB = nB; ++ui;
        if (wr == 1) PG8_BAR;
    }
    PG8_WAIT_V(0);
    PG8_BAR;
#undef PG8_SA
#undef PG8_SB
#undef PG8_STAGE
#undef PG8_STAGE_A
#undef PG8_LDA
#undef PG8_LDB
#undef PG8_MMA
#undef PG8_WAIT_V
#undef PG8_WAIT_L
#undef PG8_BAR
#undef PG8_SCHED
#undef PG8_SETV
}

DI int xcd_remap(int L, int n) { const int q = n >> 3, r = n & 7, xcd = L & 7, off = L >> 3; return (xcd < r ? xcd * (q + 1) : r * (q + 1) + (xcd - r) * q) + off; }
DI void grouped(int wgid, int nM, int nN, int& pm, int& pn) { const int nig = 8 * nN, gid = wgid / nig, fm = gid * 8, gsz = min(nM - fm, 8); pm = fm + (wgid % nig) % gsz; pn = (wgid % nig) / gsz; }

struct SchedInProj { const bf16* U; const bf16* W;
    DI bool get(int L, Unit& u) const { int pm, pn;
        if (L >= 64 * 24 + 32) return false; const int w = xcd_remap(L, 64 * 24 + 32);
        if (w < 64 * 24) grouped(w, 64, 24, pm, pn); else { const int l2 = w - 64 * 24; pm = 64 + (l2 >> 3); pn = 4 + (l2 & 7); }
        u.A = U + (size_t)pm * 256 * D; u.B = W + (size_t)pn * 256 * D; u.gat = nullptr; u.nvalid = 256; u.m0 = pm * 256; u.n0 = pn * 256; u.aux = 0; return true; } };
struct SchedDense { const bf16* A; const bf16* B; int nM, nN; size_t a_t, b_t;
    DI bool get(int L, Unit& u) const { if (L >= nM * nN) return false; int pm, pn; grouped(xcd_remap(L, nM * nN), nM, nN, pm, pn);
        u.A = A + (size_t)pm * a_t; u.B = B + (size_t)pn * b_t; u.gat = nullptr; u.nvalid = 256; u.m0 = pm * 256; u.n0 = pn * 256; u.aux = 0; return true; } };
struct SchedMoe { const LAS int* cnt; const LAS int* tb; const bf16* A; const bf16* W; const int* table; int gather; size_t a_t, w_e, w_t;
    DI bool get(int L, Unit& u) const { const int nT = __builtin_amdgcn_readfirstlane(tb[32]); if (L >= nT * 8) return false; int t, pn; grouped(xcd_remap(L, nT * 8), nT, 8, t, pn);
        int e = 0;
        for (int i = 1; i < 32; ++i) e = (tb[i] <= t) ? i : e;
        e = __builtin_amdgcn_readfirstlane(e); t = __builtin_amdgcn_readfirstlane(t); pn = __builtin_amdgcn_readfirstlane(pn);
        const int mt = __builtin_amdgcn_readfirstlane(t - tb[e]);
        if (gather) { u.A = A; u.gat = table + (size_t)e * T + mt * 256; } else { u.A = A + (size_t)t * a_t; u.gat = nullptr; }
        u.nvalid = __builtin_amdgcn_readfirstlane(min(256, cnt[e] - mt * 256));
        u.B = W + (size_t)e * w_e + (size_t)pn * w_t; u.m0 = t * 256; u.n0 = pn * 256; u.aux = e; return true; } };
struct SchedChan { const bf16* PCAT; const bf16* CSB;
    DI bool get(int L, Unit& u) const { if (L >= 512) return false; int pm, q; grouped(xcd_remap(L, 512), 64, 8, pm, q); const int g = q >> 1, pn = q & 1;
        u.A = PCAT + (size_t)pm * 256 * 4096 + g * 1024; u.B = CSB + (size_t)pn * 256 * 1024; u.gat = nullptr; u.nvalid = 256; u.m0 = pm * 256; u.n0 = g * 512 + pn * 256; u.aux = g; return true; } };

DI void st_bf16x4(bf16* p, f32x4 v) { u32x2 w; w.x = pk2(v.x, v.y); w.y = pk2(v.z, v.w); *(u32x2*)p = w; }
struct EpiStoreBf16 { bf16* O; int ldc;
    DI void operator()(const Unit& u, int r, int c, f32x4 lo, f32x4 hi) const { bf16* p = O + (size_t)(u.m0 + r) * ldc + u.n0 + c; st_bf16x4(p, lo); st_bf16x4(p + 128, hi); } };
struct EpiResid { const float* x; float* t; const float* gate;
    DI void operator()(const Unit& u, int r, int c, f32x4 lo, f32x4 hi) const { const int row = u.m0 + r, b = row >> 12; const int col = u.n0 + c;
        const size_t o = (size_t)row * D + col; const float* g = gate + (size_t)b * MODW + col;
        *(f32x4*)(t + o) = *(const f32x4*)(x + o) * ALPHA + *(const f32x4*)g * lo;
        *(f32x4*)(t + o + 128) = *(const f32x4*)(x + o + 128) * ALPHA + *(const f32x4*)(g + 128) * hi; } };
struct EpiSwiglu { bf16* H;
    DI void operator()(const Unit& u, int r, int c, f32x4 lo, f32x4 hi) const { f32x4 h;
        h.x = silu_f(lo.x) * hi.x; h.y = silu_f(lo.y) * hi.y; h.z = silu_f(lo.z) * hi.z; h.w = silu_f(lo.w) * hi.w;
        st_bf16x4(H + (size_t)(u.m0 + r) * DE + (u.n0 >> 1) + c, h); } };
DI void p0_mods_unit(const float* ada_w, const float* ada_b, float* mods, const LAS float* sl, LAS float* red, int unit, int tid) {
    const int cg = tid & 31, ks = tid >> 5, l = unit / 96, n0 = (unit % 96) * 128;
    const float* W = ada_w + (size_t)l * D * MODW + n0 + 4 * cg;
    f32x4 a0 = (f32x4){0.f, 0.f, 0.f, 0.f}, a1 = a0, a2 = a0, a3 = a0, a4 = a0;
#pragma unroll 8
    for (int k = ks * 128; k < ks * 128 + 128; ++k) { const f32x4 w = *(const f32x4*)(W + (size_t)k * MODW); a0 += w * sl[k]; a1 += w * sl[D + k]; a2 += w * sl[2 * D + k]; a3 += w * sl[3 * D + k]; a4 += w * sl[4 * D + k]; }
    *(LAS f32x4*)(red + (ks * 5 + 0) * 128 + 4 * cg) = a0; *(LAS f32x4*)(red + (ks * 5 + 1) * 128 + 4 * cg) = a1; *(LAS f32x4*)(red + (ks * 5 + 2) * 128 + 4 * cg) = a2;
    *(LAS f32x4*)(red + (ks * 5 + 3) * 128 + 4 * cg) = a3; *(LAS f32x4*)(red + (ks * 5 + 4) * 128 + 4 * cg) = a4;
    __syncthreads();
    for (int i = tid; i < 640; i += 512) { const int r = i >> 7, q = i & 127; float sacc = 0.f;
#pragma unroll
        for (int k2 = 0; k2 < 16; ++k2) sacc += red[(k2 * 5 + r) * 128 + q];
        mods[((size_t)l * 5 + r) * MODW + n0 + q] = sacc + ada_b[(size_t)l * MODW + n0 + q]; }
    __syncthreads();
}
DI void tr_item(const float* W, int N, int Kd, int k0, int n0, bf16* WT, int drow0, LAS unsigned char* scr, int lane) {
    const int ng = lane & 15, kl = lane >> 4;
    f32x4 v[2][8];
    const float* src = W + (size_t)(k0 + 16 * kl) * N + n0 + 4 * ng;
#pragma unroll
    for (int pp = 0; pp < 2; ++pp)
#pragma unroll
        for (int i = 0; i < 8; ++i) v[pp][i] = *(const f32x4*)(src + (size_t)(8 * pp + i) * N);
#pragma unroll
    for (int pp = 0; pp < 2; ++pp)
#pragma unroll
        for (int c = 0; c < 4; ++c) { u32x4 o; o.x = pk2(v[pp][0][c], v[pp][1][c]); o.y = pk2(v[pp][2][c], v[pp][3][c]); o.z = pk2(v[pp][4][c], v[pp][5][c]); o.w = pk2(v[pp][6][c], v[pp][7][c]);
            *(LAS u32x4*)(scr + (4 * ng + c) * 144 + (16 * kl + 8 * pp) * 2) = o; }
    asm volatile("s_waitcnt lgkmcnt(0)" ::: "memory");
#pragma unroll
    for (int j = 0; j < 8; ++j) { const int row = (lane >> 3) + 8 * j, ch = lane & 7;
        const u32x4 o = *(const LAS u32x4*)(scr + row * 144 + ch * 16);
        *(u32x4*)(WT + (size_t)(drow0 + row) * Kd + k0 + 8 * ch) = o; }
    asm volatile("s_waitcnt lgkmcnt(0)" ::: "memory");
}
constexpr int P0_S_IN = 8 * 48, P0_S_SQ = 8 * 16, P0_S_E = 64 * 64, P0_NSI = P0_S_IN + 2 * P0_S_SQ + 3 * P0_S_E, P0_NMODS = 192;
DI void p0_weight_item(int si, const float* w_in, const float* w_out, const float* w_f, const float* w_gate, const float* w_up, const float* w_down,
                       bf16* WIN, bf16* WO, bf16* WF, bf16* WGU, bf16* WD, LAS unsigned char* scr, int wave, int lane) {
    const int dk = wave >> 1, dn = wave & 1; int r = si;
    if (r < P0_S_IN) { const int kb = (r / 48) * 4 + dk, nb = (r % 48) * 2 + dn; tr_item(w_in, NMIX, D, kb * 64, nb * 64, WIN, nb * 64, scr, lane); return; } r -= P0_S_IN;
    if (r < P0_S_SQ) { const int kb = (r >> 4) * 4 + dk, nb = (r & 15) * 2 + dn; tr_item(w_out, D, D, kb * 64, nb * 64, WO, nb * 64, scr, lane); return; } r -= P0_S_SQ;
    if (r < P0_S_SQ) { const int kb = (r >> 4) * 4 + dk, nb = (r & 15) * 2 + dn; tr_item(w_f, D, D, kb * 64, nb * 64, WF, nb * 64, scr, lane); return; } r -= P0_S_SQ;
    if (r < 2 * P0_S_E) { const int up = r >= P0_S_E; if (up) r -= P0_S_E; const int mat = r >> 6, rr = r & 63, kb = (rr >> 3) * 4 + dk, nb = (rr & 7) * 2 + dn, n0 = nb * 64;
        tr_item((up ? w_up : w_gate) + (size_t)mat * D * DE, DE, D, kb * 64, n0, WGU + (size_t)mat * D * D, (n0 >> 7) * 256 + (n0 & 127) + (up ? 128 : 0), scr, lane); return; } r -= 2 * P0_S_E;
    { const int mat = r >> 6, rr = r & 63, kb = (rr >> 4) * 4 + dk, nb = (rr & 15) * 2 + dn; tr_item(w_down + (size_t)mat * DE * D, D, DE, kb * 64, nb * 64, WD + (size_t)mat * D * DE, nb * 64, scr, lane); }
}
DI void p0_dft(bf16* CSB, int gtid, int GT) {
    for (int i = gtid; i < 512 * 128; i += GT) { const int cp = i >> 7, k8 = (i & 127) * 8; unsigned w[4];
#pragma unroll
        for (int e = 0; e < 4; ++e) { float v[2];
#pragma unroll
            for (int q = 0; q < 2; ++q) { const int kk = k8 + 2 * e + q; const int m = (cp * (kk & 511)) & 511; const float ang = (float)m * (1.f / 256.f); v[q] = (kk < 512 ? cospif(ang) : sinpif(ang)) * 0.04419417382415922f; }
            w[e] = pk2(v[0], v[1]); }
        *(u32x4*)(CSB + (size_t)cp * 1024 + k8) = (u32x4){w[0], w[1], w[2], w[3]}; }
}
DI void ln_mod_phase(const float* x, const float* ctx, const float* mods_l, int sh_chunk, bf16* U, int nrows, int gw, int NGW, int lane) {
    int row = gw; if (row >= nrows) return;
    Row cur; row_load(cur, row < T ? x + (size_t)row * D : ctx + (size_t)(row - T) * D, lane);
    for (; row < nrows; row += NGW) {
        const int nr = row + NGW < nrows ? row + NGW : row;
        Row nxt; row_load(nxt, nr < T ? x + (size_t)nr * D : ctx + (size_t)(nr - T) * D, lane);
        const int rb = row < T ? (row >> 12) : 4;
        row_ln(cur);
        const float* mr = mods_l + (size_t)rb * MODW + sh_chunk * D;
        row_modulate(cur, mr, mr + D, lane);
        row_store_bf16(cur, U + (size_t)row * D, lane);
        cur = nxt;
    }
}
DI void attn_simple(const bf16* P, const float* rpb, bf16* MIX, LAS float* scr, int gw, int NGW, int lane) {
    const float scale = 0.08838834764831845f;
    for (int item = gw; item < T * NH; item += NGW) {
        const int tok = item >> 3, h = item & 7, b = tok >> 12, l = tok & 4095, r = l >> 6, qc = l & 63;
        const int rs = min(max(r - 4, 0), 56), cs = min(max(qc - 8, 0), 48);
        { const unsigned w = *((const unsigned*)(P + (size_t)tok * NMIX + h * HD) + lane); scr[2 * lane] = bflo(w); scr[2 * lane + 1] = bfhi(w); }
        asm volatile("s_waitcnt lgkmcnt(0)" ::: "memory");
        float s[6];
#pragma unroll
        for (int i = 0; i < 6; ++i) {
            const int kk = lane + 64 * i; size_t krow; float bias = 0.f;
            if (kk < 128) { const int a = kk >> 4, j = kk & 15; krow = (size_t)b * SEQ + 64 * (rs + a) + cs + j; bias = rpb[(h * 15 + (rs + a - r + 7)) * 31 + (cs + j - qc + 15)]; }
            else krow = (size_t)T + b * CTXL + (kk - 128);
            const u32x4* kp = (const u32x4*)(P + krow * NMIX + D / 2 + h * HD);
            float acc = 0.f;
#pragma unroll 4
            for (int d8 = 0; d8 < 16; ++d8) { const u32x4 kv = kp[d8]; const LAS f32x4* qv = (const LAS f32x4*)scr + 2 * d8; const f32x4 q0 = qv[0], q1 = qv[1];
                acc += bflo(kv.x) * q0.x + bfhi(kv.x) * q0.y + bflo(kv.y) * q0.z + bfhi(kv.y) * q0.w + bflo(kv.z) * q1.x + bfhi(kv.z) * q1.y + bflo(kv.w) * q1.z + bfhi(kv.w) * q1.w; }
            s[i] = acc * scale + bias;
        }
        float m = s[0];
#pragma unroll
        for (int i = 1; i < 6; ++i) m = fmaxf(m, s[i]);
        m = wave_max(m); float sum = 0.f;
#pragma unroll
        for (int i = 0; i < 6; ++i) { s[i] = expf(s[i] - m); sum += s[i]; scr[128 + lane + 64 * i] = s[i]; }
        sum = wave_sum(sum);
        asm volatile("s_waitcnt lgkmcnt(0)" ::: "memory");
        float o0 = 0.f, o1 = 0.f;
        for (int kk = 0; kk < 384; ++kk) {
            size_t vrow; if (kk < 128) vrow = (size_t)b * SEQ + 64 * (rs + (kk >> 4)) + cs + (kk & 15); else vrow = (size_t)T + b * CTXL + (kk - 128);
            const unsigned w = *((const unsigned*)(P + vrow * NMIX + D + h * HD) + lane); const float p = scr[128 + kk];
            o0 += p * bflo(w); o1 += p * bfhi(w);
        }
        const float inv = 1.f / sum;
        *((unsigned*)(MIX + (size_t)tok * D + h * HD) + lane) = pk2(o0 * inv, o1 * inv);
        asm volatile("s_waitcnt lgkmcnt(0)" ::: "memory");
    }
}

constexpr int ATT_RS = 288, ATT_TILE = 64 * ATT_RS, ATT_BUF = 2 * ATT_TILE;
typedef short s16x4 __attribute__((ext_vector_type(4)));
struct AttState { f32x4 sc[32]; unsigned pk[32][2]; f32x4 o[8]; u32x4 stg[4]; bf16x8 qf[4]; float inv; unsigned g_off, w_off, ka_off, va_off; };
struct AttCtx { const bf16* P; LAS unsigned char* lds; const LAS float* lrpb; int b, r, rs, hp, hs, c0, qc, csq, quad; };
template <int STEP> DI void att_load(AttState& S, const AttCtx& C) {
    constexpr int ti = STEP % 12; const int colb = (STEP < 12 ? 1024 : 2048) + C.hp * 256;
    const size_t tok0 = ti < 8 ? (size_t)C.b * SEQ + 64 * (C.rs + ti) : (size_t)T + C.b * CTXL + (ti - 8) * 64;
    const char* ub = (const char*)(C.P + tok0 * NMIX + colb);
#pragma unroll
    for (int k = 0; k < 4; ++k) S.stg[k] = *(const u32x4*)(ub + (size_t)(32 * (k & 1)) * NMIX * 2 + (k >> 1) * 256 + S.g_off);
}
template <int BUFI> DI void att_write(AttState& S, const AttCtx& C) {
#pragma unroll
    for (int k = 0; k < 4; ++k) *(LAS u32x4*)(C.lds + BUFI * ATT_BUF + (k >> 1) * ATT_TILE + 32 * (k & 1) * ATT_RS + S.w_off) = S.stg[k];
}
template <int STEP> DI void att_step(AttState& S, const AttCtx& C) {
    const float scale = 0.08838834764831845f;
    asm volatile("" : "+v"(S.g_off), "+v"(S.w_off), "+v"(S.ka_off), "+v"(S.va_off));
    if constexpr (STEP + 1 < 24) att_load<STEP + 1>(S, C);
    constexpr int bo = (STEP & 1) * ATT_BUF;
    if constexpr (STEP < 12) {
        constexpr int ti = STEP;
        if constexpr (ti < 8) {
            const int aidx = C.rs + ti - C.r + 7;
            const LAS float* brow = C.lrpb + C.hs * 465 + aidx * 31;
#pragma unroll
            for (int t = 0; t < 2; ++t) { const int krow0 = C.c0 + 16 * t; f32x4 acc = (f32x4){0.f, 0.f, 0.f, 0.f};
                const LAS unsigned char* ka = C.lds + bo + krow0 * ATT_RS + S.ka_off;
#pragma unroll
                for (int s4 = 0; s4 < 4; ++s4) acc = __builtin_amdgcn_mfma_f32_16x16x32_bf16(*(const LAS bf16x8*)(ka + s4 * 64), S.qf[s4], acc, 0, 0, 0);
#pragma unroll
                for (int i = 0; i < 4; ++i) { const int kcol = krow0 + C.quad * 4 + i; const bool ok = kcol >= C.csq && kcol < C.csq + 16; const int bi = min(max(kcol - C.qc + 15, 0), 30);
                    const float bias = brow[bi]; S.sc[ti * 2 + t][i] = ok ? acc[i] * scale + bias : -1e30f; } }
        } else {
#pragma unroll
            for (int t = 0; t < 4; ++t) { f32x4 acc = (f32x4){0.f, 0.f, 0.f, 0.f};
                const LAS unsigned char* ka = C.lds + bo + 16 * t * ATT_RS + S.ka_off;
#pragma unroll
                for (int s4 = 0; s4 < 4; ++s4) acc = __builtin_amdgcn_mfma_f32_16x16x32_bf16(*(const LAS bf16x8*)(ka + s4 * 64), S.qf[s4], acc, 0, 0, 0);
                S.sc[16 + (ti - 8) * 4 + t] = acc * scale; }
        }
    } else {
        if constexpr (STEP == 12) {
            float m = -1e30f;
#pragma unroll
            for (int sl = 0; sl < 32; ++sl) m = fmaxf(fmaxf(m, fmaxf(S.sc[sl][0], S.sc[sl][1])), fmaxf(S.sc[sl][2], S.sc[sl][3]));
            m = fmaxf(m, __shfl_xor(m, 16)); m = fmaxf(m, __shfl_xor(m, 32));
            float sum = 0.f;
#pragma unroll
            for (int sl = 0; sl < 32; ++sl) { const float e0 = __expf(S.sc[sl][0] - m), e1 = __expf(S.sc[sl][1] - m), e2 = __expf(S.sc[sl][2] - m), e3 = __expf(S.sc[sl][3] - m);
                sum += (e0 + e1) + (e2 + e3); S.pk[sl][0] = pk2(e0, e1); S.pk[sl][1] = pk2(e2, e3); }
            sum += __shfl_xor(sum, 16); sum += __shfl_xor(sum, 32); S.inv = 1.f / sum;
#pragma unroll
            for (int dt = 0; dt < 8; ++dt) S.o[dt] = (f32x4){0.f, 0.f, 0.f, 0.f};
        }
        constexpr int ti = STEP - 12; constexpr int nks = ti < 8 ? 1 : 2;
#pragma unroll
        for (int kk = 0; kk < nks; ++kk) {
            const int sa = ti < 8 ? ti * 2 : 16 + (ti - 8) * 4 + 2 * kk; const int rb = ti < 8 ? C.c0 : 32 * kk;
            const u32x4 pw = (u32x4){S.pk[sa][0], S.pk[sa][1], S.pk[sa + 1][0], S.pk[sa + 1][1]}; const bf16x8 pf = __builtin_bit_cast(bf16x8, pw);
            const LAS unsigned char* va = C.lds + bo + rb * ATT_RS + S.va_off;
#pragma unroll
            for (int dt = 0; dt < 8; ++dt) { const s16x4 v1 = __builtin_amdgcn_ds_read_tr16_b64_v4i16((LAS s16x4*)(va + dt * 32)); const s16x4 v2 = __builtin_amdgcn_ds_read_tr16_b64_v4i16((LAS s16x4*)(va + 16 * ATT_RS + dt * 32));
                const bf16x8 vf = __builtin_shufflevector(v1, v2, 0, 1, 2, 3, 4, 5, 6, 7); S.o[dt] = __builtin_amdgcn_mfma_f32_16x16x32_bf16(vf, pf, S.o[dt], 0, 0, 0); }
        }
    }
    if constexpr (STEP + 1 < 24) { if constexpr (STEP >= 12) asm volatile("s_waitcnt lgkmcnt(0)" ::: "memory");
        att_write<(STEP + 1) & 1>(S, C); }
    __syncthreads();
}
DI void attn_phase(const bf16* P, const float* rpb, bf16* MIX, LAS unsigned char* lds, LAS float* lrpb) {
    const int tid = threadIdx.x, wid = __builtin_amdgcn_readfirstlane(tid >> 6), lane = tid & 63, hs = wid >> 2, j = wid & 3, lq = lane & 15, quad = lane >> 4;
    const int srow = tid >> 4, sch = tid & 15;
    AttState S; AttCtx C;
    C.P = P; C.lds = lds; C.lrpb = lrpb; C.hs = hs; C.quad = quad;
    C.c0 = (j == 0) ? 0 : (j == 1) ? 8 : (j == 2) ? 24 : 32;
    C.qc = 16 * j + lq; C.csq = min(max(C.qc - 8, 0), 48);
    S.g_off = (unsigned)(srow * NMIX + sch * 8) * 2u;
    S.w_off = (unsigned)(srow * ATT_RS + sch * 16);
    S.ka_off = (unsigned)(hs * ATT_TILE + lq * ATT_RS + quad * 16);
    S.va_off = (unsigned)(hs * ATT_TILE + (4 * quad + (lq >> 2)) * ATT_RS + 8 * (lq & 3));
    for (int unit = blockIdx.x; unit < 1024; unit += gridDim.x) {
        const int r = unit & 63, hp = (unit >> 6) & 3, b = unit >> 8, h = 2 * hp + hs;
        C.r = r; C.hp = hp; C.b = b; C.rs = min(max(r - 4, 0), 56);
        __syncthreads();
        for (int i = tid; i < 930; i += 512) lrpb[i] = rpb[(size_t)hp * 930 + i];
        const size_t tq = (size_t)b * SEQ + 64 * r + C.qc;
#pragma unroll
        for (int s4 = 0; s4 < 4; ++s4) S.qf[s4] = *(const bf16x8*)(P + tq * NMIX + h * HD + s4 * 32 + quad * 8);
        att_load<0>(S, C); att_write<0>(S, C); __syncthreads();
        att_step<0>(S, C); att_step<1>(S, C); att_step<2>(S, C); att_step<3>(S, C); att_step<4>(S, C); att_step<5>(S, C); att_step<6>(S, C); att_step<7>(S, C);
        att_step<8>(S, C); att_step<9>(S, C); att_step<10>(S, C); att_step<11>(S, C); att_step<12>(S, C); att_step<13>(S, C); att_step<14>(S, C); att_step<15>(S, C);
        att_step<16>(S, C); att_step<17>(S, C); att_step<18>(S, C); att_step<19>(S, C); att_step<20>(S, C); att_step<21>(S, C); att_step<22>(S, C); att_step<23>(S, C);
        bf16* op = MIX + tq * D + h * HD + quad * 4;
#pragma unroll
        for (int dt = 0; dt < 8; ++dt) st_bf16x4(op + dt * 16, S.o[dt] * S.inv);
    }
}


constexpr int FF_RS = 544;
DI bf16x8 fft_frag(int kind  , int k, int s, int kq) {
    unsigned w[4];
#pragma unroll
    for (int p = 0; p < 4; ++p) { float v[2];
#pragma unroll
        for (int q = 0; q < 2; ++q) { const int j = 2 * p + q; const int jj = 32 * s + (j < 4 ? 4 * kq + j : 16 + 4 * kq + (j - 4)); const float ang = (float)((k * jj) & 63) * (1.f / 32.f);
            v[q] = (kind == 0 ? cospif(ang) : kind == 1 ? -sinpif(ang) : sinpif(ang)) * 0.125f; }
        w[p] = pk2(v[0], v[1]); }
    return __builtin_bit_cast(bf16x8, (u32x4){w[0], w[1], w[2], w[3]});
}
DI bf16x8 fft_tr(const LAS unsigned char* p) { const s16x4 v1 = __builtin_amdgcn_ds_read_tr16_b64_v4i16((LAS s16x4*)p), v2 = __builtin_amdgcn_ds_read_tr16_b64_v4i16((LAS s16x4*)(p + 16 * FF_RS));
    return __builtin_shufflevector(v1, v2, 0, 1, 2, 3, 4, 5, 6, 7); }
DI void fft1_phase(const bf16* Up, bf16* YP, LAS unsigned char* lds) {
    const int tid = threadIdx.x, wave = __builtin_amdgcn_readfirstlane(tid >> 6), lane = tid & 63, ml = lane & 15, quad = lane >> 4;
    bf16x8 Ff[8][2];
#pragma unroll
    for (int mt = 0; mt < 8; ++mt)
#pragma unroll
        for (int s2 = 0; s2 < 2; ++s2) Ff[mt][s2] = fft_frag(mt < 4 ? 0 : 1, (16 * mt + ml) & 63, s2, quad);
    LAS float* tw = (LAS float*)(lds + 64 * FF_RS);
    const unsigned va_off = (unsigned)((4 * quad + (ml >> 2)) * FF_RS + 8 * (ml & 3) + 64 * wave);
    u32x4 pre[4];
#define FFT1_LOAD(u_) do { const int b_ = (u_) >> 9, j2_ = ((u_) >> 3) & 63, c0_ = ((u_) & 7) * 256; _Pragma("unroll") for (int q = 0; q < 4; ++q) { const int j1 = (tid >> 5) + 16 * q; \
        pre[q] = *(const u32x4*)(Up + ((size_t)b_ * SEQ + 64 * j1 + j2_) * D + c0_ + (tid & 31) * 8); } } while (0)
    if ((int)blockIdx.x < 2048) FFT1_LOAD((int)blockIdx.x);
    for (int unit = blockIdx.x; unit < 2048; unit += gridDim.x) {
        const int b = unit >> 9, j2 = (unit >> 3) & 63, c0 = (unit & 7) * 256;
        __syncthreads();
#pragma unroll
        for (int q = 0; q < 4; ++q) { const int j1 = (tid >> 5) + 16 * q; *(LAS u32x4*)(lds + j1 * FF_RS + (tid & 31) * 16) = pre[q]; }
        if (tid < 64) { const float ang = (float)(j2 * tid) * (1.f / 2048.f); tw[2 * tid] = cospif(ang); tw[2 * tid + 1] = sinpif(ang); }
        __syncthreads();
        if (unit + (int)gridDim.x < 2048) FFT1_LOAD(unit + (int)gridDim.x);
        float cth4[4], sth4[4];
#pragma unroll
        for (int mp = 0; mp < 4; ++mp) { cth4[mp] = tw[2 * (16 * mp + ml)]; sth4[mp] = tw[2 * (16 * mp + ml) + 1]; }
        asm volatile("s_waitcnt lgkmcnt(0)" : "+v"(cth4[0]), "+v"(cth4[1]), "+v"(cth4[2]), "+v"(cth4[3]), "+v"(sth4[0]), "+v"(sth4[1]), "+v"(sth4[2]), "+v"(sth4[3]) :: "memory");
        f32x4 acc[8][2];
#pragma unroll
        for (int mt = 0; mt < 8; ++mt) { acc[mt][0] = (f32x4){0.f, 0.f, 0.f, 0.f}; acc[mt][1] = acc[mt][0]; }
#pragma unroll
        for (int s2 = 0; s2 < 2; ++s2)
#pragma unroll
            for (int nt = 0; nt < 2; ++nt) { const bf16x8 zf = fft_tr(lds + va_off + 32 * s2 * FF_RS + 32 * nt);
#pragma unroll
                for (int mt = 0; mt < 8; ++mt) acc[mt][nt] = __builtin_amdgcn_mfma_f32_16x16x32_bf16(zf, Ff[mt][s2], acc[mt][nt], 0, 0, 0); }
#pragma unroll
        for (int mp = 0; mp < 4; ++mp) { const int k1 = 16 * mp + ml; const float cth = cth4[mp], sth = sth4[mp];
            bf16* dr = YP + ((((size_t)b * 64 + k1) * 2) * 64 + j2) * D + c0 + 32 * wave + 4 * quad;
#pragma unroll
            for (int nt = 0; nt < 2; ++nt) { const f32x4 yr = acc[mp][nt], yi = acc[mp + 4][nt];
                st_bf16x4(dr + 16 * nt, yr * cth + yi * sth); st_bf16x4(dr + (size_t)64 * D + 16 * nt, yi * cth - yr * sth); } }
    }
}
#undef FFT1_LOAD
DI void fft2_phase(const bf16* YP, bf16* PCAT, LAS unsigned char* lds) {
    const int tid = threadIdx.x, wave = __builtin_amdgcn_readfirstlane(tid >> 6), lane = tid & 63, ml = lane & 15, quad = lane >> 4;
    bf16x8 Cf[4][2], Sf[4][2], Nf[4][2];
#pragma unroll
    for (int mt = 0; mt < 4; ++mt)
#pragma unroll
        for (int s2 = 0; s2 < 2; ++s2) { Cf[mt][s2] = fft_frag(0, 16 * mt + ml, s2, quad); Nf[mt][s2] = fft_frag(1, 16 * mt + ml, s2, quad); Sf[mt][s2] = fft_frag(2, 16 * mt + ml, s2, quad); }
    const unsigned va_off = (unsigned)((4 * quad + (ml >> 2)) * FF_RS + 8 * (ml & 3) + 64 * wave);
    u32x4 pre[8];
#define FFT2_LOAD(u_) do { const int b_ = (u_) >> 9, k1_ = ((u_) >> 3) & 63, c0_ = ((u_) & 7) * 256; _Pragma("unroll") for (int q = 0; q < 8; ++q) { const int kr = (tid >> 5) + 16 * q; \
        pre[q] = *(const u32x4*)(YP + (((size_t)b_ * 64 + k1_) * 128 + kr) * D + c0_ + (tid & 31) * 8); } } while (0)
    if ((int)blockIdx.x < 2048) FFT2_LOAD((int)blockIdx.x);
    for (int unit = blockIdx.x; unit < 2048; unit += gridDim.x) {
        const int b = unit >> 9, k1 = (unit >> 3) & 63, cc = unit & 7;
        __syncthreads();
#pragma unroll
        for (int q = 0; q < 8; ++q) { const int kr = (tid >> 5) + 16 * q; *(LAS u32x4*)(lds + kr * FF_RS + (tid & 31) * 16) = pre[q]; }
        __syncthreads();
        if (unit + (int)gridDim.x < 2048) FFT2_LOAD(unit + (int)gridDim.x);
        f32x4 acc[8][2];
#pragma unroll
        for (int mt = 0; mt < 8; ++mt) { acc[mt][0] = (f32x4){0.f, 0.f, 0.f, 0.f}; acc[mt][1] = acc[mt][0]; }
#pragma unroll
        for (int s4 = 0; s4 < 4; ++s4)
#pragma unroll
            for (int nt = 0; nt < 2; ++nt) { const bf16x8 yf = fft_tr(lds + va_off + 32 * s4 * FF_RS + 32 * nt);
#pragma unroll
                for (int mt = 0; mt < 4; ++mt) {
                    if (s4 < 2) { acc[mt][nt] = __builtin_amdgcn_mfma_f32_16x16x32_bf16(yf, Cf[mt][s4], acc[mt][nt], 0, 0, 0); acc[mt + 4][nt] = __builtin_amdgcn_mfma_f32_16x16x32_bf16(yf, Nf[mt][s4], acc[mt + 4][nt], 0, 0, 0); }
                    else { acc[mt][nt] = __builtin_amdgcn_mfma_f32_16x16x32_bf16(yf, Sf[mt][s4 - 2], acc[mt][nt], 0, 0, 0); acc[mt + 4][nt] = __builtin_amdgcn_mfma_f32_16x16x32_bf16(yf, Cf[mt][s4 - 2], acc[mt + 4][nt], 0, 0, 0); } } }
        const int g = cc >> 1, cp0 = (cc & 1) * 256 + 32 * wave + 4 * quad;
#pragma unroll
        for (int mt = 0; mt < 8; ++mt) { const int part = mt >> 2, k2 = 16 * (mt & 3) + ml;
            bf16* dp = PCAT + ((size_t)b * SEQ + k1 + 64 * k2) * 4096 + g * 1024 + part * 512 + cp0;
            st_bf16x4(dp, acc[mt][0]); st_bf16x4(dp + 16, acc[mt][1]); }
    }
}

#undef FFT2_LOAD
DI void conv_phase(const bf16* P, const float* cw, bf16* MIX, int gtid, int GT) {
    for (int i = gtid; i < T * 128; i += GT) {
        const int tok = i >> 7, c8 = (i & 127) * 8, l = tok & 4095;
        const bf16* base = P + (size_t)tok * NMIX + 3072 + c8;
        const u32x4 gb = *(const u32x4*)base;
        float z[3][8];
#pragma unroll
        for (int j = 0; j < 3; ++j) { const int ll = l + j - 1; const bool ok = ll >= 0 && ll < SEQ;
            u32x4 gc = (u32x4){0u, 0u, 0u, 0u}, xi = gc;
            if (ok) { const bf16* pj = base + (ptrdiff_t)(j - 1) * NMIX; gc = *(const u32x4*)(pj + 1024); xi = *(const u32x4*)(pj + 2048); }
            z[j][0] = bflo(gc.x) * bflo(xi.x); z[j][1] = bfhi(gc.x) * bfhi(xi.x); z[j][2] = bflo(gc.y) * bflo(xi.y); z[j][3] = bfhi(gc.y) * bfhi(xi.y);
            z[j][4] = bflo(gc.z) * bflo(xi.z); z[j][5] = bfhi(gc.z) * bfhi(xi.z); z[j][6] = bflo(gc.w) * bflo(xi.w); z[j][7] = bfhi(gc.w) * bfhi(xi.w); }
        float gbf[8] = {bflo(gb.x), bfhi(gb.x), bflo(gb.y), bfhi(gb.y), bflo(gb.z), bfhi(gb.z), bflo(gb.w), bfhi(gb.w)};
        float o[8];
#pragma unroll
        for (int e = 0; e < 8; ++e) o[e] = gbf[e] * (cw[c8 + e] * z[0][e] + cw[1024 + c8 + e] * z[1][e] + cw[2048 + c8 + e] * z[2][e]);
        *(u32x4*)(MIX + (size_t)tok * D + 1024 + c8) = (u32x4){pk2(o[0], o[1]), pk2(o[2], o[3]), pk2(o[4], o[5]), pk2(o[6], o[7])};
    }
}
constexpr int RT_RS = 4112, RT_IMG = 16 * RT_RS;
DI void split_bf16(const float* w8, bf16x8& hi, bf16x8& lo) {
    unsigned h[4], l[4];
#pragma unroll
    for (int p = 0; p < 4; ++p) { const unsigned a = f2bf(w8[2 * p]), b = f2bf(w8[2 * p + 1]); h[p] = a | (b << 16);
        l[p] = pk2(w8[2 * p] - __uint_as_float(a << 16), w8[2 * p + 1] - __uint_as_float(b << 16)); }
    hi = __builtin_bit_cast(bf16x8, (u32x4){h[0], h[1], h[2], h[3]}); lo = __builtin_bit_cast(bf16x8, (u32x4){l[0], l[1], l[2], l[3]});
}
DI void ln_router_phase(const float* TBp, const float* lng, const float* lnb, const float* mods_l, const float* rw, const float* rbias,
                        float* X1p, bf16* Up, unsigned* counts, int* tablep, unsigned* tokinfop, LAS unsigned char* lds) {
    const int tid = threadIdx.x, wave = __builtin_amdgcn_readfirstlane(tid >> 6), lane = tid & 63, fr = lane & 15, fq = lane >> 4;
    bf16x8 bh[8][2], bl[8][2];
#pragma unroll
    for (int ks = 0; ks < 8; ++ks)
#pragma unroll
        for (int nt = 0; nt < 2; ++nt) { float w8[8];
#pragma unroll
            for (int j = 0; j < 8; ++j) w8[j] = rw[(size_t)(256 * wave + 32 * ks + 8 * fq + j) * NE + nt * 16 + fr];
            split_bf16(w8, bh[ks][nt], bl[ks][nt]); }
    LAS float* part = (LAS float*)lds; LAS float* lgs = (LAS float*)(lds + 16384);
    for (int rg = blockIdx.x; rg < T / 16; rg += gridDim.x) {
        __syncthreads();
#pragma unroll 1
        for (int rr = 0; rr < 2; ++rr) {
            const int lr = 2 * wave + rr, row = rg * 16 + lr;
            Row r; row_load(r, TBp + (size_t)row * D, lane); row_ln(r); row_affine(r, lng, lnb, lane);
            row_store(r, X1p + (size_t)row * D, lane);
            row_ln(r);
            const float* mr = mods_l + (size_t)(row >> 12) * MODW + 3 * D;
            row_modulate(r, mr, mr + D, lane);
            u32x2* uq = (u32x2*)(Up + (size_t)row * D) + lane;
#pragma unroll
            for (int j = 0; j < 8; ++j) { const unsigned a = f2bf(r.v[j].x), b = f2bf(r.v[j].y), c = f2bf(r.v[j].z), d = f2bf(r.v[j].w);
                u32x2 hi; hi.x = a | (b << 16); hi.y = c | (d << 16); uq[64 * j] = hi;
                u32x2 lo; lo.x = pk2(r.v[j].x - __uint_as_float(a << 16), r.v[j].y - __uint_as_float(b << 16)); lo.y = pk2(r.v[j].z - __uint_as_float(c << 16), r.v[j].w - __uint_as_float(d << 16));
                *(LAS u32x2*)(lds + lr * RT_RS + (4 * lane + 256 * j) * 2) = hi; *(LAS u32x2*)(lds + RT_IMG + lr * RT_RS + (4 * lane + 256 * j) * 2) = lo; }
        }
        __syncthreads();
        f32x4 acc[2]; acc[0] = (f32x4){0.f, 0.f, 0.f, 0.f}; acc[1] = acc[0];
        const LAS unsigned char* ap = lds + fr * RT_RS + (256 * wave + 8 * fq) * 2;
#pragma unroll
        for (int ks = 0; ks < 8; ++ks) { const bf16x8 ah = *(const LAS bf16x8*)(ap + ks * 64), al = *(const LAS bf16x8*)(ap + RT_IMG + ks * 64);
#pragma unroll
            for (int nt = 0; nt < 2; ++nt) { acc[nt] = __builtin_amdgcn_mfma_f32_16x16x32_bf16(ah, bh[ks][nt], acc[nt], 0, 0, 0); acc[nt] = __builtin_amdgcn_mfma_f32_16x16x32_bf16(ah, bl[ks][nt], acc[nt], 0, 0, 0);
                acc[nt] = __builtin_amdgcn_mfma_f32_16x16x32_bf16(al, bh[ks][nt], acc[nt], 0, 0, 0); } }
        __syncthreads();
#pragma unroll
        for (int nt = 0; nt < 2; ++nt)
#pragma unroll
            for (int i = 0; i < 4; ++i) part[(wave * 16 + fq * 4 + i) * 32 + nt * 16 + fr] = acc[nt][i];
        __syncthreads();
        { const int r16 = tid >> 5, e = tid & 31; float sacc = 0.f;
#pragma unroll
            for (int w = 0; w < 8; ++w) sacc += part[(w * 16 + r16) * 32 + e];
            const float af = 1.f / (1.f + expf(-sacc)); const float bi = af + rbias[e];
            lgs[r16 * 32 + e] = af; lgs[512 + r16 * 32 + e] = bi;
            const float b1 = dpp_f<0xB1>(bi), b2 = dpp_f<0x4E>(bi), b3 = dpp_f<0x1B>(bi);
            const float hi1 = fmaxf(bi, b1), lo1 = fminf(bi, b1), hi2 = fmaxf(b2, b3), lo2 = fminf(b2, b3);
            const float scg = fmaxf(hi1, hi2) + fmaxf(fminf(hi1, hi2), fmaxf(lo1, lo2));
            if ((e & 3) == 0) lgs[1024 + r16 * 8 + (e >> 2)] = scg; }
        __syncthreads();
        if (tid < 16) {
            const int row = rg * 16 + tid; const LAS float* gs = lgs + 1024 + tid * 8;
            float best = -1e30f; int grp = 0;
#pragma unroll
            for (int g = 0; g < 8; ++g) { const float scg = gs[g]; if (scg > best) { best = scg; grp = g; } }
            float ga[4], gv[4];
#pragma unroll
            for (int i = 0; i < 4; ++i) { ga[i] = lgs[tid * 32 + 4 * grp + i]; gv[i] = lgs[512 + tid * 32 + 4 * grp + i]; }
            int i1 = 0; float v1 = gv[0]; if (gv[1] > v1) { v1 = gv[1]; i1 = 1; } if (gv[2] > v1) { v1 = gv[2]; i1 = 2; } if (gv[3] > v1) { v1 = gv[3]; i1 = 3; }
            int i2 = -1; float v2 = -1e30f;
            if (i1 != 0 && gv[0] > v2) { v2 = gv[0]; i2 = 0; } if (i1 != 1 && gv[1] > v2) { v2 = gv[1]; i2 = 1; } if (i1 != 2 && gv[2] > v2) { v2 = gv[2]; i2 = 2; } if (i1 != 3 && gv[3] > v2) { v2 = gv[3]; i2 = 3; }
            const float a1 = i1 == 0 ? ga[0] : i1 == 1 ? ga[1] : i1 == 2 ? ga[2] : ga[3], a2 = i2 == 0 ? ga[0] : i2 == 1 ? ga[1] : i2 == 2 ? ga[2] : ga[3];
            const float w1 = a1 / (a1 + a2), w2 = a2 / (a1 + a2);
            const int e1 = grp * 4 + i1, e2 = grp * 4 + i2;
            const unsigned p1 = __hip_atomic_fetch_add(counts + e1, 1u, __ATOMIC_RELAXED, __HIP_MEMORY_SCOPE_AGENT);
            const unsigned p2 = __hip_atomic_fetch_add(counts + e2, 1u, __ATOMIC_RELAXED, __HIP_MEMORY_SCOPE_AGENT);
            tablep[(size_t)e1 * T + p1] = row; tablep[(size_t)e2 * T + p2] = row;
            u32x4 ta; ta.x = (unsigned)e1; ta.y = (unsigned)e2; ta.z = p1; ta.w = p2; u32x4 tb2; tb2.x = __float_as_uint(w1); tb2.y = __float_as_uint(w2); tb2.z = 0u; tb2.w = 0u;
            *(u32x4*)(tokinfop + (size_t)row * 8) = ta; *(u32x4*)(tokinfop + (size_t)row * 8 + 4) = tb2;
        }
    }
}
DI void moe_prefix(const unsigned* counts, LAS int* cnt, LAS int* tb, int tid) {
    __syncthreads();
    if (tid < 32) cnt[tid] = (int)__hip_atomic_load(counts + tid, __ATOMIC_RELAXED, __HIP_MEMORY_SCOPE_AGENT);
    __syncthreads();
    if (tid == 0) { int a = 0; for (int e = 0; e < 32; ++e) { tb[e] = a; a += (cnt[e] + 255) >> 8; } tb[32] = a; }
    __syncthreads();
}
DI void combine_phase(const float* X1, const bf16* Y, const unsigned* tokinfo, const LAS int* tb, const float* mods_l, const float* lng, const float* lnb,
                      float* XO, const float* mods_next, bf16* U, int gw, int NGW, int lane) {
    if (gw >= T) return;
    u32x4 ta = *(const u32x4*)(tokinfo + (size_t)gw * 8), tw = *(const u32x4*)(tokinfo + (size_t)gw * 8 + 4);
    for (int row = gw; row < T; row += NGW) {
        const int nr = row + NGW < T ? row + NGW : row;
        const u32x4 tan = *(const u32x4*)(tokinfo + (size_t)nr * 8), twn = *(const u32x4*)(tokinfo + (size_t)nr * 8 + 4);
        const int e0 = __builtin_amdgcn_readfirstlane((int)ta.x), e1 = __builtin_amdgcn_readfirstlane((int)ta.y);
        const size_t r0 = (size_t)(__builtin_amdgcn_readfirstlane(tb[e0]) * 256 + __builtin_amdgcn_readfirstlane((int)ta.z)), r1 = (size_t)(__builtin_amdgcn_readfirstlane(tb[e1]) * 256 + __builtin_amdgcn_readfirstlane((int)ta.w));
        const float w0 = __uint_as_float(tw.x), w1 = __uint_as_float(tw.y);
        Row r; row_load(r, X1 + (size_t)row * D, lane);
        const u32x2* y0 = (const u32x2*)(Y + r0 * D) + lane; const u32x2* y1 = (const u32x2*)(Y + r1 * D) + lane;
        const f32x4* g2 = (const f32x4*)(mods_l + (size_t)(row >> 12) * MODW + 5 * D) + lane;
#pragma unroll
        for (int j = 0; j < 8; ++j) { const u32x2 a = y0[64 * j], b = y1[64 * j]; f32x4 f;
            f.x = w0 * bflo(a.x) + w1 * bflo(b.x); f.y = w0 * bfhi(a.x) + w1 * bfhi(b.x); f.z = w0 * bflo(a.y) + w1 * bflo(b.y); f.w = w0 * bfhi(a.y) + w1 * bfhi(b.y);
            r.v[j] = r.v[j] * ALPHA + g2[64 * j] * f; }
        row_ln(r); row_affine(r, lng, lnb, lane);
        row_store(r, XO + (size_t)row * D, lane);
        if (U) { row_ln(r); const float* mr = mods_next + (size_t)(row >> 12) * MODW; row_modulate(r, mr, mr + D, lane); row_store_bf16(r, U + (size_t)row * D, lane); }
        ta = tan; tw = twn;
    }
}

struct Args { const float* in[18]; float* out; unsigned char* ws; int ph_lo, ph_hi; };
__global__ void __launch_bounds__(512, 2) fwd(Args args) {
    extern __shared__ __attribute__((aligned(16))) unsigned char lds_raw[];
    LAS unsigned char* lds = (LAS unsigned char*)lds_raw;
#define PH_IDS int tid = threadIdx.x; asm volatile("" : "+v"(tid)); const int lane = tid & 63, wave = __builtin_amdgcn_readfirstlane(tid >> 6); \
    const int gw = blockIdx.x * 8 + wave, NGW = gridDim.x * 8, gtid = blockIdx.x * 512 + tid, GT = gridDim.x * 512; (void)lane; (void)gw; (void)NGW; (void)gtid; (void)GT;
    volatile LAS unsigned* LCTL = (volatile LAS unsigned*)(lds + LDSCTL_OFF);
    LAS int* l_cnt = (LAS int*)(lds + LDSCTL_OFF) + 16; LAS int* l_tb = (LAS int*)(lds + LDSCTL_OFF) + 48;
    for (int u = threadIdx.x; u < (LDS_BYTES - LDSCTL_OFF) / 4; u += 512) ((LAS unsigned*)(lds + LDSCTL_OFF))[u] = 0u;
    __syncthreads();
    unsigned char* ws = args.ws;
    unsigned* ctl = (unsigned*)(ws + WS_CTL);
#define XIN ((const float*)args.in[0])
#define c_in args.in[1]
#define ctx args.in[2]
#define c_ctx args.in[3]
#define ada_w args.in[4]
#define ada_b args.in[5]
#define w_mix_in args.in[6]
#define rpb args.in[7]
#define conv_w args.in[8]
#define w_mix_out args.in[9]
#define w_fourier args.in[10]
#define router_w args.in[11]
#define router_b args.in[12]
#define w_gate args.in[13]
#define w_up args.in[14]
#define w_down args.in[15]
#define ln_g args.in[16]
#define ln_b args.in[17]
#define mods ((float*)(ws + WS_MODS))
#define tokinfo ((unsigned*)(ws + WS_TOKINFO))
#define table ((int*)(ws + WS_TABLE))
#define WIN ((bf16*)(ws + WS_WIN))
#define WO ((bf16*)(ws + WS_WO))
#define WF ((bf16*)(ws + WS_WF))
#define CSM ((bf16*)(ws + WS_CS))
#define U ((bf16*)(ws + WS_U))
#define P ((bf16*)(ws + WS_P))
#define YB ((bf16*)(ws + WS_P))
#define YPB ((bf16*)(ws + WS_P))
#define PCATB ((bf16*)(ws + WS_TB))
#define MIX ((bf16*)(ws + WS_MIX))
#define REZ ((bf16*)(ws + WS_MIX))
#define HB ((bf16*)(ws + WS_H))
#define WGU ((bf16*)(ws + WS_WGU))
#define WD ((bf16*)(ws + WS_WD))
#define TB ((float*)(ws + WS_TB))
#define X1 ((float*)(ws + WS_X1))
#define X2 ((float*)(ws + WS_X2))
    XcdBarrier bar; bar.bar = ctl + CW_BAR; bar.x = 0; bar.st = nullptr;
    if (N_LAUNCHES != NPHASE) bar = xcd_barrier_post(ctl + CW_BAR, LCTL);
    const int lo = args.ph_lo, hi = args.ph_hi;
#ifndef DUP_MASK
#define DUP_MASK 0x0000
#endif
#define RUN(k, ...) do { __VA_ARGS__ if constexpr ((((DUP_MASK) >> (k)) & 1) != 0) { __VA_ARGS__ } } while (0)
#ifndef PH_MASK
#define PH_MASK 0x1ffff
#endif
#define IN(k) ((((PH_MASK) >> (k)) & 1) && lo <= (k) && (k) < hi)
#define SEAM(k) do { if (IN(k) && IN((k) + 1)) xcd_barrier(bar); } while (0)

    RUN(0, if (IN(0)) { PH_IDS
        LAS float* sl = (LAS float*)lds; LAS float* red = sl + 5 * D; volatile LAS int* qslot = (volatile LAS int*)(lds + LDSCTL_OFF) + 8;
        for (int i = tid; i < 5 * D; i += 512) { const float v = i < 4 * D ? c_in[i] : c_ctx[i - 4 * D]; sl[i] = silu_f(v); }
        __syncthreads();
        for (;;) {
            if (tid == 0) *qslot = (int)__hip_atomic_fetch_add(ctl + 160, 1u, __ATOMIC_RELAXED, __HIP_MEMORY_SCOPE_AGENT);
            __syncthreads();
            const int item = __builtin_amdgcn_readfirstlane(*qslot);
            __syncthreads();
            if (item >= P0_NMODS + P0_NSI) break;
            if (item < P0_NMODS) p0_mods_unit(ada_w, ada_b, mods, sl, red, item, tid);
            else p0_weight_item(item - P0_NMODS, w_mix_in, w_mix_out, w_fourier, w_gate, w_up, w_down, WIN, WO, WF, WGU, WD, lds + wave * 16384, wave, lane);
        }
        p0_dft(CSM, gtid, GT);
    });
    SEAM(0);
    RUN(1, if (IN(1)) { PH_IDS ln_mod_phase(XIN, ctx, mods, 0, U, TALL, gw, NGW, lane); });
    SEAM(1);
    RUN(2, if (IN(2)) { SchedInProj S{U, WIN}; EpiStoreBf16 E{P, NMIX}; gemm_pg8<false>(lds, S, E, D, D, D); });
    SEAM(2);
    RUN(3, if (IN(3)) { PH_IDS attn_phase(P, rpb, MIX, lds, (LAS float*)(lds + LDSCTL_OFF + 1024)); conv_phase(P, conv_w, MIX, gtid, GT); });
    SEAM(3);
    RUN(4, if (IN(4)) { SchedDense S{MIX, WO, 64, 8, (size_t)256 * D, (size_t)256 * D}; EpiResid E{XIN, TB, mods + 2 * D}; gemm_pg8<false>(lds, S, E, D, D, D); });
    SEAM(4);
    RUN(5, if (IN(5)) { PH_IDS ln_router_phase(TB, ln_g, ln_b, mods, router_w, router_b, X1, U, ctl + CW_CNT, table, tokinfo, lds); });
    SEAM(5);
    RUN(6, if (IN(6)) { PH_IDS moe_prefix(ctl + CW_CNT, l_cnt, l_tb, tid); SchedMoe S{l_cnt, l_tb, U, WGU, table, 1, 0, (size_t)D * D, (size_t)256 * D}; EpiSwiglu E{HB}; gemm_pg8<true>(lds, S, E, D, D, D); });
    SEAM(6);
    RUN(7, if (IN(7)) { PH_IDS moe_prefix(ctl + CW_CNT, l_cnt, l_tb, tid); SchedMoe S{l_cnt, l_tb, HB, WD, table, 0, (size_t)256 * DE, (size_t)D * DE, (size_t)256 * DE}; EpiStoreBf16 E{YB, D}; gemm_pg8<false>(lds, S, E, DE, DE, DE); });
    SEAM(7);
    RUN(8, if (IN(8)) { PH_IDS moe_prefix(ctl + CW_CNT, l_cnt, l_tb, tid); combine_phase(X1, YB, tokinfo, l_tb, mods, ln_g + D, ln_b + D, X2, mods + 5 * MODW, U, gw, NGW, lane); });
    SEAM(8);
    RUN(9, if (IN(9)) { fft1_phase(U, YPB, lds); });
    SEAM(9);
    RUN(10, if (IN(10)) { fft2_phase(YPB, PCATB, lds); });
    SEAM(10);
    RUN(11, if (IN(11)) { SchedChan S{PCATB, CSM}; EpiStoreBf16 E{REZ, D}; gemm_pg8<false>(lds, S, E, 4096, 1024, 1024); });
    SEAM(11);
    RUN(12, if (IN(12)) { SchedDense S{REZ, WF, 64, 8, (size_t)256 * D, (size_t)256 * D}; EpiResid E{X2, TB, mods + 5 * MODW + 2 * D}; gemm_pg8<false>(lds, S, E, D, D, D); });
    SEAM(12);
    RUN(13, if (IN(13)) { PH_IDS ln_router_phase(TB, ln_g + 2 * D, ln_b + 2 * D, mods + 5 * MODW, router_w, router_b, X1, U, ctl + CW_CNT + 32, table + (size_t)NE * T, tokinfo + (size_t)T * 8, lds); });
    SEAM(13);
    RUN(14, if (IN(14)) { PH_IDS moe_prefix(ctl + CW_CNT + 32, l_cnt, l_tb, tid); SchedMoe S{l_cnt, l_tb, U, WGU + (size_t)NE * D * D, table + (size_t)NE * T, 1, 0, (size_t)D * D, (size_t)256 * D}; EpiSwiglu E{HB}; gemm_pg8<true>(lds, S, E, D, D, D); });
    SEAM(14);
    RUN(15, if (IN(15)) { PH_IDS moe_prefix(ctl + CW_CNT + 32, l_cnt, l_tb, tid); SchedMoe S{l_cnt, l_tb, HB, WD + (size_t)NE * D * DE, table, 0, (size_t)256 * DE, (size_t)D * DE, (size_t)256 * DE}; EpiStoreBf16 E{YB, D}; gemm_pg8<false>(lds, S, E, DE, DE, DE); });
    SEAM(15);
    RUN(16, if (IN(16)) { PH_IDS moe_prefix(ctl + CW_CNT + 32, l_cnt, l_tb, tid); combine_phase(X1, YB, tokinfo + (size_t)T * 8, l_tb, mods + 5 * MODW, ln_g + 3 * D, ln_b + 3 * D, args.out, nullptr, nullptr, gw, NGW, lane); });
#undef IN
#undef SEAM
}

extern "C" void kernel_launch(void* const* d_in, const int* in_sizes, int n_in, void* d_out, int out_size, void* d_ws, size_t ws_size, hipStream_t stream) {
    static int grid = 0;
    if (grid == 0) {
        if (n_in != 18 || out_size != T * D || ws_size < WS_END) { fprintf(stderr, "kernel_launch: unexpected shapes (n_in %d, out %d, ws %zu)\n", n_in, out_size, ws_size); grid = -1; return; }
        int dev = 0, cus = 0, per_cu = 0;
        if (hipGetDevice(&dev) != hipSuccess || hipDeviceGetAttribute(&cus, hipDeviceAttributeMultiprocessorCount, dev) != hipSuccess) { grid = -1; return; }
        if (hipFuncSetAttribute((const void*)fwd, hipFuncAttributeMaxDynamicSharedMemorySize, LDS_BYTES) != hipSuccess) { fprintf(stderr, "kernel_launch: hipFuncSetAttribute failed\n"); grid = -1; return; }
        if (hipOccupancyMaxActiveBlocksPerMultiprocessor(&per_cu, (const void*)fwd, 512, LDS_BYTES) != hipSuccess || per_cu < 1) fprintf(stderr, "kernel_launch: occupancy query says %d\n", per_cu);
        (void)hipGetLastError();
        grid = cus;
    }
    if (grid < 0) return;
    (void)hipMemsetAsync((char*)d_ws + WS_CTL, 0, CTL_ZERO_BYTES, stream);
    Args a{};
    for (int i = 0; i < 18; ++i) a.in[i] = (const float*)d_in[i];
    a.out = (float*)d_out; a.ws = (unsigned char*)d_ws;
    if (N_LAUNCHES == 1) { a.ph_lo = 0; a.ph_hi = NPHASE; hipLaunchKernelGGL(fwd, dim3(grid), dim3(512), LDS_BYTES, stream, a); }
    else for (int p = 0; p < NPHASE; ++p) { a.ph_lo = p; a.ph_hi = p + 1; hipLaunchKernelGGL(fwd, dim3(grid), dim3(512), LDS_BYTES, stream, a); }
}
```

```cpp
#include <hip/hip_runtime.h>
#include <cstdio>
#include <cstdint>

#define DI __device__ __forceinline__
#define LAS __attribute__((address_space(3)))
typedef unsigned short bf16;
typedef float f32x4 __attribute__((ext_vector_type(4)));
typedef short bf16x8 __attribute__((ext_vector_type(8)));
typedef unsigned u32x4 __attribute__((ext_vector_type(4)));
typedef unsigned u32x2 __attribute__((ext_vector_type(2)));

constexpr int D = 2048, NB = 4, SEQ = 4096, T = NB * SEQ, CTXL = 256, TC = NB * CTXL, TALL = T + TC;
constexpr int NMIX = 6144, NE = 32, DE = 1024, NH = 8, HD = 128, MODW = 6 * D;
constexpr float ALPHA = 1.41421356237309515f;
constexpr float LN_EPS = 1e-6f;
constexpr int NPHASE = 17;
#ifndef MK_N_LAUNCHES
#define MK_N_LAUNCHES 1
#endif
constexpr int N_LAUNCHES = MK_N_LAUNCHES;

constexpr size_t MiB = 1u << 20;
constexpr size_t WS_CTL = 0, CTL_ZERO_BYTES = 64 * 1024;
constexpr size_t WS_MODS = 1 * MiB;
constexpr size_t WS_TOKINFO = 2 * MiB;
constexpr size_t WS_TABLE = 4 * MiB;
constexpr size_t WS_WIN = 8 * MiB, WS_WO = 32 * MiB, WS_WF = 40 * MiB, WS_CS = 48 * MiB, WS_ACS = 64 * MiB;
constexpr size_t WS_U = 128 * MiB;
constexpr size_t WS_P = 196 * MiB;
constexpr size_t WS_MIX = 400 * MiB;
constexpr size_t WS_TB = 464 * MiB, WS_X1 = 592 * MiB, WS_X2 = 720 * MiB;
constexpr size_t WS_H = 848 * MiB;
constexpr size_t WS_WGU = 928 * MiB;
constexpr size_t WS_WD = 1440 * MiB;
constexpr size_t WS_END = 1696 * MiB;
constexpr int CW_CNT = 64;
constexpr int CW_BAR = 1024;

constexpr int LDS_SCR = 133120;
constexpr int LDSCTL_OFF = LDS_SCR;
constexpr int LDS_BYTES = 147456;

template <int CTRL> DI float dpp_f(float v) { return __builtin_bit_cast(float, __builtin_amdgcn_mov_dpp(__builtin_bit_cast(int, v), CTRL, 0xF, 0xF, true)); }
DI float wave_sum(float v) {
    v += dpp_f<0xB1>(v); v += dpp_f<0x4E>(v); v += dpp_f<0x141>(v); v += dpp_f<0x140>(v);
    const int iv = __builtin_bit_cast(int, v);
    const float r0 = __builtin_bit_cast(float, __builtin_amdgcn_readlane(iv, 0)), r1 = __builtin_bit_cast(float, __builtin_amdgcn_readlane(iv, 16)),
                r2 = __builtin_bit_cast(float, __builtin_amdgcn_readlane(iv, 32)), r3 = __builtin_bit_cast(float, __builtin_amdgcn_readlane(iv, 48));
    return (r0 + r1) + (r2 + r3);
}
DI float wave_max(float v) {
    v = fmaxf(v, dpp_f<0xB1>(v)); v = fmaxf(v, dpp_f<0x4E>(v)); v = fmaxf(v, dpp_f<0x141>(v)); v = fmaxf(v, dpp_f<0x140>(v));
    const int iv = __builtin_bit_cast(int, v);
    const float r0 = __builtin_bit_cast(float, __builtin_amdgcn_readlane(iv, 0)), r1 = __builtin_bit_cast(float, __builtin_amdgcn_readlane(iv, 16)),
                r2 = __builtin_bit_cast(float, __builtin_amdgcn_readlane(iv, 32)), r3 = __builtin_bit_cast(float, __builtin_amdgcn_readlane(iv, 48));
    return fmaxf(fmaxf(r0, r1), fmaxf(r2, r3));
}
DI unsigned f2bf(float f) { unsigned u = __float_as_uint(f); return (u + 0x7fffu + ((u >> 16) & 1u)) >> 16; }
typedef float f32x2_t __attribute__((ext_vector_type(2)));
typedef __bf16 bf16x2_t __attribute__((ext_vector_type(2)));
DI unsigned pk2(float lo, float hi) { const f32x2_t v = {lo, hi}; return __builtin_bit_cast(unsigned, __builtin_convertvector(v, bf16x2_t)); }
DI float bflo(unsigned w) { return __uint_as_float(w << 16); }
DI float bfhi(unsigned w) { return __uint_as_float(w & 0xffff0000u); }
DI float silu_f(float v) { return v / (1.f + expf(-v)); }
DI float silu_fast(float v) { return v * __builtin_amdgcn_rcpf(1.f + __builtin_amdgcn_exp2f(v * -1.4426950408889634f)); }

#define XB_TMO      128
#define XB_XCNT(j)  (256  + 64 * (j))
#define XB_XSUB(j)  (1280 + 64 * (j))
#define XB_XGEN(j)  (2304 + 64 * (j))
#define XB_TOP      3328
#define XB_TOPGEN   3392
#define XCD_BAR_WORDS 3456
#define XB_SPIN_CAP (1u << 18)
__device__ __forceinline__ unsigned xb_ld(unsigned* p)              { return __hip_atomic_load(p, __ATOMIC_RELAXED, __HIP_MEMORY_SCOPE_AGENT); }
__device__ __forceinline__ unsigned xb_add(unsigned* p, unsigned v) { return __hip_atomic_fetch_add(p, v, __ATOMIC_RELAXED, __HIP_MEMORY_SCOPE_AGENT); }
__device__ __forceinline__ unsigned xb_xcc_id() { return (unsigned)__builtin_amdgcn_s_getreg((3 << 11) | 20) & 0xFu; }
#define XB_SPIN(cond, bar) do { unsigned _sp = 0; while (cond) { __builtin_amdgcn_s_sleep(1); \
    if ((++_sp & 255u) == 0u) { if (xb_ld(&(bar)[XB_TMO])) break; if (_sp > XB_SPIN_CAP) { atomicAdd(&(bar)[XB_TMO], 1u); break; } } } } while (0)
struct XcdBarrier { unsigned* bar; unsigned x; volatile LAS unsigned* st; };
__device__ __forceinline__ XcdBarrier xcd_barrier_post(unsigned* bar, volatile LAS unsigned* st) {
    XcdBarrier b; b.bar = bar; b.x = xb_xcc_id(); b.st = st;
    if (threadIdx.x == 0) (void)xb_add(&bar[XB_XCNT(b.x)], 1u);
    return b;
}
__device__ __forceinline__ void xcd_barrier_complete(unsigned* bar, unsigned x, unsigned& nloc, unsigned& nx) {
    const unsigned G = gridDim.x * gridDim.y * gridDim.z;
    unsigned sum, cnt, mine, sp = 0u;
    for (;;) {
        sum = 0u; cnt = 0u; mine = 0u;
#pragma unroll
        for (unsigned j = 0; j < 16; ++j) { const unsigned c = xb_ld(&bar[XB_XCNT(j)]); sum += c; cnt += (c > 0u) ? 1u : 0u; mine = (j == x) ? c : mine; }
        if (sum == G) break;
        __builtin_amdgcn_s_sleep(1);
        if ((++sp & 255u) == 0u) { if (xb_ld(&bar[XB_TMO])) break; if (sp > XB_SPIN_CAP) { atomicAdd(&bar[XB_TMO], 1u); break; } }
    }
    nloc = mine > 0u ? mine : 1u; nx = cnt > 0u ? cnt : 1u;
}
__device__ __forceinline__ void xcd_barrier(const XcdBarrier& b) {
    asm volatile("s_waitcnt vmcnt(0)" ::: "memory");
    __syncthreads();
    if (threadIdx.x == 0) {
        unsigned* bar = b.bar;
        __builtin_amdgcn_s_waitcnt(0);
        unsigned nloc = b.st[0], nx = b.st[1];
        if (nloc == 0u) { xcd_barrier_complete(bar, b.x, nloc, nx); b.st[0] = nloc; b.st[1] = nx; }
        const unsigned old = xb_add(&bar[XB_XSUB(b.x)], 1u);
        const unsigned gen = old / nloc;
        if (old + 1u == (gen + 1u) * nloc) {
            __builtin_amdgcn_fence(__ATOMIC_RELEASE, "agent");
            asm volatile("s_waitcnt vmcnt(0)" ::: "memory");
            const unsigned og = xb_add(&bar[XB_TOP], 1u);
            const unsigned tg = og / nx;
            if (og + 1u == (tg + 1u) * nx) xb_add(&bar[XB_TOPGEN], 1u);
            else XB_SPIN(xb_ld(&bar[XB_TOPGEN]) == tg, bar);
            __builtin_amdgcn_fence(__ATOMIC_ACQUIRE, "agent");
            xb_add(&bar[XB_XGEN(b.x)], 1u);
            asm volatile("s_waitcnt vmcnt(0)" ::: "memory");
        } else {
            XB_SPIN(xb_ld(&bar[XB_XGEN(b.x)]) == gen, bar);
            __builtin_amdgcn_fence(__ATOMIC_ACQUIRE, "agent");
            asm volatile("s_waitcnt vmcnt(0)" ::: "memory");
        }
    }
    __syncthreads();
}

struct Row { f32x4 v[8]; };
DI void row_load(Row& r, const float* p, int lane) { const f32x4* q = (const f32x4*)p + lane;
#pragma unroll
    for (int j = 0; j < 8; ++j) r.v[j] = q[64 * j]; }
DI void row_store(const Row& r, float* p, int lane) { f32x4* q = (f32x4*)p + lane;
#pragma unroll
    for (int j = 0; j < 8; ++j) q[64 * j] = r.v[j]; }
DI void row_store_bf16(const Row& r, bf16* p, int lane) { u32x2* q = (u32x2*)p + lane;
#pragma unroll
    for (int j = 0; j < 8; ++j) { u32x2 w; w.x = pk2(r.v[j].x, r.v[j].y); w.y = pk2(r.v[j].z, r.v[j].w); q[64 * j] = w; } }
DI void row_ln(Row& r) {
    float s = 0.f;
#pragma unroll
    for (int j = 0; j < 8; ++j) s += (r.v[j].x + r.v[j].y) + (r.v[j].z + r.v[j].w);
    const float mean = wave_sum(s) * (1.f / D); float s2 = 0.f;
#pragma unroll
    for (int j = 0; j < 8; ++j) { r.v[j] = r.v[j] - mean; s2 += (r.v[j].x * r.v[j].x + r.v[j].y * r.v[j].y) + (r.v[j].z * r.v[j].z + r.v[j].w * r.v[j].w); }
    const float rstd = 1.f / sqrtf(wave_sum(s2) * (1.f / D) + LN_EPS);
#pragma unroll
    for (int j = 0; j < 8; ++j) r.v[j] = r.v[j] * rstd;
}
DI void row_affine(Row& r, const float* g, const float* b, int lane) {
    const f32x4* gq = (const f32x4*)g + lane; const f32x4* bq = (const f32x4*)b + lane;
#pragma unroll
    for (int j = 0; j < 8; ++j) r.v[j] = r.v[j] * gq[64 * j] + bq[64 * j];
}
DI void row_modulate(Row& r, const float* sh, const float* sc, int lane) {
    const f32x4* hq = (const f32x4*)sh + lane; const f32x4* cq = (const f32x4*)sc + lane;
#pragma unroll
    for (int j = 0; j < 8; ++j) r.v[j] = r.v[j] * (cq[64 * j] + 1.f) + hq[64 * j];
}

struct Unit { const bf16* A; const bf16* B; const int* gat; int nvalid; int m0, n0, aux; };

template <class Sched, class Epi>
DI void gemm_simple(const Sched& S, const Epi& E, const int lda, const int ldb, const int K) {
    const int tid = threadIdx.x, wid = tid >> 6, lane = tid & 63, fr = lane & 15, fq = lane >> 4;
    for (int L = blockIdx.x; ; L += gridDim.x) {
        Unit u; if (!S.get(L, u)) break;
        const bf16* arow[2];
#pragma unroll
        for (int m = 0; m < 2; ++m) { const int r = 32 * wid + 16 * m + fr; size_t grow = (size_t)r; if (u.gat) grow = (size_t)(r < u.nvalid ? u.gat[r] : 0); arow[m] = u.A + grow * lda + fq * 8; }
        for (int cc = 0; cc < 4; ++cc) {
            f32x4 acc[2][4];
#pragma unroll
            for (int m = 0; m < 2; ++m)
#pragma unroll
                for (int j = 0; j < 4; ++j) acc[m][j] = (f32x4){0.f, 0.f, 0.f, 0.f};
            const bf16* brow[4];
#pragma unroll
            for (int j = 0; j < 4; ++j) { const int col = (j >> 1) * 128 + cc * 32 + (j & 1) * 16 + fr; brow[j] = u.B + (size_t)col * ldb + fq * 8; }
            for (int k = 0; k < K; k += 32) {
                bf16x8 a[2], b[4];
#pragma unroll
                for (int m = 0; m < 2; ++m) a[m] = *(const bf16x8*)(arow[m] + k);
#pragma unroll
                for (int j = 0; j < 4; ++j) b[j] = *(const bf16x8*)(brow[j] + k);
#pragma unroll
                for (int m = 0; m < 2; ++m)
#pragma unroll
                    for (int j = 0; j < 4; ++j) acc[m][j] = __builtin_amdgcn_mfma_f32_16x16x32_bf16(b[j], a[m], acc[m][j], 0, 0, 0);
            }
#pragma unroll
            for (int m = 0; m < 2; ++m)
#pragma unroll
                for (int nn = 0; nn < 2; ++nn) E(u, 32 * wid + 16 * m + fr, cc * 32 + nn * 16 + 4 * fq, acc[m][nn], acc[m][nn + 2]);
        }
    }
}


namespace pg8 {
constexpr int BK = 64, HALF = 128, HTB = HALF * BK * 2, STAGE_BYTES = 8 * HTB;
DI int lds_byte(int r, int c) { const int st = (r >> 4) * 2 + (c >> 5), rr = r & 15, cc = c & 31, ob = rr * 64 + cc * 2; return st * 1024 + (ob ^ (((ob >> 9) & 1) << 5)); }
DI void stage_rc(int b, int& R, int& C) { const int st = b / 1024, sb = b % 1024, swz = sb ^ (((sb >> 9) & 1) << 5); R = (st >> 1) * 16 + swz / 64; C = (st & 1) * 32 + (swz % 64) / 2; }
}
template <bool GATHER, class Sched, class Epi>
DI void gemm_pg8(LAS unsigned char* lds, const Sched& S, const Epi& E, const int lda, const int ldb, const int K) {
    using namespace pg8;
    const int tid = threadIdx.x, wid = __builtin_amdgcn_readfirstlane(tid >> 6), lane = tid & 63, wr = wid >> 2, wc = wid & 3, fr = lane & 15, fq = lane >> 4;
    const int nt = K / BK, G = gridDim.x, cblk = blockIdx.x;
    unsigned voffB[2], vA[2][2];
#pragma unroll
    for (int i = 0; i < 2; ++i) { int R_, C_; stage_rc(tid * 16 + i * 8192, R_, C_); voffB[i] = (unsigned)(R_ * ldb + C_) * 2u; }
    const size_t kstep = (size_t)(BK * 2), hstepA = (size_t)HALF * lda * 2, hstepB = (size_t)HALF * ldb * 2;
    const unsigned ldsw = (unsigned)wid * 1024u;
    const int aoff = lds_byte(wr * 64 + fr, fq * 8), boff = lds_byte(wc * 32 + fr, fq * 8);
#define PG8_SA(b, h) (((b) * 2 + (h)) * HTB)
#define PG8_SB(b, h) ((4 + (b) * 2 + (h)) * HTB)
#define PG8_STAGE(bufoff, gbase, voff) do { _Pragma("unroll") for (int _i = 0; _i < 2; ++_i) \
        __builtin_amdgcn_global_load_lds((const unsigned*)((const char*)(gbase) + (voff)[_i]), (LAS unsigned*)(lds + (bufoff) + ldsw + _i * 8192), 16, 0, 0); } while (0)
#define PG8_STAGE_A(bufoff, gbase, h) do { if constexpr (GATHER) PG8_STAGE(bufoff, gbase, vA[h]); else PG8_STAGE(bufoff, (gbase) + (h) * hstepA, vA[0]); } while (0)
#define PG8_LDA(dst, b, h) do { _Pragma("unroll") for (int m = 0; m < 4; ++m) _Pragma("unroll") for (int k = 0; k < 2; ++k) dst[m][k] = *(const LAS bf16x8*)(lds + PG8_SA(b, h) + aoff + m * 2048 + k * 1024); } while (0)
#define PG8_LDB(dst, b, h) do { _Pragma("unroll") for (int n = 0; n < 2; ++n) _Pragma("unroll") for (int k = 0; k < 2; ++k) dst[n][k] = *(const LAS bf16x8*)(lds + PG8_SB(b, h) + boff + n * 2048 + k * 1024); } while (0)
#define PG8_MMA(ai, bj, At, Bt) do { __builtin_amdgcn_s_setprio(1); _Pragma("unroll") for (int m = 0; m < 4; ++m) _Pragma("unroll") for (int n = 0; n < 2; ++n) _Pragma("unroll") for (int k = 0; k < 2; ++k) \
        acc[ai][bj][m][n] = __builtin_amdgcn_mfma_f32_16x16x32_bf16(Bt[n][k], At[m][k], acc[ai][bj][m][n], 0, 0, 0); __builtin_amdgcn_s_setprio(0); } while (0)
#define PG8_WAIT_V(n) asm volatile("s_waitcnt vmcnt(" #n ")" ::: "memory")
#define PG8_WAIT_L(n) asm volatile("s_waitcnt lgkmcnt(" #n ")" ::: "memory")
#define PG8_BAR __builtin_amdgcn_s_barrier()
#define PG8_SCHED __builtin_amdgcn_sched_barrier(0)
#define PG8_SETV(dst, u) do { _Pragma("unroll") for (int _h = 0; _h < 2; ++_h) _Pragma("unroll") for (int _i = 0; _i < 2; ++_i) { int _R, _C; stage_rc(tid * 16 + _i * 8192, _R, _C); const int _r = _h * HALF + _R; \
        if constexpr (GATHER) { const int _g = _r < (u).nvalid ? (u).gat[_r] : 0; dst[_h][_i] = (unsigned)(_g * lda + _C) * 2u; } else dst[_h][_i] = (unsigned)(_R * lda + _C) * 2u; } } while (0)
    Unit cur, nxt; int ui = 0;
    if (!S.get(cblk, cur)) return;
    f32x4 acc[2][2][4][2];
#pragma unroll
    for (int a = 0; a < 2; ++a)
#pragma unroll
        for (int b = 0; b < 2; ++b)
#pragma unroll
            for (int m = 0; m < 4; ++m)
#pragma unroll
                for (int n = 0; n < 2; ++n) acc[a][b][m][n] = (f32x4){0.f, 0.f, 0.f, 0.f};
    bf16x8 At[4][2], B0[2][2], B1[2][2];
    const char* cA = (const char*)cur.A; const char* cB = (const char*)cur.B;
    PG8_SETV(vA, cur);
    PG8_STAGE(PG8_SB(0, 0), cB, voffB); PG8_STAGE(PG8_SB(0, 1), cB + hstepB, voffB); PG8_STAGE_A(PG8_SA(0, 0), cA, 0); PG8_STAGE_A(PG8_SA(0, 1), cA, 1);
    if (wr == 1) PG8_BAR;
    PG8_WAIT_V(2); PG8_BAR;
    PG8_STAGE(PG8_SB(1, 0), cB + kstep, voffB); PG8_STAGE_A(PG8_SA(1, 0), cA + kstep, 0); PG8_STAGE(PG8_SB(1, 1), cB + hstepB + kstep, voffB);
    PG8_WAIT_V(6); PG8_BAR;
    for (;;) {
        const bool has_next = S.get((ui + 1) * G + cblk, nxt);
        const char* nA = has_next ? (const char*)nxt.A : cA; const char* nB = has_next ? (const char*)nxt.B : cB;
        for (int t = 0; t < nt; t += 2) {
            const bool last = (t == nt - 2);
            const char* a1 = cA + (size_t)(t + 1) * kstep;
            const char* a2 = last ? nA : cA + (size_t)(t + 2) * kstep; const char* b2 = last ? nB : cB + (size_t)(t + 2) * kstep;
            const char* a3 = a2 + kstep; const char* b3 = b2 + kstep;
            PG8_LDB(B0, 0, 0); PG8_LDB(B1, 0, 1); PG8_SCHED; PG8_LDA(At, 0, 0); PG8_STAGE_A(PG8_SA(1, 1), a1, 1);
            PG8_WAIT_V(8); PG8_WAIT_L(0); PG8_BAR; PG8_MMA(0, 0, At, B0); PG8_MMA(0, 1, At, B1); PG8_BAR; PG8_SCHED;
            if constexpr (GATHER) { if (last && has_next) PG8_SETV(vA, nxt); }
            PG8_LDA(At, 0, 1); PG8_STAGE(PG8_SB(0, 0), b2, voffB); PG8_STAGE(PG8_SB(0, 1), b2 + hstepB, voffB); PG8_STAGE_A(PG8_SA(0, 0), a2, 0);
            PG8_WAIT_V(8); PG8_WAIT_L(0); PG8_BAR; PG8_MMA(1, 0, At, B0); PG8_MMA(1, 1, At, B1); PG8_BAR; PG8_SCHED;
            PG8_LDB(B0, 1, 0); PG8_LDB(B1, 1, 1); PG8_SCHED; PG8_LDA(At, 1, 0); PG8_STAGE_A(PG8_SA(0, 1), a2, 1);
            PG8_WAIT_V(8); PG8_WAIT_L(0); PG8_BAR; PG8_MMA(0, 0, At, B0); PG8_MMA(0, 1, At, B1); PG8_BAR; PG8_SCHED;
            PG8_LDA(At, 1, 1); PG8_STAGE(PG8_SB(1, 0), b3, voffB); PG8_STAGE(PG8_SB(1, 1), b3 + hstepB, voffB); PG8_STAGE_A(PG8_SA(1, 0), a3, 0);
            PG8_WAIT_V(8); PG8_WAIT_L(0); PG8_BAR; PG8_MMA(1, 0, At, B0); PG8_MMA(1, 1, At, B1); PG8_BAR; PG8_SCHED;
        }
        if (wr == 0) PG8_BAR;
#pragma unroll
        for (int ai = 0; ai < 2; ++ai)
#pragma unroll
            for (int m = 0; m < 4; ++m)
#pragma unroll
                for (int n = 0; n < 2; ++n) E(cur, ai * HALF + wr * 64 + m * 16 + fr, wc * 32 + n * 16 + 4 * fq, acc[ai][0][m][n], acc[ai][1][m][n]);
        if (!has_next) break;
#pragma unroll
        for (int a = 0; a < 2; ++a)
#pragma unroll
            for (int b = 0; b < 2; ++b)
#pragma unroll
                for (int m = 0; m < 4; ++m)
#pragma unroll
                    for (int n = 0; n < 2; ++n) acc[a][b][m][n] = (f32x4){0.f, 0.f, 0.f, 0.f};
        cur = nxt; cA = nA; cB = nB; ++ui;
        if (wr == 1) PG8_BAR;
    }
    PG8_WAIT_V(0);
    PG8_BAR;
#undef PG8_SA
#undef PG8_SB
#undef PG8_STAGE
#undef PG8_STAGE_A
#undef PG8_LDA
#undef PG8_LDB
#undef PG8_MMA
#undef PG8_WAIT_V
#undef PG8_WAIT_L
#undef PG8_BAR
#undef PG8_SCHED
#undef PG8_SETV
}

DI int xcd_remap(int L, int n) { const int q = n >> 3, r = n & 7, xcd = L & 7, off = L >> 3; return (xcd < r ? xcd * (q + 1) : r * (q + 1) + (xcd - r) * q) + off; }
DI void grouped(int wgid, int nM, int nN, int& pm, int& pn) { const int nig = 8 * nN, gid = wgid / nig, fm = gid * 8, gsz = min(nM - fm, 8); pm = fm + (wgid % nig) % gsz; pn = (wgid % nig) / gsz; }

struct SchedInProj { const bf16* U; const bf16* W;
    DI bool get(int L, Unit& u) const { int pm, pn;
        if (L >= 64 * 24 + 32) return false; const int w = xcd_remap(L, 64 * 24 + 32);
        if (w < 64 * 24) grouped(w, 64, 24, pm, pn); else { const int l2 = w - 64 * 24; pm = 64 + (l2 >> 3); pn = 4 + (l2 & 7); }
        u.A = U + (size_t)pm * 256 * D; u.B = W + (size_t)pn * 256 * D; u.gat = nullptr; u.nvalid = 256; u.m0 = pm * 256; u.n0 = pn * 256; u.aux = 0; return true; } };
struct SchedDense { const bf16* A; const bf16* B; int nM, nN; size_t a_t, b_t;
    DI bool get(int L, Unit& u) const { if (L >= nM * nN) return false; int pm, pn; grouped(xcd_remap(L, nM * nN), nM, nN, pm, pn);
        u.A = A + (size_t)pm * a_t; u.B = B + (size_t)pn * b_t; u.gat = nullptr; u.nvalid = 256; u.m0 = pm * 256; u.n0 = pn * 256; u.aux = 0; return true; } };
struct SchedMoe { const LAS int* cnt; const LAS int* tb; const bf16* A; const bf16* W; const int* table; int gather; size_t a_t, w_e, w_t;
    DI bool get(int L, Unit& u) const { const int nT = __builtin_amdgcn_readfirstlane(tb[32]); if (L >= nT * 8) return false; int t, pn; grouped(xcd_remap(L, nT * 8), nT, 8, t, pn);
        int e = 0;
        for (int i = 1; i < 32; ++i) e = (tb[i] <= t) ? i : e;
        e = __builtin_amdgcn_readfirstlane(e); t = __builtin_amdgcn_readfirstlane(t); pn = __builtin_amdgcn_readfirstlane(pn);
        const int mt = __builtin_amdgcn_readfirstlane(t - tb[e]);
        if (gather) { u.A = A; u.gat = table + (size_t)e * T + mt * 256; } else { u.A = A + (size_t)t * a_t; u.gat = nullptr; }
        u.nvalid = __builtin_amdgcn_readfirstlane(min(256, cnt[e] - mt * 256));
        u.B = W + (size_t)e * w_e + (size_t)pn * w_t; u.m0 = t * 256; u.n0 = pn * 256; u.aux = e; return true; } };
struct SchedChan { const bf16* PCAT; const bf16* CSB;
    DI bool get(int L, Unit& u) const { if (L >= 512) return false; int pm, q; grouped(xcd_remap(L, 512), 64, 8, pm, q); const int g = q >> 1, pn = q & 1;
        u.A = PCAT + (size_t)pm * 256 * 4096 + g * 1024; u.B = CSB + (size_t)pn * 256 * 1024; u.gat = nullptr; u.nvalid = 256; u.m0 = pm * 256; u.n0 = g * 512 + pn * 256; u.aux = g; return true; } };

DI void st_bf16x4(bf16* p, f32x4 v) { u32x2 w; w.x = pk2(v.x, v.y); w.y = pk2(v.z, v.w); *(u32x2*)p = w; }
struct EpiStoreBf16 { bf16* O; int ldc;
    DI void operator()(const Unit& u, int r, int c, f32x4 lo, f32x4 hi) const { bf16* p = O + (size_t)(u.m0 + r) * ldc + u.n0 + c; st_bf16x4(p, lo); st_bf16x4(p + 128, hi); } };
struct EpiResid { const float* x; float* t; const float* gate;
    DI void operator()(const Unit& u, int r, int c, f32x4 lo, f32x4 hi) const { const int row = u.m0 + r, b = row >> 12; const int col = u.n0 + c;
        const size_t o = (size_t)row * D + col; const float* g = gate + (size_t)b * MODW + col;
        *(f32x4*)(t + o) = *(const f32x4*)(x + o) * ALPHA + *(const f32x4*)g * lo;
        *(f32x4*)(t + o + 128) = *(const f32x4*)(x + o + 128) * ALPHA + *(const f32x4*)(g + 128) * hi; } };
struct EpiSwiglu { bf16* H;
    DI void operator()(const Unit& u, int r, int c, f32x4 lo, f32x4 hi) const { f32x4 h;
        h.x = silu_fast(lo.x) * hi.x; h.y = silu_fast(lo.y) * hi.y; h.z = silu_fast(lo.z) * hi.z; h.w = silu_fast(lo.w) * hi.w;
        st_bf16x4(H + (size_t)(u.m0 + r) * DE + (u.n0 >> 1) + c, h); } };
DI void p0_mods_unit(const float* ada_w, const float* ada_b, float* mods, const LAS float* sl, LAS float* red, int unit, int tid) {
    const int cg = tid & 31, ks = tid >> 5, l = unit / 96, n0 = (unit % 96) * 128;
    const float* W = ada_w + (size_t)l * D * MODW + n0 + 4 * cg;
    f32x4 a0 = (f32x4){0.f, 0.f, 0.f, 0.f}, a1 = a0, a2 = a0, a3 = a0, a4 = a0;
#pragma unroll 8
    for (int k = ks * 128; k < ks * 128 + 128; ++k) { const f32x4 w = *(const f32x4*)(W + (size_t)k * MODW); a0 += w * sl[k]; a1 += w * sl[D + k]; a2 += w * sl[2 * D + k]; a3 += w * sl[3 * D + k]; a4 += w * sl[4 * D + k]; }
    *(LAS f32x4*)(red + (ks * 5 + 0) * 128 + 4 * cg) = a0; *(LAS f32x4*)(red + (ks * 5 + 1) * 128 + 4 * cg) = a1; *(LAS f32x4*)(red + (ks * 5 + 2) * 128 + 4 * cg) = a2;
    *(LAS f32x4*)(red + (ks * 5 + 3) * 128 + 4 * cg) = a3; *(LAS f32x4*)(red + (ks * 5 + 4) * 128 + 4 * cg) = a4;
    __syncthreads();
    for (int i = tid; i < 640; i += 512) { const int r = i >> 7, q = i & 127; float sacc = 0.f;
#pragma unroll
        for (int k2 = 0; k2 < 16; ++k2) sacc += red[(k2 * 5 + r) * 128 + q];
        mods[((size_t)l * 5 + r) * MODW + n0 + q] = sacc + ada_b[(size_t)l * MODW + n0 + q]; }
    __syncthreads();
}
DI void tr_item(const float* W, int N, int Kd, int k0, int n0, bf16* WT, int drow0, LAS unsigned char* scr, int lane) {
    const int ng = lane & 15, kl = lane >> 4;
    f32x4 v[2][8];
    const float* src = W + (size_t)(k0 + 16 * kl) * N + n0 + 4 * ng;
#pragma unroll
    for (int pp = 0; pp < 2; ++pp)
#pragma unroll
        for (int i = 0; i < 8; ++i) v[pp][i] = *(const f32x4*)(src + (size_t)(8 * pp + i) * N);
#pragma unroll
    for (int pp = 0; pp < 2; ++pp)
#pragma unroll
        for (int c = 0; c < 4; ++c) { u32x4 o; o.x = pk2(v[pp][0][c], v[pp][1][c]); o.y = pk2(v[pp][2][c], v[pp][3][c]); o.z = pk2(v[pp][4][c], v[pp][5][c]); o.w = pk2(v[pp][6][c], v[pp][7][c]);
            *(LAS u32x4*)(scr + (4 * ng + c) * 144 + (16 * kl + 8 * pp) * 2) = o; }
    asm volatile("s_waitcnt lgkmcnt(0)" ::: "memory");
#pragma unroll
    for (int j = 0; j < 8; ++j) { const int row = (lane >> 3) + 8 * j, ch = lane & 7;
        const u32x4 o = *(const LAS u32x4*)(scr + row * 144 + ch * 16);
        *(u32x4*)(WT + (size_t)(drow0 + row) * Kd + k0 + 8 * ch) = o; }
    asm volatile("s_waitcnt lgkmcnt(0)" ::: "memory");
}
constexpr int P0_S_IN = 8 * 48, P0_S_SQ = 8 * 16, P0_S_E = 64 * 64, P0_NSI = P0_S_IN + 2 * P0_S_SQ + 3 * P0_S_E, P0_NMODS = 192;
DI void p0_weight_item(int si, const float* w_in, const float* w_out, const float* w_f, const float* w_gate, const float* w_up, const float* w_down,
                       bf16* WIN, bf16* WO, bf16* WF, bf16* WGU, bf16* WD, LAS unsigned char* scr, int wave, int lane) {
    const int dk = wave >> 1, dn = wave & 1; int r = si;
    if (r < P0_S_IN) { const int kb = (r / 48) * 4 + dk, nb = (r % 48) * 2 + dn; tr_item(w_in, NMIX, D, kb * 64, nb * 64, WIN, nb * 64, scr, lane); return; } r -= P0_S_IN;
    if (r < P0_S_SQ) { const int kb = (r >> 4) * 4 + dk, nb = (r & 15) * 2 + dn; tr_item(w_out, D, D, kb * 64, nb * 64, WO, nb * 64, scr, lane); return; } r -= P0_S_SQ;
    if (r < P0_S_SQ) { const int kb = (r >> 4) * 4 + dk, nb = (r & 15) * 2 + dn; tr_item(w_f, D, D, kb * 64, nb * 64, WF, nb * 64, scr, lane); return; } r -= P0_S_SQ;
    if (r < 2 * P0_S_E) { const int up = r >= P0_S_E; if (up) r -= P0_S_E; const int mat = r >> 6, rr = r & 63, kb = (rr >> 3) * 4 + dk, nb = (rr & 7) * 2 + dn, n0 = nb * 64;
        tr_item((up ? w_up : w_gate) + (size_t)mat * D * DE, DE, D, kb * 64, n0, WGU + (size_t)mat * D * D, (n0 >> 7) * 256 + (n0 & 127) + (up ? 128 : 0), scr, lane); return; } r -= 2 * P0_S_E;
    { const int mat = r >> 6, rr = r & 63, kb = (rr >> 4) * 4 + dk, nb = (rr & 15) * 2 + dn; tr_item(w_down + (size_t)mat * DE * D, D, DE, kb * 64, nb * 64, WD + (size_t)mat * D * DE, nb * 64, scr, lane); }
}
DI void p0_dft(bf16* CSB, int gtid, int GT) {
    for (int i = gtid; i < 512 * 128; i += GT) { const int cp = i >> 7, k8 = (i & 127) * 8; unsigned w[4];
#pragma unroll
        for (int e = 0; e < 4; ++e) { float v[2];
#pragma unroll
            for (int q = 0; q < 2; ++q) { const int kk = k8 + 2 * e + q; const int m = (cp * (kk & 511)) & 511; const float ang = (float)m * (1.f / 256.f); v[q] = (kk < 512 ? cospif(ang) : sinpif(ang)) * 0.04419417382415922f; }
            w[e] = pk2(v[0], v[1]); }
        *(u32x4*)(CSB + (size_t)cp * 1024 + k8) = (u32x4){w[0], w[1], w[2], w[3]}; }
}
DI void ln_mod_phase(const float* x, const float* ctx, const float* mods_l, int sh_chunk, bf16* U, int nrows, int gw, int NGW, int lane) {
    int row = gw; if (row >= nrows) return;
    Row cur; row_load(cur, row < T ? x + (size_t)row * D : ctx + (size_t)(row - T) * D, lane);
    for (; row < nrows; row += NGW) {
        const int nr = row + NGW < nrows ? row + NGW : row;
        Row nxt; row_load(nxt, nr < T ? x + (size_t)nr * D : ctx + (size_t)(nr - T) * D, lane);
        const int rb = row < T ? (row >> 12) : 4;
        row_ln(cur);
        const float* mr = mods_l + (size_t)rb * MODW + sh_chunk * D;
        row_modulate(cur, mr, mr + D, lane);
        row_store_bf16(cur, U + (size_t)row * D, lane);
        cur = nxt;
    }
}
DI void attn_simple(const bf16* P, const float* rpb, bf16* MIX, LAS float* scr, int gw, int NGW, int lane) {
    const float scale = 0.08838834764831845f;
    for (int item = gw; item < T * NH; item += NGW) {
        const int tok = item >> 3, h = item & 7, b = tok >> 12, l = tok & 4095, r = l >> 6, qc = l & 63;
        const int rs = min(max(r - 4, 0), 56), cs = min(max(qc - 8, 0), 48);
        { const unsigned w = *((const unsigned*)(P + (size_t)tok * NMIX + h * HD) + lane); scr[2 * lane] = bflo(w); scr[2 * lane + 1] = bfhi(w); }
        asm volatile("s_waitcnt lgkmcnt(0)" ::: "memory");
        float s[6];
#pragma unroll
        for (int i = 0; i < 6; ++i) {
            const int kk = lane + 64 * i; size_t krow; float bias = 0.f;
            if (kk < 128) { const int a = kk >> 4, j = kk & 15; krow = (size_t)b * SEQ + 64 * (rs + a) + cs + j; bias = rpb[(h * 15 + (rs + a - r + 7)) * 31 + (cs + j - qc + 15)]; }
            else krow = (size_t)T + b * CTXL + (kk - 128);
            const u32x4* kp = (const u32x4*)(P + krow * NMIX + D / 2 + h * HD);
            float acc = 0.f;
#pragma unroll 4
            for (int d8 = 0; d8 < 16; ++d8) { const u32x4 kv = kp[d8]; const LAS f32x4* qv = (const LAS f32x4*)scr + 2 * d8; const f32x4 q0 = qv[0], q1 = qv[1];
                acc += bflo(kv.x) * q0.x + bfhi(kv.x) * q0.y + bflo(kv.y) * q0.z + bfhi(kv.y) * q0.w + bflo(kv.z) * q1.x + bfhi(kv.z) * q1.y + bflo(kv.w) * q1.z + bfhi(kv.w) * q1.w; }
            s[i] = acc * scale + bias;
        }
        float m = s[0];
#pragma unroll
        for (int i = 1; i < 6; ++i) m = fmaxf(m, s[i]);
        m = wave_max(m); float sum = 0.f;
#pragma unroll
        for (int i = 0; i < 6; ++i) { s[i] = expf(s[i] - m); sum += s[i]; scr[128 + lane + 64 * i] = s[i]; }
        sum = wave_sum(sum);
        asm volatile("s_waitcnt lgkmcnt(0)" ::: "memory");
        float o0 = 0.f, o1 = 0.f;
        for (int kk = 0; kk < 384; ++kk) {
            size_t vrow; if (kk < 128) vrow = (size_t)b * SEQ + 64 * (rs + (kk >> 4)) + cs + (kk & 15); else vrow = (size_t)T + b * CTXL + (kk - 128);
            const unsigned w = *((const unsigned*)(P + vrow * NMIX + D + h * HD) + lane); const float p = scr[128 + kk];
            o0 += p * bflo(w); o1 += p * bfhi(w);
        }
        const float inv = 1.f / sum;
        *((unsigned*)(MIX + (size_t)tok * D + h * HD) + lane) = pk2(o0 * inv, o1 * inv);
        asm volatile("s_waitcnt lgkmcnt(0)" ::: "memory");
    }
}

constexpr int ATT_RS = 288, ATT_TILE = 64 * ATT_RS, ATT_BUF = 2 * ATT_TILE;
typedef short s16x4 __attribute__((ext_vector_type(4)));
struct AttState { f32x4 sc[32]; unsigned pk[32][2]; f32x4 o[8]; u32x4 stg[4]; bf16x8 qf[4]; float inv; unsigned g_off, w_off, ka_off, va_off; };
struct AttCtx { const bf16* P; LAS unsigned char* lds; const LAS float* lrpb; int b, r, rs, hp, hs, c0, qc, csq, quad; };
template <int STEP> DI void att_load(AttState& S, const AttCtx& C) {
    constexpr int ti = STEP % 12; const int colb = (STEP < 12 ? 1024 : 2048) + C.hp * 256;
    const size_t tok0 = ti < 8 ? (size_t)C.b * SEQ + 64 * (C.rs + ti) : (size_t)T + C.b * CTXL + (ti - 8) * 64;
    const char* ub = (const char*)(C.P + tok0 * NMIX + colb);
#pragma unroll
    for (int k = 0; k < 4; ++k) S.stg[k] = *(const u32x4*)(ub + (size_t)(32 * (k & 1)) * NMIX * 2 + (k >> 1) * 256 + S.g_off);
}
template <int BUFI> DI void att_write(AttState& S, const AttCtx& C) {
#pragma unroll
    for (int k = 0; k < 4; ++k) *(LAS u32x4*)(C.lds + BUFI * ATT_BUF + (k >> 1) * ATT_TILE + 32 * (k & 1) * ATT_RS + S.w_off) = S.stg[k];
}
template <int STEP> DI void att_step(AttState& S, const AttCtx& C) {
    const float scale = 0.08838834764831845f;
    asm volatile("" : "+v"(S.g_off), "+v"(S.w_off), "+v"(S.ka_off), "+v"(S.va_off));
    if constexpr (STEP + 1 < 24) att_load<STEP + 1>(S, C);
    constexpr int bo = (STEP & 1) * ATT_BUF;
    if constexpr (STEP < 12) {
        constexpr int ti = STEP;
        if constexpr (ti < 8) {
            const int aidx = C.rs + ti - C.r + 7;
            const LAS float* brow = C.lrpb + C.hs * 465 + aidx * 31;
#pragma unroll
            for (int t = 0; t < 2; ++t) { const int krow0 = C.c0 + 16 * t; f32x4 acc = (f32x4){0.f, 0.f, 0.f, 0.f};
                const LAS unsigned char* ka = C.lds + bo + krow0 * ATT_RS + S.ka_off;
#pragma unroll
                for (int s4 = 0; s4 < 4; ++s4) acc = __builtin_amdgcn_mfma_f32_16x16x32_bf16(*(const LAS bf16x8*)(ka + s4 * 64), S.qf[s4], acc, 0, 0, 0);
#pragma unroll
                for (int i = 0; i < 4; ++i) { const int kcol = krow0 + C.quad * 4 + i; const bool ok = kcol >= C.csq && kcol < C.csq + 16; const int bi = min(max(kcol - C.qc + 15, 0), 30);
                    const float bias = brow[bi]; S.sc[ti * 2 + t][i] = ok ? acc[i] * scale + bias : -1e30f; } }
        } else {
#pragma unroll
            for (int t = 0; t < 4; ++t) { f32x4 acc = (f32x4){0.f, 0.f, 0.f, 0.f};
                const LAS unsigned char* ka = C.lds + bo + 16 * t * ATT_RS + S.ka_off;
#pragma unroll
                for (int s4 = 0; s4 < 4; ++s4) acc = __builtin_amdgcn_mfma_f32_16x16x32_bf16(*(const LAS bf16x8*)(ka + s4 * 64), S.qf[s4], acc, 0, 0, 0);
                S.sc[16 + (ti - 8) * 4 + t] = acc * scale; }
        }
    } else {
        if constexpr (STEP == 12) {
            float m = -1e30f;
#pragma unroll
            for (int sl = 0; sl < 32; ++sl) m = fmaxf(fmaxf(m, fmaxf(S.sc[sl][0], S.sc[sl][1])), fmaxf(S.sc[sl][2], S.sc[sl][3]));
            m = fmaxf(m, __shfl_xor(m, 16)); m = fmaxf(m, __shfl_xor(m, 32));
            float sum = 0.f;
#pragma unroll
            for (int sl = 0; sl < 32; ++sl) { const float e0 = __expf(S.sc[sl][0] - m), e1 = __expf(S.sc[sl][1] - m), e2 = __expf(S.sc[sl][2] - m), e3 = __expf(S.sc[sl][3] - m);
                sum += (e0 + e1) + (e2 + e3); S.pk[sl][0] = pk2(e0, e1); S.pk[sl][1] = pk2(e2, e3); }
            sum += __shfl_xor(sum, 16); sum += __shfl_xor(sum, 32); S.inv = 1.f / sum;
#pragma unroll
            for (int dt = 0; dt < 8; ++dt) S.o[dt] = (f32x4){0.f, 0.f, 0.f, 0.f};
        }
        constexpr int ti = STEP - 12; constexpr int nks = ti < 8 ? 1 : 2;
#pragma unroll
        for (int kk = 0; kk < nks; ++kk) {
            const int sa = ti < 8 ? ti * 2 : 16 + (ti - 8) * 4 + 2 * kk; const int rb = ti < 8 ? C.c0 : 32 * kk;
            const u32x4 pw = (u32x4){S.pk[sa][0], S.pk[sa][1], S.pk[sa + 1][0], S.pk[sa + 1][1]}; const bf16x8 pf = __builtin_bit_cast(bf16x8, pw);
            const LAS unsigned char* va = C.lds + bo + rb * ATT_RS + S.va_off;
#pragma unroll
            for (int dt = 0; dt < 8; ++dt) { const s16x4 v1 = __builtin_amdgcn_ds_read_tr16_b64_v4i16((LAS s16x4*)(va + dt * 32)); const s16x4 v2 = __builtin_amdgcn_ds_read_tr16_b64_v4i16((LAS s16x4*)(va + 16 * ATT_RS + dt * 32));
                const bf16x8 vf = __builtin_shufflevector(v1, v2, 0, 1, 2, 3, 4, 5, 6, 7); S.o[dt] = __builtin_amdgcn_mfma_f32_16x16x32_bf16(vf, pf, S.o[dt], 0, 0, 0); }
        }
    }
    if constexpr (STEP + 1 < 24) { if constexpr (STEP >= 12) asm volatile("s_waitcnt lgkmcnt(0)" ::: "memory");
        att_write<(STEP + 1) & 1>(S, C); }
    __syncthreads();
}
DI void attn_phase(const bf16* P, const float* rpb, bf16* MIX, LAS unsigned char* lds, LAS float* lrpb) {
    const int tid = threadIdx.x, wid = __builtin_amdgcn_readfirstlane(tid >> 6), lane = tid & 63, hs = wid >> 2, j = wid & 3, lq = lane & 15, quad = lane >> 4;
    const int srow = tid >> 4, sch = tid & 15;
    AttState S; AttCtx C;
    C.P = P; C.lds = lds; C.lrpb = lrpb; C.hs = hs; C.quad = quad;
    C.c0 = (j == 0) ? 0 : (j == 1) ? 8 : (j == 2) ? 24 : 32;
    C.qc = 16 * j + lq; C.csq = min(max(C.qc - 8, 0), 48);
    S.g_off = (unsigned)(srow * NMIX + sch * 8) * 2u;
    S.w_off = (unsigned)(srow * ATT_RS + sch * 16);
    S.ka_off = (unsigned)(hs * ATT_TILE + lq * ATT_RS + quad * 16);
    S.va_off = (unsigned)(hs * ATT_TILE + (4 * quad + (lq >> 2)) * ATT_RS + 8 * (lq & 3));
    for (int unit = blockIdx.x; unit < 1024; unit += gridDim.x) {
        const int r = unit & 63, hp = (unit >> 6) & 3, b = unit >> 8, h = 2 * hp + hs;
        C.r = r; C.hp = hp; C.b = b; C.rs = min(max(r - 4, 0), 56);
        __syncthreads();
        for (int i = tid; i < 930; i += 512) lrpb[i] = rpb[(size_t)hp * 930 + i];
        const size_t tq = (size_t)b * SEQ + 64 * r + C.qc;
#pragma unroll
        for (int s4 = 0; s4 < 4; ++s4) S.qf[s4] = *(const bf16x8*)(P + tq * NMIX + h * HD + s4 * 32 + quad * 8);
        att_load<0>(S, C); att_write<0>(S, C); __syncthreads();
        att_step<0>(S, C); att_step<1>(S, C); att_step<2>(S, C); att_step<3>(S, C); att_step<4>(S, C); att_step<5>(S, C); att_step<6>(S, C); att_step<7>(S, C);
        att_step<8>(S, C); att_step<9>(S, C); att_step<10>(S, C); att_step<11>(S, C); att_step<12>(S, C); att_step<13>(S, C); att_step<14>(S, C); att_step<15>(S, C);
        att_step<16>(S, C); att_step<17>(S, C); att_step<18>(S, C); att_step<19>(S, C); att_step<20>(S, C); att_step<21>(S, C); att_step<22>(S, C); att_step<23>(S, C);
        bf16* op = MIX + tq * D + h * HD + quad * 4;
#pragma unroll
        for (int dt = 0; dt < 8; ++dt) st_bf16x4(op + dt * 16, S.o[dt] * S.inv);
    }
}


constexpr int FF_RS = 544;
DI bf16x8 fft_frag(int kind  , int k, int s, int kq) {
    unsigned w[4];
#pragma unroll
    for (int p = 0; p < 4; ++p) { float v[2];
#pragma unroll
        for (int q = 0; q < 2; ++q) { const int j = 2 * p + q; const int jj = 32 * s + (j < 4 ? 4 * kq + j : 16 + 4 * kq + (j - 4)); const float rev = (float)((k * jj) & 63) * (1.f / 64.f);
            v[q] = (kind == 0 ? __builtin_amdgcn_cosf(rev) : kind == 1 ? -__builtin_amdgcn_sinf(rev) : __builtin_amdgcn_sinf(rev)) * 0.125f; }
        w[p] = pk2(v[0], v[1]); }
    return __builtin_bit_cast(bf16x8, (u32x4){w[0], w[1], w[2], w[3]});
}
DI bf16x8 fft_tr(const LAS unsigned char* p) { const s16x4 v1 = __builtin_amdgcn_ds_read_tr16_b64_v4i16((LAS s16x4*)p), v2 = __builtin_amdgcn_ds_read_tr16_b64_v4i16((LAS s16x4*)(p + 16 * FF_RS));
    return __builtin_shufflevector(v1, v2, 0, 1, 2, 3, 4, 5, 6, 7); }
DI void fft1_phase(const bf16* Up, bf16* YP, LAS unsigned char* lds) {
    const int tid = threadIdx.x, wave = __builtin_amdgcn_readfirstlane(tid >> 6), lane = tid & 63, ml = lane & 15, quad = lane >> 4;
    bf16x8 Ff[8][2];
#pragma unroll
    for (int mt = 0; mt < 8; ++mt)
#pragma unroll
        for (int s2 = 0; s2 < 2; ++s2) Ff[mt][s2] = fft_frag(mt < 4 ? 0 : 1, (16 * mt + ml) & 63, s2, quad);
    LAS float* tw = (LAS float*)(lds + 64 * FF_RS);
    const unsigned va_off = (unsigned)((4 * quad + (ml >> 2)) * FF_RS + 8 * (ml & 3) + 64 * wave);
    for (int unit = blockIdx.x; unit < 2048; unit += gridDim.x) {
        const int b = unit >> 9, j2 = (unit >> 3) & 63, c0 = (unit & 7) * 256;
        __syncthreads();
#pragma unroll
        for (int q = 0; q < 4; ++q) { const int j1 = (tid >> 5) + 16 * q;
            *(LAS u32x4*)(lds + j1 * FF_RS + (tid & 31) * 16) = *(const u32x4*)(Up + ((size_t)b * SEQ + 64 * j1 + j2) * D + c0 + (tid & 31) * 8); }
        if (tid < 64) { const float rev = (float)(j2 * tid) * (1.f / 4096.f); tw[2 * tid] = __builtin_amdgcn_cosf(rev); tw[2 * tid + 1] = __builtin_amdgcn_sinf(rev); }
        __syncthreads();
        float cth4[4], sth4[4];
#pragma unroll
        for (int mp = 0; mp < 4; ++mp) { cth4[mp] = tw[2 * (16 * mp + ml)]; sth4[mp] = tw[2 * (16 * mp + ml) + 1]; }
        asm volatile("s_waitcnt lgkmcnt(0)" : "+v"(cth4[0]), "+v"(cth4[1]), "+v"(cth4[2]), "+v"(cth4[3]), "+v"(sth4[0]), "+v"(sth4[1]), "+v"(sth4[2]), "+v"(sth4[3]) :: "memory");
        f32x4 acc[8][2];
#pragma unroll
        for (int mt = 0; mt < 8; ++mt) { acc[mt][0] = (f32x4){0.f, 0.f, 0.f, 0.f}; acc[mt][1] = acc[mt][0]; }
#pragma unroll
        for (int s2 = 0; s2 < 2; ++s2)
#pragma unroll
            for (int nt = 0; nt < 2; ++nt) { const bf16x8 zf = fft_tr(lds + va_off + 32 * s2 * FF_RS + 32 * nt);
#pragma unroll
                for (int mt = 0; mt < 8; ++mt) acc[mt][nt] = __builtin_amdgcn_mfma_f32_16x16x32_bf16(zf, Ff[mt][s2], acc[mt][nt], 0, 0, 0); }
#pragma unroll
        for (int mp = 0; mp < 4; ++mp) { const int k1 = 16 * mp + ml; const float cth = cth4[mp], sth = sth4[mp];
            bf16* dr = YP + ((((size_t)b * 64 + k1) * 2) * 64 + j2) * D + c0 + 32 * wave + 4 * quad;
#pragma unroll
            for (int nt = 0; nt < 2; ++nt) { const f32x4 yr = acc[mp][nt], yi = acc[mp + 4][nt];
                st_bf16x4(dr + 16 * nt, yr * cth + yi * sth); st_bf16x4(dr + (size_t)64 * D + 16 * nt, yi * cth - yr * sth); } }
    }
}
DI void fft2_phase(const bf16* YP, bf16* PCAT, LAS unsigned char* lds) {
    const int tid = threadIdx.x, wave = __builtin_amdgcn_readfirstlane(tid >> 6), lane = tid & 63, ml = lane & 15, quad = lane >> 4;
    bf16x8 Cf[4][2], Sf[4][2], Nf[4][2];
#pragma unroll
    for (int mt = 0; mt < 4; ++mt)
#pragma unroll
        for (int s2 = 0; s2 < 2; ++s2) { Cf[mt][s2] = fft_frag(0, 16 * mt + ml, s2, quad); Nf[mt][s2] = fft_frag(1, 16 * mt + ml, s2, quad); Sf[mt][s2] = fft_frag(2, 16 * mt + ml, s2, quad); }
    const unsigned va_off = (unsigned)((4 * quad + (ml >> 2)) * FF_RS + 8 * (ml & 3) + 64 * wave);
    for (int unit = blockIdx.x; unit < 2048; unit += gridDim.x) {
        const int b = unit >> 9, k1 = (unit >> 3) & 63, cc = unit & 7, c0 = cc * 256;
        __syncthreads();
#pragma unroll
        for (int q = 0; q < 8; ++q) { const int kr = (tid >> 5) + 16 * q;
            *(LAS u32x4*)(lds + kr * FF_RS + (tid & 31) * 16) = *(const u32x4*)(YP + (((size_t)b * 64 + k1) * 128 + kr) * D + c0 + (tid & 31) * 8); }
        __syncthreads();
        f32x4 acc[8][2];
#pragma unroll
        for (int mt = 0; mt < 8; ++mt) { acc[mt][0] = (f32x4){0.f, 0.f, 0.f, 0.f}; acc[mt][1] = acc[mt][0]; }
#pragma unroll
        for (int s4 = 0; s4 < 4; ++s4)
#pragma unroll
            for (int nt = 0; nt < 2; ++nt) { const bf16x8 yf = fft_tr(lds + va_off + 32 * s4 * FF_RS + 32 * nt);
#pragma unroll
                for (int mt = 0; mt < 4; ++mt) {
                    if (s4 < 2) { acc[mt][nt] = __builtin_amdgcn_mfma_f32_16x16x32_bf16(yf, Cf[mt][s4], acc[mt][nt], 0, 0, 0); acc[mt + 4][nt] = __builtin_amdgcn_mfma_f32_16x16x32_bf16(yf, Nf[mt][s4], acc[mt + 4][nt], 0, 0, 0); }
                    else { acc[mt][nt] = __builtin_amdgcn_mfma_f32_16x16x32_bf16(yf, Sf[mt][s4 - 2], acc[mt][nt], 0, 0, 0); acc[mt + 4][nt] = __builtin_amdgcn_mfma_f32_16x16x32_bf16(yf, Cf[mt][s4 - 2], acc[mt + 4][nt], 0, 0, 0); } } }
        const int g = cc >> 1, cp0 = (cc & 1) * 256 + 32 * wave + 4 * quad;
#pragma unroll
        for (int mt = 0; mt < 8; ++mt) { const int part = mt >> 2, k2 = 16 * (mt & 3) + ml;
            bf16* dp = PCAT + ((size_t)b * SEQ + k1 + 64 * k2) * 4096 + g * 1024 + part * 512 + cp0;
            st_bf16x4(dp, acc[mt][0]); st_bf16x4(dp + 16, acc[mt][1]); }
    }
}

DI void conv_phase(const bf16* P, const float* cw, bf16* MIX, int gtid, int GT) {
    for (int i = gtid; i < T * 128; i += GT) {
        const int tok = i >> 7, c8 = (i & 127) * 8, l = tok & 4095;
        const bf16* base = P + (size_t)tok * NMIX + 3072 + c8;
        const u32x4 gb = *(const u32x4*)base;
        float z[3][8];
#pragma unroll
        for (int j = 0; j < 3; ++j) { const int ll = l + j - 1; const bool ok = ll >= 0 && ll < SEQ;
            u32x4 gc = (u32x4){0u, 0u, 0u, 0u}, xi = gc;
            if (ok) { const bf16* pj = base + (ptrdiff_t)(j - 1) * NMIX; gc = *(const u32x4*)(pj + 1024); xi = *(const u32x4*)(pj + 2048); }
            z[j][0] = bflo(gc.x) * bflo(xi.x); z[j][1] = bfhi(gc.x) * bfhi(xi.x); z[j][2] = bflo(gc.y) * bflo(xi.y); z[j][3] = bfhi(gc.y) * bfhi(xi.y);
            z[j][4] = bflo(gc.z) * bflo(xi.z); z[j][5] = bfhi(gc.z) * bfhi(xi.z); z[j][6] = bflo(gc.w) * bflo(xi.w); z[j][7] = bfhi(gc.w) * bfhi(xi.w); }
        float gbf[8] = {bflo(gb.x), bfhi(gb.x), bflo(gb.y), bfhi(gb.y), bflo(gb.z), bfhi(gb.z), bflo(gb.w), bfhi(gb.w)};
        float o[8];
#pragma unroll
        for (int e = 0; e < 8; ++e) o[e] = gbf[e] * (cw[c8 + e] * z[0][e] + cw[1024 + c8 + e] * z[1][e] + cw[2048 + c8 + e] * z[2][e]);
        *(u32x4*)(MIX + (size_t)tok * D + 1024 + c8) = (u32x4){pk2(o[0], o[1]), pk2(o[2], o[3]), pk2(o[4], o[5]), pk2(o[6], o[7])};
    }
}
constexpr int RT_RS = 4112, RT_IMG = 16 * RT_RS;
DI void split_bf16(const float* w8, bf16x8& hi, bf16x8& lo) {
    unsigned h[4], l[4];
#pragma unroll
    for (int p = 0; p < 4; ++p) { const unsigned a = f2bf(w8[2 * p]), b = f2bf(w8[2 * p + 1]); h[p] = a | (b << 16);
        l[p] = pk2(w8[2 * p] - __uint_as_float(a << 16), w8[2 * p + 1] - __uint_as_float(b << 16)); }
    hi = __builtin_bit_cast(bf16x8, (u32x4){h[0], h[1], h[2], h[3]}); lo = __builtin_bit_cast(bf16x8, (u32x4){l[0], l[1], l[2], l[3]});
}
DI void ln_router_phase(const float* TBp, const float* lng, const float* lnb, const float* mods_l, const float* rw, const float* rbias,
                        float* X1p, bf16* Up, unsigned* counts, int* tablep, unsigned* tokinfop, LAS unsigned char* lds) {
    const int tid = threadIdx.x, wave = __builtin_amdgcn_readfirstlane(tid >> 6), lane = tid & 63, fr = lane & 15, fq = lane >> 4;
    bf16x8 bh[8][2], bl[8][2];
#pragma unroll
    for (int ks = 0; ks < 8; ++ks)
#pragma unroll
        for (int nt = 0; nt < 2; ++nt) { float w8[8];
#pragma unroll
            for (int j = 0; j < 8; ++j) w8[j] = rw[(size_t)(256 * wave + 32 * ks + 8 * fq + j) * NE + nt * 16 + fr];
            split_bf16(w8, bh[ks][nt], bl[ks][nt]); }
    LAS float* part = (LAS float*)lds; LAS float* lgs = (LAS float*)(lds + 16384);
    for (int rg = blockIdx.x; rg < T / 16; rg += gridDim.x) {
        __syncthreads();
#pragma unroll 1
        for (int rr = 0; rr < 2; ++rr) {
            const int lr = 2 * wave + rr, row = rg * 16 + lr;
            Row r; row_load(r, TBp + (size_t)row * D, lane); row_ln(r); row_affine(r, lng, lnb, lane);
            row_store(r, X1p + (size_t)row * D, lane);
            row_ln(r);
            const float* mr = mods_l + (size_t)(row >> 12) * MODW + 3 * D;
            row_modulate(r, mr, mr + D, lane);
            u32x2* uq = (u32x2*)(Up + (size_t)row * D) + lane;
#pragma unroll
            for (int j = 0; j < 8; ++j) { const unsigned a = f2bf(r.v[j].x), b = f2bf(r.v[j].y), c = f2bf(r.v[j].z), d = f2bf(r.v[j].w);
                u32x2 hi; hi.x = a | (b << 16); hi.y = c | (d << 16); uq[64 * j] = hi;
                u32x2 lo; lo.x = pk2(r.v[j].x - __uint_as_float(a << 16), r.v[j].y - __uint_as_float(b << 16)); lo.y = pk2(r.v[j].z - __uint_as_float(c << 16), r.v[j].w - __uint_as_float(d << 16));
                *(LAS u32x2*)(lds + lr * RT_RS + (4 * lane + 256 * j) * 2) = hi; *(LAS u32x2*)(lds + RT_IMG + lr * RT_RS + (4 * lane + 256 * j) * 2) = lo; }
        }
        __syncthreads();
        f32x4 acc[2]; acc[0] = (f32x4){0.f, 0.f, 0.f, 0.f}; acc[1] = acc[0];
        const LAS unsigned char* ap = lds + fr * RT_RS + (256 * wave + 8 * fq) * 2;
#pragma unroll
        for (int ks = 0; ks < 8; ++ks) { const bf16x8 ah = *(const LAS bf16x8*)(ap + ks * 64), al = *(const LAS bf16x8*)(ap + RT_IMG + ks * 64);
#pragma unroll
            for (int nt = 0; nt < 2; ++nt) { acc[nt] = __builtin_amdgcn_mfma_f32_16x16x32_bf16(ah, bh[ks][nt], acc[nt], 0, 0, 0); acc[nt] = __builtin_amdgcn_mfma_f32_16x16x32_bf16(ah, bl[ks][nt], acc[nt], 0, 0, 0);
                acc[nt] = __builtin_amdgcn_mfma_f32_16x16x32_bf16(al, bh[ks][nt], acc[nt], 0, 0, 0); } }
        __syncthreads();
#pragma unroll
        for (int nt = 0; nt < 2; ++nt)
#pragma unroll
            for (int i = 0; i < 4; ++i) part[(wave * 16 + fq * 4 + i) * 32 + nt * 16 + fr] = acc[nt][i];
        __syncthreads();
        { const int r16 = tid >> 5, e = tid & 31; float sacc = 0.f;
#pragma unroll
            for (int w = 0; w < 8; ++w) sacc += part[(w * 16 + r16) * 32 + e];
            const float af = 1.f / (1.f + expf(-sacc)); const float bi = af + rbias[e];
            lgs[r16 * 32 + e] = af; lgs[512 + r16 * 32 + e] = bi;
            const float b1 = dpp_f<0xB1>(bi), b2 = dpp_f<0x4E>(bi), b3 = dpp_f<0x1B>(bi);
            const float hi1 = fmaxf(bi, b1), lo1 = fminf(bi, b1), hi2 = fmaxf(b2, b3), lo2 = fminf(b2, b3);
            const float scg = fmaxf(hi1, hi2) + fmaxf(fminf(hi1, hi2), fmaxf(lo1, lo2));
            if ((e & 3) == 0) lgs[1024 + r16 * 8 + (e >> 2)] = scg; }
        __syncthreads();
        if (tid < 16) {
            const int row = rg * 16 + tid; const LAS float* gs = lgs + 1024 + tid * 8;
            float best = -1e30f; int grp = 0;
#pragma unroll
            for (int g = 0; g < 8; ++g) { const float scg = gs[g]; if (scg > best) { best = scg; grp = g; } }
            float ga[4], gv[4];
#pragma unroll
            for (int i = 0; i < 4; ++i) { ga[i] = lgs[tid * 32 + 4 * grp + i]; gv[i] = lgs[512 + tid * 32 + 4 * grp + i]; }
            int i1 = 0; float v1 = gv[0]; if (gv[1] > v1) { v1 = gv[1]; i1 = 1; } if (gv[2] > v1) { v1 = gv[2]; i1 = 2; } if (gv[3] > v1) { v1 = gv[3]; i1 = 3; }
            int i2 = -1; float v2 = -1e30f;
            if (i1 != 0 && gv[0] > v2) { v2 = gv[0]; i2 = 0; } if (i1 != 1 && gv[1] > v2) { v2 = gv[1]; i2 = 1; } if (i1 != 2 && gv[2] > v2) { v2 = gv[2]; i2 = 2; } if (i1 != 3 && gv[3] > v2) { v2 = gv[3]; i2 = 3; }
            const float a1 = i1 == 0 ? ga[0] : i1 == 1 ? ga[1] : i1 == 2 ? ga[2] : ga[3], a2 = i2 == 0 ? ga[0] : i2 == 1 ? ga[1] : i2 == 2 ? ga[2] : ga[3];
            const float w1 = a1 / (a1 + a2), w2 = a2 / (a1 + a2);
            const int e1 = grp * 4 + i1, e2 = grp * 4 + i2;
            const unsigned p1 = __hip_atomic_fetch_add(counts + e1, 1u, __ATOMIC_RELAXED, __HIP_MEMORY_SCOPE_AGENT);
            const unsigned p2 = __hip_atomic_fetch_add(counts + e2, 1u, __ATOMIC_RELAXED, __HIP_MEMORY_SCOPE_AGENT);
            tablep[(size_t)e1 * T + p1] = row; tablep[(size_t)e2 * T + p2] = row;
            u32x4 ta; ta.x = (unsigned)e1; ta.y = (unsigned)e2; ta.z = p1; ta.w = p2; u32x4 tb2; tb2.x = __float_as_uint(w1); tb2.y = __float_as_uint(w2); tb2.z = 0u; tb2.w = 0u;
            *(u32x4*)(tokinfop + (size_t)row * 8) = ta; *(u32x4*)(tokinfop + (size_t)row * 8 + 4) = tb2;
        }
    }
}
DI void moe_prefix(const unsigned* counts, LAS int* cnt, LAS int* tb, int tid) {
    __syncthreads();
    if (tid < 32) cnt[tid] = (int)__hip_atomic_load(counts + tid, __ATOMIC_RELAXED, __HIP_MEMORY_SCOPE_AGENT);
    __syncthreads();
    if (tid == 0) { int a = 0; for (int e = 0; e < 32; ++e) { tb[e] = a; a += (cnt[e] + 255) >> 8; } tb[32] = a; }
    __syncthreads();
}
DI void combine_phase(const float* X1, const bf16* Y, const unsigned* tokinfo, const LAS int* tb, const float* mods_l, const float* lng, const float* lnb,
                      float* XO, const float* mods_next, bf16* U, int gw, int NGW, int lane) {
    if (gw >= T) return;
    u32x4 ta = *(const u32x4*)(tokinfo + (size_t)gw * 8), tw = *(const u32x4*)(tokinfo + (size_t)gw * 8 + 4);
    for (int row = gw; row < T; row += NGW) {
        const int nr = row + NGW < T ? row + NGW : row;
        const u32x4 tan = *(const u32x4*)(tokinfo + (size_t)nr * 8), twn = *(const u32x4*)(tokinfo + (size_t)nr * 8 + 4);
        const int e0 = __builtin_amdgcn_readfirstlane((int)ta.x), e1 = __builtin_amdgcn_readfirstlane((int)ta.y);
        const size_t r0 = (size_t)(__builtin_amdgcn_readfirstlane(tb[e0]) * 256 + __builtin_amdgcn_readfirstlane((int)ta.z)), r1 = (size_t)(__builtin_amdgcn_readfirstlane(tb[e1]) * 256 + __builtin_amdgcn_readfirstlane((int)ta.w));
        const float w0 = __uint_as_float(tw.x), w1 = __uint_as_float(tw.y);
        Row r; row_load(r, X1 + (size_t)row * D, lane);
        const u32x2* y0 = (const u32x2*)(Y + r0 * D) + lane; const u32x2* y1 = (const u32x2*)(Y + r1 * D) + lane;
        const f32x4* g2 = (const f32x4*)(mods_l + (size_t)(row >> 12) * MODW + 5 * D) + lane;
#pragma unroll
        for (int j = 0; j < 8; ++j) { const u32x2 a = y0[64 * j], b = y1[64 * j]; f32x4 f;
            f.x = w0 * bflo(a.x) + w1 * bflo(b.x); f.y = w0 * bfhi(a.x) + w1 * bfhi(b.x); f.z = w0 * bflo(a.y) + w1 * bflo(b.y); f.w = w0 * bfhi(a.y) + w1 * bfhi(b.y);
            r.v[j] = r.v[j] * ALPHA + g2[64 * j] * f; }
        row_ln(r); row_affine(r, lng, lnb, lane);
        row_store(r, XO + (size_t)row * D, lane);
        if (U) { row_ln(r); const float* mr = mods_next + (size_t)(row >> 12) * MODW; row_modulate(r, mr, mr + D, lane); row_store_bf16(r, U + (size_t)row * D, lane); }
        ta = tan; tw = twn;
    }
}

struct Args { const float* in[18]; float* out; unsigned char* ws; int ph_lo, ph_hi; };
__global__ void __launch_bounds__(512, 2) fwd(Args args) {
    extern __shared__ __attribute__((aligned(16))) unsigned char lds_raw[];
    LAS unsigned char* lds = (LAS unsigned char*)lds_raw;
#define PH_IDS int tid = threadIdx.x; asm volatile("" : "+v"(tid)); const int lane = tid & 63, wave = __builtin_amdgcn_readfirstlane(tid >> 6); \
    const int gw = blockIdx.x * 8 + wave, NGW = gridDim.x * 8, gtid = blockIdx.x * 512 + tid, GT = gridDim.x * 512; (void)lane; (void)gw; (void)NGW; (void)gtid; (void)GT;
    volatile LAS unsigned* LCTL = (volatile LAS unsigned*)(lds + LDSCTL_OFF);
    LAS int* l_cnt = (LAS int*)(lds + LDSCTL_OFF) + 16; LAS int* l_tb = (LAS int*)(lds + LDSCTL_OFF) + 48;
    for (int u = threadIdx.x; u < (LDS_BYTES - LDSCTL_OFF) / 4; u += 512) ((LAS unsigned*)(lds + LDSCTL_OFF))[u] = 0u;
    __syncthreads();
    unsigned char* ws = args.ws;
    unsigned* ctl = (unsigned*)(ws + WS_CTL);
#define XIN ((const float*)args.in[0])
#define c_in args.in[1]
#define ctx args.in[2]
#define c_ctx args.in[3]
#define ada_w args.in[4]
#define ada_b args.in[5]
#define w_mix_in args.in[6]
#define rpb args.in[7]
#define conv_w args.in[8]
#define w_mix_out args.in[9]
#define w_fourier args.in[10]
#define router_w args.in[11]
#define router_b args.in[12]
#define w_gate args.in[13]
#define w_up args.in[14]
#define w_down args.in[15]
#define ln_g args.in[16]
#define ln_b args.in[17]
#define mods ((float*)(ws + WS_MODS))
#define tokinfo ((unsigned*)(ws + WS_TOKINFO))
#define table ((int*)(ws + WS_TABLE))
#define WIN ((bf16*)(ws + WS_WIN))
#define WO ((bf16*)(ws + WS_WO))
#define WF ((bf16*)(ws + WS_WF))
#define CSM ((bf16*)(ws + WS_CS))
#define U ((bf16*)(ws + WS_U))
#define P ((bf16*)(ws + WS_P))
#define YB ((bf16*)(ws + WS_P))
#define YPB ((bf16*)(ws + WS_P))
#define PCATB ((bf16*)(ws + WS_TB))
#define MIX ((bf16*)(ws + WS_MIX))
#define REZ ((bf16*)(ws + WS_MIX))
#define HB ((bf16*)(ws + WS_H))
#define WGU ((bf16*)(ws + WS_WGU))
#define WD ((bf16*)(ws + WS_WD))
#define TB ((float*)(ws + WS_TB))
#define X1 ((float*)(ws + WS_X1))
#define X2 ((float*)(ws + WS_X2))
    XcdBarrier bar; bar.bar = ctl + CW_BAR; bar.x = 0; bar.st = nullptr;
    if (N_LAUNCHES != NPHASE) bar = xcd_barrier_post(ctl + CW_BAR, LCTL);
    const int lo = args.ph_lo, hi = args.ph_hi;
#ifndef DUP_MASK
#define DUP_MASK 0x0000
#endif
#define RUN(k, ...) do { __VA_ARGS__ if constexpr ((((DUP_MASK) >> (k)) & 1) != 0) { __VA_ARGS__ } } while (0)
#ifndef PH_MASK
#define PH_MASK 0x1ffff
#endif
#define IN(k) ((((PH_MASK) >> (k)) & 1) && lo <= (k) && (k) < hi)
#define SEAM(k) do { if (IN(k) && IN((k) + 1)) xcd_barrier(bar); } while (0)

    RUN(0, if (IN(0)) { PH_IDS
        LAS float* sl = (LAS float*)lds; LAS float* red = sl + 5 * D; volatile LAS int* qslot = (volatile LAS int*)(lds + LDSCTL_OFF) + 8;
        for (int i = tid; i < 5 * D; i += 512) { const float v = i < 4 * D ? c_in[i] : c_ctx[i - 4 * D]; sl[i] = silu_f(v); }
        __syncthreads();
        for (;;) {
            if (tid == 0) *qslot = (int)__hip_atomic_fetch_add(ctl + 160, 1u, __ATOMIC_RELAXED, __HIP_MEMORY_SCOPE_AGENT);
            __syncthreads();
            const int item = __builtin_amdgcn_readfirstlane(*qslot);
            __syncthreads();
            if (item >= P0_NMODS + P0_NSI) break;
            if (item < P0_NMODS) p0_mods_unit(ada_w, ada_b, mods, sl, red, item, tid);
            else p0_weight_item(item - P0_NMODS, w_mix_in, w_mix_out, w_fourier, w_gate, w_up, w_down, WIN, WO, WF, WGU, WD, lds + wave * 16384, wave, lane);
        }
        p0_dft(CSM, gtid, GT);
    });
    SEAM(0);
    RUN(1, if (IN(1)) { PH_IDS ln_mod_phase(XIN, ctx, mods, 0, U, TALL, gw, NGW, lane); });
    SEAM(1);
    RUN(2, if (IN(2)) { SchedInProj S{U, WIN}; EpiStoreBf16 E{P, NMIX}; gemm_pg8<false>(lds, S, E, D, D, D); });
    SEAM(2);
    RUN(3, if (IN(3)) { PH_IDS attn_phase(P, rpb, MIX, lds, (LAS float*)(lds + LDSCTL_OFF + 1024)); conv_phase(P, conv_w, MIX, gtid, GT); });
    SEAM(3);
    RUN(4, if (IN(4)) { SchedDense S{MIX, WO, 64, 8, (size_t)256 * D, (size_t)256 * D}; EpiResid E{XIN, TB, mods + 2 * D}; gemm_pg8<false>(lds, S, E, D, D, D); });
    SEAM(4);
    RUN(5, if (IN(5)) { PH_IDS ln_router_phase(TB, ln_g, ln_b, mods, router_w, router_b, X1, U, ctl + CW_CNT, table, tokinfo, lds); });
    SEAM(5);
    RUN(6, if (IN(6)) { PH_IDS moe_prefix(ctl + CW_CNT, l_cnt, l_tb, tid); SchedMoe S{l_cnt, l_tb, U, WGU, table, 1, 0, (size_t)D * D, (size_t)256 * D}; EpiSwiglu E{HB}; gemm_pg8<true>(lds, S, E, D, D, D); });
    SEAM(6);
    RUN(7, if (IN(7)) { PH_IDS moe_prefix(ctl + CW_CNT, l_cnt, l_tb, tid); SchedMoe S{l_cnt, l_tb, HB, WD, table, 0, (size_t)256 * DE, (size_t)D * DE, (size_t)256 * DE}; EpiStoreBf16 E{YB, D}; gemm_pg8<false>(lds, S, E, DE, DE, DE); });
    SEAM(7);
    RUN(8, if (IN(8)) { PH_IDS moe_prefix(ctl + CW_CNT, l_cnt, l_tb, tid); combine_phase(X1, YB, tokinfo, l_tb, mods, ln_g + D, ln_b + D, X2, mods + 5 * MODW, U, gw, NGW, lane); });
    SEAM(8);
    RUN(9, if (IN(9)) { fft1_phase(U, YPB, lds); });
    SEAM(9);
    RUN(10, if (IN(10)) { fft2_phase(YPB, PCATB, lds); });
    SEAM(10);
    RUN(11, if (IN(11)) { SchedChan S{PCATB, CSM}; EpiStoreBf16 E{REZ, D}; gemm_pg8<false>(lds, S, E, 4096, 1024, 1024); });
    SEAM(11);
    RUN(12, if (IN(12)) { SchedDense S{REZ, WF, 64, 8, (size_t)256 * D, (size_t)256 * D}; EpiResid E{X2, TB, mods + 5 * MODW + 2 * D}; gemm_pg8<false>(lds, S, E, D, D, D); });
    SEAM(12);
    RUN(13, if (IN(13)) { PH_IDS ln_router_phase(TB, ln_g + 2 * D, ln_b + 2 * D, mods + 5 * MODW, router_w, router_b, X1, U, ctl + CW_CNT + 32, table + (size_t)NE * T, tokinfo + (size_t)T * 8, lds); });
    SEAM(13);
    RUN(14, if (IN(14)) { PH_IDS moe_prefix(ctl + CW_CNT + 32, l_cnt, l_tb, tid); SchedMoe S{l_cnt, l_tb, U, WGU + (size_t)NE * D * D, table + (size_t)NE * T, 1, 0, (size_t)D * D, (size_t)256 * D}; EpiSwiglu E{HB}; gemm_pg8<true>(lds, S, E, D, D, D); });
    SEAM(14);
    RUN(15, if (IN(15)) { PH_IDS moe_prefix(ctl + CW_CNT + 32, l_cnt, l_tb, tid); SchedMoe S{l_cnt, l_tb, HB, WD + (size_t)NE * D * DE, table, 0, (size_t)256 * DE, (size_t)D * DE, (size_t)256 * DE}; EpiStoreBf16 E{YB, D}; gemm_pg8<false>(lds, S, E, DE, DE, DE); });
    SEAM(15);
    RUN(16, if (IN(16)) { PH_IDS moe_prefix(ctl + CW_CNT + 32, l_cnt, l_tb, tid); combine_phase(X1, YB, tokinfo + (size_t)T * 8, l_tb, mods + 5 * MODW, ln_g + 3 * D, ln_b + 3 * D, args.out, nullptr, nullptr, gw, NGW, lane); });
#undef IN
#undef SEAM
}

extern "C" void kernel_launch(void* const* d_in, const int* in_sizes, int n_in, void* d_out, int out_size, void* d_ws, size_t ws_size, hipStream_t stream) {
    static int grid = 0;
    if (grid == 0) {
        if (n_in != 18 || out_size != T * D || ws_size < WS_END) { fprintf(stderr, "kernel_launch: unexpected shapes (n_in %d, out %d, ws %zu)\n", n_in, out_size, ws_size); grid = -1; return; }
        int dev = 0, cus = 0, per_cu = 0;
        if (hipGetDevice(&dev) != hipSuccess || hipDeviceGetAttribute(&cus, hipDeviceAttributeMultiprocessorCount, dev) != hipSuccess) { grid = -1; return; }
        if (hipFuncSetAttribute((const void*)fwd, hipFuncAttributeMaxDynamicSharedMemorySize, LDS_BYTES) != hipSuccess) { fprintf(stderr, "kernel_launch: hipFuncSetAttribute failed\n"); grid = -1; return; }
        if (hipOccupancyMaxActiveBlocksPerMultiprocessor(&per_cu, (const void*)fwd, 512, LDS_BYTES) != hipSuccess || per_cu < 1) fprintf(stderr, "kernel_launch: occupancy query says %d\n", per_cu);
        (void)hipGetLastError();
        grid = cus;
    }
    if (grid < 0) return;
    (void)hipMemsetAsync((char*)d_ws + WS_CTL, 0, CTL_ZERO_BYTES, stream);
    Args a{};
    for (int i = 0; i < 18; ++i) a.in[i] = (const float*)d_in[i];
    a.out = (float*)d_out; a.ws = (unsigned char*)d_ws;
    if (N_LAUNCHES == 1) { a.ph_lo = 0; a.ph_hi = NPHASE; hipLaunchKernelGGL(fwd, dim3(grid), dim3(512), LDS_BYTES, stream, a); }
    else for (int p = 0; p < NPHASE; ++p) { a.ph_lo = p; a.ph_hi = p + 1; hipLaunchKernelGGL(fwd, dim3(grid), dim3(512), LDS_BYTES, stream, a); }
}
```

```cpp
#include <hip/hip_runtime.h>
#include <cstdio>
#include <cstdint>

#define DI __device__ __forceinline__
#define LAS __attribute__((address_space(3)))
typedef unsigned short bf16;
typedef float f32x4 __attribute__((ext_vector_type(4)));
typedef short bf16x8 __attribute__((ext_vector_type(8)));
typedef unsigned u32x4 __attribute__((ext_vector_type(4)));
typedef unsigned u32x2 __attribute__((ext_vector_type(2)));

constexpr int D = 2048, NB = 4, SEQ = 4096, T = NB * SEQ, CTXL = 256, TC = NB * CTXL, TALL = T + TC;
constexpr int NMIX = 6144, NE = 32, DE = 1024, NH = 8, HD = 128, MODW = 6 * D;
constexpr float ALPHA = 1.41421356237309515f;
constexpr float LN_EPS = 1e-6f;
constexpr int NPHASE = 17;
#ifndef MK_N_LAUNCHES
#define MK_N_LAUNCHES 1
#endif
constexpr int N_LAUNCHES = MK_N_LAUNCHES;

constexpr size_t MiB = 1u << 20;
constexpr size_t WS_CTL = 0, CTL_ZERO_BYTES = 64 * 1024;
constexpr size_t WS_MODS = 1 * MiB;
constexpr size_t WS_TOKINFO = 2 * MiB;
constexpr size_t WS_TABLE = 4 * MiB;
constexpr size_t WS_WIN = 8 * MiB, WS_WO = 32 * MiB, WS_WF = 40 * MiB, WS_CS = 48 * MiB, WS_ACS = 64 * MiB;
constexpr size_t WS_U = 128 * MiB;
constexpr size_t WS_P = 196 * MiB;
constexpr size_t WS_MIX = 400 * MiB;
constexpr size_t WS_TB = 464 * MiB, WS_X1 = 592 * MiB, WS_X2 = 720 * MiB;
constexpr size_t WS_H = 848 * MiB;
constexpr size_t WS_WGU = 928 * MiB;
constexpr size_t WS_WD = 1440 * MiB;
constexpr size_t WS_END = 1696 * MiB;
constexpr int CW_CNT = 64;
constexpr int CW_BAR = 1024;

constexpr int LDS_SCR = 133120;
constexpr int LDSCTL_OFF = LDS_SCR;
constexpr int LDS_BYTES = 147456;

template <int CTRL> DI float dpp_f(float v) { return __builtin_bit_cast(float, __builtin_amdgcn_mov_dpp(__builtin_bit_cast(int, v), CTRL, 0xF, 0xF, true)); }
DI float wave_sum(float v) {
    v += dpp_f<0xB1>(v); v += dpp_f<0x4E>(v); v += dpp_f<0x141>(v); v += dpp_f<0x140>(v);
    const int iv = __builtin_bit_cast(int, v);
    const float r0 = __builtin_bit_cast(float, __builtin_amdgcn_readlane(iv, 0)), r1 = __builtin_bit_cast(float, __builtin_amdgcn_readlane(iv, 16)),
                r2 = __builtin_bit_cast(float, __builtin_amdgcn_readlane(iv, 32)), r3 = __builtin_bit_cast(float, __builtin_amdgcn_readlane(iv, 48));
    return (r0 + r1) + (r2 + r3);
}
DI float wave_max(float v) {
    v = fmaxf(v, dpp_f<0xB1>(v)); v = fmaxf(v, dpp_f<0x4E>(v)); v = fmaxf(v, dpp_f<0x141>(v)); v = fmaxf(v, dpp_f<0x140>(v));
    const int iv = __builtin_bit_cast(int, v);
    const float r0 = __builtin_bit_cast(float, __builtin_amdgcn_readlane(iv, 0)), r1 = __builtin_bit_cast(float, __builtin_amdgcn_readlane(iv, 16)),
                r2 = __builtin_bit_cast(float, __builtin_amdgcn_readlane(iv, 32)), r3 = __builtin_bit_cast(float, __builtin_amdgcn_readlane(iv, 48));
    return fmaxf(fmaxf(r0, r1), fmaxf(r2, r3));
}
DI unsigned f2bf(float f) { unsigned u = __float_as_uint(f); return (u + 0x7fffu + ((u >> 16) & 1u)) >> 16; }
typedef float f32x2_t __attribute__((ext_vector_type(2)));
typedef __bf16 bf16x2_t __attribute__((ext_vector_type(2)));
DI unsigned pk2(float lo, float hi) { const f32x2_t v = {lo, hi}; return __builtin_bit_cast(unsigned, __builtin_convertvector(v, bf16x2_t)); }
DI float bflo(unsigned w) { return __uint_as_float(w << 16); }
DI float bfhi(unsigned w) { return __uint_as_float(w & 0xffff0000u); }
DI float silu_f(float v) { return v / (1.f + expf(-v)); }
DI float silu_fast(float v) { return v * __builtin_amdgcn_rcpf(1.f + __builtin_amdgcn_exp2f(v * -1.4426950408889634f)); }

#define XB_TMO      128
#define XB_XCNT(j)  (256  + 64 * (j))
#define XB_XSUB(j)  (1280 + 64 * (j))
#define XB_XGEN(j)  (2304 + 64 * (j))
#define XB_TOP      3328
#define XB_TOPGEN   3392
#define XCD_BAR_WORDS 3456
#define XB_SPIN_CAP (1u << 18)
__device__ __forceinline__ unsigned xb_ld(unsigned* p)              { return __hip_atomic_load(p, __ATOMIC_RELAXED, __HIP_MEMORY_SCOPE_AGENT); }
__device__ __forceinline__ unsigned xb_add(unsigned* p, unsigned v) { return __hip_atomic_fetch_add(p, v, __ATOMIC_RELAXED, __HIP_MEMORY_SCOPE_AGENT); }
__device__ __forceinline__ unsigned xb_xcc_id() { return (unsigned)__builtin_amdgcn_s_getreg((3 << 11) | 20) & 0xFu; }
#define XB_SPIN(cond, bar) do { unsigned _sp = 0; while (cond) { __builtin_amdgcn_s_sleep(1); \
    if ((++_sp & 255u) == 0u) { if (xb_ld(&(bar)[XB_TMO])) break; if (_sp > XB_SPIN_CAP) { atomicAdd(&(bar)[XB_TMO], 1u); break; } } } } while (0)
struct XcdBarrier { unsigned* bar; unsigned x; volatile LAS unsigned* st; };
__device__ __forceinline__ XcdBarrier xcd_barrier_post(unsigned* bar, volatile LAS unsigned* st) {
    XcdBarrier b; b.bar = bar; b.x = xb_xcc_id(); b.st = st;
    if (threadIdx.x == 0) (void)xb_add(&bar[XB_XCNT(b.x)], 1u);
    return b;
}
__device__ __forceinline__ void xcd_barrier_complete(unsigned* bar, unsigned x, unsigned& nloc, unsigned& nx) {
    const unsigned G = gridDim.x * gridDim.y * gridDim.z;
    unsigned sum, cnt, mine, sp = 0u;
    for (;;) {
        sum = 0u; cnt = 0u; mine = 0u;
#pragma unroll
        for (unsigned j = 0; j < 16; ++j) { const unsigned c = xb_ld(&bar[XB_XCNT(j)]); sum += c; cnt += (c > 0u) ? 1u : 0u; mine = (j == x) ? c : mine; }
        if (sum == G) break;
        __builtin_amdgcn_s_sleep(1);
        if ((++sp & 255u) == 0u) { if (xb_ld(&bar[XB_TMO])) break; if (sp > XB_SPIN_CAP) { atomicAdd(&bar[XB_TMO], 1u); break; } }
    }
    nloc = mine > 0u ? mine : 1u; nx = cnt > 0u ? cnt : 1u;
}
__device__ __forceinline__ void xcd_barrier(const XcdBarrier& b) {
    asm volatile("s_waitcnt vmcnt(0)" ::: "memory");
    __syncthreads();
    if (threadIdx.x == 0) {
        unsigned* bar = b.bar;
        __builtin_amdgcn_s_waitcnt(0);
        unsigned nloc = b.st[0], nx = b.st[1];
        if (nloc == 0u) { xcd_barrier_complete(bar, b.x, nloc, nx); b.st[0] = nloc; b.st[1] = nx; }
        const unsigned old = xb_add(&bar[XB_XSUB(b.x)], 1u);
        const unsigned gen = old / nloc;
        if (old + 1u == (gen + 1u) * nloc) {
            __builtin_amdgcn_fence(__ATOMIC_RELEASE, "agent");
            asm volatile("s_waitcnt vmcnt(0)" ::: "memory");
            const unsigned og = xb_add(&bar[XB_TOP], 1u);
            const unsigned tg = og / nx;
            if (og + 1u == (tg + 1u) * nx) xb_add(&bar[XB_TOPGEN], 1u);
            else XB_SPIN(xb_ld(&bar[XB_TOPGEN]) == tg, bar);
            __builtin_amdgcn_fence(__ATOMIC_ACQUIRE, "agent");
            xb_add(&bar[XB_XGEN(b.x)], 1u);
            asm volatile("s_waitcnt vmcnt(0)" ::: "memory");
        } else {
            XB_SPIN(xb_ld(&bar[XB_XGEN(b.x)]) == gen, bar);
            __builtin_amdgcn_fence(__ATOMIC_ACQUIRE, "agent");
            asm volatile("s_waitcnt vmcnt(0)" ::: "memory");
        }
    }
    __syncthreads();
}

struct Row { f32x4 v[8]; };
DI void row_load(Row& r, const float* p, int lane) { const f32x4* q = (const f32x4*)p + lane;
#pragma unroll
    for (int j = 0; j < 8; ++j) r.v[j] = q[64 * j]; }
DI void row_store(const Row& r, float* p, int lane) { f32x4* q = (f32x4*)p + lane;
#pragma unroll
    for (int j = 0; j < 8; ++j) q[64 * j] = r.v[j]; }
DI void row_store_bf16(const Row& r, bf16* p, int lane) { u32x2* q = (u32x2*)p + lane;
#pragma unroll
    for (int j = 0; j < 8; ++j) { u32x2 w; w.x = pk2(r.v[j].x, r.v[j].y); w.y = pk2(r.v[j].z, r.v[j].w); q[64 * j] = w; } }
DI void row_ln(Row& r) {
    float s = 0.f;
#pragma unroll
    for (int j = 0; j < 8; ++j) s += (r.v[j].x + r.v[j].y) + (r.v[j].z + r.v[j].w);
    const float mean = wave_sum(s) * (1.f / D); float s2 = 0.f;
#pragma unroll
    for (int j = 0; j < 8; ++j) { r.v[j] = r.v[j] - mean; s2 += (r.v[j].x * r.v[j].x + r.v[j].y * r.v[j].y) + (r.v[j].z * r.v[j].z + r.v[j].w * r.v[j].w); }
    const float rstd = 1.f / sqrtf(wave_sum(s2) * (1.f / D) + LN_EPS);
#pragma unroll
    for (int j = 0; j < 8; ++j) r.v[j] = r.v[j] * rstd;
}
DI void row_affine(Row& r, const float* g, const float* b, int lane) {
    const f32x4* gq = (const f32x4*)g + lane; const f32x4* bq = (const f32x4*)b + lane;
#pragma unroll
    for (int j = 0; j < 8; ++j) r.v[j] = r.v[j] * gq[64 * j] + bq[64 * j];
}
DI void row_modulate(Row& r, const float* sh, const float* sc, int lane) {
    const f32x4* hq = (const f32x4*)sh + lane; const f32x4* cq = (const f32x4*)sc + lane;
#pragma unroll
    for (int j = 0; j < 8; ++j) r.v[j] = r.v[j] * (cq[64 * j] + 1.f) + hq[64 * j];
}

struct Unit { const bf16* A; const bf16* B; const int* gat; int nvalid; int m0, n0, aux; };

template <class Sched, class Epi>
DI void gemm_simple(const Sched& S, const Epi& E, const int lda, const int ldb, const int K) {
    const int tid = threadIdx.x, wid = tid >> 6, lane = tid & 63, fr = lane & 15, fq = lane >> 4;
    for (int L = blockIdx.x; ; L += gridDim.x) {
        Unit u; if (!S.get(L, u)) break;
        const bf16* arow[2];
#pragma unroll
        for (int m = 0; m < 2; ++m) { const int r = 32 * wid + 16 * m + fr; size_t grow = (size_t)r; if (u.gat) grow = (size_t)(r < u.nvalid ? u.gat[r] : 0); arow[m] = u.A + grow * lda + fq * 8; }
        for (int cc = 0; cc < 4; ++cc) {
            f32x4 acc[2][4];
#pragma unroll
            for (int m = 0; m < 2; ++m)
#pragma unroll
                for (int j = 0; j < 4; ++j) acc[m][j] = (f32x4){0.f, 0.f, 0.f, 0.f};
            const bf16* brow[4];
#pragma unroll
            for (int j = 0; j < 4; ++j) { const int col = (j >> 1) * 128 + cc * 32 + (j & 1) * 16 + fr; brow[j] = u.B + (size_t)col * ldb + fq * 8; }
            for (int k = 0; k < K; k += 32) {
                bf16x8 a[2], b[4];
#pragma unroll
                for (int m = 0; m < 2; ++m) a[m] = *(const bf16x8*)(arow[m] + k);
#pragma unroll
                for (int j = 0; j < 4; ++j) b[j] = *(const bf16x8*)(brow[j] + k);
#pragma unroll
                for (int m = 0; m < 2; ++m)
#pragma unroll
                    for (int j = 0; j < 4; ++j) acc[m][j] = __builtin_amdgcn_mfma_f32_16x16x32_bf16(b[j], a[m], acc[m][j], 0, 0, 0);
            }
#pragma unroll
            for (int m = 0; m < 2; ++m)
#pragma unroll
                for (int nn = 0; nn < 2; ++nn) E(u, 32 * wid + 16 * m + fr, cc * 32 + nn * 16 + 4 * fq, acc[m][nn], acc[m][nn + 2]);
        }
    }
}


namespace pg8 {
constexpr int BK = 64, HALF = 128, HTB = HALF * BK * 2, STAGE_BYTES = 8 * HTB;
DI int lds_byte(int r, int c) { const int st = (r >> 4) * 2 + (c >> 5), rr = r & 15, cc = c & 31, ob = rr * 64 + cc * 2; return st * 1024 + (ob ^ (((ob >> 9) & 1) << 5)); }
DI void stage_rc(int b, int& R, int& C) { const int st = b / 1024, sb = b % 1024, swz = sb ^ (((sb >> 9) & 1) << 5); R = (st >> 1) * 16 + swz / 64; C = (st & 1) * 32 + (swz % 64) / 2; }
}
template <bool GATHER, class Sched, class Epi>
DI void gemm_pg8(LAS unsigned char* lds, const Sched& S, const Epi& E, const int lda, const int ldb, const int K) {
    using namespace pg8;
    const int tid = threadIdx.x, wid = __builtin_amdgcn_readfirstlane(tid >> 6), lane = tid & 63, wr = wid >> 2, wc = wid & 3, fr = lane & 15, fq = lane >> 4;
    const int nt = K / BK, G = gridDim.x, cblk = blockIdx.x;
    unsigned voffB[2], vA[2][2];
#pragma unroll
    for (int i = 0; i < 2; ++i) { int R_, C_; stage_rc(tid * 16 + i * 8192, R_, C_); voffB[i] = (unsigned)(R_ * ldb + C_) * 2u; }
    const size_t kstep = (size_t)(BK * 2), hstepA = (size_t)HALF * lda * 2, hstepB = (size_t)HALF * ldb * 2;
    const unsigned ldsw = (unsigned)wid * 1024u;
    const int aoff = lds_byte(wr * 64 + fr, fq * 8), boff = lds_byte(wc * 32 + fr, fq * 8);
#define PG8_SA(b, h) (((b) * 2 + (h)) * HTB)
#define PG8_SB(b, h) ((4 + (b) * 2 + (h)) * HTB)
#define PG8_STAGE(bufoff, gbase, voff) do { _Pragma("unroll") for (int _i = 0; _i < 2; ++_i) \
        __builtin_amdgcn_global_load_lds((const unsigned*)((const char*)(gbase) + (voff)[_i]), (LAS unsigned*)(lds + (bufoff) + ldsw + _i * 8192), 16, 0, 0); } while (0)
#define PG8_STAGE_A(bufoff, gbase, h) do { if constexpr (GATHER) PG8_STAGE(bufoff, gbase, vA[h]); else PG8_STAGE(bufoff, (gbase) + (h) * hstepA, vA[0]); } while (0)
#define PG8_LDA(dst, b, h) do { _Pragma("unroll") for (int m = 0; m < 4; ++m) _Pragma("unroll") for (int k = 0; k < 2; ++k) dst[m][k] = *(const LAS bf16x8*)(lds + PG8_SA(b, h) + aoff + m * 2048 + k * 1024); } while (0)
#define PG8_LDB(dst, b, h) do { _Pragma("unroll") for (int n = 0; n < 2; ++n) _Pragma("unroll") for (int k = 0; k < 2; ++k) dst[n][k] = *(const LAS bf16x8*)(lds + PG8_SB(b, h) + boff + n * 2048 + k * 1024); } while (0)
#define PG8_MMA(ai, bj, At, Bt) do { __builtin_amdgcn_s_setprio(1); _Pragma("unroll") for (int m = 0; m < 4; ++m) _Pragma("unroll") for (int n = 0; n < 2; ++n) _Pragma("unroll") for (int k = 0; k < 2; ++k) \
        acc[ai][bj][m][n] = __builtin_amdgcn_mfma_f32_16x16x32_bf16(Bt[n][k], At[m][k], acc[ai][bj][m][n], 0, 0, 0); __builtin_amdgcn_s_setprio(0); } while (0)
#define PG8_WAIT_V(n) asm volatile("s_waitcnt vmcnt(" #n ")" ::: "memory")
#define PG8_WAIT_L(n) asm volatile("s_waitcnt lgkmcnt(" #n ")" ::: "memory")
#define PG8_BAR __builtin_amdgcn_s_barrier()
#define PG8_SCHED __builtin_amdgcn_sched_barrier(0)
#define PG8_SETV(dst, u) do { _Pragma("unroll") for (int _h = 0; _h < 2; ++_h) _Pragma("unroll") for (int _i = 0; _i < 2; ++_i) { int _R, _C; stage_rc(tid * 16 + _i * 8192, _R, _C); const int _r = _h * HALF + _R; \
        if constexpr (GATHER) { const int _g = _r < (u).nvalid ? (u).gat[_r] : 0; dst[_h][_i] = (unsigned)(_g * lda + _C) * 2u; } else dst[_h][_i] = (unsigned)(_R * lda + _C) * 2u; } } while (0)
    Unit cur, nxt; int ui = 0;
    if (!S.get(cblk, cur)) return;
    f32x4 acc[2][2][4][2];
#pragma unroll
    for (int a = 0; a < 2; ++a)
#pragma unroll
        for (int b = 0; b < 2; ++b)
#pragma unroll
            for (int m = 0; m < 4; ++m)
#pragma unroll
                for (int n = 0; n < 2; ++n) acc[a][b][m][n] = (f32x4){0.f, 0.f, 0.f, 0.f};
    bf16x8 At[4][2], B0[2][2], B1[2][2];
    const char* cA = (const char*)cur.A; const char* cB = (const char*)cur.B;
    PG8_SETV(vA, cur);
    PG8_STAGE(PG8_SB(0, 0), cB, voffB); PG8_STAGE(PG8_SB(0, 1), cB + hstepB, voffB); PG8_STAGE_A(PG8_SA(0, 0), cA, 0); PG8_STAGE_A(PG8_SA(0, 1), cA, 1);
    if (wr == 1) PG8_BAR;
    PG8_WAIT_V(2); PG8_BAR;
    PG8_STAGE(PG8_SB(1, 0), cB + kstep, voffB); PG8_STAGE_A(PG8_SA(1, 0), cA + kstep, 0); PG8_STAGE(PG8_SB(1, 1), cB + hstepB + kstep, voffB);
    PG8_WAIT_V(6); PG8_BAR;
    for (;;) {
        const bool has_next = S.get((ui + 1) * G + cblk, nxt);
        const char* nA = has_next ? (const char*)nxt.A : cA; const char* nB = has_next ? (const char*)nxt.B : cB;
        for (int t = 0; t < nt; t += 2) {
            const bool last = (t == nt - 2);
            const char* a1 = cA + (size_t)(t + 1) * kstep;
            const char* a2 = last ? nA : cA + (size_t)(t + 2) * kstep; const char* b2 = last ? nB : cB + (size_t)(t + 2) * kstep;
            const char* a3 = a2 + kstep; const char* b3 = b2 + kstep;
            PG8_LDB(B0, 0, 0); PG8_LDB(B1, 0, 1); PG8_SCHED; PG8_LDA(At, 0, 0); PG8_STAGE_A(PG8_SA(1, 1), a1, 1);
            PG8_WAIT_V(8); PG8_WAIT_L(0); PG8_BAR; PG8_MMA(0, 0, At, B0); PG8_MMA(0, 1, At, B1); PG8_BAR; PG8_SCHED;
            if constexpr (GATHER) { if (last && has_next) PG8_SETV(vA, nxt); }
            PG8_LDA(At, 0, 1); PG8_STAGE(PG8_SB(0, 0), b2, voffB); PG8_STAGE(PG8_SB(0, 1), b2 + hstepB, voffB); PG8_STAGE_A(PG8_SA(0, 0), a2, 0);
            PG8_WAIT_V(8); PG8_WAIT_L(0); PG8_BAR; PG8_MMA(1, 0, At, B0); PG8_MMA(1, 1, At, B1); PG8_BAR; PG8_SCHED;
            PG8_LDB(B0, 1, 0); PG8_LDB(B1, 1, 1); PG8_SCHED; PG8_LDA(At, 1, 0); PG8_STAGE_A(PG8_SA(0, 1), a2, 1);
            PG8_WAIT_V(8); PG8_WAIT_L(0); PG8_BAR; PG8_MMA(0, 0, At, B0); PG8_MMA(0, 1, At, B1); PG8_BAR; PG8_SCHED;
            PG8_LDA(At, 1, 1); PG8_STAGE(PG8_SB(1, 0), b3, voffB); PG8_STAGE(PG8_SB(1, 1), b3 + hstepB, voffB); PG8_STAGE_A(PG8_SA(1, 0), a3, 0);
            PG8_WAIT_V(8); PG8_WAIT_L(0); PG8_BAR; PG8_MMA(1, 0, At, B0); PG8_MMA(1, 1, At, B1); PG8_BAR; PG8_SCHED;
        }
        if (wr == 0) PG8_BAR;
#pragma unroll
        for (int ai = 0; ai < 2; ++ai)
#pragma unroll
            for (int m = 0; m < 4; ++m)
#pragma unroll
                for (int n = 0; n < 2; ++n) E(cur, ai * HALF + wr * 64 + m * 16 + fr, wc * 32 + n * 16 + 4 * fq, acc[ai][0][m][n], acc[ai][1][m][n]);
        if (!has_next) break;
#pragma unroll
        for (int a = 0; a < 2; ++a)
#pragma unroll
            for (int b = 0; b < 2; ++b)
#pragma unroll
                for (int m = 0; m < 4; ++m)
#pragma unroll
                    for (int n = 0; n < 2; ++n) acc[a][b][m][n] = (f32x4){0.f, 0.f, 0.f, 0.f};
        cur = nxt; cA = nA; cB = nB; ++ui;
        if (wr == 1) PG8_BAR;
    }
    PG8_WAIT_V(0);
    PG8_BAR;
#undef PG8_SA
#undef PG8_SB
#undef PG8_STAGE
#undef PG8_STAGE_A
#undef PG8_LDA
#undef PG8_LDB
#undef PG8_MMA
#undef PG8_WAIT_V
#undef PG8_WAIT_L
#undef PG8_BAR
#undef PG8_SCHED
#undef PG8_SETV
}

DI int xcd_remap(int L, int n) { const int q = n >> 3, r = n & 7, xcd = L & 7, off = L >> 3; return (xcd < r ? xcd * (q + 1) : r * (q + 1) + (xcd - r) * q) + off; }
DI void grouped(int wgid, int nM, int nN, int& pm, int& pn) { const int nig = 8 * nN, gid = wgid / nig, fm = gid * 8, gsz = min(nM - fm, 8); pm = fm + (wgid % nig) % gsz; pn = (wgid % nig) / gsz; }

struct SchedInProj { const bf16* U; const bf16* W;
    DI bool get(int L, Unit& u) const { int pm, pn;
        if (L >= 64 * 24 + 32) return false; const int w = xcd_remap(L, 64 * 24 + 32);
        if (w < 64 * 24) grouped(w, 64, 24, pm, pn); else { const int l2 = w - 64 * 24; pm = 64 + (l2 >> 3); pn = 4 + (l2 & 7); }
        u.A = U + (size_t)pm * 256 * D; u.B = W + (size_t)pn * 256 * D; u.gat = nullptr; u.nvalid = 256; u.m0 = pm * 256; u.n0 = pn * 256; u.aux = 0; return true; } };
struct SchedDense { const bf16* A; const bf16* B; int nM, nN; size_t a_t, b_t;
    DI bool get(int L, Unit& u) const { if (L >= nM * nN) return false; int pm, pn; grouped(xcd_remap(L, nM * nN), nM, nN, pm, pn);
        u.A = A + (size_t)pm * a_t; u.B = B + (size_t)pn * b_t; u.gat = nullptr; u.nvalid = 256; u.m0 = pm * 256; u.n0 = pn * 256; u.aux = 0; return true; } };
struct SchedMoe { const LAS int* cnt; const LAS int* tb; const bf16* A; const bf16* W; const int* table; int gather; size_t a_t, w_e, w_t;
    DI bool get(int L, Unit& u) const { const int nT = __builtin_amdgcn_readfirstlane(tb[32]); if (L >= nT * 8) return false; int t, pn; grouped(xcd_remap(L, nT * 8), nT, 8, t, pn);
        int e = 0;
        for (int i = 1; i < 32; ++i) e = (tb[i] <= t) ? i : e;
        e = __builtin_amdgcn_readfirstlane(e); t = __builtin_amdgcn_readfirstlane(t); pn = __builtin_amdgcn_readfirstlane(pn);
        const int mt = __builtin_amdgcn_readfirstlane(t - tb[e]);
        if (gather) { u.A = A; u.gat = table + (size_t)e * T + mt * 256; } else { u.A = A + (size_t)t * a_t; u.gat = nullptr; }
        u.nvalid = __builtin_amdgcn_readfirstlane(min(256, cnt[e] - mt * 256));
        u.B = W + (size_t)e * w_e + (size_t)pn * w_t; u.m0 = t * 256; u.n0 = pn * 256; u.aux = e; return true; } };
struct SchedChan { const bf16* PCAT; const bf16* CSB;
    DI bool get(int L, Unit& u) const { if (L >= 512) return false; int pm, q; grouped(xcd_remap(L, 512), 64, 8, pm, q); const int g = q >> 1, pn = q & 1;
        u.A = PCAT + (size_t)pm * 256 * 4096 + g * 1024; u.B = CSB + (size_t)pn * 256 * 1024; u.gat = nullptr; u.nvalid = 256; u.m0 = pm * 256; u.n0 = g * 512 + pn * 256; u.aux = g; return true; } };

DI void st_bf16x4(bf16* p, f32x4 v) { u32x2 w; w.x = pk2(v.x, v.y); w.y = pk2(v.z, v.w); *(u32x2*)p = w; }
struct EpiStoreBf16 { bf16* O; int ldc;
    DI void operator()(const Unit& u, int r, int c, f32x4 lo, f32x4 hi) const { bf16* p = O + (size_t)(u.m0 + r) * ldc + u.n0 + c; st_bf16x4(p, lo); st_bf16x4(p + 128, hi); } };
struct EpiResid { const float* x; float* t; const float* gate;
    DI void operator()(const Unit& u, int r, int c, f32x4 lo, f32x4 hi) const { const int row = u.m0 + r, b = row >> 12; const int col = u.n0 + c;
        const size_t o = (size_t)row * D + col; const float* g = gate + (size_t)b * MODW + col;
        *(f32x4*)(t + o) = *(const f32x4*)(x + o) * ALPHA + *(const f32x4*)g * lo;
        *(f32x4*)(t + o + 128) = *(const f32x4*)(x + o + 128) * ALPHA + *(const f32x4*)(g + 128) * hi; } };
struct EpiSwiglu { bf16* H;
    DI void operator()(const Unit& u, int r, int c, f32x4 lo, f32x4 hi) const { f32x4 h;
        h.x = silu_fast(lo.x) * hi.x; h.y = silu_fast(lo.y) * hi.y; h.z = silu_fast(lo.z) * hi.z; h.w = silu_fast(lo.w) * hi.w;
        st_bf16x4(H + (size_t)(u.m0 + r) * DE + (u.n0 >> 1) + c, h); } };
DI void p0_mods_unit(const float* ada_w, const float* ada_b, float* mods, const LAS float* sl, LAS float* red, int unit, int tid) {
    const int cg = tid & 31, ks = tid >> 5, l = unit / 96, n0 = (unit % 96) * 128;
    const float* W = ada_w + (size_t)l * D * MODW + n0 + 4 * cg;
    f32x4 a0 = (f32x4){0.f, 0.f, 0.f, 0.f}, a1 = a0, a2 = a0, a3 = a0, a4 = a0;
#pragma unroll 8
    for (int k = ks * 128; k < ks * 128 + 128; ++k) { const f32x4 w = *(const f32x4*)(W + (size_t)k * MODW); a0 += w * sl[k]; a1 += w * sl[D + k]; a2 += w * sl[2 * D + k]; a3 += w * sl[3 * D + k]; a4 += w * sl[4 * D + k]; }
    *(LAS f32x4*)(red + (ks * 5 + 0) * 128 + 4 * cg) = a0; *(LAS f32x4*)(red + (ks * 5 + 1) * 128 + 4 * cg) = a1; *(LAS f32x4*)(red + (ks * 5 + 2) * 128 + 4 * cg) = a2;
    *(LAS f32x4*)(red + (ks * 5 + 3) * 128 + 4 * cg) = a3; *(LAS f32x4*)(red + (ks * 5 + 4) * 128 + 4 * cg) = a4;
    __syncthreads();
    for (int i = tid; i < 640; i += 512) { const int r = i >> 7, q = i & 127; float sacc = 0.f;
#pragma unroll
        for (int k2 = 0; k2 < 16; ++k2) sacc += red[(k2 * 5 + r) * 128 + q];
        mods[((size_t)l * 5 + r) * MODW + n0 + q] = sacc + ada_b[(size_t)l * MODW + n0 + q]; }
    __syncthreads();
}
DI void tr_item(const float* W, int N, int Kd, int k0, int n0, bf16* WT, int drow0, LAS unsigned char* scr, int lane) {
    const int ng = lane & 15, kl = lane >> 4;
    f32x4 v[2][8];
    const float* src = W + (size_t)(k0 + 16 * kl) * N + n0 + 4 * ng;
#pragma unroll
    for (int pp = 0; pp < 2; ++pp)
#pragma unroll
        for (int i = 0; i < 8; ++i) v[pp][i] = *(const f32x4*)(src + (size_t)(8 * pp + i) * N);
#pragma unroll
    for (int pp = 0; pp < 2; ++pp)
#pragma unroll
        for (int c = 0; c < 4; ++c) { u32x4 o; o.x = pk2(v[pp][0][c], v[pp][1][c]); o.y = pk2(v[pp][2][c], v[pp][3][c]); o.z = pk2(v[pp][4][c], v[pp][5][c]); o.w = pk2(v[pp][6][c], v[pp][7][c]);
            *(LAS u32x4*)(scr + (4 * ng + c) * 144 + (16 * kl + 8 * pp) * 2) = o; }
    asm volatile("s_waitcnt lgkmcnt(0)" ::: "memory");
#pragma unroll
    for (int j = 0; j < 8; ++j) { const int row = (lane >> 3) + 8 * j, ch = lane & 7;
        const u32x4 o = *(const LAS u32x4*)(scr + row * 144 + ch * 16);
        *(u32x4*)(WT + (size_t)(drow0 + row) * Kd + k0 + 8 * ch) = o; }
    asm volatile("s_waitcnt lgkmcnt(0)" ::: "memory");
}
constexpr int P0_S_IN = 8 * 48, P0_S_SQ = 8 * 16, P0_S_E = 64 * 64, P0_NSI = P0_S_IN + 2 * P0_S_SQ + 3 * P0_S_E, P0_NMODS = 192;
DI void p0_weight_item(int si, const float* w_in, const float* w_out, const float* w_f, const float* w_gate, const float* w_up, const float* w_down,
                       bf16* WIN, bf16* WO, bf16* WF, bf16* WGU, bf16* WD, LAS unsigned char* scr, int wave, int lane) {
    const int dk = wave >> 1, dn = wave & 1; int r = si;
    if (r < P0_S_IN) { const int kb = (r / 48) * 4 + dk, nb = (r % 48) * 2 + dn; tr_item(w_in, NMIX, D, kb * 64, nb * 64, WIN, nb * 64, scr, lane); return; } r -= P0_S_IN;
    if (r < P0_S_SQ) { const int kb = (r >> 4) * 4 + dk, nb = (r & 15) * 2 + dn; tr_item(w_out, D, D, kb * 64, nb * 64, WO, nb * 64, scr, lane); return; } r -= P0_S_SQ;
    if (r < P0_S_SQ) { const int kb = (r >> 4) * 4 + dk, nb = (r & 15) * 2 + dn; tr_item(w_f, D, D, kb * 64, nb * 64, WF, nb * 64, scr, lane); return; } r -= P0_S_SQ;
    if (r < 2 * P0_S_E) { const int up = r >= P0_S_E; if (up) r -= P0_S_E; const int mat = r >> 6, rr = r & 63, kb = (rr >> 3) * 4 + dk, nb = (rr & 7) * 2 + dn, n0 = nb * 64;
        tr_item((up ? w_up : w_gate) + (size_t)mat * D * DE, DE, D, kb * 64, n0, WGU + (size_t)mat * D * D, (n0 >> 7) * 256 + (n0 & 127) + (up ? 128 : 0), scr, lane); return; } r -= 2 * P0_S_E;
    { const int mat = r >> 6, rr = r & 63, kb = (rr >> 4) * 4 + dk, nb = (rr & 15) * 2 + dn; tr_item(w_down + (size_t)mat * DE * D, D, DE, kb * 64, nb * 64, WD + (size_t)mat * D * DE, nb * 64, scr, lane); }
}
DI void p0_dft(bf16* CSB, int gtid, int GT) {
    for (int i = gtid; i < 512 * 128; i += GT) { const int cp = i >> 7, k8 = (i & 127) * 8; unsigned w[4];
#pragma unroll
        for (int e = 0; e < 4; ++e) { float v[2];
#pragma unroll
            for (int q = 0; q < 2; ++q) { const int kk = k8 + 2 * e + q; const int m = (cp * (kk & 511)) & 511; const float ang = (float)m * (1.f / 256.f); v[q] = (kk < 512 ? cospif(ang) : sinpif(ang)) * 0.04419417382415922f; }
            w[e] = pk2(v[0], v[1]); }
        *(u32x4*)(CSB + (size_t)cp * 1024 + k8) = (u32x4){w[0], w[1], w[2], w[3]}; }
}
DI void ln_mod_phase(const float* x, const float* ctx, const float* mods_l, int sh_chunk, bf16* U, int nrows, int gw, int NGW, int lane) {
    int row = gw; if (row >= nrows) return;
    Row cur; row_load(cur, row < T ? x + (size_t)row * D : ctx + (size_t)(row - T) * D, lane);
    for (; row < nrows; row += NGW) {
        const int nr = row + NGW < nrows ? row + NGW : row;
        Row nxt; row_load(nxt, nr < T ? x + (size_t)nr * D : ctx + (size_t)(nr - T) * D, lane);
        const int rb = row < T ? (row >> 12) : 4;
        row_ln(cur);
        const float* mr = mods_l + (size_t)rb * MODW + sh_chunk * D;
        row_modulate(cur, mr, mr + D, lane);
        row_store_bf16(cur, U + (size_t)row * D, lane);
        cur = nxt;
    }
}
DI void attn_simple(const bf16* P, const float* rpb, bf16* MIX, LAS float* scr, int gw, int NGW, int lane) {
    const float scale = 0.08838834764831845f;
    for (int item = gw; item < T * NH; item += NGW) {
        const int tok = item >> 3, h = item & 7, b = tok >> 12, l = tok & 4095, r = l >> 6, qc = l & 63;
        const int rs = min(max(r - 4, 0), 56), cs = min(max(qc - 8, 0), 48);
        { const unsigned w = *((const unsigned*)(P + (size_t)tok * NMIX + h * HD) + lane); scr[2 * lane] = bflo(w); scr[2 * lane + 1] = bfhi(w); }
        asm volatile("s_waitcnt lgkmcnt(0)" ::: "memory");
        float s[6];
#pragma unroll
        for (int i = 0; i < 6; ++i) {
            const int kk = lane + 64 * i; size_t krow; float bias = 0.f;
            if (kk < 128) { const int a = kk >> 4, j = kk & 15; krow = (size_t)b * SEQ + 64 * (rs + a) + cs + j; bias = rpb[(h * 15 + (rs + a - r + 7)) * 31 + (cs + j - qc + 15)]; }
            else krow = (size_t)T + b * CTXL + (kk - 128);
            const u32x4* kp = (const u32x4*)(P + krow * NMIX + D / 2 + h * HD);
            float acc = 0.f;
#pragma unroll 4
            for (int d8 = 0; d8 < 16; ++d8) { const u32x4 kv = kp[d8]; const LAS f32x4* qv = (const LAS f32x4*)scr + 2 * d8; const f32x4 q0 = qv[0], q1 = qv[1];
                acc += bflo(kv.x) * q0.x + bfhi(kv.x) * q0.y + bflo(kv.y) * q0.z + bfhi(kv.y) * q0.w + bflo(kv.z) * q1.x + bfhi(kv.z) * q1.y + bflo(kv.w) * q1.z + bfhi(kv.w) * q1.w; }
            s[i] = acc * scale + bias;
        }
        float m = s[0];
#pragma unroll
        for (int i = 1; i < 6; ++i) m = fmaxf(m, s[i]);
        m = wave_max(m); float sum = 0.f;
#pragma unroll
        for (int i = 0; i < 6; ++i) { s[i] = expf(s[i] - m); sum += s[i]; scr[128 + lane + 64 * i] = s[i]; }
        sum = wave_sum(sum);
        asm volatile("s_waitcnt lgkmcnt(0)" ::: "memory");
        float o0 = 0.f, o1 = 0.f;
        for (int kk = 0; kk < 384; ++kk) {
            size_t vrow; if (kk < 128) vrow = (size_t)b * SEQ + 64 * (rs + (kk >> 4)) + cs + (kk & 15); else vrow = (size_t)T + b * CTXL + (kk - 128);
            const unsigned w = *((const unsigned*)(P + vrow * NMIX + D + h * HD) + lane); const float p = scr[128 + kk];
            o0 += p * bflo(w); o1 += p * bfhi(w);
        }
        const float inv = 1.f / sum;
        *((unsigned*)(MIX + (size_t)tok * D + h * HD) + lane) = pk2(o0 * inv, o1 * inv);
        asm volatile("s_waitcnt lgkmcnt(0)" ::: "memory");
    }
}

constexpr int ATT_RS = 288, ATT_TILE = 64 * ATT_RS, ATT_BUF = 2 * ATT_TILE;
typedef short s16x4 __attribute__((ext_vector_type(4)));
struct AttState { f32x4 sc[32]; unsigned pk[32][2]; f32x4 o[8]; u32x4 stg[4]; bf16x8 qf[4]; float inv; unsigned g_off, w_off, ka_off, va_off; };
struct AttCtx { const bf16* P; LAS unsigned char* lds; const LAS float* lrpb; int b, r, rs, hp, hs, c0, qc, csq, quad; };
template <int STEP> DI void att_load(AttState& S, const AttCtx& C) {
    constexpr int ti = STEP % 12; const int colb = (STEP < 12 ? 1024 : 2048) + C.hp * 256;
    const size_t tok0 = ti < 8 ? (size_t)C.b * SEQ + 64 * (C.rs + ti) : (size_t)T + C.b * CTXL + (ti - 8) * 64;
    const char* ub = (const char*)(C.P + tok0 * NMIX + colb);
#pragma unroll
    for (int k = 0; k < 4; ++k) S.stg[k] = *(const u32x4*)(ub + (size_t)(32 * (k & 1)) * NMIX * 2 + (k >> 1) * 256 + S.g_off);
}
template <int BUFI> DI void att_write(AttState& S, const AttCtx& C) {
#pragma unroll
    for (int k = 0; k < 4; ++k) *(LAS u32x4*)(C.lds + BUFI * ATT_BUF + (k >> 1) * ATT_TILE + 32 * (k & 1) * ATT_RS + S.w_off) = S.stg[k];
}
template <int STEP> DI void att_step(AttState& S, const AttCtx& C) {
    const float scale = 0.08838834764831845f;
    asm volatile("" : "+v"(S.g_off), "+v"(S.w_off), "+v"(S.ka_off), "+v"(S.va_off));
    if constexpr (STEP + 1 < 24) att_load<STEP + 1>(S, C);
    constexpr int bo = (STEP & 1) * ATT_BUF;
    if constexpr (STEP < 12) {
        constexpr int ti = STEP;
        if constexpr (ti < 8) {
            const int aidx = C.rs + ti - C.r + 7;
            const LAS float* brow = C.lrpb + C.hs * 465 + aidx * 31;
#pragma unroll
            for (int t = 0; t < 2; ++t) { const int krow0 = C.c0 + 16 * t; f32x4 acc = (f32x4){0.f, 0.f, 0.f, 0.f};
                const LAS unsigned char* ka = C.lds + bo + krow0 * ATT_RS + S.ka_off;
#pragma unroll
                for (int s4 = 0; s4 < 4; ++s4) acc = __builtin_amdgcn_mfma_f32_16x16x32_bf16(*(const LAS bf16x8*)(ka + s4 * 64), S.qf[s4], acc, 0, 0, 0);
#pragma unroll
                for (int i = 0; i < 4; ++i) { const int kcol = krow0 + C.quad * 4 + i; const bool ok = kcol >= C.csq && kcol < C.csq + 16; const int bi = min(max(kcol - C.qc + 15, 0), 30);
                    const float bias = brow[bi]; S.sc[ti * 2 + t][i] = ok ? acc[i] * scale + bias : -1e30f; } }
        } else {
#pragma unroll
            for (int t = 0; t < 4; ++t) { f32x4 acc = (f32x4){0.f, 0.f, 0.f, 0.f};
                const LAS unsigned char* ka = C.lds + bo + 16 * t * ATT_RS + S.ka_off;
#pragma unroll
                for (int s4 = 0; s4 < 4; ++s4) acc = __builtin_amdgcn_mfma_f32_16x16x32_bf16(*(const LAS bf16x8*)(ka + s4 * 64), S.qf[s4], acc, 0, 0, 0);
                S.sc[16 + (ti - 8) * 4 + t] = acc * scale; }
        }
    } else {
        if constexpr (STEP == 12) {
            float m = -1e30f;
#pragma unroll
            for (int sl = 0; sl < 32; ++sl) m = fmaxf(fmaxf(m, fmaxf(S.sc[sl][0], S.sc[sl][1])), fmaxf(S.sc[sl][2], S.sc[sl][3]));
            m = fmaxf(m, __shfl_xor(m, 16)); m = fmaxf(m, __shfl_xor(m, 32));
            float sum = 0.f;
#pragma unroll
            for (int sl = 0; sl < 32; ++sl) { const float e0 = __expf(S.sc[sl][0] - m), e1 = __expf(S.sc[sl][1] - m), e2 = __expf(S.sc[sl][2] - m), e3 = __expf(S.sc[sl][3] - m);
                sum += (e0 + e1) + (e2 + e3); S.pk[sl][0] = pk2(e0, e1); S.pk[sl][1] = pk2(e2, e3); }
            sum += __shfl_xor(sum, 16); sum += __shfl_xor(sum, 32); S.inv = 1.f / sum;
#pragma unroll
            for (int dt = 0; dt < 8; ++dt) S.o[dt] = (f32x4){0.f, 0.f, 0.f, 0.f};
        }
        constexpr int ti = STEP - 12; constexpr int nks = ti < 8 ? 1 : 2;
#pragma unroll
        for (int kk = 0; kk < nks; ++kk) {
            const int sa = ti < 8 ? ti * 2 : 16 + (ti - 8) * 4 + 2 * kk; const int rb = ti < 8 ? C.c0 : 32 * kk;
            const u32x4 pw = (u32x4){S.pk[sa][0], S.pk[sa][1], S.pk[sa + 1][0], S.pk[sa + 1][1]}; const bf16x8 pf = __builtin_bit_cast(bf16x8, pw);
            const LAS unsigned char* va = C.lds + bo + rb * ATT_RS + S.va_off;
#pragma unroll
            for (int dt = 0; dt < 8; ++dt) { const s16x4 v1 = __builtin_amdgcn_ds_read_tr16_b64_v4i16((LAS s16x4*)(va + dt * 32)); const s16x4 v2 = __builtin_amdgcn_ds_read_tr16_b64_v4i16((LAS s16x4*)(va + 16 * ATT_RS + dt * 32));
                const bf16x8 vf = __builtin_shufflevector(v1, v2, 0, 1, 2, 3, 4, 5, 6, 7); S.o[dt] = __builtin_amdgcn_mfma_f32_16x16x32_bf16(vf, pf, S.o[dt], 0, 0, 0); }
        }
    }
    if constexpr (STEP + 1 < 24) { if constexpr (STEP >= 12) asm volatile("s_waitcnt lgkmcnt(0)" ::: "memory");
        att_write<(STEP + 1) & 1>(S, C); }
    __syncthreads();
}
DI void attn_phase(const bf16* P, const float* rpb, bf16* MIX, LAS unsigned char* lds, LAS float* lrpb) {
    const int tid = threadIdx.x, wid = __builtin_amdgcn_readfirstlane(tid >> 6), lane = tid & 63, hs = wid >> 2, j = wid & 3, lq = lane & 15, quad = lane >> 4;
    const int srow = tid >> 4, sch = tid & 15;
    AttState S; AttCtx C;
    C.P = P; C.lds = lds; C.lrpb = lrpb; C.hs = hs; C.quad = quad;
    C.c0 = (j == 0) ? 0 : (j == 1) ? 8 : (j == 2) ? 24 : 32;
    C.qc = 16 * j + lq; C.csq = min(max(C.qc - 8, 0), 48);
    S.g_off = (unsigned)(srow * NMIX + sch * 8) * 2u;
    S.w_off = (unsigned)(srow * ATT_RS + sch * 16);
    S.ka_off = (unsigned)(hs * ATT_TILE + lq * ATT_RS + quad * 16);
    S.va_off = (unsigned)(hs * ATT_TILE + (4 * quad + (lq >> 2)) * ATT_RS + 8 * (lq & 3));
    for (int unit = blockIdx.x; unit < 1024; unit += gridDim.x) {
        const int r = unit & 63, hp = (unit >> 6) & 3, b = unit >> 8, h = 2 * hp + hs;
        C.r = r; C.hp = hp; C.b = b; C.rs = min(max(r - 4, 0), 56);
        __syncthreads();
        for (int i = tid; i < 930; i += 512) lrpb[i] = rpb[(size_t)hp * 930 + i];
        const size_t tq = (size_t)b * SEQ + 64 * r + C.qc;
#pragma unroll
        for (int s4 = 0; s4 < 4; ++s4) S.qf[s4] = *(const bf16x8*)(P + tq * NMIX + h * HD + s4 * 32 + quad * 8);
        att_load<0>(S, C); att_write<0>(S, C); __syncthreads();
        att_step<0>(S, C); att_step<1>(S, C); att_step<2>(S, C); att_step<3>(S, C); att_step<4>(S, C); att_step<5>(S, C); att_step<6>(S, C); att_step<7>(S, C);
        att_step<8>(S, C); att_step<9>(S, C); att_step<10>(S, C); att_step<11>(S, C); att_step<12>(S, C); att_step<13>(S, C); att_step<14>(S, C); att_step<15>(S, C);
        att_step<16>(S, C); att_step<17>(S, C); att_step<18>(S, C); att_step<19>(S, C); att_step<20>(S, C); att_step<21>(S, C); att_step<22>(S, C); att_step<23>(S, C);
        bf16* op = MIX + tq * D + h * HD + quad * 4;
#pragma unroll
        for (int dt = 0; dt < 8; ++dt) st_bf16x4(op + dt * 16, S.o[dt] * S.inv);
    }
}


constexpr int FF_RS = 544;
DI bf16x8 fft_frag(int kind  , int k, int s, int kq) {
    unsigned w[4];
#pragma unroll
    for (int p = 0; p < 4; ++p) { float v[2];
#pragma unroll
        for (int q = 0; q < 2; ++q) { const int j = 2 * p + q; const int jj = 32 * s + (j < 4 ? 4 * kq + j : 16 + 4 * kq + (j - 4)); const float rev = (float)((k * jj) & 63) * (1.f / 64.f);
            v[q] = (kind == 0 ? __builtin_amdgcn_cosf(rev) : kind == 1 ? -__builtin_amdgcn_sinf(rev) : __builtin_amdgcn_sinf(rev)) * 0.125f; }
        w[p] = pk2(v[0], v[1]); }
    return __builtin_bit_cast(bf16x8, (u32x4){w[0], w[1], w[2], w[3]});
}
DI bf16x8 fft_tr(const LAS unsigned char* p) { const s16x4 v1 = __builtin_amdgcn_ds_read_tr16_b64_v4i16((LAS s16x4*)p), v2 = __builtin_amdgcn_ds_read_tr16_b64_v4i16((LAS s16x4*)(p + 16 * FF_RS));
    return __builtin_shufflevector(v1, v2, 0, 1, 2, 3, 4, 5, 6, 7); }
DI void fft1_phase(const bf16* Up, bf16* YP, LAS unsigned char* lds) {
    const int tid = threadIdx.x, wave = __builtin_amdgcn_readfirstlane(tid >> 6), lane = tid & 63, ml = lane & 15, quad = lane >> 4;
    bf16x8 Ff[8][2];
#pragma unroll
    for (int mt = 0; mt < 8; ++mt)
#pragma unroll
        for (int s2 = 0; s2 < 2; ++s2) Ff[mt][s2] = fft_frag(mt < 4 ? 0 : 1, (16 * mt + ml) & 63, s2, quad);
    LAS float* tw = (LAS float*)(lds + 64 * FF_RS);
    const unsigned va_off = (unsigned)((4 * quad + (ml >> 2)) * FF_RS + 8 * (ml & 3) + 64 * wave);
    for (int unit = blockIdx.x; unit < 2048; unit += gridDim.x) {
        const int b = unit >> 9, j2 = (unit >> 3) & 63, c0 = (unit & 7) * 256;
        __syncthreads();
#pragma unroll
        for (int q = 0; q < 4; ++q) { const int j1 = (tid >> 5) + 16 * q;
            *(LAS u32x4*)(lds + j1 * FF_RS + (tid & 31) * 16) = *(const u32x4*)(Up + ((size_t)b * SEQ + 64 * j1 + j2) * D + c0 + (tid & 31) * 8); }
        if (tid < 64) { const float rev = (float)(j2 * tid) * (1.f / 4096.f); tw[2 * tid] = __builtin_amdgcn_cosf(rev); tw[2 * tid + 1] = __builtin_amdgcn_sinf(rev); }
        __syncthreads();
        float cth4[4], sth4[4];
#pragma unroll
        for (int mp = 0; mp < 4; ++mp) { cth4[mp] = tw[2 * (16 * mp + ml)]; sth4[mp] = tw[2 * (16 * mp + ml) + 1]; }
        asm volatile("s_waitcnt lgkmcnt(0)" : "+v"(cth4[0]), "+v"(cth4[1]), "+v"(cth4[2]), "+v"(cth4[3]), "+v"(sth4[0]), "+v"(sth4[1]), "+v"(sth4[2]), "+v"(sth4[3]) :: "memory");
        f32x4 acc[8][2];
#pragma unroll
        for (int mt = 0; mt < 8; ++mt) { acc[mt][0] = (f32x4){0.f, 0.f, 0.f, 0.f}; acc[mt][1] = acc[mt][0]; }
#pragma unroll
        for (int s2 = 0; s2 < 2; ++s2)
#pragma unroll
            for (int nt = 0; nt < 2; ++nt) { const bf16x8 zf = fft_tr(lds + va_off + 32 * s2 * FF_RS + 32 * nt);
#pragma unroll
                for (int mt = 0; mt < 8; ++mt) acc[mt][nt] = __builtin_amdgcn_mfma_f32_16x16x32_bf16(zf, Ff[mt][s2], acc[mt][nt], 0, 0, 0); }
#pragma unroll
        for (int mp = 0; mp < 4; ++mp) { const int k1 = 16 * mp + ml; const float cth = cth4[mp], sth = sth4[mp];
            bf16* dr = YP + ((((size_t)b * 64 + k1) * 2) * 64 + j2) * D + c0 + 32 * wave + 4 * quad;
#pragma unroll
            for (int nt = 0; nt < 2; ++nt) { const f32x4 yr = acc[mp][nt], yi = acc[mp + 4][nt];
                st_bf16x4(dr + 16 * nt, yr * cth + yi * sth); st_bf16x4(dr + (size_t)64 * D + 16 * nt, yi * cth - yr * sth); } }
    }
}
DI void fft2_phase(const bf16* YP, bf16* PCAT, LAS unsigned char* lds) {
    const int tid = threadIdx.x, wave = __builtin_amdgcn_readfirstlane(tid >> 6), lane = tid & 63, ml = lane & 15, quad = lane >> 4;
    bf16x8 Cf[4][2], Sf[4][2], Nf[4][2];
#pragma unroll
    for (int mt = 0; mt < 4; ++mt)
#pragma unroll
        for (int s2 = 0; s2 < 2; ++s2) { Cf[mt][s2] = fft_frag(0, 16 * mt + ml, s2, quad); Nf[mt][s2] = fft_frag(1, 16 * mt + ml, s2, quad); Sf[mt][s2] = fft_frag(2, 16 * mt + ml, s2, quad); }
    const unsigned va_off = (unsigned)((4 * quad + (ml >> 2)) * FF_RS + 8 * (ml & 3) + 64 * wave);
    for (int unit = blockIdx.x; unit < 2048; unit += gridDim.x) {
        const int b = unit >> 9, k1 = (unit >> 3) & 63, cc = unit & 7, c0 = cc * 256;
        __syncthreads();
#pragma unroll
        for (int q = 0; q < 8; ++q) { const int kr = (tid >> 5) + 16 * q;
            *(LAS u32x4*)(lds + kr * FF_RS + (tid & 31) * 16) = *(const u32x4*)(YP + (((size_t)b * 64 + k1) * 128 + kr) * D + c0 + (tid & 31) * 8); }
        __syncthreads();
        f32x4 acc[8][2];
#pragma unroll
        for (int mt = 0; mt < 8; ++mt) { acc[mt][0] = (f32x4){0.f, 0.f, 0.f, 0.f}; acc[mt][1] = acc[mt][0]; }
#pragma unroll
        for (int s4 = 0; s4 < 4; ++s4)
#pragma unroll
            for (int nt = 0; nt < 2; ++nt) { const bf16x8 yf = fft_tr(lds + va_off + 32 * s4 * FF_RS + 32 * nt);
#pragma unroll
                for (int mt = 0; mt < 4; ++mt) {
                    if (s4 < 2) { acc[mt][nt] = __builtin_amdgcn_mfma_f32_16x16x32_bf16(yf, Cf[mt][s4], acc[mt][nt], 0, 0, 0); acc[mt + 4][nt] = __builtin_amdgcn_mfma_f32_16x16x32_bf16(yf, Nf[mt][s4], acc[mt + 4][nt], 0, 0, 0); }
                    else { acc[mt][nt] = __builtin_amdgcn_mfma_f32_16x16x32_bf16(yf, Sf[mt][s4 - 2], acc[mt][nt], 0, 0, 0); acc[mt + 4][nt] = __builtin_amdgcn_mfma_f32_16x16x32_bf16(yf, Cf[mt][s4 - 2], acc[mt + 4][nt], 0, 0, 0); } } }
        const int g = cc >> 1, cp0 = (cc & 1) * 256 + 32 * wave + 4 * quad;
#pragma unroll
        for (int mt = 0; mt < 8; ++mt) { const int part = mt >> 2, k2 = 16 * (mt & 3) + ml;
            bf16* dp = PCAT + ((size_t)b * SEQ + k1 + 64 * k2) * 4096 + g * 1024 + part * 512 + cp0;
            st_bf16x4(dp, acc[mt][0]); st_bf16x4(dp + 16, acc[mt][1]); }
    }
}

DI void conv_phase(const bf16* P, const float* cw, bf16* MIX, int gtid, int GT) {
    for (int i = gtid; i < T * 128; i += GT) {
        const int tok = i >> 7, c8 = (i & 127) * 8, l = tok & 4095;
        const bf16* base = P + (size_t)tok * NMIX + 3072 + c8;
        const u32x4 gb = *(const u32x4*)base;
        float z[3][8];
#pragma unroll
        for (int j = 0; j < 3; ++j) { const int ll = l + j - 1; const bool ok = ll >= 0 && ll < SEQ;
            u32x4 gc = (u32x4){0u, 0u, 0u, 0u}, xi = gc;
            if (ok) { const bf16* pj = base + (ptrdiff_t)(j - 1) * NMIX; gc = *(const u32x4*)(pj + 1024); xi = *(const u32x4*)(pj + 2048); }
            z[j][0] = bflo(gc.x) * bflo(xi.x); z[j][1] = bfhi(gc.x) * bfhi(xi.x); z[j][2] = bflo(gc.y) * bflo(xi.y); z[j][3] = bfhi(gc.y) * bfhi(xi.y);
            z[j][4] = bflo(gc.z) * bflo(xi.z); z[j][5] = bfhi(gc.z) * bfhi(xi.z); z[j][6] = bflo(gc.w) * bflo(xi.w); z[j][7] = bfhi(gc.w) * bfhi(xi.w); }
        float gbf[8] = {bflo(gb.x), bfhi(gb.x), bflo(gb.y), bfhi(gb.y), bflo(gb.z), bfhi(gb.z), bflo(gb.w), bfhi(gb.w)};
        float o[8];
#pragma unroll
        for (int e = 0; e < 8; ++e) o[e] = gbf[e] * (cw[c8 + e] * z[0][e] + cw[1024 + c8 + e] * z[1][e] + cw[2048 + c8 + e] * z[2][e]);
        *(u32x4*)(MIX + (size_t)tok * D + 1024 + c8) = (u32x4){pk2(o[0], o[1]), pk2(o[2], o[3]), pk2(o[4], o[5]), pk2(o[6], o[7])};
    }
}
constexpr int RT_RS = 4112, RT_IMG = 16 * RT_RS;
DI void split_bf16(const float* w8, bf16x8& hi, bf16x8& lo) {
    unsigned h[4], l[4];
#pragma unroll
    for (int p = 0; p < 4; ++p) { const unsigned a = f2bf(w8[2 * p]), b = f2bf(w8[2 * p + 1]); h[p] = a | (b << 16);
        l[p] = pk2(w8[2 * p] - __uint_as_float(a << 16), w8[2 * p + 1] - __uint_as_float(b << 16)); }
    hi = __builtin_bit_cast(bf16x8, (u32x4){h[0], h[1], h[2], h[3]}); lo = __builtin_bit_cast(bf16x8, (u32x4){l[0], l[1], l[2], l[3]});
}
DI void ln_router_phase(const float* XSp, const bf16* YMp, const float* lng, const float* lnb, const float* mods_l, const float* rw, const float* rbias,
                        float* X1p, bf16* Up, unsigned* counts, int* tablep, unsigned* tokinfop, LAS unsigned char* lds) {
    const int tid = threadIdx.x, wave = __builtin_amdgcn_readfirstlane(tid >> 6), lane = tid & 63, fr = lane & 15, fq = lane >> 4;
    bf16x8 bh[8][2], bl[8][2];
#pragma unroll
    for (int ks = 0; ks < 8; ++ks)
#pragma unroll
        for (int nt = 0; nt < 2; ++nt) { float w8[8];
#pragma unroll
            for (int j = 0; j < 8; ++j) w8[j] = rw[(size_t)(256 * wave + 32 * ks + 8 * fq + j) * NE + nt * 16 + fr];
            split_bf16(w8, bh[ks][nt], bl[ks][nt]); }
    LAS float* part = (LAS float*)lds; LAS float* lgs = (LAS float*)(lds + 16384);
    for (int rg = blockIdx.x; rg < T / 16; rg += gridDim.x) {
        __syncthreads();
#pragma unroll 1
        for (int rr = 0; rr < 2; ++rr) {
            const int lr = 2 * wave + rr, row = rg * 16 + lr;
            Row r; row_load(r, XSp + (size_t)row * D, lane);
            { const u32x2* yq = (const u32x2*)(YMp + (size_t)row * D) + lane; const f32x4* g1 = (const f32x4*)(mods_l + (size_t)(row >> 12) * MODW + 2 * D) + lane;
#pragma unroll
              for (int j = 0; j < 8; ++j) { const u32x2 yv = yq[64 * j]; const f32x4 yf = (f32x4){bflo(yv.x), bfhi(yv.x), bflo(yv.y), bfhi(yv.y)}; r.v[j] = r.v[j] * ALPHA + g1[64 * j] * yf; } }
            row_ln(r); row_affine(r, lng, lnb, lane);
            row_store(r, X1p + (size_t)row * D, lane);
            row_ln(r);
            const float* mr = mods_l + (size_t)(row >> 12) * MODW + 3 * D;
            row_modulate(r, mr, mr + D, lane);
            u32x2* uq = (u32x2*)(Up + (size_t)row * D) + lane;
#pragma unroll
            for (int j = 0; j < 8; ++j) { const unsigned a = f2bf(r.v[j].x), b = f2bf(r.v[j].y), c = f2bf(r.v[j].z), d = f2bf(r.v[j].w);
                u32x2 hi; hi.x = a | (b << 16); hi.y = c | (d << 16); uq[64 * j] = hi;
                u32x2 lo; lo.x = pk2(r.v[j].x - __uint_as_float(a << 16), r.v[j].y - __uint_as_float(b << 16)); lo.y = pk2(r.v[j].z - __uint_as_float(c << 16), r.v[j].w - __uint_as_float(d << 16));
                *(LAS u32x2*)(lds + lr * RT_RS + (4 * lane + 256 * j) * 2) = hi; *(LAS u32x2*)(lds + RT_IMG + lr * RT_RS + (4 * lane + 256 * j) * 2) = lo; }
        }
        __syncthreads();
        f32x4 acc[2]; acc[0] = (f32x4){0.f, 0.f, 0.f, 0.f}; acc[1] = acc[0];
        const LAS unsigned char* ap = lds + fr * RT_RS + (256 * wave + 8 * fq) * 2;
#pragma unroll
        for (int ks = 0; ks < 8; ++ks) { const bf16x8 ah = *(const LAS bf16x8*)(ap + ks * 64), al = *(const LAS bf16x8*)(ap + RT_IMG + ks * 64);
#pragma unroll
            for (int nt = 0; nt < 2; ++nt) { acc[nt] = __builtin_amdgcn_mfma_f32_16x16x32_bf16(ah, bh[ks][nt], acc[nt], 0, 0, 0); acc[nt] = __builtin_amdgcn_mfma_f32_16x16x32_bf16(ah, bl[ks][nt], acc[nt], 0, 0, 0);
                acc[nt] = __builtin_amdgcn_mfma_f32_16x16x32_bf16(al, bh[ks][nt], acc[nt], 0, 0, 0); } }
        __syncthreads();
#pragma unroll
        for (int nt = 0; nt < 2; ++nt)
#pragma unroll
            for (int i = 0; i < 4; ++i) part[(wave * 16 + fq * 4 + i) * 32 + nt * 16 + fr] = acc[nt][i];
        __syncthreads();
        { const int r16 = tid >> 5, e = tid & 31; float sacc = 0.f;
#pragma unroll
            for (int w = 0; w < 8; ++w) sacc += part[(w * 16 + r16) * 32 + e];
            const float af = 1.f / (1.f + expf(-sacc)); const float bi = af + rbias[e];
            lgs[r16 * 32 + e] = af; lgs[512 + r16 * 32 + e] = bi;
            const float b1 = dpp_f<0xB1>(bi), b2 = dpp_f<0x4E>(bi), b3 = dpp_f<0x1B>(bi);
            const float hi1 = fmaxf(bi, b1), lo1 = fminf(bi, b1), hi2 = fmaxf(b2, b3), lo2 = fminf(b2, b3);
            const float scg = fmaxf(hi1, hi2) + fmaxf(fminf(hi1, hi2), fmaxf(lo1, lo2));
            if ((e & 3) == 0) lgs[1024 + r16 * 8 + (e >> 2)] = scg; }
        __syncthreads();
        if (tid < 16) {
            const int row = rg * 16 + tid; const LAS float* gs = lgs + 1024 + tid * 8;
            float best = -1e30f; int grp = 0;
#pragma unroll
            for (int g = 0; g < 8; ++g) { const float scg = gs[g]; if (scg > best) { best = scg; grp = g; } }
            float ga[4], gv[4];
#pragma unroll
            for (int i = 0; i < 4; ++i) { ga[i] = lgs[tid * 32 + 4 * grp + i]; gv[i] = lgs[512 + tid * 32 + 4 * grp + i]; }
            int i1 = 0; float v1 = gv[0]; if (gv[1] > v1) { v1 = gv[1]; i1 = 1; } if (gv[2] > v1) { v1 = gv[2]; i1 = 2; } if (gv[3] > v1) { v1 = gv[3]; i1 = 3; }
            int i2 = -1; float v2 = -1e30f;
            if (i1 != 0 && gv[0] > v2) { v2 = gv[0]; i2 = 0; } if (i1 != 1 && gv[1] > v2) { v2 = gv[1]; i2 = 1; } if (i1 != 2 && gv[2] > v2) { v2 = gv[2]; i2 = 2; } if (i1 != 3 && gv[3] > v2) { v2 = gv[3]; i2 = 3; }
            const float a1 = i1 == 0 ? ga[0] : i1 == 1 ? ga[1] : i1 == 2 ? ga[2] : ga[3], a2 = i2 == 0 ? ga[0] : i2 == 1 ? ga[1] : i2 == 2 ? ga[2] : ga[3];
            const float w1 = a1 / (a1 + a2), w2 = a2 / (a1 + a2);
            const int e1 = grp * 4 + i1, e2 = grp * 4 + i2;
            const unsigned p1 = __hip_atomic_fetch_add(counts + e1, 1u, __ATOMIC_RELAXED, __HIP_MEMORY_SCOPE_AGENT);
            const unsigned p2 = __hip_atomic_fetch_add(counts + e2, 1u, __ATOMIC_RELAXED, __HIP_MEMORY_SCOPE_AGENT);
            tablep[(size_t)e1 * T + p1] = row; tablep[(size_t)e2 * T + p2] = row;
            u32x4 ta; ta.x = (unsigned)e1; ta.y = (unsigned)e2; ta.z = p1; ta.w = p2; u32x4 tb2; tb2.x = __float_as_uint(w1); tb2.y = __float_as_uint(w2); tb2.z = 0u; tb2.w = 0u;
            *(u32x4*)(tokinfop + (size_t)row * 8) = ta; *(u32x4*)(tokinfop + (size_t)row * 8 + 4) = tb2;
        }
    }
}
DI void moe_prefix(const unsigned* counts, LAS int* cnt, LAS int* tb, int tid) {
    __syncthreads();
    if (tid < 32) cnt[tid] = (int)__hip_atomic_load(counts + tid, __ATOMIC_RELAXED, __HIP_MEMORY_SCOPE_AGENT);
    __syncthreads();
    if (tid == 0) { int a = 0; for (int e = 0; e < 32; ++e) { tb[e] = a; a += (cnt[e] + 255) >> 8; } tb[32] = a; }
    __syncthreads();
}
DI void combine_phase(const float* X1, const bf16* Y, const unsigned* tokinfo, const LAS int* tb, const float* mods_l, const float* lng, const float* lnb,
                      float* XO, const float* mods_next, bf16* U, int gw, int NGW, int lane) {
    if (gw >= T) return;
    u32x4 ta = *(const u32x4*)(tokinfo + (size_t)gw * 8), tw = *(const u32x4*)(tokinfo + (size_t)gw * 8 + 4);
    for (int row = gw; row < T; row += NGW) {
        const int nr = row + NGW < T ? row + NGW : row;
        const u32x4 tan = *(const u32x4*)(tokinfo + (size_t)nr * 8), twn = *(const u32x4*)(tokinfo + (size_t)nr * 8 + 4);
        const int e0 = __builtin_amdgcn_readfirstlane((int)ta.x), e1 = __builtin_amdgcn_readfirstlane((int)ta.y);
        const size_t r0 = (size_t)(__builtin_amdgcn_readfirstlane(tb[e0]) * 256 + __builtin_amdgcn_readfirstlane((int)ta.z)), r1 = (size_t)(__builtin_amdgcn_readfirstlane(tb[e1]) * 256 + __builtin_amdgcn_readfirstlane((int)ta.w));
        const float w0 = __uint_as_float(tw.x), w1 = __uint_as_float(tw.y);
        Row r; row_load(r, X1 + (size_t)row * D, lane);
        const u32x2* y0 = (const u32x2*)(Y + r0 * D) + lane; const u32x2* y1 = (const u32x2*)(Y + r1 * D) + lane;
        const f32x4* g2 = (const f32x4*)(mods_l + (size_t)(row >> 12) * MODW + 5 * D) + lane;
#pragma unroll
        for (int j = 0; j < 8; ++j) { const u32x2 a = y0[64 * j], b = y1[64 * j]; f32x4 f;
            f.x = w0 * bflo(a.x) + w1 * bflo(b.x); f.y = w0 * bfhi(a.x) + w1 * bfhi(b.x); f.z = w0 * bflo(a.y) + w1 * bflo(b.y); f.w = w0 * bfhi(a.y) + w1 * bfhi(b.y);
            r.v[j] = r.v[j] * ALPHA + g2[64 * j] * f; }
        row_ln(r); row_affine(r, lng, lnb, lane);
        row_store(r, XO + (size_t)row * D, lane);
        if (U) { row_ln(r); const float* mr = mods_next + (size_t)(row >> 12) * MODW; row_modulate(r, mr, mr + D, lane); row_store_bf16(r, U + (size_t)row * D, lane); }
        ta = tan; tw = twn;
    }
}

struct Args { const float* in[18]; float* out; unsigned char* ws; int ph_lo, ph_hi; };
__global__ void __launch_bounds__(512, 2) fwd(Args args) {
    extern __shared__ __attribute__((aligned(16))) unsigned char lds_raw[];
    LAS unsigned char* lds = (LAS unsigned char*)lds_raw;
#define PH_IDS int tid = threadIdx.x; asm volatile("" : "+v"(tid)); const int lane = tid & 63, wave = __builtin_amdgcn_readfirstlane(tid >> 6); \
    const int gw = blockIdx.x * 8 + wave, NGW = gridDim.x * 8, gtid = blockIdx.x * 512 + tid, GT = gridDim.x * 512; (void)lane; (void)gw; (void)NGW; (void)gtid; (void)GT;
    volatile LAS unsigned* LCTL = (volatile LAS unsigned*)(lds + LDSCTL_OFF);
    LAS int* l_cnt = (LAS int*)(lds + LDSCTL_OFF) + 16; LAS int* l_tb = (LAS int*)(lds + LDSCTL_OFF) + 48;
    for (int u = threadIdx.x; u < (LDS_BYTES - LDSCTL_OFF) / 4; u += 512) ((LAS unsigned*)(lds + LDSCTL_OFF))[u] = 0u;
    __syncthreads();
    unsigned char* ws = args.ws;
    unsigned* ctl = (unsigned*)(ws + WS_CTL);
#define XIN ((const float*)args.in[0])
#define c_in args.in[1]
#define ctx args.in[2]
#define c_ctx args.in[3]
#define ada_w args.in[4]
#define ada_b args.in[5]
#define w_mix_in args.in[6]
#define rpb args.in[7]
#define conv_w args.in[8]
#define w_mix_out args.in[9]
#define w_fourier args.in[10]
#define router_w args.in[11]
#define router_b args.in[12]
#define w_gate args.in[13]
#define w_up args.in[14]
#define w_down args.in[15]
#define ln_g args.in[16]
#define ln_b args.in[17]
#define mods ((float*)(ws + WS_MODS))
#define tokinfo ((unsigned*)(ws + WS_TOKINFO))
#define table ((int*)(ws + WS_TABLE))
#define WIN ((bf16*)(ws + WS_WIN))
#define WO ((bf16*)(ws + WS_WO))
#define WF ((bf16*)(ws + WS_WF))
#define CSM ((bf16*)(ws + WS_CS))
#define U ((bf16*)(ws + WS_U))
#define P ((bf16*)(ws + WS_P))
#define YB ((bf16*)(ws + WS_P))
#define YPB ((bf16*)(ws + WS_P))
#define PCATB ((bf16*)(ws + WS_TB))
#define MIX ((bf16*)(ws + WS_MIX))
#define REZ ((bf16*)(ws + WS_MIX))
#define HB ((bf16*)(ws + WS_H))
#define WGU ((bf16*)(ws + WS_WGU))
#define WD ((bf16*)(ws + WS_WD))
#define TB ((float*)(ws + WS_TB))
#define YMB ((bf16*)(ws + WS_TB))
#define X1 ((float*)(ws + WS_X1))
#define X2 ((float*)(ws + WS_X2))
    XcdBarrier bar; bar.bar = ctl + CW_BAR; bar.x = 0; bar.st = nullptr;
    if (N_LAUNCHES != NPHASE) bar = xcd_barrier_post(ctl + CW_BAR, LCTL);
    const int lo = args.ph_lo, hi = args.ph_hi;
#ifndef DUP_MASK
#define DUP_MASK 0x0000
#endif
#define RUN(k, ...) do { __VA_ARGS__ if constexpr ((((DUP_MASK) >> (k)) & 1) != 0) { __VA_ARGS__ } } while (0)
#ifndef PH_MASK
#define PH_MASK 0x1ffff
#endif
#define IN(k) ((((PH_MASK) >> (k)) & 1) && lo <= (k) && (k) < hi)
#define SEAM(k) do { if (IN(k) && IN((k) + 1)) xcd_barrier(bar); } while (0)

    RUN(0, if (IN(0)) { PH_IDS
        LAS float* sl = (LAS float*)lds; LAS float* red = sl + 5 * D; volatile LAS int* qslot = (volatile LAS int*)(lds + LDSCTL_OFF) + 8;
        for (int i = tid; i < 5 * D; i += 512) { const float v = i < 4 * D ? c_in[i] : c_ctx[i - 4 * D]; sl[i] = silu_f(v); }
        __syncthreads();
        for (;;) {
            if (tid == 0) *qslot = (int)__hip_atomic_fetch_add(ctl + 160, 1u, __ATOMIC_RELAXED, __HIP_MEMORY_SCOPE_AGENT);
            __syncthreads();
            const int item = __builtin_amdgcn_readfirstlane(*qslot);
            __syncthreads();
            if (item >= P0_NMODS + P0_NSI) break;
            if (item < P0_NMODS) p0_mods_unit(ada_w, ada_b, mods, sl, red, item, tid);
            else p0_weight_item(item - P0_NMODS, w_mix_in, w_mix_out, w_fourier, w_gate, w_up, w_down, WIN, WO, WF, WGU, WD, lds + wave * 16384, wave, lane);
        }
        p0_dft(CSM, gtid, GT);
    });
    SEAM(0);
    RUN(1, if (IN(1)) { PH_IDS ln_mod_phase(XIN, ctx, mods, 0, U, TALL, gw, NGW, lane); });
    SEAM(1);
    RUN(2, if (IN(2)) { SchedInProj S{U, WIN}; EpiStoreBf16 E{P, NMIX}; gemm_pg8<false>(lds, S, E, D, D, D); });
    SEAM(2);
    RUN(3, if (IN(3)) { PH_IDS attn_phase(P, rpb, MIX, lds, (LAS float*)(lds + LDSCTL_OFF + 1024)); conv_phase(P, conv_w, MIX, gtid, GT); });
    SEAM(3);
    RUN(4, if (IN(4)) { SchedDense S{MIX, WO, 64, 8, (size_t)256 * D, (size_t)256 * D}; EpiStoreBf16 E{YMB, D}; gemm_pg8<false>(lds, S, E, D, D, D); });
    SEAM(4);
    RUN(5, if (IN(5)) { PH_IDS ln_router_phase(XIN, YMB, ln_g, ln_b, mods, router_w, router_b, X1, U, ctl + CW_CNT, table, tokinfo, lds); });
    SEAM(5);
    RUN(6, if (IN(6)) { PH_IDS moe_prefix(ctl + CW_CNT, l_cnt, l_tb, tid); SchedMoe S{l_cnt, l_tb, U, WGU, table, 1, 0, (size_t)D * D, (size_t)256 * D}; EpiSwiglu E{HB}; gemm_pg8<true>(lds, S, E, D, D, D); });
    SEAM(6);
    RUN(7, if (IN(7)) { PH_IDS moe_prefix(ctl + CW_CNT, l_cnt, l_tb, tid); SchedMoe S{l_cnt, l_tb, HB, WD, table, 0, (size_t)256 * DE, (size_t)D * DE, (size_t)256 * DE}; EpiStoreBf16 E{YB, D}; gemm_pg8<false>(lds, S, E, DE, DE, DE); });
    SEAM(7);
    RUN(8, if (IN(8)) { PH_IDS moe_prefix(ctl + CW_CNT, l_cnt, l_tb, tid); combine_phase(X1, YB, tokinfo, l_tb, mods, ln_g + D, ln_b + D, X2, mods + 5 * MODW, U, gw, NGW, lane); });
    SEAM(8);
    RUN(9, if (IN(9)) { fft1_phase(U, YPB, lds); });
    SEAM(9);
    RUN(10, if (IN(10)) { fft2_phase(YPB, PCATB, lds); });
    SEAM(10);
    RUN(11, if (IN(11)) { SchedChan S{PCATB, CSM}; EpiStoreBf16 E{REZ, D}; gemm_pg8<false>(lds, S, E, 4096, 1024, 1024); });
    SEAM(11);
    RUN(12, if (IN(12)) { SchedDense S{REZ, WF, 64, 8, (size_t)256 * D, (size_t)256 * D}; EpiStoreBf16 E{YMB, D}; gemm_pg8<false>(lds, S, E, D, D, D); });
    SEAM(12);
    RUN(13, if (IN(13)) { PH_IDS ln_router_phase(X2, YMB, ln_g + 2 * D, ln_b + 2 * D, mods + 5 * MODW, router_w, router_b, X1, U, ctl + CW_CNT + 32, table + (size_t)NE * T, tokinfo + (size_t)T * 8, lds); });
    SEAM(13);
    RUN(14, if (IN(14)) { PH_IDS moe_prefix(ctl + CW_CNT + 32, l_cnt, l_tb, tid); SchedMoe S{l_cnt, l_tb, U, WGU + (size_t)NE * D * D, table + (size_t)NE * T, 1, 0, (size_t)D * D, (size_t)256 * D}; EpiSwiglu E{HB}; gemm_pg8<true>(lds, S, E, D, D, D); });
    SEAM(14);
    RUN(15, if (IN(15)) { PH_IDS moe_prefix(ctl + CW_CNT + 32, l_cnt, l_tb, tid); SchedMoe S{l_cnt, l_tb, HB, WD + (size_t)NE * D * DE, table, 0, (size_t)256 * DE, (size_t)D * DE, (size_t)256 * DE}; EpiStoreBf16 E{YB, D}; gemm_pg8<false>(lds, S, E, DE, DE, DE); });
    SEAM(15);
    RUN(16, if (IN(16)) { PH_IDS moe_prefix(ctl + CW_CNT + 32, l_cnt, l_tb, tid); combine_phase(X1, YB, tokinfo + (size_t)T * 8, l_tb, mods + 5 * MODW, ln_g + 3 * D, ln_b + 3 * D, args.out, nullptr, nullptr, gw, NGW, lane); });
#undef IN
#undef SEAM
}

extern "C" void kernel_launch(void* const* d_in, const int* in_sizes, int n_in, void* d_out, int out_size, void* d_ws, size_t ws_size, hipStream_t stream) {
    static int grid = 0;
    if (grid == 0) {
        if (n_in != 18 || out_size != T * D || ws_size < WS_END) { fprintf(stderr, "kernel_launch: unexpected shapes (n_in %d, out %d, ws %zu)\n", n_in, out_size, ws_size); grid = -1; return; }
        int dev = 0, cus = 0, per_cu = 0;
        if (hipGetDevice(&dev) != hipSuccess || hipDeviceGetAttribute(&cus, hipDeviceAttributeMultiprocessorCount, dev) != hipSuccess) { grid = -1; return; }
        if (hipFuncSetAttribute((const void*)fwd, hipFuncAttributeMaxDynamicSharedMemorySize, LDS_BYTES) != hipSuccess) { fprintf(stderr, "kernel_launch: hipFuncSetAttribute failed\n"); grid = -1; return; }
        if (hipOccupancyMaxActiveBlocksPerMultiprocessor(&per_cu, (const void*)fwd, 512, LDS_BYTES) != hipSuccess || per_cu < 1) fprintf(stderr, "kernel_launch: occupancy query says %d\n", per_cu);
        (void)hipGetLastError();
        grid = cus;
    }
    if (grid < 0) return;
    (void)hipMemsetAsync((char*)d_ws + WS_CTL, 0, CTL_ZERO_BYTES, stream);
    Args a{};
    for (int i = 0; i < 18; ++i) a.in[i] = (const float*)d_in[i];
    a.out = (float*)d_out; a.ws = (unsigned char*)d_ws;
    if (N_LAUNCHES == 1) { a.ph_lo = 0; a.ph_hi = NPHASE; hipLaunchKernelGGL(fwd, dim3(grid), dim3(512), LDS_BYTES, stream, a); }
    else for (int p = 0; p < NPHASE; ++p) { a.ph_lo = p; a.ph_hi = p + 1; hipLaunchKernelGGL(fwd, dim3(grid), dim3(512), LDS_BYTES, stream, a); }
}
```

```cpp
#include <hip/hip_runtime.h>
#include <cstdio>
#include <cstdint>

#define DI __device__ __forceinline__
#define LAS __attribute__((address_space(3)))
typedef unsigned short bf16;
typedef float f32x4 __attribute__((ext_vector_type(4)));
typedef short bf16x8 __attribute__((ext_vector_type(8)));
typedef unsigned u32x4 __attribute__((ext_vector_type(4)));
typedef unsigned u32x2 __attribute__((ext_vector_type(2)));

constexpr int D = 2048, NB = 4, SEQ = 4096, T = NB * SEQ, CTXL = 256, TC = NB * CTXL, TALL = T + TC;
constexpr int NMIX = 6144, PLD = 6272  , NE = 32, DE = 1024, NH = 8, HD = 128, MODW = 6 * D;
constexpr float ALPHA = 1.41421356237309515f;
constexpr float LN_EPS = 1e-6f;
constexpr int NPHASE = 17;
#ifndef MK_N_LAUNCHES
#define MK_N_LAUNCHES 1
#endif
constexpr int N_LAUNCHES = MK_N_LAUNCHES;

constexpr size_t MiB = 1u << 20;
constexpr size_t WS_CTL = 0, CTL_ZERO_BYTES = 64 * 1024;
constexpr size_t WS_MODS = 1 * MiB;
constexpr size_t WS_TOKINFO = 2 * MiB;
constexpr size_t WS_TABLE = 4 * MiB;
constexpr size_t WS_WIN = 8 * MiB, WS_WO = 32 * MiB, WS_WF = 40 * MiB, WS_CS = 48 * MiB, WS_ACS = 64 * MiB;
constexpr size_t WS_U = 116 * MiB;
constexpr size_t WS_P = 184 * MiB;
constexpr size_t WS_MIX = 400 * MiB;
constexpr size_t WS_TB = 464 * MiB, WS_X1 = 592 * MiB, WS_X2 = 720 * MiB;
constexpr size_t WS_H = 848 * MiB;
constexpr size_t WS_WGU = 928 * MiB;
constexpr size_t WS_WD = 1440 * MiB;
constexpr size_t WS_END = 1696 * MiB;
constexpr int CW_CNT = 64;
constexpr int CW_BAR = 1024;

constexpr int LDS_SCR = 133120;
constexpr int LDSCTL_OFF = LDS_SCR;
constexpr int LDS_BYTES = 147456;

template <int CTRL> DI float dpp_f(float v) { return __builtin_bit_cast(float, __builtin_amdgcn_mov_dpp(__builtin_bit_cast(int, v), CTRL, 0xF, 0xF, true)); }
DI float wave_sum(float v) {
    v += dpp_f<0xB1>(v); v += dpp_f<0x4E>(v); v += dpp_f<0x141>(v); v += dpp_f<0x140>(v);
    const int iv = __builtin_bit_cast(int, v);
    const float r0 = __builtin_bit_cast(float, __builtin_amdgcn_readlane(iv, 0)), r1 = __builtin_bit_cast(float, __builtin_amdgcn_readlane(iv, 16)),
                r2 = __builtin_bit_cast(float, __builtin_amdgcn_readlane(iv, 32)), r3 = __builtin_bit_cast(float, __builtin_amdgcn_readlane(iv, 48));
    return (r0 + r1) + (r2 + r3);
}
DI float wave_max(float v) {
    v = fmaxf(v, dpp_f<0xB1>(v)); v = fmaxf(v, dpp_f<0x4E>(v)); v = fmaxf(v, dpp_f<0x141>(v)); v = fmaxf(v, dpp_f<0x140>(v));
    const int iv = __builtin_bit_cast(int, v);
    const float r0 = __builtin_bit_cast(float, __builtin_amdgcn_readlane(iv, 0)), r1 = __builtin_bit_cast(float, __builtin_amdgcn_readlane(iv, 16)),
                r2 = __builtin_bit_cast(float, __builtin_amdgcn_readlane(iv, 32)), r3 = __builtin_bit_cast(float, __builtin_amdgcn_readlane(iv, 48));
    return fmaxf(fmaxf(r0, r1), fmaxf(r2, r3));
}
DI unsigned f2bf(float f) { unsigned u = __float_as_uint(f); return (u + 0x7fffu + ((u >> 16) & 1u)) >> 16; }
typedef float f32x2_t __attribute__((ext_vector_type(2)));
typedef __bf16 bf16x2_t __attribute__((ext_vector_type(2)));
DI unsigned pk2(float lo, float hi) { const f32x2_t v = {lo, hi}; return __builtin_bit_cast(unsigned, __builtin_convertvector(v, bf16x2_t)); }
DI float bflo(unsigned w) { return __uint_as_float(w << 16); }
DI float bfhi(unsigned w) { return __uint_as_float(w & 0xffff0000u); }
DI float silu_f(float v) { return v / (1.f + expf(-v)); }
DI float silu_fast(float v) { return v * __builtin_amdgcn_rcpf(1.f + __builtin_amdgcn_exp2f(v * -1.4426950408889634f)); }

#define XB_TMO      128
#define XB_XCNT(j)  (256  + 64 * (j))
#define XB_XSUB(j)  (1280 + 64 * (j))
#define XB_XGEN(j)  (2304 + 64 * (j))
#define XB_TOP      3328
#define XB_TOPGEN   3392
#define XCD_BAR_WORDS 3456
#define XB_SPIN_CAP (1u << 18)
__device__ __forceinline__ unsigned xb_ld(unsigned* p)              { return __hip_atomic_load(p, __ATOMIC_RELAXED, __HIP_MEMORY_SCOPE_AGENT); }
__device__ __forceinline__ unsigned xb_add(unsigned* p, unsigned v) { return __hip_atomic_fetch_add(p, v, __ATOMIC_RELAXED, __HIP_MEMORY_SCOPE_AGENT); }
__device__ __forceinline__ unsigned xb_xcc_id() { return (unsigned)__builtin_amdgcn_s_getreg((3 << 11) | 20) & 0xFu; }
#define XB_SPIN(cond, bar) do { unsigned _sp = 0; while (cond) { __builtin_amdgcn_s_sleep(1); \
    if ((++_sp & 255u) == 0u) { if (xb_ld(&(bar)[XB_TMO])) break; if (_sp > XB_SPIN_CAP) { atomicAdd(&(bar)[XB_TMO], 1u); break; } } } } while (0)
struct XcdBarrier { unsigned* bar; unsigned x; volatile LAS unsigned* st; };
__device__ __forceinline__ XcdBarrier xcd_barrier_post(unsigned* bar, volatile LAS unsigned* st) {
    XcdBarrier b; b.bar = bar; b.x = xb_xcc_id(); b.st = st;
    if (threadIdx.x == 0) (void)xb_add(&bar[XB_XCNT(b.x)], 1u);
    return b;
}
__device__ __forceinline__ void xcd_barrier_complete(unsigned* bar, unsigned x, unsigned& nloc, unsigned& nx) {
    const unsigned G = gridDim.x * gridDim.y * gridDim.z;
    unsigned sum, cnt, mine, sp = 0u;
    for (;;) {
        sum = 0u; cnt = 0u; mine = 0u;
#pragma unroll
        for (unsigned j = 0; j < 16; ++j) { const unsigned c = xb_ld(&bar[XB_XCNT(j)]); sum += c; cnt += (c > 0u) ? 1u : 0u; mine = (j == x) ? c : mine; }
        if (sum == G) break;
        __builtin_amdgcn_s_sleep(1);
        if ((++sp & 255u) == 0u) { if (xb_ld(&bar[XB_TMO])) break; if (sp > XB_SPIN_CAP) { atomicAdd(&bar[XB_TMO], 1u); break; } }
    }
    nloc = mine > 0u ? mine : 1u; nx = cnt > 0u ? cnt : 1u;
}
__device__ __forceinline__ void xcd_barrier(const XcdBarrier& b) {
    asm volatile("s_waitcnt vmcnt(0)" ::: "memory");
    __syncthreads();
    if (threadIdx.x == 0) {
        unsigned* bar = b.bar;
        __builtin_amdgcn_s_waitcnt(0);
        unsigned nloc = b.st[0], nx = b.st[1];
        if (nloc == 0u) { xcd_barrier_complete(bar, b.x, nloc, nx); b.st[0] = nloc; b.st[1] = nx; }
        const unsigned old = xb_add(&bar[XB_XSUB(b.x)], 1u);
        const unsigned gen = old / nloc;
        if (old + 1u == (gen + 1u) * nloc) {
            __builtin_amdgcn_fence(__ATOMIC_RELEASE, "agent");
            asm volatile("s_waitcnt vmcnt(0)" ::: "memory");
            const unsigned og = xb_add(&bar[XB_TOP], 1u);
            const unsigned tg = og / nx;
            if (og + 1u == (tg + 1u) * nx) xb_add(&bar[XB_TOPGEN], 1u);
            else XB_SPIN(xb_ld(&bar[XB_TOPGEN]) == tg, bar);
            __builtin_amdgcn_fence(__ATOMIC_ACQUIRE, "agent");
            xb_add(&bar[XB_XGEN(b.x)], 1u);
            asm volatile("s_waitcnt vmcnt(0)" ::: "memory");
        } else {
            XB_SPIN(xb_ld(&bar[XB_XGEN(b.x)]) == gen, bar);
            __builtin_amdgcn_fence(__ATOMIC_ACQUIRE, "agent");
            asm volatile("s_waitcnt vmcnt(0)" ::: "memory");
        }
    }
    __syncthreads();
}

struct Row { f32x4 v[8]; };
DI void row_load(Row& r, const float* p, int lane) { const f32x4* q = (const f32x4*)p + lane;
#pragma unroll
    for (int j = 0; j < 8; ++j) r.v[j] = q[64 * j]; }
DI void row_store(const Row& r, float* p, int lane) { f32x4* q = (f32x4*)p + lane;
#pragma unroll
    for (int j = 0; j < 8; ++j) q[64 * j] = r.v[j]; }
DI void row_store_bf16(const Row& r, bf16* p, int lane) { u32x2* q = (u32x2*)p + lane;
#pragma unroll
    for (int j = 0; j < 8; ++j) { u32x2 w; w.x = pk2(r.v[j].x, r.v[j].y); w.y = pk2(r.v[j].z, r.v[j].w); q[64 * j] = w; } }
DI void row_load(Row& r, const bf16* p, int lane) { const u32x2* q = (const u32x2*)p + lane; u32x2 w[8];
#pragma unroll
    for (int j = 0; j < 8; ++j) w[j] = q[64 * j];
#pragma unroll
    for (int j = 0; j < 8; ++j) r.v[j] = (f32x4){bflo(w[j].x), bfhi(w[j].x), bflo(w[j].y), bfhi(w[j].y)}; }
DI void row_store(const Row& r, bf16* p, int lane) { row_store_bf16(r, p, lane); }
DI void row_load_nt(Row& r, const float* p, int lane) { const f32x4* q = (const f32x4*)p + lane;
#pragma unroll
    for (int j = 0; j < 8; ++j) r.v[j] = __builtin_nontemporal_load(q + 64 * j); }
DI void row_load_nt(Row& r, const bf16* p, int lane) { const u32x2* q = (const u32x2*)p + lane; u32x2 w[8];
#pragma unroll
    for (int j = 0; j < 8; ++j) w[j] = __builtin_nontemporal_load(q + 64 * j);
#pragma unroll
    for (int j = 0; j < 8; ++j) r.v[j] = (f32x4){bflo(w[j].x), bfhi(w[j].x), bflo(w[j].y), bfhi(w[j].y)}; }
DI void row_store_nt(const Row& r, float* p, int lane) { f32x4* q = (f32x4*)p + lane;
#pragma unroll
    for (int j = 0; j < 8; ++j) __builtin_nontemporal_store(r.v[j], q + 64 * j); }
DI void row_store_nt(const Row& r, bf16* p, int lane) { u32x2* q = (u32x2*)p + lane;
#pragma unroll
    for (int j = 0; j < 8; ++j) { u32x2 w; w.x = pk2(r.v[j].x, r.v[j].y); w.y = pk2(r.v[j].z, r.v[j].w); __builtin_nontemporal_store(w, q + 64 * j); } }
DI void row_ln(Row& r) {
    float s = 0.f;
#pragma unroll
    for (int j = 0; j < 8; ++j) s += (r.v[j].x + r.v[j].y) + (r.v[j].z + r.v[j].w);
    const float mean = wave_sum(s) * (1.f / D); float s2 = 0.f;
#pragma unroll
    for (int j = 0; j < 8; ++j) { r.v[j] = r.v[j] - mean; s2 += (r.v[j].x * r.v[j].x + r.v[j].y * r.v[j].y) + (r.v[j].z * r.v[j].z + r.v[j].w * r.v[j].w); }
    const float rstd = 1.f / sqrtf(wave_sum(s2) * (1.f / D) + LN_EPS);
#pragma unroll
    for (int j = 0; j < 8; ++j) r.v[j] = r.v[j] * rstd;
}
DI void row_affine(Row& r, const float* g, const float* b, int lane) {
    const f32x4* gq = (const f32x4*)g + lane; const f32x4* bq = (const f32x4*)b + lane;
#pragma unroll
    for (int j = 0; j < 8; ++j) r.v[j] = r.v[j] * gq[64 * j] + bq[64 * j];
}
DI void row_modulate(Row& r, const float* sh, const float* sc, int lane) {
    const f32x4* hq = (const f32x4*)sh + lane; const f32x4* cq = (const f32x4*)sc + lane;
#pragma unroll
    for (int j = 0; j < 8; ++j) r.v[j] = r.v[j] * (cq[64 * j] + 1.f) + hq[64 * j];
}

struct Unit { const bf16* A; const bf16* B; const int* gat; int nvalid; int m0, n0, aux; };

namespace pg8 {
constexpr int BK = 64, HALF = 128, HTB = HALF * BK * 2, STAGE_BYTES = 8 * HTB;
DI int lds_byte(int r, int c) { const int st = (r >> 4) * 2 + (c >> 5), rr = r & 15, cc = c & 31, ob = rr * 64 + cc * 2; return st * 1024 + (ob ^ (((ob >> 9) & 1) << 5)); }
DI void stage_rc(int b, int& R, int& C) { const int st = b / 1024, sb = b % 1024, swz = sb ^ (((sb >> 9) & 1) << 5); R = (st >> 1) * 16 + swz / 64; C = (st & 1) * 32 + (swz % 64) / 2; }
}
template <bool GATHER, class Sched, class Epi>
DI void gemm_pg8(LAS unsigned char* lds, const Sched& S, const Epi& E, const int lda, const int ldb, const int K) {
    using namespace pg8;
    const int tid = threadIdx.x, wid = __builtin_amdgcn_readfirstlane(tid >> 6), lane = tid & 63, wr = wid >> 2, wc = wid & 3, fr = lane & 15, fq = lane >> 4;
    const int nt = K / BK, G = gridDim.x, cblk = blockIdx.x;
    unsigned voffB[2], vA[2][2];
#pragma unroll
    for (int i = 0; i < 2; ++i) { int R_, C_; stage_rc(tid * 16 + i * 8192, R_, C_); const int n_ = (R_ >> 4) & 1, i_ = R_ & 15, Rb = (R_ & ~31) + 8 * (i_ >> 2) + 4 * n_ + (i_ & 3);
        voffB[i] = (unsigned)(Rb * ldb + C_) * 2u; }
    const size_t kstep = (size_t)(BK * 2), hstepA = (size_t)HALF * lda * 2, hstepB = (size_t)HALF * ldb * 2;
    const unsigned ldsw = (unsigned)wid * 1024u;
    const int aoff = lds_byte(wr * 64 + fr, fq * 8), boff = lds_byte(wc * 32 + fr, fq * 8);
#define PG8_SA(b, h) (((b) * 2 + (h)) * HTB)
#define PG8_SB(b, h) ((4 + (b) * 2 + (h)) * HTB)
#define PG8_STAGE(bufoff, gbase, voff) do { _Pragma("unroll") for (int _i = 0; _i < 2; ++_i) \
        __builtin_amdgcn_global_load_lds((const unsigned*)((const char*)(gbase) + (voff)[_i]), (LAS unsigned*)(lds + (bufoff) + ldsw + _i * 8192), 16, 0, 0); } while (0)
#define PG8_STAGE_A(bufoff, gbase, h) do { if constexpr (GATHER) PG8_STAGE(bufoff, gbase, vA[h]); else PG8_STAGE(bufoff, (gbase) + (h) * hstepA, vA[0]); } while (0)
#define PG8_LDA(dst, b, h) do { _Pragma("unroll") for (int m = 0; m < 4; ++m) _Pragma("unroll") for (int k = 0; k < 2; ++k) dst[m][k] = *(const LAS bf16x8*)(lds + PG8_SA(b, h) + aoff + m * 2048 + k * 1024); } while (0)
#define PG8_LDB(dst, b, h) do { _Pragma("unroll") for (int n = 0; n < 2; ++n) _Pragma("unroll") for (int k = 0; k < 2; ++k) dst[n][k] = *(const LAS bf16x8*)(lds + PG8_SB(b, h) + boff + n * 2048 + k * 1024); } while (0)
#define PG8_MMA(ai, bj, At, Bt) do { __builtin_amdgcn_s_setprio(1); _Pragma("unroll") for (int m = 0; m < 4; ++m) _Pragma("unroll") for (int n = 0; n < 2; ++n) _Pragma("unroll") for (int k = 0; k < 2; ++k) \
        acc[ai][bj][m][n] = __builtin_amdgcn_mfma_f32_16x16x32_bf16(Bt[n][k], At[m][k], acc[ai][bj][m][n], 0, 0, 0); __builtin_amdgcn_s_setprio(0); } while (0)
#define PG8_WAIT_V(n) asm volatile("s_waitcnt vmcnt(" #n ")" ::: "memory")
#define PG8_WAIT_L(n) asm volatile("s_waitcnt lgkmcnt(" #n ")" ::: "memory")
#define PG8_BAR __builtin_amdgcn_s_barrier()
#define PG8_SCHED __builtin_amdgcn_sched_barrier(0)
#define PG8_SETV(dst, u) do { _Pragma("unroll") for (int _h = 0; _h < 2; ++_h) _Pragma("unroll") for (int _i = 0; _i < 2; ++_i) { int _R, _C; stage_rc(tid * 16 + _i * 8192, _R, _C); const int _r = _h * HALF + _R; \
        if constexpr (GATHER) { const int _g = (u).gat[_r < (u).nvalid ? _r : (u).nvalid - 1]; dst[_h][_i] = (unsigned)(_g * lda + _C) * 2u; }     else dst[_h][_i] = (unsigned)(_R * lda + _C) * 2u; } } while (0)
    Unit cur, nxt; int ui = 0;
    if (!S.get(cblk, cur)) return;
    f32x4 acc[2][2][4][2];
#pragma unroll
    for (int a = 0; a < 2; ++a)
#pragma unroll
        for (int b = 0; b < 2; ++b)
#pragma unroll
            for (int m = 0; m < 4; ++m)
#pragma unroll
                for (int n = 0; n < 2; ++n) acc[a][b][m][n] = (f32x4){0.f, 0.f, 0.f, 0.f};
    bf16x8 At[4][2], B0[2][2], B1[2][2];
    const char* cA = (const char*)cur.A; const char* cB = (const char*)cur.B;
    PG8_SETV(vA, cur);
    PG8_STAGE(PG8_SB(0, 0), cB, voffB); PG8_STAGE(PG8_SB(0, 1), cB + hstepB, voffB); PG8_STAGE_A(PG8_SA(0, 0), cA, 0); PG8_STAGE_A(PG8_SA(0, 1), cA, 1);
    if (wr == 1) PG8_BAR;
    PG8_WAIT_V(2); PG8_BAR;
    PG8_STAGE(PG8_SB(1, 0), cB + kstep, voffB); PG8_STAGE_A(PG8_SA(1, 0), cA + kstep, 0); PG8_STAGE(PG8_SB(1, 1), cB + hstepB + kstep, voffB);
    PG8_WAIT_V(6); PG8_BAR;
    for (;;) {
        const bool has_next = S.get((ui + 1) * G + cblk, nxt);
        const char* nA = has_next ? (const char*)nxt.A : cA; const char* nB = has_next ? (const char*)nxt.B : cB;
        for (int t = 0; t < nt; t += 2) {
            const bool last = (t == nt - 2);
            const char* a1 = cA + (size_t)(t + 1) * kstep;
            const char* a2 = last ? nA : cA + (size_t)(t + 2) * kstep; const char* b2 = last ? nB : cB + (size_t)(t + 2) * kstep;
            const char* a3 = a2 + kstep; const char* b3 = b2 + kstep;
            PG8_LDB(B0, 0, 0); PG8_LDB(B1, 0, 1); PG8_SCHED; PG8_LDA(At, 0, 0); PG8_STAGE_A(PG8_SA(1, 1), a1, 1);
            PG8_WAIT_V(8); PG8_WAIT_L(0); PG8_BAR; PG8_MMA(0, 0, At, B0); PG8_MMA(0, 1, At, B1); PG8_BAR; PG8_SCHED;
            if constexpr (GATHER) { if (last && has_next) PG8_SETV(vA, nxt); }
            PG8_LDA(At, 0, 1); PG8_STAGE(PG8_SB(0, 0), b2, voffB); PG8_STAGE(PG8_SB(0, 1), b2 + hstepB, voffB); PG8_STAGE_A(PG8_SA(0, 0), a2, 0);
            PG8_WAIT_V(8); PG8_WAIT_L(0); PG8_BAR; PG8_MMA(1, 0, At, B0); PG8_MMA(1, 1, At, B1); PG8_BAR; PG8_SCHED;
            PG8_LDB(B0, 1, 0); PG8_LDB(B1, 1, 1); PG8_SCHED; PG8_LDA(At, 1, 0); PG8_STAGE_A(PG8_SA(0, 1), a2, 1);
            PG8_WAIT_V(8); PG8_WAIT_L(0); PG8_BAR; PG8_MMA(0, 0, At, B0); PG8_MMA(0, 1, At, B1); PG8_BAR; PG8_SCHED;
            PG8_LDA(At, 1, 1); PG8_STAGE(PG8_SB(1, 0), b3, voffB); PG8_STAGE(PG8_SB(1, 1), b3 + hstepB, voffB); PG8_STAGE_A(PG8_SA(1, 0), a3, 0);
            PG8_WAIT_V(8); PG8_WAIT_L(0); PG8_BAR; PG8_MMA(1, 0, At, B0); PG8_MMA(1, 1, At, B1); PG8_BAR; PG8_SCHED;
        }
        if (wr == 0) PG8_BAR;
#pragma unroll
        for (int ai = 0; ai < 2; ++ai)
#pragma unroll
            for (int m = 0; m < 4; ++m) E(cur, ai * HALF + wr * 64 + m * 16 + fr, wc * 32 + 8 * fq, acc[ai][0][m][0], acc[ai][0][m][1], acc[ai][1][m][0], acc[ai][1][m][1]);
        if (!has_next) break;
#pragma unroll
        for (int a = 0; a < 2; ++a)
#pragma unroll
            for (int b = 0; b < 2; ++b)
#pragma unroll
                for (int m = 0; m < 4; ++m)
#pragma unroll
                    for (int n = 0; n < 2; ++n) acc[a][b][m][n] = (f32x4){0.f, 0.f, 0.f, 0.f};
        cur = nxt; cA = nA; cB = nB; ++ui;
        if (wr == 1) PG8_BAR;
    }
    PG8_WAIT_V(0);
    PG8_BAR;
#undef PG8_SA
#undef PG8_SB
#undef PG8_STAGE
#undef PG8_STAGE_A
#undef PG8_LDA
#undef PG8_LDB
#undef PG8_MMA
#undef PG8_WAIT_V
#undef PG8_WAIT_L
#undef PG8_BAR
#undef PG8_SCHED
#undef PG8_SETV
}

DI int xcd_remap(int L, int n) { const int q = n >> 3, r = n & 7, xcd = L & 7, off = L >> 3; return (xcd < r ? xcd * (q + 1) : r * (q + 1) + (xcd - r) * q) + off; }
DI void grouped(int wgid, int nM, int nN, int& pm, int& pn) { const int nig = 8 * nN, gid = wgid / nig, fm = gid * 8, gsz = min(nM - fm, 8); pm = fm + (wgid % nig) % gsz; pn = (wgid % nig) / gsz; }

struct SchedInProj { const bf16* U; const bf16* W;
    DI bool get(int L, Unit& u) const { int pm, pn;
        if (L >= 64 * 24 + 32) return false; const int w = xcd_remap(L, 64 * 24 + 32);
        if (w < 64 * 24) grouped(w, 64, 24, pm, pn); else { const int l2 = w - 64 * 24; pm = 64 + (l2 >> 3); pn = 4 + (l2 & 7); }
        u.A = U + (size_t)pm * 256 * D; u.B = W + (size_t)pn * 256 * D; u.gat = nullptr; u.nvalid = 256; u.m0 = pm * 256; u.n0 = pn * 256; u.aux = 0; return true; } };
struct SchedDense { const bf16* A; const bf16* B; int nM, nN; size_t a_t, b_t;
    DI bool get(int L, Unit& u) const { if (L >= nM * nN) return false; int pm, pn; grouped(xcd_remap(L, nM * nN), nM, nN, pm, pn);
        u.A = A + (size_t)pm * a_t; u.B = B + (size_t)pn * b_t; u.gat = nullptr; u.nvalid = 256; u.m0 = pm * 256; u.n0 = pn * 256; u.aux = 0; return true; } };
struct SchedMoe { const LAS int* cnt; const LAS int* tb; const bf16* A; const bf16* W; const int* table; int gather; size_t a_t, w_e, w_t;
    DI bool get(int L, Unit& u) const { const int nT = __builtin_amdgcn_readfirstlane(tb[32]); if (L >= nT * 8) return false; int t, pn; grouped(xcd_remap(L, nT * 8), nT, 8, t, pn);
        int e = 0;
        for (int i = 1; i < 32; ++i) e = (tb[i] <= t) ? i : e;
        e = __builtin_amdgcn_readfirstlane(e); t = __builtin_amdgcn_readfirstlane(t); pn = __builtin_amdgcn_readfirstlane(pn);
        const int mt = __builtin_amdgcn_readfirstlane(t - tb[e]);
        if (gather) { u.A = A; u.gat = table + (size_t)e * T + mt * 256; } else { u.A = A + (size_t)t * a_t; u.gat = nullptr; }
        u.nvalid = __builtin_amdgcn_readfirstlane(min(256, cnt[e] - mt * 256));
        u.B = W + (size_t)e * w_e + (size_t)pn * w_t; u.m0 = t * 256; u.n0 = pn * 256; u.aux = e; return true; } };
struct SchedChan { const bf16* PCAT; const bf16* CSB;
    DI bool get(int L, Unit& u) const { if (L >= 512) return false; int pm, q; grouped(xcd_remap(L, 512), 64, 8, pm, q); const int g = q >> 1, pn = q & 1;
        u.A = PCAT + (size_t)pm * 256 * 4096 + g * 1024; u.B = CSB + (size_t)pn * 256 * 1024; u.gat = nullptr; u.nvalid = 256; u.m0 = pm * 256; u.n0 = g * 512 + pn * 256; u.aux = g; return true; } };

DI void st_bf16x4(bf16* p, f32x4 v) { u32x2 w; w.x = pk2(v.x, v.y); w.y = pk2(v.z, v.w); *(u32x2*)p = w; }
DI void st_bf16x8(bf16* p, f32x4 a, f32x4 b) { u32x4 w; w.x = pk2(a.x, a.y); w.y = pk2(a.z, a.w); w.z = pk2(b.x, b.y); w.w = pk2(b.z, b.w); *(u32x4*)p = w; }
struct EpiStoreBf16 { bf16* O; int ldc;
    DI void operator()(const Unit& u, int r, int c, f32x4 l0, f32x4 l1, f32x4 h0, f32x4 h1) const { bf16* p = O + (size_t)(u.m0 + r) * ldc + u.n0 + c; st_bf16x8(p, l0, l1); st_bf16x8(p + 128, h0, h1); } };
struct EpiSwiglu { bf16* H;
    DI void operator()(const Unit& u, int r, int c, f32x4 l0, f32x4 l1, f32x4 h0, f32x4 h1) const { f32x4 a, b;
        a.x = silu_fast(l0.x) * h0.x; a.y = silu_fast(l0.y) * h0.y; a.z = silu_fast(l0.z) * h0.z; a.w = silu_fast(l0.w) * h0.w;
        b.x = silu_fast(l1.x) * h1.x; b.y = silu_fast(l1.y) * h1.y; b.z = silu_fast(l1.z) * h1.z; b.w = silu_fast(l1.w) * h1.w;
        st_bf16x8(H + (size_t)(u.m0 + r) * DE + (u.n0 >> 1) + c, a, b); } };
DI void p0_mods_unit(const float* ada_w, const float* ada_b, float* mods, const LAS float* sl, LAS float* red, int unit, int tid) {
    const int cg = tid & 31, ks = tid >> 5, l = unit / 96, n0 = (unit % 96) * 128;
    const float* W = ada_w + (size_t)l * D * MODW + n0 + 4 * cg;
    f32x4 a0 = (f32x4){0.f, 0.f, 0.f, 0.f}, a1 = a0, a2 = a0, a3 = a0, a4 = a0;
#pragma unroll 8
    for (int k = ks * 128; k < ks * 128 + 128; ++k) { const f32x4 w = __builtin_nontemporal_load((const f32x4*)(W + (size_t)k * MODW)); a0 += w * sl[k]; a1 += w * sl[D + k]; a2 += w * sl[2 * D + k]; a3 += w * sl[3 * D + k]; a4 += w * sl[4 * D + k]; }
    *(LAS f32x4*)(red + (ks * 5 + 0) * 128 + 4 * cg) = a0; *(LAS f32x4*)(red + (ks * 5 + 1) * 128 + 4 * cg) = a1; *(LAS f32x4*)(red + (ks * 5 + 2) * 128 + 4 * cg) = a2;
    *(LAS f32x4*)(red + (ks * 5 + 3) * 128 + 4 * cg) = a3; *(LAS f32x4*)(red + (ks * 5 + 4) * 128 + 4 * cg) = a4;
    __syncthreads();
    for (int i = tid; i < 640; i += 512) { const int r = i >> 7, q = i & 127; float sacc = 0.f;
#pragma unroll
        for (int k2 = 0; k2 < 16; ++k2) sacc += red[(k2 * 5 + r) * 128 + q];
        mods[((size_t)l * 5 + r) * MODW + n0 + q] = sacc + ada_b[(size_t)l * MODW + n0 + q]; }
    __syncthreads();
}
DI void tr_item(const float* W, int N, int Kd, int k0, int n0, bf16* WT, int drow0, LAS unsigned char* scr, int lane) {
    const int ng = lane & 15, kl = lane >> 4;
    f32x4 v[2][8];
    const float* src = W + (size_t)(k0 + 16 * kl) * N + n0 + 4 * ng;
#pragma unroll
    for (int pp = 0; pp < 2; ++pp)
#pragma unroll
        for (int i = 0; i < 8; ++i) v[pp][i] = __builtin_nontemporal_load((const f32x4*)(src + (size_t)(8 * pp + i) * N));
#pragma unroll
    for (int pp = 0; pp < 2; ++pp)
#pragma unroll
        for (int c = 0; c < 4; ++c) { u32x4 o; o.x = pk2(v[pp][0][c], v[pp][1][c]); o.y = pk2(v[pp][2][c], v[pp][3][c]); o.z = pk2(v[pp][4][c], v[pp][5][c]); o.w = pk2(v[pp][6][c], v[pp][7][c]);
            *(LAS u32x4*)(scr + (4 * ng + c) * 144 + (16 * kl + 8 * pp) * 2) = o; }
    asm volatile("s_waitcnt lgkmcnt(0)" ::: "memory");
#pragma unroll
    for (int j = 0; j < 8; ++j) { const int row = (lane >> 3) + 8 * j, ch = lane & 7;
        const u32x4 o = *(const LAS u32x4*)(scr + row * 144 + ch * 16);
        __builtin_nontemporal_store(o, (u32x4*)(WT + (size_t)(drow0 + row) * Kd + k0 + 8 * ch)); }
    asm volatile("s_waitcnt lgkmcnt(0)" ::: "memory");
}
constexpr int P0_S_IN = 8 * 48, P0_S_SQ = 8 * 16, P0_S_E = 64 * 64, P0_NSI = P0_S_IN + 2 * P0_S_SQ + 3 * P0_S_E, P0_NMODS = 192;
DI void p0_weight_item(int si, const float* w_in, const float* w_out, const float* w_f, const float* w_gate, const float* w_up, const float* w_down,
                       bf16* WIN, bf16* WO, bf16* WF, bf16* WGU, bf16* WD, LAS unsigned char* scr, int wave, int lane) {
    const int dk = wave >> 1, dn = wave & 1; int r = si;
    if (r < P0_S_IN) { const int kb = (r / 48) * 4 + dk, nb = (r % 48) * 2 + dn; tr_item(w_in, NMIX, D, kb * 64, nb * 64, WIN, nb * 64, scr, lane); return; } r -= P0_S_IN;
    if (r < P0_S_SQ) { const int kb = (r >> 4) * 4 + dk, nb = (r & 15) * 2 + dn; tr_item(w_out, D, D, kb * 64, nb * 64, WO, nb * 64, scr, lane); return; } r -= P0_S_SQ;
    if (r < P0_S_SQ) { const int kb = (r >> 4) * 4 + dk, nb = (r & 15) * 2 + dn; tr_item(w_f, D, D, kb * 64, nb * 64, WF, nb * 64, scr, lane); return; } r -= P0_S_SQ;
    if (r < 2 * P0_S_E) { const int up = r >= P0_S_E; if (up) r -= P0_S_E; const int mat = r >> 6, rr = r & 63, kb = (rr >> 3) * 4 + dk, nb = (rr & 7) * 2 + dn, n0 = nb * 64;
        tr_item((up ? w_up : w_gate) + (size_t)mat * D * DE, DE, D, kb * 64, n0, WGU + (size_t)mat * D * D, (n0 >> 7) * 256 + (n0 & 127) + (up ? 128 : 0), scr, lane); return; } r -= 2 * P0_S_E;
    { const int mat = r >> 6, rr = r & 63, kb = (rr >> 4) * 4 + dk, nb = (rr & 15) * 2 + dn; tr_item(w_down + (size_t)mat * DE * D, D, DE, kb * 64, nb * 64, WD + (size_t)mat * D * DE, nb * 64, scr, lane); }
}
struct ConvCtx { const float *w_in, *w_out, *w_f, *w_gate, *w_up, *w_down; bf16 *WIN_, *WO_, *WF_, *WGU_, *WD_; unsigned *q0, *q1; };
constexpr int MOE_QN = 6144;
DI int moe_item_si(int item) { const int layer = item >= MOE_QN, j = item - layer * MOE_QN, part = j >> 11, jj = j & 2047; return P0_S_IN + 2 * P0_S_SQ + part * P0_S_E + (layer * 32 + (jj >> 6)) * 64 + (jj & 63); }
DI int moe_take(const ConvCtx& c, volatile LAS int* fl  , bool q0_only) {
    if (!fl[0]) { const int j = (int)__hip_atomic_fetch_add(c.q0, 1u, __ATOMIC_RELAXED, __HIP_MEMORY_SCOPE_AGENT); if (j < MOE_QN) return j; fl[0] = 1; }
    if (!q0_only && !fl[1]) { const int j = (int)__hip_atomic_fetch_add(c.q1, 1u, __ATOMIC_RELAXED, __HIP_MEMORY_SCOPE_AGENT); if (j < MOE_QN) return MOE_QN + j; fl[1] = 1; }
    return -1;
}
DI void moe_conv_item(const ConvCtx& c, int item, LAS unsigned char* lds, int wave, int lane) {
    p0_weight_item(moe_item_si(item), c.w_in, c.w_out, c.w_f, c.w_gate, c.w_up, c.w_down, c.WIN_, c.WO_, c.WF_, c.WGU_, c.WD_, lds + wave * 16384, wave, lane);
}
DI void moe_drain(const ConvCtx& c, int layer, LAS unsigned char* lds) {
    int tid = threadIdx.x; asm volatile("" : "+v"(tid)); const int wave = __builtin_amdgcn_readfirstlane(tid >> 6), lane = tid & 63;
    volatile LAS int* sl = (volatile LAS int*)(lds + LDSCTL_OFF) + 8;
    for (;;) {
        if (tid == 0) { int j = -1; if (!sl[2 + layer]) { j = (int)__hip_atomic_fetch_add(layer ? c.q1 : c.q0, 2u, __ATOMIC_RELAXED, __HIP_MEMORY_SCOPE_AGENT); if (j >= MOE_QN) { sl[2 + layer] = 1; j = -1; } else j += layer * MOE_QN; } sl[0] = j; }
        __syncthreads();
        const int item = __builtin_amdgcn_readfirstlane(sl[0]);
        __syncthreads();
        if (item < 0) break;
#pragma unroll 1
        for (int k = 0; k < 2; ++k) if (item + k < (layer + 1) * MOE_QN) moe_conv_item(c, item + k, lds, wave, lane);
    }
}
DI void xcd_barrier_steal(const XcdBarrier& b, const ConvCtx& c, bool q0_only, LAS unsigned char* lds) {
    int tid = threadIdx.x; asm volatile("" : "+v"(tid)); const int wave = __builtin_amdgcn_readfirstlane(tid >> 6), lane = tid & 63;
    volatile LAS int* sl = (volatile LAS int*)(lds + LDSCTL_OFF) + 8;
    asm volatile("s_waitcnt vmcnt(0)" ::: "memory");
    __syncthreads();
    if (tid == 0) {
        unsigned* bar = b.bar;
        __builtin_amdgcn_s_waitcnt(0);
        unsigned nloc = b.st[0], nx = b.st[1];
        if (nloc == 0u) { xcd_barrier_complete(bar, b.x, nloc, nx); b.st[0] = nloc; b.st[1] = nx; }
        const unsigned old = xb_add(&bar[XB_XSUB(b.x)], 1u);
        const unsigned gen = old / nloc;
        if (old + 1u == (gen + 1u) * nloc) {
            __builtin_amdgcn_fence(__ATOMIC_RELEASE, "agent");
            asm volatile("s_waitcnt vmcnt(0)" ::: "memory");
            const unsigned og = xb_add(&bar[XB_TOP], 1u);
            const unsigned tg = og / nx;
            if (og + 1u == (tg + 1u) * nx) xb_add(&bar[XB_TOPGEN], 1u);
            else XB_SPIN(xb_ld(&bar[XB_TOPGEN]) == tg, bar);
            __builtin_amdgcn_fence(__ATOMIC_ACQUIRE, "agent");
            xb_add(&bar[XB_XGEN(b.x)], 1u);
            asm volatile("s_waitcnt vmcnt(0)" ::: "memory");
            sl[1] = -1;
        } else sl[1] = (int)gen;
    }
    __syncthreads();
    const int st = __builtin_amdgcn_readfirstlane(sl[1]);
    __syncthreads();
    if (st != -1) {
        unsigned spins = 0;
        for (;;) {
            if (tid == 0) { unsigned* bar = b.bar; int j = -3;
                const unsigned g = xb_ld(&bar[XB_XGEN(b.x)]), tm = xb_ld(&bar[XB_TMO]), xs = xb_ld(&bar[XB_XSUB(b.x)]);
                if (g != (unsigned)st || tm) j = -2;
                else if (++spins > XB_SPIN_CAP) { atomicAdd(&bar[XB_TMO], 1u); j = -2; }
                else { const unsigned nloc = b.st[0]; const unsigned arrived = xs - (unsigned)st * nloc;
                       if (arrived + 2u <= nloc) { const int t = moe_take(c, sl + 2, q0_only); if (t >= 0) j = t; } }
                sl[0] = j; }
            __syncthreads();
            const int j = __builtin_amdgcn_readfirstlane(sl[0]);
            __syncthreads();
            if (j == -2) break;
            if (j >= 0) moe_conv_item(c, j, lds, wave, lane); else __builtin_amdgcn_s_sleep(4);
        }
        if (tid == 0) { __builtin_amdgcn_fence(__ATOMIC_ACQUIRE, "agent"); asm volatile("s_waitcnt vmcnt(0)" ::: "memory"); }
    }
    __syncthreads();
}
DI void p0_dft(bf16* CSB, int gtid, int GT) {
    for (int i = gtid; i < 512 * 128; i += GT) { const int cp = i >> 7, k8 = (i & 127) * 8; unsigned w[4];
#pragma unroll
        for (int e = 0; e < 4; ++e) { float v[2];
#pragma unroll
            for (int q = 0; q < 2; ++q) { const int kk = k8 + 2 * e + q; const int m = (cp * (kk & 511)) & 511; const float ang = (float)m * (1.f / 256.f); v[q] = (kk < 512 ? cospif(ang) : sinpif(ang)) * 0.04419417382415922f; }
            w[e] = pk2(v[0], v[1]); }
        *(u32x4*)(CSB + (size_t)cp * 1024 + k8) = (u32x4){w[0], w[1], w[2], w[3]}; }
}
DI void ln_mod_phase(const float* x, const float* ctx, const float* mods_l, int sh_chunk, bf16* U, int nrows, LAS unsigned char* lds, int tid, int wave, int lane) {
    LAS f32x4* par = (LAS f32x4*)lds;
    const int step = gridDim.x * 8; int cur_b = -1;
    int base = blockIdx.x * 8;
    Row nxt;
    if (base < nrows) { const int row = base + wave; row_load_nt(nxt, row < T ? x + (size_t)row * D : ctx + (size_t)(row - T) * D, lane); }
    asm volatile("" : "+v"(nxt.v[0]), "+v"(nxt.v[1]), "+v"(nxt.v[2]), "+v"(nxt.v[3]), "+v"(nxt.v[4]), "+v"(nxt.v[5]), "+v"(nxt.v[6]), "+v"(nxt.v[7]));
    for (; base < nrows; base += step) {
        const int row = base + wave, rb = base < T ? (base >> 12) : 4;
        if (rb != cur_b) { cur_b = rb; __syncthreads(); const float* mr = mods_l + (size_t)rb * MODW + sh_chunk * D; par[tid] = ((const f32x4*)mr)[tid]; par[512 + tid] = ((const f32x4*)(mr + D))[tid]; __syncthreads(); }
        Row cur = nxt;
        asm volatile("" : "+v"(cur.v[0]), "+v"(cur.v[1]), "+v"(cur.v[2]), "+v"(cur.v[3]), "+v"(cur.v[4]), "+v"(cur.v[5]), "+v"(cur.v[6]), "+v"(cur.v[7]));
        if (base + step < nrows) { const int nr = row + step; row_load_nt(nxt, nr < T ? x + (size_t)nr * D : ctx + (size_t)(nr - T) * D, lane); }
        __builtin_amdgcn_sched_barrier(0);
        row_ln(cur);
#pragma unroll
        for (int j = 0; j < 8; ++j) cur.v[j] = cur.v[j] * (par[512 + lane + 64 * j] + 1.f) + par[lane + 64 * j];
        row_store_bf16(cur, U + (size_t)row * D, lane);
    }
}
constexpr int ATT_RS = 288, ATT_TILE = 64 * ATT_RS, ATT_BUF = 2 * ATT_TILE;
typedef short s16x4 __attribute__((ext_vector_type(4)));
struct AttState { f32x4 sc[32]; unsigned pk[32][2]; f32x4 o[8]; u32x4 stg[4]; bf16x8 qf[4]; float inv; unsigned g_off, w_off, ka_off, va_off; };
struct AttCtx { const bf16* P; LAS unsigned char* lds; const LAS float* lrpb; int b, r, rs, hp, hs, c0, qc, csq, quad; };
template <int STEP> DI void att_load(AttState& S, const AttCtx& C) {
    constexpr int ti = STEP % 12; const int colb = (STEP < 12 ? 1024 : 2048) + C.hp * 256;
    const size_t tok0 = ti < 8 ? (size_t)C.b * SEQ + 64 * (C.rs + ti) : (size_t)T + C.b * CTXL + (ti - 8) * 64;
    const char* ub = (const char*)(C.P + tok0 * PLD + colb);
#pragma unroll
    for (int k = 0; k < 4; ++k) S.stg[k] = *(const u32x4*)(ub + (size_t)(32 * (k & 1)) * PLD * 2 + (k >> 1) * 256 + S.g_off);
}
template <int BUFI> DI void att_write(AttState& S, const AttCtx& C) {
#pragma unroll
    for (int k = 0; k < 4; ++k) *(LAS u32x4*)(C.lds + BUFI * ATT_BUF + (k >> 1) * ATT_TILE + 32 * (k & 1) * ATT_RS + S.w_off) = S.stg[k];
}
template <int STEP> DI void att_step(AttState& S, const AttCtx& C) {
    const float scale = 0.08838834764831845f;
    asm volatile("" : "+v"(S.g_off), "+v"(S.w_off), "+v"(S.ka_off), "+v"(S.va_off));
    if constexpr (STEP + 1 < 24) att_load<STEP + 1>(S, C);
    constexpr int bo = (STEP & 1) * ATT_BUF;
    if constexpr (STEP < 12) {
        constexpr int ti = STEP;
        if constexpr (ti < 8) {
            const int aidx = C.rs + ti - C.r + 7;
            const LAS float* brow = C.lrpb + C.hs * 465 + aidx * 31;
            bf16x8 kf[2][4]; f32x4 accs[2];
#pragma unroll
            for (int t = 0; t < 2; ++t) { const LAS unsigned char* ka = C.lds + bo + (C.c0 + 16 * t) * ATT_RS + S.ka_off; accs[t] = (f32x4){0.f, 0.f, 0.f, 0.f};
#pragma unroll
                for (int s4 = 0; s4 < 4; ++s4) kf[t][s4] = *(const LAS bf16x8*)(ka + s4 * 64); }
            asm volatile("" : "+v"(kf[0][0]), "+v"(kf[0][1]), "+v"(kf[0][2]), "+v"(kf[0][3]), "+v"(kf[1][0]), "+v"(kf[1][1]), "+v"(kf[1][2]), "+v"(kf[1][3]));
#pragma unroll
            for (int s4 = 0; s4 < 4; ++s4)
#pragma unroll
                for (int t = 0; t < 2; ++t) accs[t] = __builtin_amdgcn_mfma_f32_16x16x32_bf16(kf[t][s4], S.qf[s4], accs[t], 0, 0, 0);
#pragma unroll
            for (int t = 0; t < 2; ++t) { const int krow0 = C.c0 + 16 * t; const f32x4 acc = accs[t];
                float bias[4];
#pragma unroll
                for (int i = 0; i < 4; ++i) bias[i] = brow[min(max(krow0 + C.quad * 4 + i - C.qc + 15, 0), 30)];
                asm volatile("" : "+v"(bias[0]), "+v"(bias[1]), "+v"(bias[2]), "+v"(bias[3]));
#pragma unroll
                for (int i = 0; i < 4; ++i) { const int kcol = krow0 + C.quad * 4 + i; const bool ok = kcol >= C.csq && kcol < C.csq + 16; S.sc[ti * 2 + t][i] = ok ? acc[i] * scale + bias[i] : -1e30f; } }
        } else {
#pragma unroll
            for (int tp = 0; tp < 2; ++tp) {
                bf16x8 kf[2][4]; f32x4 accs[2];
#pragma unroll
                for (int t = 0; t < 2; ++t) { const LAS unsigned char* ka = C.lds + bo + 16 * (2 * tp + t) * ATT_RS + S.ka_off; accs[t] = (f32x4){0.f, 0.f, 0.f, 0.f};
#pragma unroll
                    for (int s4 = 0; s4 < 4; ++s4) kf[t][s4] = *(const LAS bf16x8*)(ka + s4 * 64); }
                asm volatile("" : "+v"(kf[0][0]), "+v"(kf[0][1]), "+v"(kf[0][2]), "+v"(kf[0][3]), "+v"(kf[1][0]), "+v"(kf[1][1]), "+v"(kf[1][2]), "+v"(kf[1][3]));
#pragma unroll
                for (int s4 = 0; s4 < 4; ++s4)
#pragma unroll
                    for (int t = 0; t < 2; ++t) accs[t] = __builtin_amdgcn_mfma_f32_16x16x32_bf16(kf[t][s4], S.qf[s4], accs[t], 0, 0, 0);
#pragma unroll
                for (int t = 0; t < 2; ++t) S.sc[16 + (ti - 8) * 4 + 2 * tp + t] = accs[t] * scale; }
        }
    } else {
        if constexpr (STEP == 12) {
            float m = -1e30f;
#pragma unroll
            for (int sl = 0; sl < 32; ++sl) m = fmaxf(fmaxf(m, fmaxf(S.sc[sl][0], S.sc[sl][1])), fmaxf(S.sc[sl][2], S.sc[sl][3]));
            m = fmaxf(m, __shfl_xor(m, 16)); m = fmaxf(m, __shfl_xor(m, 32));
            float sum = 0.f;
#pragma unroll
            for (int sl = 0; sl < 32; ++sl) { const float e0 = __expf(S.sc[sl][0] - m), e1 = __expf(S.sc[sl][1] - m), e2 = __expf(S.sc[sl][2] - m), e3 = __expf(S.sc[sl][3] - m);
                sum += (e0 + e1) + (e2 + e3); S.pk[sl][0] = pk2(e0, e1); S.pk[sl][1] = pk2(e2, e3); }
            sum += __shfl_xor(sum, 16); sum += __shfl_xor(sum, 32); S.inv = 1.f / sum;
#pragma unroll
            for (int dt = 0; dt < 8; ++dt) S.o[dt] = (f32x4){0.f, 0.f, 0.f, 0.f};
        }
        constexpr int ti = STEP - 12; constexpr int nks = ti < 8 ? 1 : 2;
#pragma unroll
        for (int kk = 0; kk < nks; ++kk) {
            const int sa = ti < 8 ? ti * 2 : 16 + (ti - 8) * 4 + 2 * kk; const int rb = ti < 8 ? C.c0 : 32 * kk;
            const u32x4 pw = (u32x4){S.pk[sa][0], S.pk[sa][1], S.pk[sa + 1][0], S.pk[sa + 1][1]}; const bf16x8 pf = __builtin_bit_cast(bf16x8, pw);
            const LAS unsigned char* va = C.lds + bo + rb * ATT_RS + S.va_off;
            s16x4 v1[8], v2[8];
#pragma unroll
            for (int dt = 0; dt < 8; ++dt) { v1[dt] = __builtin_amdgcn_ds_read_tr16_b64_v4i16((LAS s16x4*)(va + dt * 32)); v2[dt] = __builtin_amdgcn_ds_read_tr16_b64_v4i16((LAS s16x4*)(va + 16 * ATT_RS + dt * 32)); }
            asm volatile("s_waitcnt lgkmcnt(0)" : "+v"(v1[0]), "+v"(v1[1]), "+v"(v1[2]), "+v"(v1[3]), "+v"(v1[4]), "+v"(v1[5]), "+v"(v1[6]), "+v"(v1[7]),
                                                  "+v"(v2[0]), "+v"(v2[1]), "+v"(v2[2]), "+v"(v2[3]), "+v"(v2[4]), "+v"(v2[5]), "+v"(v2[6]), "+v"(v2[7]));
#pragma unroll
            for (int dt = 0; dt < 8; ++dt) { const bf16x8 vf = __builtin_shufflevector(v1[dt], v2[dt], 0, 1, 2, 3, 4, 5, 6, 7); S.o[dt] = __builtin_amdgcn_mfma_f32_16x16x32_bf16(vf, pf, S.o[dt], 0, 0, 0); }
        }
    }
    if constexpr (STEP + 1 < 24) { if constexpr (STEP >= 12) asm volatile("s_waitcnt lgkmcnt(0)" ::: "memory");
        att_write<(STEP + 1) & 1>(S, C); }
    __syncthreads();
}
DI void attn_phase(const bf16* P, const float* rpb, bf16* MIX, LAS unsigned char* lds, LAS float* lrpb) {
    const int tid = threadIdx.x, wid = __builtin_amdgcn_readfirstlane(tid >> 6), lane = tid & 63, hs = wid >> 2, j = wid & 3, lq = lane & 15, quad = lane >> 4;
    const int srow = tid >> 4, sch = tid & 15;
    AttState S; AttCtx C;
    C.P = P; C.lds = lds; C.lrpb = lrpb; C.hs = hs; C.quad = quad;
    C.c0 = (j == 0) ? 0 : (j == 1) ? 8 : (j == 2) ? 24 : 32;
    C.qc = 16 * j + lq; C.csq = min(max(C.qc - 8, 0), 48);
    S.g_off = (unsigned)(srow * PLD + sch * 8) * 2u;
    S.w_off = (unsigned)(srow * ATT_RS + sch * 16);
    S.ka_off = (unsigned)(hs * ATT_TILE + lq * ATT_RS + quad * 16);
    S.va_off = (unsigned)(hs * ATT_TILE + (4 * quad + (lq >> 2)) * ATT_RS + 8 * (lq & 3));
    const bool split = gridDim.x == 256;
    if (split && ((blockIdx.x >> 3) & 1)) return;
    const int L0 = split ? (int)((blockIdx.x >> 4) * 8 + (blockIdx.x & 7)) : (int)blockIdx.x, Ls = split ? 128 : (int)gridDim.x;
    for (int L = L0; L < 1024; L += Ls) {
        const int unit = xcd_remap(L, 1024);
        const int r = unit & 63, hp = (unit >> 6) & 3, b = unit >> 8, h = 2 * hp + hs;
        C.r = r; C.hp = hp; C.b = b; C.rs = min(max(r - 4, 0), 56);
        __syncthreads();
        for (int i = tid; i < 930; i += 512) lrpb[i] = rpb[(size_t)hp * 930 + i];
        const size_t tq = (size_t)b * SEQ + 64 * r + C.qc;
#pragma unroll
        for (int s4 = 0; s4 < 4; ++s4) S.qf[s4] = *(const bf16x8*)(P + tq * PLD + h * HD + s4 * 32 + quad * 8);
        att_load<0>(S, C); att_write<0>(S, C); __syncthreads();
        att_step<0>(S, C); att_step<1>(S, C); att_step<2>(S, C); att_step<3>(S, C); att_step<4>(S, C); att_step<5>(S, C); att_step<6>(S, C); att_step<7>(S, C);
        att_step<8>(S, C); att_step<9>(S, C); att_step<10>(S, C); att_step<11>(S, C); att_step<12>(S, C); att_step<13>(S, C); att_step<14>(S, C); att_step<15>(S, C);
        att_step<16>(S, C); att_step<17>(S, C); att_step<18>(S, C); att_step<19>(S, C); att_step<20>(S, C); att_step<21>(S, C); att_step<22>(S, C); att_step<23>(S, C);
        bf16* op = MIX + tq * D + h * HD + quad * 4;
#pragma unroll
        for (int dt = 0; dt < 8; ++dt) st_bf16x4(op + dt * 16, S.o[dt] * S.inv);
    }
}


constexpr int FF_RS = 544;
DI bf16x8 fft_frag(int kind  , int k, int s, int kq) {
    unsigned w[4];
#pragma unroll
    for (int p = 0; p < 4; ++p) { float v[2];
#pragma unroll
        for (int q = 0; q < 2; ++q) { const int j = 2 * p + q; const int jj = 32 * s + (j < 4 ? 4 * kq + j : 16 + 4 * kq + (j - 4)); const float rev = (float)((k * jj) & 63) * (1.f / 64.f);
            v[q] = (kind == 0 ? __builtin_amdgcn_cosf(rev) : kind == 1 ? -__builtin_amdgcn_sinf(rev) : __builtin_amdgcn_sinf(rev)) * 0.125f; }
        w[p] = pk2(v[0], v[1]); }
    return __builtin_bit_cast(bf16x8, (u32x4){w[0], w[1], w[2], w[3]});
}
DI bf16x8 fft_tr(const LAS unsigned char* p) { const s16x4 v1 = __builtin_amdgcn_ds_read_tr16_b64_v4i16((LAS s16x4*)p), v2 = __builtin_amdgcn_ds_read_tr16_b64_v4i16((LAS s16x4*)(p + 16 * FF_RS));
    return __builtin_shufflevector(v1, v2, 0, 1, 2, 3, 4, 5, 6, 7); }
DI void fft1_phase(const bf16* Up, bf16* YP, LAS unsigned char* lds) {
    const int tid = threadIdx.x, wave = __builtin_amdgcn_readfirstlane(tid >> 6), lane = tid & 63, ml = lane & 15, quad = lane >> 4;
    bf16x8 Ff[8][2];
#pragma unroll
    for (int mt = 0; mt < 8; ++mt)
#pragma unroll
        for (int s2 = 0; s2 < 2; ++s2) Ff[mt][s2] = fft_frag(mt < 4 ? 0 : 1, (16 * mt + ml) & 63, s2, quad);
    LAS float* tw = (LAS float*)(lds + 64 * FF_RS);
    const unsigned va_off = (unsigned)((4 * quad + (ml >> 2)) * FF_RS + 8 * (ml & 3) + 64 * wave);
    for (int unit = blockIdx.x; unit < 2048; unit += gridDim.x) {
        const int b = unit >> 9, j2 = (unit >> 3) & 63, c0 = (unit & 7) * 256;
        __syncthreads();
#pragma unroll
        for (int q = 0; q < 4; ++q) { const int j1 = (tid >> 5) + 16 * q;
            const u32x4 v = __builtin_nontemporal_load((const u32x4*)(Up + ((size_t)b * SEQ + 64 * j1 + j2) * D + c0 + (tid & 31) * 8));
            LAS unsigned char* wp = lds + j1 * FF_RS + (tid & 28) * 16 + (tid & 3) * 8;
            *(LAS u32x2*)wp = (u32x2){v.x, v.y}; *(LAS u32x2*)(wp + 32) = (u32x2){v.z, v.w}; }
        if (tid < 64) { const float rev = (float)(j2 * tid) * (1.f / 4096.f); tw[2 * tid] = __builtin_amdgcn_cosf(rev); tw[2 * tid + 1] = __builtin_amdgcn_sinf(rev); }
        __syncthreads();
        float cth4[4], sth4[4];
#pragma unroll
        for (int mp = 0; mp < 4; ++mp) { cth4[mp] = tw[2 * (16 * mp + ml)]; sth4[mp] = tw[2 * (16 * mp + ml) + 1]; }
        asm volatile("s_waitcnt lgkmcnt(0)" : "+v"(cth4[0]), "+v"(cth4[1]), "+v"(cth4[2]), "+v"(cth4[3]), "+v"(sth4[0]), "+v"(sth4[1]), "+v"(sth4[2]), "+v"(sth4[3]) :: "memory");
        f32x4 acc[8][2];
#pragma unroll
        for (int mt = 0; mt < 8; ++mt) { acc[mt][0] = (f32x4){0.f, 0.f, 0.f, 0.f}; acc[mt][1] = acc[mt][0]; }
#pragma unroll
        for (int s2 = 0; s2 < 2; ++s2)
#pragma unroll
            for (int nt = 0; nt < 2; ++nt) { const bf16x8 zf = fft_tr(lds + va_off + 32 * s2 * FF_RS + 32 * nt);
#pragma unroll
                for (int mt = 0; mt < 8; ++mt) acc[mt][nt] = __builtin_amdgcn_mfma_f32_16x16x32_bf16(zf, Ff[mt][s2], acc[mt][nt], 0, 0, 0); }
#pragma unroll
        for (int mp = 0; mp < 4; ++mp) { const int k1 = 16 * mp + ml; const float cth = cth4[mp], sth = sth4[mp];
            bf16* dr = YP + ((((size_t)b * 64 + k1) * 2) * 64 + j2) * D + c0 + 32 * wave + 8 * quad;
            st_bf16x8(dr, acc[mp][0] * cth + acc[mp + 4][0] * sth, acc[mp][1] * cth + acc[mp + 4][1] * sth);
            st_bf16x8(dr + (size_t)64 * D, acc[mp + 4][0] * cth - acc[mp][0] * sth, acc[mp + 4][1] * cth - acc[mp][1] * sth); }
    }
}
DI void fft2_phase(const bf16* YP, bf16* PCAT, LAS unsigned char* lds) {
    const int tid = threadIdx.x, wave = __builtin_amdgcn_readfirstlane(tid >> 6), lane = tid & 63, ml = lane & 15, quad = lane >> 4;
    bf16x8 Cf[4][2], Sf[4][2], Nf[4][2];
#pragma unroll
    for (int mt = 0; mt < 4; ++mt)
#pragma unroll
        for (int s2 = 0; s2 < 2; ++s2) { Cf[mt][s2] = fft_frag(0, 16 * mt + ml, s2, quad); Nf[mt][s2] = fft_frag(1, 16 * mt + ml, s2, quad); Sf[mt][s2] = fft_frag(2, 16 * mt + ml, s2, quad); }
    const unsigned va_off = (unsigned)((4 * quad + (ml >> 2)) * FF_RS + 8 * (ml & 3) + 64 * wave);
    for (int unit = blockIdx.x; unit < 2048; unit += gridDim.x) {
        const int b = unit >> 9, k1 = (unit >> 3) & 63, cc = unit & 7, c0 = cc * 256;
        __syncthreads();
#pragma unroll
        for (int q = 0; q < 8; ++q) { const int kr = (tid >> 5) + 16 * q;
            const u32x4 v = __builtin_nontemporal_load((const u32x4*)(YP + (((size_t)b * 64 + k1) * 128 + kr) * D + c0 + (tid & 31) * 8));
            LAS unsigned char* wp = lds + kr * FF_RS + (tid & 28) * 16 + (tid & 3) * 8;
            *(LAS u32x2*)wp = (u32x2){v.x, v.y}; *(LAS u32x2*)(wp + 32) = (u32x2){v.z, v.w}; }
        __syncthreads();
        f32x4 acc[8][2];
#pragma unroll
        for (int mt = 0; mt < 8; ++mt) { acc[mt][0] = (f32x4){0.f, 0.f, 0.f, 0.f}; acc[mt][1] = acc[mt][0]; }
#pragma unroll
        for (int s4 = 0; s4 < 4; ++s4)
#pragma unroll
            for (int nt = 0; nt < 2; ++nt) { const bf16x8 yf = fft_tr(lds + va_off + 32 * s4 * FF_RS + 32 * nt);
#pragma unroll
                for (int mt = 0; mt < 4; ++mt) {
                    if (s4 < 2) { acc[mt][nt] = __builtin_amdgcn_mfma_f32_16x16x32_bf16(yf, Cf[mt][s4], acc[mt][nt], 0, 0, 0); acc[mt + 4][nt] = __builtin_amdgcn_mfma_f32_16x16x32_bf16(yf, Nf[mt][s4], acc[mt + 4][nt], 0, 0, 0); }
                    else { acc[mt][nt] = __builtin_amdgcn_mfma_f32_16x16x32_bf16(yf, Sf[mt][s4 - 2], acc[mt][nt], 0, 0, 0); acc[mt + 4][nt] = __builtin_amdgcn_mfma_f32_16x16x32_bf16(yf, Cf[mt][s4 - 2], acc[mt + 4][nt], 0, 0, 0); } } }
        const int g = cc >> 1, cp0 = (cc & 1) * 256 + 32 * wave + 8 * quad;
#pragma unroll
        for (int mt = 0; mt < 8; ++mt) { const int part = mt >> 2, k2 = 16 * (mt & 3) + ml;
            bf16* dp = PCAT + ((size_t)b * SEQ + k1 + 64 * k2) * 4096 + g * 1024 + part * 512 + cp0;
            st_bf16x8(dp, acc[mt][0], acc[mt][1]); }
    }
}

DI void conv_phase(const bf16* P, const float* cw, bf16* MIX, int gtid, int GT) {
    const int c8 = (gtid & 127) * 8;
    float w[3][8];
#pragma unroll
    for (int j = 0; j < 3; ++j) { const f32x4 a = *(const f32x4*)(cw + j * 1024 + c8), b = *(const f32x4*)(cw + j * 1024 + c8 + 4); w[j][0] = a.x; w[j][1] = a.y; w[j][2] = a.z; w[j][3] = a.w; w[j][4] = b.x; w[j][5] = b.y; w[j][6] = b.z; w[j][7] = b.w; }
    for (int tp = gtid >> 7; tp < T / 2; tp += GT >> 7) {
        const int tok = tp * 2, l = tok & 4095;
        const bf16* base = P + (size_t)tok * PLD + 3072 + c8;
        u32x4 gc[4], xi[4];
#pragma unroll
        for (int j = 0; j < 4; ++j) { int d = j - 1; if (j == 0 && l == 0) d = 0; if (j == 3 && l + 2 >= SEQ) d = 1; const bf16* pj = base + (ptrdiff_t)d * PLD; gc[j] = *(const u32x4*)(pj + 1024); xi[j] = *(const u32x4*)(pj + 2048); }
        const u32x4 gb0 = *(const u32x4*)base, gb1 = *(const u32x4*)(base + PLD);
        float z[4][8];
#pragma unroll
        for (int j = 0; j < 4; ++j) { const float m = (j == 0 && l == 0) || (j == 3 && l + 2 >= SEQ) ? 0.f : 1.f;
            z[j][0] = m * bflo(gc[j].x) * bflo(xi[j].x); z[j][1] = m * bfhi(gc[j].x) * bfhi(xi[j].x); z[j][2] = m * bflo(gc[j].y) * bflo(xi[j].y); z[j][3] = m * bfhi(gc[j].y) * bfhi(xi[j].y);
            z[j][4] = m * bflo(gc[j].z) * bflo(xi[j].z); z[j][5] = m * bfhi(gc[j].z) * bfhi(xi[j].z); z[j][6] = m * bflo(gc[j].w) * bflo(xi[j].w); z[j][7] = m * bfhi(gc[j].w) * bfhi(xi[j].w); }
        const float g0[8] = {bflo(gb0.x), bfhi(gb0.x), bflo(gb0.y), bfhi(gb0.y), bflo(gb0.z), bfhi(gb0.z), bflo(gb0.w), bfhi(gb0.w)};
        const float g1[8] = {bflo(gb1.x), bfhi(gb1.x), bflo(gb1.y), bfhi(gb1.y), bflo(gb1.z), bfhi(gb1.z), bflo(gb1.w), bfhi(gb1.w)};
        float o0[8], o1[8];
#pragma unroll
        for (int e = 0; e < 8; ++e) { o0[e] = g0[e] * (w[0][e] * z[0][e] + w[1][e] * z[1][e] + w[2][e] * z[2][e]); o1[e] = g1[e] * (w[0][e] * z[1][e] + w[1][e] * z[2][e] + w[2][e] * z[3][e]); }
        *(u32x4*)(MIX + (size_t)tok * D + 1024 + c8) = (u32x4){pk2(o0[0], o0[1]), pk2(o0[2], o0[3]), pk2(o0[4], o0[5]), pk2(o0[6], o0[7])};
        *(u32x4*)(MIX + (size_t)(tok + 1) * D + 1024 + c8) = (u32x4){pk2(o1[0], o1[1]), pk2(o1[2], o1[3]), pk2(o1[4], o1[5]), pk2(o1[6], o1[7])};
    }
}
constexpr int RT_RS = 4112, RT_IMG = 16 * RT_RS;
DI void split_bf16(const float* w8, bf16x8& hi, bf16x8& lo) {
    unsigned h[4], l[4];
#pragma unroll
    for (int p = 0; p < 4; ++p) { const unsigned a = f2bf(w8[2 * p]), b = f2bf(w8[2 * p + 1]); h[p] = a | (b << 16);
        l[p] = pk2(w8[2 * p] - __uint_as_float(a << 16), w8[2 * p + 1] - __uint_as_float(b << 16)); }
    hi = __builtin_bit_cast(bf16x8, (u32x4){h[0], h[1], h[2], h[3]}); lo = __builtin_bit_cast(bf16x8, (u32x4){l[0], l[1], l[2], l[3]});
}
template <typename TX>
DI void ln_router_phase(const TX* XSp, const bf16* YMp, const float* lng, const float* lnb, const float* mods_l, const float* rw, const float* rbias,
                        bf16* X1p, bf16* Up, unsigned* counts, int* tablep, unsigned* tokinfop, LAS unsigned char* lds) {
    const int tid = threadIdx.x, wave = __builtin_amdgcn_readfirstlane(tid >> 6), lane = tid & 63, fr = lane & 15, fq = lane >> 4;
    bf16x8 bh[8][2], bl[8][2];
    { const bf16x8* rf = (const bf16x8*)rw + (size_t)wave * 8 * 2 * 2 * 64 + lane;
#pragma unroll
      for (int ks = 0; ks < 8; ++ks)
#pragma unroll
        for (int nt = 0; nt < 2; ++nt) { bh[ks][nt] = rf[((ks * 2 + nt) * 2 + 0) * 64]; bl[ks][nt] = rf[((ks * 2 + nt) * 2 + 1) * 64]; } }
    LAS unsigned char* par = lds + RT_IMG; LAS float* part = (LAS float*)(lds + RT_IMG + 40960); LAS float* lgs = (LAS float*)(lds + RT_IMG + 40960 + 16384);
    LAS unsigned* lcnt = (LAS unsigned*)(lds + RT_IMG + 40960 + 16384 + 4608); LAS unsigned* lbase = lcnt + 32; LAS unsigned* rinfo = lcnt + 64;
    if (tid < 32) lcnt[tid] = 0u;
    int nq = 0;
    const int per = (T / 16 + (int)gridDim.x - 1) / (int)gridDim.x, rg_end = min(T / 16, ((int)blockIdx.x + 1) * per); int cur_b = -1;
    for (int rg = blockIdx.x * per; rg < rg_end; ++rg) {
        __syncthreads();
        if (((rg * 16) >> 12) != cur_b) { cur_b = (rg * 16) >> 12; const float* mb = mods_l + (size_t)cur_b * MODW;
          const f32x4 p0 = ((const f32x4*)(mb + 2 * D))[tid], p1 = ((const f32x4*)lng)[tid], p2 = ((const f32x4*)lnb)[tid], p3 = ((const f32x4*)(mb + 3 * D))[tid], p4 = ((const f32x4*)(mb + 4 * D))[tid];
          ((LAS f32x4*)par)[tid] = p0; ((LAS f32x4*)(par + 8192))[tid] = p1; ((LAS f32x4*)(par + 16384))[tid] = p2; ((LAS f32x4*)(par + 24576))[tid] = p3; ((LAS f32x4*)(par + 32768))[tid] = p4;
          __syncthreads(); }
#pragma unroll 1
        for (int rr = 0; rr < 2; ++rr) {
            const int lr = 2 * wave + rr, row = rg * 16 + lr;
            Row r; row_load_nt(r, XSp + (size_t)row * D, lane);
            { const u32x2* yq = (const u32x2*)(YMp + (size_t)row * D) + lane; const LAS f32x4* g1 = (const LAS f32x4*)par + lane;
              u32x2 yv[8];
#pragma unroll
              for (int j = 0; j < 8; ++j) yv[j] = __builtin_nontemporal_load(yq + 64 * j);
              asm volatile("" : "+v"(yv[0]), "+v"(yv[1]), "+v"(yv[2]), "+v"(yv[3]), "+v"(yv[4]), "+v"(yv[5]), "+v"(yv[6]), "+v"(yv[7]));
#pragma unroll
              for (int j = 0; j < 8; ++j) { const f32x4 yf = (f32x4){bflo(yv[j].x), bfhi(yv[j].x), bflo(yv[j].y), bfhi(yv[j].y)}; r.v[j] = r.v[j] * ALPHA + g1[64 * j] * yf; } }
            row_ln(r);
            { const LAS f32x4* gq = (const LAS f32x4*)(par + 8192) + lane; const LAS f32x4* bq = (const LAS f32x4*)(par + 16384) + lane;
#pragma unroll
              for (int j = 0; j < 8; ++j) r.v[j] = r.v[j] * gq[64 * j] + bq[64 * j]; }
            row_store_nt(r, X1p + (size_t)row * D, lane);
            row_ln(r);
            { const LAS f32x4* hq = (const LAS f32x4*)(par + 24576) + lane; const LAS f32x4* cq = (const LAS f32x4*)(par + 32768) + lane;
#pragma unroll
              for (int j = 0; j < 8; ++j) r.v[j] = r.v[j] * (cq[64 * j] + 1.f) + hq[64 * j]; }
            u32x2* uq = (u32x2*)(Up + (size_t)row * D) + lane;
#pragma unroll
            for (int j = 0; j < 8; ++j) { const unsigned a = f2bf(r.v[j].x), b = f2bf(r.v[j].y), c = f2bf(r.v[j].z), d = f2bf(r.v[j].w);
                u32x2 hi; hi.x = a | (b << 16); hi.y = c | (d << 16); uq[64 * j] = hi;
                u32x2 lo; lo.x = pk2(r.v[j].x - __uint_as_float(a << 16), r.v[j].y - __uint_as_float(b << 16)); lo.y = pk2(r.v[j].z - __uint_as_float(c << 16), r.v[j].w - __uint_as_float(d << 16));
                *(LAS u32x2*)(lds + lr * RT_RS + (4 * lane + 256 * j) * 2) = lo; }
        }
        asm volatile("s_waitcnt vmcnt(0)" ::: "memory");
        __syncthreads();
        f32x4 acc[2]; acc[0] = (f32x4){0.f, 0.f, 0.f, 0.f}; acc[1] = acc[0];
        const LAS unsigned char* ap = lds + fr * RT_RS + (256 * wave + 8 * fq) * 2;
        const bf16* hp = Up + (size_t)(rg * 16 + fr) * D + 256 * wave + 8 * fq;
        bf16x8 ahv[8];
#pragma unroll
        for (int ks = 0; ks < 8; ++ks) ahv[ks] = __builtin_nontemporal_load((const bf16x8*)(hp + 32 * ks));
        asm volatile("" : "+v"(ahv[0]), "+v"(ahv[1]), "+v"(ahv[2]), "+v"(ahv[3]), "+v"(ahv[4]), "+v"(ahv[5]), "+v"(ahv[6]), "+v"(ahv[7]));
#pragma unroll
        for (int ks = 0; ks < 8; ++ks) { const bf16x8 ah = ahv[ks], al = *(const LAS bf16x8*)(ap + ks * 64);
#pragma unroll
            for (int nt = 0; nt < 2; ++nt) { acc[nt] = __builtin_amdgcn_mfma_f32_16x16x32_bf16(ah, bh[ks][nt], acc[nt], 0, 0, 0); acc[nt] = __builtin_amdgcn_mfma_f32_16x16x32_bf16(ah, bl[ks][nt], acc[nt], 0, 0, 0);
                acc[nt] = __builtin_amdgcn_mfma_f32_16x16x32_bf16(al, bh[ks][nt], acc[nt], 0, 0, 0); } }
#pragma unroll
        for (int nt = 0; nt < 2; ++nt)
#pragma unroll
            for (int i = 0; i < 4; ++i) part[(wave * 16 + fq * 4 + i) * 32 + nt * 16 + fr] = acc[nt][i];
        __syncthreads();
        { const int r16 = tid >> 5, e = tid & 31; float sacc = 0.f;
#pragma unroll
            for (int w = 0; w < 8; ++w) sacc += part[(w * 16 + r16) * 32 + e];
            const float af = 1.f / (1.f + expf(-sacc)); const float bi = af + rbias[e];
            lgs[r16 * 32 + e] = af; lgs[512 + r16 * 32 + e] = bi;
            const float b1 = dpp_f<0xB1>(bi), b2 = dpp_f<0x4E>(bi), b3 = dpp_f<0x1B>(bi);
            const float hi1 = fmaxf(bi, b1), lo1 = fminf(bi, b1), hi2 = fmaxf(b2, b3), lo2 = fminf(b2, b3);
            const float scg = fmaxf(hi1, hi2) + fmaxf(fminf(hi1, hi2), fmaxf(lo1, lo2));
            if ((e & 3) == 0) lgs[1024 + r16 * 8 + (e >> 2)] = scg; }
        __syncthreads();
        if (tid < 16) {
            const int row = rg * 16 + tid; const LAS float* gs = lgs + 1024 + tid * 8;
            float best = -1e30f; int grp = 0;
#pragma unroll
            for (int g = 0; g < 8; ++g) { const float scg = gs[g]; if (scg > best) { best = scg; grp = g; } }
            float ga[4], gv[4];
#pragma unroll
            for (int i = 0; i < 4; ++i) { ga[i] = lgs[tid * 32 + 4 * grp + i]; gv[i] = lgs[512 + tid * 32 + 4 * grp + i]; }
            int i1 = 0; float v1 = gv[0]; if (gv[1] > v1) { v1 = gv[1]; i1 = 1; } if (gv[2] > v1) { v1 = gv[2]; i1 = 2; } if (gv[3] > v1) { v1 = gv[3]; i1 = 3; }
            int i2 = -1; float v2 = -1e30f;
            if (i1 != 0 && gv[0] > v2) { v2 = gv[0]; i2 = 0; } if (i1 != 1 && gv[1] > v2) { v2 = gv[1]; i2 = 1; } if (i1 != 2 && gv[2] > v2) { v2 = gv[2]; i2 = 2; } if (i1 != 3 && gv[3] > v2) { v2 = gv[3]; i2 = 3; }
            const float a1 = i1 == 0 ? ga[0] : i1 == 1 ? ga[1] : i1 == 2 ? ga[2] : ga[3], a2 = i2 == 0 ? ga[0] : i2 == 1 ? ga[1] : i2 == 2 ? ga[2] : ga[3];
            const float w1 = a1 / (a1 + a2), w2 = a2 / (a1 + a2);
            const int e1 = grp * 4 + i1, e2 = grp * 4 + i2;
            const unsigned l1 = __hip_atomic_fetch_add(lcnt + e1, 1u, __ATOMIC_RELAXED, __HIP_MEMORY_SCOPE_WORKGROUP);
            const unsigned l2 = __hip_atomic_fetch_add(lcnt + e2, 1u, __ATOMIC_RELAXED, __HIP_MEMORY_SCOPE_WORKGROUP);
            LAS unsigned* ri = rinfo + (nq * 16 + tid) * 8;
            ri[0] = (unsigned)row; ri[1] = (unsigned)e1; ri[2] = (unsigned)e2; ri[3] = l1; ri[4] = l2; ri[5] = __float_as_uint(w1); ri[6] = __float_as_uint(w2);
        }
        ++nq;
        if (nq == 4 || rg + 1 >= rg_end) {
            __syncthreads();
            if (tid < 32) { const unsigned c = lcnt[tid]; lbase[tid] = c ? __hip_atomic_fetch_add(counts + tid, c, __ATOMIC_RELAXED, __HIP_MEMORY_SCOPE_AGENT) : 0u; }
            __syncthreads();
            if (tid < nq * 16) { const LAS unsigned* ri = rinfo + tid * 8;
                const unsigned row = ri[0], e1 = ri[1], e2 = ri[2], p1 = lbase[e1] + ri[3], p2 = lbase[e2] + ri[4];
                tablep[(size_t)e1 * T + p1] = (int)row; tablep[(size_t)e2 * T + p2] = (int)row;
                u32x4 ta; ta.x = e1; ta.y = e2; ta.z = p1; ta.w = p2; u32x4 tb2; tb2.x = ri[5]; tb2.y = ri[6]; tb2.z = 0u; tb2.w = 0u;
                *(u32x4*)(tokinfop + (size_t)row * 8) = ta; *(u32x4*)(tokinfop + (size_t)row * 8 + 4) = tb2; }
            __syncthreads();
            if (tid < 32) lcnt[tid] = 0u;
            nq = 0;
        }
    }
}
DI void p0_rwf(const float* rw, bf16x8* RWF, int gtid, int GT) {
    for (int i = gtid; i < 8 * 8 * 2 * 64; i += GT) { const int lane = i & 63, nt = (i >> 6) & 1, ks = (i >> 7) & 7, wave = i >> 10, fr = lane & 15, fq = lane >> 4;
        float w8[8];
#pragma unroll
        for (int j = 0; j < 8; ++j) w8[j] = rw[(size_t)(256 * wave + 32 * ks + 8 * fq + j) * NE + nt * 16 + fr];
        bf16x8 hi, lo; split_bf16(w8, hi, lo);
        RWF[(((wave * 8 + ks) * 2 + nt) * 2 + 0) * 64 + lane] = hi; RWF[(((wave * 8 + ks) * 2 + nt) * 2 + 1) * 64 + lane] = lo; }
}
DI void moe_prefix(const unsigned* counts, LAS int* cnt, LAS int* tb, int tid) {
    __syncthreads();
    if (tid < 32) cnt[tid] = (int)__hip_atomic_load(counts + tid, __ATOMIC_RELAXED, __HIP_MEMORY_SCOPE_AGENT);
    __syncthreads();
    if (tid == 0) { int a = 0; for (int e = 0; e < 32; ++e) { tb[e] = a; a += (cnt[e] + 255) >> 8; } tb[32] = a; }
    __syncthreads();
}
template <typename TO>
DI void combine_phase(const bf16* X1, const bf16* Y, const unsigned* tokinfo, const LAS int* tb, const float* mods_l, const float* lng, const float* lnb,
                      TO* XO, const float* mods_next, bf16* U, LAS unsigned char* lds, int tid, int wave, int lane) {
    LAS f32x4* par = (LAS f32x4*)lds;
    par[tid] = ((const f32x4*)lng)[tid]; par[512 + tid] = ((const f32x4*)lnb)[tid];
    const int step = gridDim.x * 8; int cur_b = -1;
    volatile LAS unsigned* tiw = (volatile LAS unsigned*)(lds + 40960) + wave * 64;
#define COMB_ISSUE(kq, rowq) do { const int e0_ = __builtin_amdgcn_readfirstlane((int)tiw[(kq) * 8]), e1_ = __builtin_amdgcn_readfirstlane((int)tiw[(kq) * 8 + 1]); \
        const size_t r0_ = (size_t)(__builtin_amdgcn_readfirstlane(tb[e0_]) * 256 + __builtin_amdgcn_readfirstlane((int)tiw[(kq) * 8 + 2])), r1_ = (size_t)(__builtin_amdgcn_readfirstlane(tb[e1_]) * 256 + __builtin_amdgcn_readfirstlane((int)tiw[(kq) * 8 + 3])); \
        nw0 = __uint_as_float(tiw[(kq) * 8 + 4]); nw1 = __uint_as_float(tiw[(kq) * 8 + 5]); \
        const u32x2* xq_ = (const u32x2*)(X1 + (size_t)(rowq) * D) + lane; const u32x2* y0_ = (const u32x2*)(Y + r0_ * D) + lane; const u32x2* y1_ = (const u32x2*)(Y + r1_ * D) + lane; \
        _Pragma("unroll") for (int j = 0; j < 8; ++j) { nx[j] = __builtin_nontemporal_load(xq_ + 64 * j); na[j] = __builtin_nontemporal_load(y0_ + 64 * j); nb[j] = __builtin_nontemporal_load(y1_ + 64 * j); } } while (0)
    u32x2 nx[8], na[8], nb[8]; float nw0 = 0.f, nw1 = 0.f;
    for (int base = blockIdx.x * 8; base < T; base += 8 * step) {
      { const int rr = base + wave + (lane >> 3) * step; tiw[lane] = rr < T ? tokinfo[(size_t)rr * 8 + (lane & 7)] : 0u; }
      COMB_ISSUE(0, base + wave);
      asm volatile("" : "+v"(nx[0]), "+v"(nx[1]), "+v"(nx[2]), "+v"(nx[3]), "+v"(nx[4]), "+v"(nx[5]), "+v"(nx[6]), "+v"(nx[7]), "+v"(na[0]), "+v"(na[1]), "+v"(na[2]), "+v"(na[3]), "+v"(na[4]), "+v"(na[5]), "+v"(na[6]), "+v"(na[7]),
                       "+v"(nb[0]), "+v"(nb[1]), "+v"(nb[2]), "+v"(nb[3]), "+v"(nb[4]), "+v"(nb[5]), "+v"(nb[6]), "+v"(nb[7]));
#pragma unroll 1
      for (int kk = 0; kk < 8; ++kk) {
        const int row = base + wave + kk * step;
        if (row - wave >= T) break;
        const int b = row >> 12;
        if (b != cur_b) { cur_b = b; __syncthreads();
            par[1024 + tid] = ((const f32x4*)(mods_l + (size_t)b * MODW + 5 * D))[tid];
            if (U) { const float* mn = mods_next + (size_t)b * MODW; par[1536 + tid] = ((const f32x4*)mn)[tid]; par[2048 + tid] = ((const f32x4*)(mn + D))[tid]; }
            __syncthreads(); }
        u32x2 xv[8], av[8], bv[8];
#pragma unroll
        for (int j = 0; j < 8; ++j) { xv[j] = nx[j]; av[j] = na[j]; bv[j] = nb[j]; }
        const float w0 = nw0, w1 = nw1;
        asm volatile("" : "+v"(xv[0]), "+v"(xv[1]), "+v"(xv[2]), "+v"(xv[3]), "+v"(xv[4]), "+v"(xv[5]), "+v"(xv[6]), "+v"(xv[7]), "+v"(av[0]), "+v"(av[1]), "+v"(av[2]), "+v"(av[3]), "+v"(av[4]), "+v"(av[5]), "+v"(av[6]), "+v"(av[7]),
                         "+v"(bv[0]), "+v"(bv[1]), "+v"(bv[2]), "+v"(bv[3]), "+v"(bv[4]), "+v"(bv[5]), "+v"(bv[6]), "+v"(bv[7]));
        if (kk + 1 < 8 && row - wave + step < T) COMB_ISSUE(kk + 1, row + step);
        __builtin_amdgcn_sched_barrier(0);
        Row r;
#pragma unroll
        for (int j = 0; j < 8; ++j) { const u32x2 x = xv[j], a = av[j], c = bv[j]; f32x4 f;
            f.x = w0 * bflo(a.x) + w1 * bflo(c.x); f.y = w0 * bfhi(a.x) + w1 * bfhi(c.x); f.z = w0 * bflo(a.y) + w1 * bflo(c.y); f.w = w0 * bfhi(a.y) + w1 * bfhi(c.y);
            r.v[j] = (f32x4){bflo(x.x), bfhi(x.x), bflo(x.y), bfhi(x.y)} * ALPHA + par[1024 + lane + 64 * j] * f; }
        row_ln(r);
#pragma unroll
        for (int j = 0; j < 8; ++j) r.v[j] = r.v[j] * par[lane + 64 * j] + par[512 + lane + 64 * j];
        row_store_nt(r, XO + (size_t)row * D, lane);
        if (U) { row_ln(r);
#pragma unroll
            for (int j = 0; j < 8; ++j) r.v[j] = r.v[j] * (par[2048 + lane + 64 * j] + 1.f) + par[1536 + lane + 64 * j];
            row_store_bf16(r, U + (size_t)row * D, lane); }
      }
    }
#undef COMB_ISSUE
}

struct Args { const float* in[18]; float* out; unsigned char* ws; int ph_lo, ph_hi; };
__global__ void __launch_bounds__(512, 2) fwd(Args args) {
    extern __shared__ __attribute__((aligned(16))) unsigned char lds_raw[];
    LAS unsigned char* lds = (LAS unsigned char*)lds_raw;
#define PH_IDS int tid = threadIdx.x; asm volatile("" : "+v"(tid)); const int lane = tid & 63, wave = __builtin_amdgcn_readfirstlane(tid >> 6); \
    const int gw = blockIdx.x * 8 + wave, NGW = gridDim.x * 8, gtid = blockIdx.x * 512 + tid, GT = gridDim.x * 512; (void)lane; (void)gw; (void)NGW; (void)gtid; (void)GT;
    volatile LAS unsigned* LCTL = (volatile LAS unsigned*)(lds + LDSCTL_OFF);
    LAS int* l_cnt = (LAS int*)(lds + LDSCTL_OFF) + 16; LAS int* l_tb = (LAS int*)(lds + LDSCTL_OFF) + 48;
    for (int u = threadIdx.x; u < (LDS_BYTES - LDSCTL_OFF) / 4; u += 512) ((LAS unsigned*)(lds + LDSCTL_OFF))[u] = 0u;
    __syncthreads();
    unsigned char* ws = args.ws;
    unsigned* ctl = (unsigned*)(ws + WS_CTL);
#define XIN ((const float*)args.in[0])
#define c_in args.in[1]
#define ctx args.in[2]
#define c_ctx args.in[3]
#define ada_w args.in[4]
#define ada_b args.in[5]
#define w_mix_in args.in[6]
#define rpb args.in[7]
#define conv_w args.in[8]
#define w_mix_out args.in[9]
#define w_fourier args.in[10]
#define router_w args.in[11]
#define router_b args.in[12]
#define w_gate args.in[13]
#define w_up args.in[14]
#define w_down args.in[15]
#define ln_g args.in[16]
#define ln_b args.in[17]
#define mods ((float*)(ws + WS_MODS))
#define tokinfo ((unsigned*)(ws + WS_TOKINFO))
#define table ((int*)(ws + WS_TABLE))
#define WIN ((bf16*)(ws + WS_WIN))
#define WO ((bf16*)(ws + WS_WO))
#define WF ((bf16*)(ws + WS_WF))
#define CSM ((bf16*)(ws + WS_CS))
#define U ((bf16*)(ws + WS_U))
#define P ((bf16*)(ws + WS_P))
#define YB ((bf16*)(ws + WS_P))
#define YPB ((bf16*)(ws + WS_P))
#define PCATB ((bf16*)(ws + WS_TB))
#define MIX ((bf16*)(ws + WS_MIX))
#define REZ ((bf16*)(ws + WS_MIX))
#define HB ((bf16*)(ws + WS_H))
#define WGU ((bf16*)(ws + WS_WGU))
#define WD ((bf16*)(ws + WS_WD))
#define TB ((float*)(ws + WS_TB))
#define YMB ((bf16*)(ws + WS_TB))
#define X1 ((bf16*)(ws + WS_X1))
#define X2 ((bf16*)(ws + WS_X2))
    XcdBarrier bar; bar.bar = ctl + CW_BAR; bar.x = 0; bar.st = nullptr;
    if (N_LAUNCHES != NPHASE) bar = xcd_barrier_post(ctl + CW_BAR, LCTL);
    const int lo = args.ph_lo, hi = args.ph_hi;
#ifndef DUP_MASK
#define DUP_MASK 0x0000
#endif
#define RUN(k, ...) do { __VA_ARGS__ if constexpr ((((DUP_MASK) >> (k)) & 1) != 0) { __VA_ARGS__ } } while (0)
#ifndef PH_MASK
#define PH_MASK 0x1ffff
#endif
#define IN(k) ((((PH_MASK) >> (k)) & 1) && lo <= (k) && (k) < hi)
    const ConvCtx cvx{w_mix_in, w_mix_out, w_fourier, w_gate, w_up, w_down, WIN, WO, WF, WGU, WD, ctl + 161, ctl + 162};
#define SEAM(k) do { if (IN(k) && IN((k) + 1)) { if ((k) == 5) moe_drain(cvx, 0, lds); if ((k) == 13) moe_drain(cvx, 1, lds); \
        if ((k) < 13 && (k) != 5) xcd_barrier_steal(bar, cvx, false, lds); else xcd_barrier(bar); } } while (0)

    RUN(0, if (IN(0)) { PH_IDS
        LAS float* sl = (LAS float*)lds; LAS float* red = sl + 5 * D; volatile LAS int* qslot = (volatile LAS int*)(lds + LDSCTL_OFF) + 8;
        for (int i = tid; i < 5 * D; i += 512) { const float v = i < 4 * D ? c_in[i] : c_ctx[i - 4 * D]; sl[i] = silu_f(v); }
        __syncthreads();
        for (bool first = true;; first = false) {
            if (tid == 0) *qslot = first ? (int)blockIdx.x : (int)gridDim.x + (int)__hip_atomic_fetch_add(ctl + 160, 1u, __ATOMIC_RELAXED, __HIP_MEMORY_SCOPE_AGENT);
            __syncthreads();
            const int item = __builtin_amdgcn_readfirstlane(*qslot);
            __syncthreads();
            if (item >= P0_NMODS + P0_S_IN + 2 * P0_S_SQ) break;
            if (item < P0_NMODS) p0_mods_unit(ada_w, ada_b, mods, sl, red, item, tid);
            else p0_weight_item(item - P0_NMODS, w_mix_in, w_mix_out, w_fourier, w_gate, w_up, w_down, WIN, WO, WF, WGU, WD, lds + wave * 16384, wave, lane);
        }
        p0_dft(CSM, gtid, GT); p0_rwf(router_w, (bf16x8*)(ws + 50 * MiB), gtid, GT);
    });
    SEAM(0);
    RUN(1, if (IN(1)) { PH_IDS ln_mod_phase(XIN, ctx, mods, 0, U, TALL, lds, tid, wave, lane); });
    SEAM(1);
    RUN(2, if (IN(2)) { SchedInProj S{U, WIN}; EpiStoreBf16 E{P, PLD}; gemm_pg8<false>(lds, S, E, D, D, D); });
    SEAM(2);
    RUN(3, if (IN(3)) { PH_IDS conv_phase(P, conv_w, MIX, gtid, GT); attn_phase(P, rpb, MIX, lds, (LAS float*)(lds + LDSCTL_OFF + 1024)); });
    SEAM(3);
    RUN(4, if (IN(4)) { SchedDense S{MIX, WO, 64, 8, (size_t)256 * D, (size_t)256 * D}; EpiStoreBf16 E{YMB, D}; gemm_pg8<false>(lds, S, E, D, D, D); });
    SEAM(4);
    RUN(5, if (IN(5)) { PH_IDS ln_router_phase(XIN, YMB, ln_g, ln_b, mods, (const float*)(ws + 50 * MiB), router_b, X1, U, ctl + CW_CNT, table, tokinfo, lds); });
    SEAM(5);
    RUN(6, if (IN(6)) { PH_IDS moe_prefix(ctl + CW_CNT, l_cnt, l_tb, tid); SchedMoe S{l_cnt, l_tb, U, WGU, table, 1, 0, (size_t)D * D, (size_t)256 * D}; EpiSwiglu E{HB}; gemm_pg8<true>(lds, S, E, D, D, D); });
    SEAM(6);
    RUN(7, if (IN(7)) { PH_IDS if (lo == 7) moe_prefix(ctl + CW_CNT, l_cnt, l_tb, tid);     SchedMoe S{l_cnt, l_tb, HB, WD, table, 0, (size_t)256 * DE, (size_t)D * DE, (size_t)256 * DE}; EpiStoreBf16 E{YB, D}; gemm_pg8<false>(lds, S, E, DE, DE, DE); });
    SEAM(7);
    RUN(8, if (IN(8)) { PH_IDS if (lo == 8) moe_prefix(ctl + CW_CNT, l_cnt, l_tb, tid);     combine_phase(X1, YB, tokinfo, l_tb, mods, ln_g + D, ln_b + D, X2, mods + 5 * MODW, U, lds, tid, wave, lane); });
    SEAM(8);
    RUN(9, if (IN(9)) { fft1_phase(U, YPB, lds); });
    SEAM(9);
    RUN(10, if (IN(10)) { fft2_phase(YPB, PCATB, lds); });
    SEAM(10);
    RUN(11, if (IN(11)) { SchedChan S{PCATB, CSM}; EpiStoreBf16 E{REZ, D}; gemm_pg8<false>(lds, S, E, 4096, 1024, 1024); });
    SEAM(11);
    RUN(12, if (IN(12)) { SchedDense S{REZ, WF, 64, 8, (size_t)256 * D, (size_t)256 * D}; EpiStoreBf16 E{YMB, D}; gemm_pg8<false>(lds, S, E, D, D, D); });
    SEAM(12);
    RUN(13, if (IN(13)) { PH_IDS ln_router_phase(X2, YMB, ln_g + 2 * D, ln_b + 2 * D, mods + 5 * MODW, (const float*)(ws + 50 * MiB), router_b, X1, U, ctl + CW_CNT + 32, table + (size_t)NE * T, tokinfo + (size_t)T * 8, lds); });
    SEAM(13);
    RUN(14, if (IN(14)) { PH_IDS moe_prefix(ctl + CW_CNT + 32, l_cnt, l_tb, tid); SchedMoe S{l_cnt, l_tb, U, WGU + (size_t)NE * D * D, table + (size_t)NE * T, 1, 0, (size_t)D * D, (size_t)256 * D}; EpiSwiglu E{HB}; gemm_pg8<true>(lds, S, E, D, D, D); });
    SEAM(14);
    RUN(15, if (IN(15)) { PH_IDS if (lo == 15) moe_prefix(ctl + CW_CNT + 32, l_cnt, l_tb, tid);     SchedMoe S{l_cnt, l_tb, HB, WD + (size_t)NE * D * DE, table, 0, (size_t)256 * DE, (size_t)D * DE, (size_t)256 * DE}; EpiStoreBf16 E{YB, D}; gemm_pg8<false>(lds, S, E, DE, DE, DE); });
    SEAM(15);
    RUN(16, if (IN(16)) { PH_IDS if (lo == 16) moe_prefix(ctl + CW_CNT + 32, l_cnt, l_tb, tid);     combine_phase(X1, YB, tokinfo + (size_t)T * 8, l_tb, mods + 5 * MODW, ln_g + 3 * D, ln_b + 3 * D, args.out, (const float*)nullptr, (bf16*)nullptr, lds, tid, wave, lane); });
#undef IN
#undef SEAM
}

extern "C" void kernel_launch(void* const* d_in, const int* in_sizes, int n_in, void* d_out, int out_size, void* d_ws, size_t ws_size, hipStream_t stream) {
    static int grid = 0;
    if (grid == 0) {
        if (n_in != 18 || out_size != T * D || ws_size < WS_END) { fprintf(stderr, "kernel_launch: unexpected shapes (n_in %d, out %d, ws %zu)\n", n_in, out_size, ws_size); grid = -1; return; }
        int dev = 0, cus = 0, per_cu = 0;
        if (hipGetDevice(&dev) != hipSuccess || hipDeviceGetAttribute(&cus, hipDeviceAttributeMultiprocessorCount, dev) != hipSuccess) { grid = -1; return; }
        if (hipFuncSetAttribute((const void*)fwd, hipFuncAttributeMaxDynamicSharedMemorySize, LDS_BYTES) != hipSuccess) { fprintf(stderr, "kernel_launch: hipFuncSetAttribute failed\n"); grid = -1; return; }
        if (hipOccupancyMaxActiveBlocksPerMultiprocessor(&per_cu, (const void*)fwd, 512, LDS_BYTES) != hipSuccess || per_cu < 1) fprintf(stderr, "kernel_launch: occupancy query says %d\n", per_cu);
        (void)hipGetLastError();
        grid = cus;
    }
    if (grid < 0) return;
    (void)hipMemsetAsync((char*)d_ws + WS_CTL, 0, CTL_ZERO_BYTES, stream);
    Args a{};
    for (int i = 0; i < 18; ++i) a.in[i] = (const float*)d_in[i];
    a.out = (float*)d_out; a.ws = (unsigned char*)d_ws;
    if (N_LAUNCHES == 1) { a.ph_lo = 0; a.ph_hi = NPHASE; hipLaunchKernelGGL(fwd, dim3(grid), dim3(512), LDS_BYTES, stream, a); }
    else for (int p = 0; p < NPHASE; ++p) { a.ph_lo = p; a.ph_hi = p + 1; hipLaunchKernelGGL(fwd, dim3(grid), dim3(512), LDS_BYTES, stream, a); }
}
```

```cpp
#include <hip/hip_runtime.h>
#include <cstdio>
#include <cstdint>

#define DI __device__ __forceinline__
#define LAS __attribute__((address_space(3)))
typedef unsigned short bf16;
typedef float f32x4 __attribute__((ext_vector_type(4)));
typedef short bf16x8 __attribute__((ext_vector_type(8)));
typedef unsigned u32x4 __attribute__((ext_vector_type(4)));
typedef unsigned u32x2 __attribute__((ext_vector_type(2)));

constexpr int D = 2048, NB = 4, SEQ = 4096, T = NB * SEQ, CTXL = 256, TC = NB * CTXL, TALL = T + TC;
constexpr int NMIX = 6144, PLD = 6272  , NE = 32, DE = 1024, NH = 8, HD = 128, MODW = 6 * D;
constexpr float ALPHA = 1.41421356237309515f;
constexpr float LN_EPS = 1e-6f;
constexpr int NPHASE = 17;
#ifndef MK_N_LAUNCHES
#define MK_N_LAUNCHES 1
#endif
constexpr int N_LAUNCHES = MK_N_LAUNCHES;

constexpr size_t MiB = 1u << 20;
constexpr size_t WS_CTL = 0, CTL_ZERO_BYTES = 64 * 1024;
constexpr size_t WS_MODS = 1 * MiB;
constexpr size_t WS_TOKINFO = 2 * MiB;
constexpr size_t WS_TABLE = 4 * MiB;
constexpr size_t WS_WIN = 8 * MiB, WS_WO = 32 * MiB, WS_WF = 40 * MiB, WS_CS = 48 * MiB, WS_ACS = 64 * MiB;
constexpr size_t WS_U = 116 * MiB;
constexpr size_t WS_P = 184 * MiB;
constexpr size_t WS_MIX = 400 * MiB;
constexpr size_t WS_TB = 464 * MiB, WS_X1 = 592 * MiB, WS_X2 = 720 * MiB;
constexpr size_t WS_H = 848 * MiB;
constexpr size_t WS_WGU = 928 * MiB;
constexpr size_t WS_WD = 1440 * MiB;
constexpr size_t WS_END = 1696 * MiB;
constexpr int CW_CNT = 64;
constexpr int CW_BAR = 1024;

constexpr int LDS_SCR = 133120;
constexpr int LDSCTL_OFF = LDS_SCR;
constexpr int LDS_BYTES = 147456;

template <int CTRL> DI float dpp_f(float v) { return __builtin_bit_cast(float, __builtin_amdgcn_mov_dpp(__builtin_bit_cast(int, v), CTRL, 0xF, 0xF, true)); }
DI float wave_sum(float v) {
    v += dpp_f<0xB1>(v); v += dpp_f<0x4E>(v); v += dpp_f<0x141>(v); v += dpp_f<0x140>(v);
    const int iv = __builtin_bit_cast(int, v);
    const float r0 = __builtin_bit_cast(float, __builtin_amdgcn_readlane(iv, 0)), r1 = __builtin_bit_cast(float, __builtin_amdgcn_readlane(iv, 16)),
                r2 = __builtin_bit_cast(float, __builtin_amdgcn_readlane(iv, 32)), r3 = __builtin_bit_cast(float, __builtin_amdgcn_readlane(iv, 48));
    return (r0 + r1) + (r2 + r3);
}
DI float wave_max(float v) {
    v = fmaxf(v, dpp_f<0xB1>(v)); v = fmaxf(v, dpp_f<0x4E>(v)); v = fmaxf(v, dpp_f<0x141>(v)); v = fmaxf(v, dpp_f<0x140>(v));
    const int iv = __builtin_bit_cast(int, v);
    const float r0 = __builtin_bit_cast(float, __builtin_amdgcn_readlane(iv, 0)), r1 = __builtin_bit_cast(float, __builtin_amdgcn_readlane(iv, 16)),
                r2 = __builtin_bit_cast(float, __builtin_amdgcn_readlane(iv, 32)), r3 = __builtin_bit_cast(float, __builtin_amdgcn_readlane(iv, 48));
    return fmaxf(fmaxf(r0, r1), fmaxf(r2, r3));
}
DI unsigned f2bf(float f) { unsigned u = __float_as_uint(f); return (u + 0x7fffu + ((u >> 16) & 1u)) >> 16; }
typedef float f32x2_t __attribute__((ext_vector_type(2)));
typedef __bf16 bf16x2_t __attribute__((ext_vector_type(2)));
DI unsigned pk2(float lo, float hi) { const f32x2_t v = {lo, hi}; return __builtin_bit_cast(unsigned, __builtin_convertvector(v, bf16x2_t)); }
DI float bflo(unsigned w) { return __uint_as_float(w << 16); }
DI float bfhi(unsigned w) { return __uint_as_float(w & 0xffff0000u); }
DI float silu_f(float v) { return v / (1.f + expf(-v)); }
DI float silu_fast(float v) { return v * __builtin_amdgcn_rcpf(1.f + __builtin_amdgcn_exp2f(v * -1.4426950408889634f)); }

#define XB_TMO      128
#define XB_XCNT(j)  (256  + 64 * (j))
#define XB_XSUB(j)  (1280 + 64 * (j))
#define XB_XGEN(j)  (2304 + 64 * (j))
#define XB_TOP      3328
#define XB_TOPGEN   3392
#define XCD_BAR_WORDS 3456
#define XB_SPIN_CAP (1u << 18)
__device__ __forceinline__ unsigned xb_ld(unsigned* p)              { return __hip_atomic_load(p, __ATOMIC_RELAXED, __HIP_MEMORY_SCOPE_AGENT); }
__device__ __forceinline__ unsigned xb_add(unsigned* p, unsigned v) { return __hip_atomic_fetch_add(p, v, __ATOMIC_RELAXED, __HIP_MEMORY_SCOPE_AGENT); }
__device__ __forceinline__ unsigned xb_xcc_id() { return (unsigned)__builtin_amdgcn_s_getreg((3 << 11) | 20) & 0xFu; }
#define XB_SPIN(cond, bar) do { unsigned _sp = 0; while (cond) { __builtin_amdgcn_s_sleep(1); \
    if ((++_sp & 255u) == 0u) { if (xb_ld(&(bar)[XB_TMO])) break; if (_sp > XB_SPIN_CAP) { atomicAdd(&(bar)[XB_TMO], 1u); break; } } } } while (0)
struct XcdBarrier { unsigned* bar; unsigned x; volatile LAS unsigned* st; };
__device__ __forceinline__ XcdBarrier xcd_barrier_post(unsigned* bar, volatile LAS unsigned* st) {
    XcdBarrier b; b.bar = bar; b.x = xb_xcc_id(); b.st = st;
    if (threadIdx.x == 0) (void)xb_add(&bar[XB_XCNT(b.x)], 1u);
    return b;
}
__device__ __forceinline__ void xcd_barrier_complete(unsigned* bar, unsigned x, unsigned& nloc, unsigned& nx) {
    const unsigned G = gridDim.x * gridDim.y * gridDim.z;
    unsigned sum, cnt, mine, sp = 0u;
    for (;;) {
        sum = 0u; cnt = 0u; mine = 0u;
#pragma unroll
        for (unsigned j = 0; j < 16; ++j) { const unsigned c = xb_ld(&bar[XB_XCNT(j)]); sum += c; cnt += (c > 0u) ? 1u : 0u; mine = (j == x) ? c : mine; }
        if (sum == G) break;
        __builtin_amdgcn_s_sleep(1);
        if ((++sp & 255u) == 0u) { if (xb_ld(&bar[XB_TMO])) break; if (sp > XB_SPIN_CAP) { atomicAdd(&bar[XB_TMO], 1u); break; } }
    }
    nloc = mine > 0u ? mine : 1u; nx = cnt > 0u ? cnt : 1u;
}
__device__ __forceinline__ void xcd_barrier(const XcdBarrier& b) {
    asm volatile("s_waitcnt vmcnt(0)" ::: "memory");
    __syncthreads();
    if (threadIdx.x == 0) {
        unsigned* bar = b.bar;
        __builtin_amdgcn_s_waitcnt(0);
        unsigned nloc = b.st[0], nx = b.st[1];
        if (nloc == 0u) { xcd_barrier_complete(bar, b.x, nloc, nx); b.st[0] = nloc; b.st[1] = nx; }
        const unsigned old = xb_add(&bar[XB_XSUB(b.x)], 1u);
        const unsigned gen = old / nloc;
        if (old + 1u == (gen + 1u) * nloc) {
            __builtin_amdgcn_fence(__ATOMIC_RELEASE, "agent");
            asm volatile("s_waitcnt vmcnt(0)" ::: "memory");
            const unsigned og = xb_add(&bar[XB_TOP], 1u);
            const unsigned tg = og / nx;
            if (og + 1u == (tg + 1u) * nx) xb_add(&bar[XB_TOPGEN], 1u);
            else XB_SPIN(xb_ld(&bar[XB_TOPGEN]) == tg, bar);
            __builtin_amdgcn_fence(__ATOMIC_ACQUIRE, "agent");
            xb_add(&bar[XB_XGEN(b.x)], 1u);
            asm volatile("s_waitcnt vmcnt(0)" ::: "memory");
        } else {
            XB_SPIN(xb_ld(&bar[XB_XGEN(b.x)]) == gen, bar);
            __builtin_amdgcn_fence(__ATOMIC_ACQUIRE, "agent");
            asm volatile("s_waitcnt vmcnt(0)" ::: "memory");
        }
    }
    __syncthreads();
}

struct Row { f32x4 v[8]; };
DI void row_load(Row& r, const float* p, int lane) { const f32x4* q = (const f32x4*)p + lane;
#pragma unroll
    for (int j = 0; j < 8; ++j) r.v[j] = q[64 * j]; }
DI void row_store(const Row& r, float* p, int lane) { f32x4* q = (f32x4*)p + lane;
#pragma unroll
    for (int j = 0; j < 8; ++j) q[64 * j] = r.v[j]; }
DI void row_store_bf16(const Row& r, bf16* p, int lane) { u32x2* q = (u32x2*)p + lane;
#pragma unroll
    for (int j = 0; j < 8; ++j) { u32x2 w; w.x = pk2(r.v[j].x, r.v[j].y); w.y = pk2(r.v[j].z, r.v[j].w); q[64 * j] = w; } }
DI void row_load(Row& r, const bf16* p, int lane) { const u32x2* q = (const u32x2*)p + lane; u32x2 w[8];
#pragma unroll
    for (int j = 0; j < 8; ++j) w[j] = q[64 * j];
#pragma unroll
    for (int j = 0; j < 8; ++j) r.v[j] = (f32x4){bflo(w[j].x), bfhi(w[j].x), bflo(w[j].y), bfhi(w[j].y)}; }
DI void row_store(const Row& r, bf16* p, int lane) { row_store_bf16(r, p, lane); }
DI void row_load_nt(Row& r, const float* p, int lane) { const f32x4* q = (const f32x4*)p + lane;
#pragma unroll
    for (int j = 0; j < 8; ++j) r.v[j] = __builtin_nontemporal_load(q + 64 * j); }
DI void row_load_nt(Row& r, const bf16* p, int lane) { const u32x2* q = (const u32x2*)p + lane; u32x2 w[8];
#pragma unroll
    for (int j = 0; j < 8; ++j) w[j] = __builtin_nontemporal_load(q + 64 * j);
#pragma unroll
    for (int j = 0; j < 8; ++j) r.v[j] = (f32x4){bflo(w[j].x), bfhi(w[j].x), bflo(w[j].y), bfhi(w[j].y)}; }
DI void row_store_nt(const Row& r, float* p, int lane) { f32x4* q = (f32x4*)p + lane;
#pragma unroll
    for (int j = 0; j < 8; ++j) __builtin_nontemporal_store(r.v[j], q + 64 * j); }
DI void row_store_nt(const Row& r, bf16* p, int lane) { u32x2* q = (u32x2*)p + lane;
#pragma unroll
    for (int j = 0; j < 8; ++j) { u32x2 w; w.x = pk2(r.v[j].x, r.v[j].y); w.y = pk2(r.v[j].z, r.v[j].w); __builtin_nontemporal_store(w, q + 64 * j); } }
DI void row_ln(Row& r) {
    float s = 0.f;
#pragma unroll
    for (int j = 0; j < 8; ++j) s += (r.v[j].x + r.v[j].y) + (r.v[j].z + r.v[j].w);
    const float mean = wave_sum(s) * (1.f / D); float s2 = 0.f;
#pragma unroll
    for (int j = 0; j < 8; ++j) { r.v[j] = r.v[j] - mean; s2 += (r.v[j].x * r.v[j].x + r.v[j].y * r.v[j].y) + (r.v[j].z * r.v[j].z + r.v[j].w * r.v[j].w); }
    const float rstd = 1.f / sqrtf(wave_sum(s2) * (1.f / D) + LN_EPS);
#pragma unroll
    for (int j = 0; j < 8; ++j) r.v[j] = r.v[j] * rstd;
}
DI void row_affine(Row& r, const float* g, const float* b, int lane) {
    const f32x4* gq = (const f32x4*)g + lane; const f32x4* bq = (const f32x4*)b + lane;
#pragma unroll
    for (int j = 0; j < 8; ++j) r.v[j] = r.v[j] * gq[64 * j] + bq[64 * j];
}
DI void row_modulate(Row& r, const float* sh, const float* sc, int lane) {
    const f32x4* hq = (const f32x4*)sh + lane; const f32x4* cq = (const f32x4*)sc + lane;
#pragma unroll
    for (int j = 0; j < 8; ++j) r.v[j] = r.v[j] * (cq[64 * j] + 1.f) + hq[64 * j];
}

struct Unit { const bf16* A; const bf16* B; const int* gat; int nvalid; int m0, n0, aux; };

namespace pg8 {
constexpr int BK = 64, HALF = 128, HTB = HALF * BK * 2, STAGE_BYTES = 8 * HTB;
DI int lds_byte(int r, int c) { const int st = (r >> 4) * 2 + (c >> 5), rr = r & 15, cc = c & 31, ob = rr * 64 + cc * 2; return st * 1024 + (ob ^ (((ob >> 9) & 1) << 5)); }
DI void stage_rc(int b, int& R, int& C) { const int st = b / 1024, sb = b % 1024, swz = sb ^ (((sb >> 9) & 1) << 5); R = (st >> 1) * 16 + swz / 64; C = (st & 1) * 32 + (swz % 64) / 2; }
}
template <bool GATHER, class Sched, class Epi>
DI void gemm_pg8(LAS unsigned char* lds, const Sched& S, const Epi& E, const int lda, const int ldb, const int K) {
    using namespace pg8;
    const int tid = threadIdx.x, wid = __builtin_amdgcn_readfirstlane(tid >> 6), lane = tid & 63, wr = wid >> 2, wc = wid & 3, fr = lane & 15, fq = lane >> 4;
    const int nt = K / BK, G = gridDim.x, cblk = blockIdx.x;
    unsigned voffB[2], vA[2][2];
#pragma unroll
    for (int i = 0; i < 2; ++i) { int R_, C_; stage_rc(tid * 16 + i * 8192, R_, C_); const int n_ = (R_ >> 4) & 1, i_ = R_ & 15, Rb = (R_ & ~31) + 8 * (i_ >> 2) + 4 * n_ + (i_ & 3);
        voffB[i] = (unsigned)(Rb * ldb + C_) * 2u; }
    const size_t kstep = (size_t)(BK * 2), hstepA = (size_t)HALF * lda * 2, hstepB = (size_t)HALF * ldb * 2;
    const unsigned ldsw = (unsigned)wid * 1024u;
    const int aoff = lds_byte(wr * 64 + fr, fq * 8), boff = lds_byte(wc * 32 + fr, fq * 8);
#define PG8_SA(b, h) (((b) * 2 + (h)) * HTB)
#define PG8_SB(b, h) ((4 + (b) * 2 + (h)) * HTB)
#define PG8_STAGE(bufoff, gbase, voff) do { _Pragma("unroll") for (int _i = 0; _i < 2; ++_i) \
        __builtin_amdgcn_global_load_lds((const unsigned*)((const char*)(gbase) + (voff)[_i]), (LAS unsigned*)(lds + (bufoff) + ldsw + _i * 8192), 16, 0, 0); } while (0)
#define PG8_STAGE_A(bufoff, gbase, h) do { if constexpr (GATHER) PG8_STAGE(bufoff, gbase, vA[h]); else PG8_STAGE(bufoff, (gbase) + (h) * hstepA, vA[0]); } while (0)
#define PG8_LDA(dst, b, h) do { _Pragma("unroll") for (int m = 0; m < 4; ++m) _Pragma("unroll") for (int k = 0; k < 2; ++k) dst[m][k] = *(const LAS bf16x8*)(lds + PG8_SA(b, h) + aoff + m * 2048 + k * 1024); } while (0)
#define PG8_LDB(dst, b, h) do { _Pragma("unroll") for (int n = 0; n < 2; ++n) _Pragma("unroll") for (int k = 0; k < 2; ++k) dst[n][k] = *(const LAS bf16x8*)(lds + PG8_SB(b, h) + boff + n * 2048 + k * 1024); } while (0)
#define PG8_MMA(ai, bj, At, Bt) do { __builtin_amdgcn_s_setprio(1); _Pragma("unroll") for (int m = 0; m < 4; ++m) _Pragma("unroll") for (int n = 0; n < 2; ++n) _Pragma("unroll") for (int k = 0; k < 2; ++k) \
        acc[ai][bj][m][n] = __builtin_amdgcn_mfma_f32_16x16x32_bf16(Bt[n][k], At[m][k], acc[ai][bj][m][n], 0, 0, 0); __builtin_amdgcn_s_setprio(0); } while (0)
#define PG8_WAIT_V(n) asm volatile("s_waitcnt vmcnt(" #n ")" ::: "memory")
#define PG8_WAIT_L(n) asm volatile("s_waitcnt lgkmcnt(" #n ")" ::: "memory")
#define PG8_BAR __builtin_amdgcn_s_barrier()
#define PG8_SCHED __builtin_amdgcn_sched_barrier(0)
#define PG8_SETV(dst, u) do { _Pragma("unroll") for (int _h = 0; _h < 2; ++_h) _Pragma("unroll") for (int _i = 0; _i < 2; ++_i) { int _R, _C; stage_rc(tid * 16 + _i * 8192, _R, _C); const int _r = _h * HALF + _R; \
        if constexpr (GATHER) { const int _g = (u).gat[_r < (u).nvalid ? _r : (u).nvalid - 1]; dst[_h][_i] = (unsigned)(_g * lda + _C) * 2u; }     else dst[_h][_i] = (unsigned)(_R * lda + _C) * 2u; } } while (0)
    Unit cur, nxt; int ui = 0;
    if (!S.get(cblk, cur)) return;
    f32x4 acc[2][2][4][2];
#pragma unroll
    for (int a = 0; a < 2; ++a)
#pragma unroll
        for (int b = 0; b < 2; ++b)
#pragma unroll
            for (int m = 0; m < 4; ++m)
#pragma unroll
                for (int n = 0; n < 2; ++n) acc[a][b][m][n] = (f32x4){0.f, 0.f, 0.f, 0.f};
    bf16x8 At[4][2], B0[2][2], B1[2][2];
    const char* cA = (const char*)cur.A; const char* cB = (const char*)cur.B;
    PG8_SETV(vA, cur);
    PG8_STAGE(PG8_SB(0, 0), cB, voffB); PG8_STAGE(PG8_SB(0, 1), cB + hstepB, voffB); PG8_STAGE_A(PG8_SA(0, 0), cA, 0); PG8_STAGE_A(PG8_SA(0, 1), cA, 1);
    if (wr == 1) PG8_BAR;
    PG8_WAIT_V(2); PG8_BAR;
    PG8_STAGE(PG8_SB(1, 0), cB + kstep, voffB); PG8_STAGE_A(PG8_SA(1, 0), cA + kstep, 0); PG8_STAGE(PG8_SB(1, 1), cB + hstepB + kstep, voffB);
    PG8_WAIT_V(6); PG8_BAR;
    for (;;) {
        const bool has_next = S.get((ui + 1) * G + cblk, nxt);
        const char* nA = has_next ? (const char*)nxt.A : cA; const char* nB = has_next ? (const char*)nxt.B : cB;
        for (int t = 0; t < nt; t += 2) {
            const bool last = (t == nt - 2);
            const char* a1 = cA + (size_t)(t + 1) * kstep;
            const char* a2 = last ? nA : cA + (size_t)(t + 2) * kstep; const char* b2 = last ? nB : cB + (size_t)(t + 2) * kstep;
            const char* a3 = a2 + kstep; const char* b3 = b2 + kstep;
            PG8_LDB(B0, 0, 0); PG8_LDB(B1, 0, 1); PG8_SCHED; PG8_LDA(At, 0, 0); PG8_STAGE_A(PG8_SA(1, 1), a1, 1);
            PG8_WAIT_V(8); PG8_WAIT_L(0); PG8_BAR; PG8_MMA(0, 0, At, B0); PG8_MMA(0, 1, At, B1); PG8_BAR; PG8_SCHED;
            if constexpr (GATHER) { if (last && has_next) PG8_SETV(vA, nxt); }
            PG8_LDA(At, 0, 1); PG8_STAGE(PG8_SB(0, 0), b2, voffB); PG8_STAGE(PG8_SB(0, 1), b2 + hstepB, voffB); PG8_STAGE_A(PG8_SA(0, 0), a2, 0);
            PG8_WAIT_V(8); PG8_WAIT_L(0); PG8_BAR; PG8_MMA(1, 0, At, B0); PG8_MMA(1, 1, At, B1); PG8_BAR; PG8_SCHED;
            PG8_LDB(B0, 1, 0); PG8_LDB(B1, 1, 1); PG8_SCHED; PG8_LDA(At, 1, 0); PG8_STAGE_A(PG8_SA(0, 1), a2, 1);
            PG8_WAIT_V(8); PG8_WAIT_L(0); PG8_BAR; PG8_MMA(0, 0, At, B0); PG8_MMA(0, 1, At, B1); PG8_BAR; PG8_SCHED;
            PG8_LDA(At, 1, 1); PG8_STAGE(PG8_SB(1, 0), b3, voffB); PG8_STAGE(PG8_SB(1, 1), b3 + hstepB, voffB); PG8_STAGE_A(PG8_SA(1, 0), a3, 0);
            PG8_WAIT_V(8); PG8_WAIT_L(0); PG8_BAR; PG8_MMA(1, 0, At, B0); PG8_MMA(1, 1, At, B1); PG8_BAR; PG8_SCHED;
        }
        if (wr == 0) PG8_BAR;
#pragma unroll
        for (int ai = 0; ai < 2; ++ai)
#pragma unroll
            for (int m = 0; m < 4; ++m) E(cur, ai * HALF + wr * 64 + m * 16 + fr, wc * 32 + 8 * fq, acc[ai][0][m][0], acc[ai][0][m][1], acc[ai][1][m][0], acc[ai][1][m][1]);
        if (!has_next) break;
#pragma unroll
        for (int a = 0; a < 2; ++a)
#pragma unroll
            for (int b = 0; b < 2; ++b)
#pragma unroll
                for (int m = 0; m < 4; ++m)
#pragma unroll
                    for (int n = 0; n < 2; ++n) acc[a][b][m][n] = (f32x4){0.f, 0.f, 0.f, 0.f};
        cur = nxt; cA = nA; cB = nB; ++ui;
        if (wr == 1) PG8_BAR;
    }
    PG8_WAIT_V(0);
    PG8_BAR;
#undef PG8_SA
#undef PG8_SB
#undef PG8_STAGE
#undef PG8_STAGE_A
#undef PG8_LDA
#undef PG8_LDB
#undef PG8_MMA
#undef PG8_WAIT_V
#undef PG8_WAIT_L
#undef PG8_BAR
#undef PG8_SCHED
#undef PG8_SETV
}

DI int xcd_remap(int L, int n) { const int q = n >> 3, r = n & 7, xcd = L & 7, off = L >> 3; return (xcd < r ? xcd * (q + 1) : r * (q + 1) + (xcd - r) * q) + off; }
DI void grouped(int wgid, int nM, int nN, int& pm, int& pn) { const int nig = 8 * nN, gid = wgid / nig, fm = gid * 8, gsz = min(nM - fm, 8); pm = fm + (wgid % nig) % gsz; pn = (wgid % nig) / gsz; }

struct SchedInProj { const bf16* U; const bf16* W;
    DI bool get(int L, Unit& u) const { int pm, pn;
        if (L >= 64 * 24 + 32) return false; const int w = xcd_remap(L, 64 * 24 + 32);
        if (w < 64 * 24) grouped(w, 64, 24, pm, pn); else { const int l2 = w - 64 * 24; pm = 64 + (l2 >> 3); pn = 4 + (l2 & 7); }
        u.A = U + (size_t)pm * 256 * D; u.B = W + (size_t)pn * 256 * D; u.gat = nullptr; u.nvalid = 256; u.m0 = pm * 256; u.n0 = pn * 256; u.aux = 0; return true; } };
struct SchedDense { const bf16* A; const bf16* B; int nM, nN; size_t a_t, b_t;
    DI bool get(int L, Unit& u) const { if (L >= nM * nN) return false; int pm, pn; grouped(xcd_remap(L, nM * nN), nM, nN, pm, pn);
        u.A = A + (size_t)pm * a_t; u.B = B + (size_t)pn * b_t; u.gat = nullptr; u.nvalid = 256; u.m0 = pm * 256; u.n0 = pn * 256; u.aux = 0; return true; } };
struct SchedMoe { const LAS int* cnt; const LAS int* tb; const bf16* A; const bf16* W; const int* table; int gather; size_t a_t, w_e, w_t;
    DI bool get(int L, Unit& u) const { const int nT = __builtin_amdgcn_readfirstlane(tb[32]); if (L >= nT * 8) return false; int t, pn; grouped(xcd_remap(L, nT * 8), nT, 8, t, pn);
        int e = 0;
        for (int i = 1; i < 32; ++i) e = (tb[i] <= t) ? i : e;
        e = __builtin_amdgcn_readfirstlane(e); t = __builtin_amdgcn_readfirstlane(t); pn = __builtin_amdgcn_readfirstlane(pn);
        const int mt = __builtin_amdgcn_readfirstlane(t - tb[e]);
        if (gather) { u.A = A; u.gat = table + (size_t)e * T + mt * 256; } else { u.A = A + (size_t)t * a_t; u.gat = nullptr; }
        u.nvalid = __builtin_amdgcn_readfirstlane(min(256, cnt[e] - mt * 256));
        u.B = W + (size_t)e * w_e + (size_t)pn * w_t; u.m0 = t * 256; u.n0 = pn * 256; u.aux = e; return true; } };
struct SchedChan { const bf16* PCAT; const bf16* CSB;
    DI bool get(int L, Unit& u) const { if (L >= 512) return false; int pm, q; grouped(xcd_remap(L, 512), 64, 8, pm, q); const int g = q >> 1, pn = q & 1;
        u.A = PCAT + (size_t)pm * 256 * 4096 + g * 1024; u.B = CSB + (size_t)pn * 256 * 1024; u.gat = nullptr; u.nvalid = 256; u.m0 = pm * 256; u.n0 = g * 512 + pn * 256; u.aux = g; return true; } };

DI void st_bf16x4(bf16* p, f32x4 v) { u32x2 w; w.x = pk2(v.x, v.y); w.y = pk2(v.z, v.w); *(u32x2*)p = w; }
DI void st_bf16x8(bf16* p, f32x4 a, f32x4 b) { u32x4 w; w.x = pk2(a.x, a.y); w.y = pk2(a.z, a.w); w.z = pk2(b.x, b.y); w.w = pk2(b.z, b.w); *(u32x4*)p = w; }
struct EpiStoreBf16 { bf16* O; int ldc;
    DI void operator()(const Unit& u, int r, int c, f32x4 l0, f32x4 l1, f32x4 h0, f32x4 h1) const { bf16* p = O + (size_t)(u.m0 + r) * ldc + u.n0 + c; st_bf16x8(p, l0, l1); st_bf16x8(p + 128, h0, h1); } };
struct EpiSwiglu { bf16* H;
    DI void operator()(const Unit& u, int r, int c, f32x4 l0, f32x4 l1, f32x4 h0, f32x4 h1) const { f32x4 a, b;
        a.x = silu_fast(l0.x) * h0.x; a.y = silu_fast(l0.y) * h0.y; a.z = silu_fast(l0.z) * h0.z; a.w = silu_fast(l0.w) * h0.w;
        b.x = silu_fast(l1.x) * h1.x; b.y = silu_fast(l1.y) * h1.y; b.z = silu_fast(l1.z) * h1.z; b.w = silu_fast(l1.w) * h1.w;
        st_bf16x8(H + (size_t)(u.m0 + r) * DE + (u.n0 >> 1) + c, a, b); } };
DI void p0_mods_unit(const float* ada_w, const float* ada_b, float* mods, const LAS float* sl, LAS float* red, int unit, int tid) {
    const int cg = tid & 31, ks = tid >> 5, l = unit / 96, n0 = (unit % 96) * 128;
    const float* W = ada_w + (size_t)l * D * MODW + n0 + 4 * cg;
    f32x4 a0 = (f32x4){0.f, 0.f, 0.f, 0.f}, a1 = a0, a2 = a0, a3 = a0, a4 = a0;
#pragma unroll 8
    for (int k = ks * 128; k < ks * 128 + 128; ++k) { const f32x4 w = __builtin_nontemporal_load((const f32x4*)(W + (size_t)k * MODW)); a0 += w * sl[k]; a1 += w * sl[D + k]; a2 += w * sl[2 * D + k]; a3 += w * sl[3 * D + k]; a4 += w * sl[4 * D + k]; }
    *(LAS f32x4*)(red + (ks * 5 + 0) * 128 + 4 * cg) = a0; *(LAS f32x4*)(red + (ks * 5 + 1) * 128 + 4 * cg) = a1; *(LAS f32x4*)(red + (ks * 5 + 2) * 128 + 4 * cg) = a2;
    *(LAS f32x4*)(red + (ks * 5 + 3) * 128 + 4 * cg) = a3; *(LAS f32x4*)(red + (ks * 5 + 4) * 128 + 4 * cg) = a4;
    __syncthreads();
    for (int i = tid; i < 640; i += 512) { const int r = i >> 7, q = i & 127; float sacc = 0.f;
#pragma unroll
        for (int k2 = 0; k2 < 16; ++k2) sacc += red[(k2 * 5 + r) * 128 + q];
        mods[((size_t)l * 5 + r) * MODW + n0 + q] = sacc + ada_b[(size_t)l * MODW + n0 + q]; }
    __syncthreads();
}
DI void tr_item(const float* W, int N, int Kd, int k0, int n0, bf16* WT, int drow0, LAS unsigned char* scr, int lane) {
    const int ng = lane & 15, kl = lane >> 4;
    f32x4 v[2][8];
    const float* src = W + (size_t)(k0 + 16 * kl) * N + n0 + 4 * ng;
#pragma unroll
    for (int pp = 0; pp < 2; ++pp)
#pragma unroll
        for (int i = 0; i < 8; ++i) v[pp][i] = __builtin_nontemporal_load((const f32x4*)(src + (size_t)(8 * pp + i) * N));
#pragma unroll
    for (int pp = 0; pp < 2; ++pp)
#pragma unroll
        for (int c = 0; c < 4; ++c) { u32x4 o; o.x = pk2(v[pp][0][c], v[pp][1][c]); o.y = pk2(v[pp][2][c], v[pp][3][c]); o.z = pk2(v[pp][4][c], v[pp][5][c]); o.w = pk2(v[pp][6][c], v[pp][7][c]);
            *(LAS u32x4*)(scr + (4 * ng + c) * 144 + (16 * kl + 8 * pp) * 2) = o; }
    asm volatile("s_waitcnt lgkmcnt(0)" ::: "memory");
#pragma unroll
    for (int j = 0; j < 8; ++j) { const int row = (lane >> 3) + 8 * j, ch = lane & 7;
        const u32x4 o = *(const LAS u32x4*)(scr + row * 144 + ch * 16);
        __builtin_nontemporal_store(o, (u32x4*)(WT + (size_t)(drow0 + row) * Kd + k0 + 8 * ch)); }
    asm volatile("s_waitcnt lgkmcnt(0)" ::: "memory");
}
constexpr int P0_S_IN = 8 * 48, P0_S_SQ = 8 * 16, P0_S_E = 64 * 64, P0_NSI = P0_S_IN + 2 * P0_S_SQ + 3 * P0_S_E, P0_NMODS = 192;
DI void p0_weight_item(int si, const float* w_in, const float* w_out, const float* w_f, const float* w_gate, const float* w_up, const float* w_down,
                       bf16* WIN, bf16* WO, bf16* WF, bf16* WGU, bf16* WD, LAS unsigned char* scr, int wave, int lane) {
    const int dk = wave >> 1, dn = wave & 1; int r = si;
    if (r < P0_S_IN) { const int kb = (r / 48) * 4 + dk, nb = (r % 48) * 2 + dn; tr_item(w_in, NMIX, D, kb * 64, nb * 64, WIN, nb * 64, scr, lane); return; } r -= P0_S_IN;
    if (r < P0_S_SQ) { const int kb = (r >> 4) * 4 + dk, nb = (r & 15) * 2 + dn; tr_item(w_out, D, D, kb * 64, nb * 64, WO, nb * 64, scr, lane); return; } r -= P0_S_SQ;
    if (r < P0_S_SQ) { const int kb = (r >> 4) * 4 + dk, nb = (r & 15) * 2 + dn; tr_item(w_f, D, D, kb * 64, nb * 64, WF, nb * 64, scr, lane); return; } r -= P0_S_SQ;
    if (r < 2 * P0_S_E) { const int up = r >= P0_S_E; if (up) r -= P0_S_E; const int mat = r >> 6, rr = r & 63, kb = (rr >> 3) * 4 + dk, nb = (rr & 7) * 2 + dn, n0 = nb * 64;
        tr_item((up ? w_up : w_gate) + (size_t)mat * D * DE, DE, D, kb * 64, n0, WGU + (size_t)mat * D * D, (n0 >> 7) * 256 + (n0 & 127) + (up ? 128 : 0), scr, lane); return; } r -= 2 * P0_S_E;
    { const int mat = r >> 6, rr = r & 63, kb = (rr >> 4) * 4 + dk, nb = (rr & 15) * 2 + dn; tr_item(w_down + (size_t)mat * DE * D, D, DE, kb * 64, nb * 64, WD + (size_t)mat * D * DE, nb * 64, scr, lane); }
}
struct ConvCtx { const float *w_in, *w_out, *w_f, *w_gate, *w_up, *w_down; bf16 *WIN_, *WO_, *WF_, *WGU_, *WD_; unsigned *q0, *q1; };
constexpr int MOE_QN = 6144;
DI int moe_item_si(int item) { const int layer = item >= MOE_QN, j = item - layer * MOE_QN, part = j >> 11, jj = j & 2047; return P0_S_IN + 2 * P0_S_SQ + part * P0_S_E + (layer * 32 + (jj >> 6)) * 64 + (jj & 63); }
DI int moe_take(const ConvCtx& c, volatile LAS int* fl  , bool q0_only) {
    if (!fl[0]) { const int j = (int)__hip_atomic_fetch_add(c.q0, 1u, __ATOMIC_RELAXED, __HIP_MEMORY_SCOPE_AGENT); if (j < MOE_QN) return j; fl[0] = 1; }
    if (!q0_only && !fl[1]) { const int j = (int)__hip_atomic_fetch_add(c.q1, 1u, __ATOMIC_RELAXED, __HIP_MEMORY_SCOPE_AGENT); if (j < MOE_QN) return MOE_QN + j; fl[1] = 1; }
    return -1;
}
DI void moe_conv_item(const ConvCtx& c, int item, LAS unsigned char* lds, int wave, int lane) {
    p0_weight_item(moe_item_si(item), c.w_in, c.w_out, c.w_f, c.w_gate, c.w_up, c.w_down, c.WIN_, c.WO_, c.WF_, c.WGU_, c.WD_, lds + wave * 16384, wave, lane);
}
DI void moe_drain(const ConvCtx& c, int layer, LAS unsigned char* lds, int limit = MOE_QN) {
    int tid = threadIdx.x; asm volatile("" : "+v"(tid)); const int wave = __builtin_amdgcn_readfirstlane(tid >> 6), lane = tid & 63;
    volatile LAS int* sl = (volatile LAS int*)(lds + LDSCTL_OFF) + 8;
    for (;;) {
        if (tid == 0) { int j = -1; if (!sl[2 + layer] && (limit >= MOE_QN || (int)__hip_atomic_load(layer ? c.q1 : c.q0, __ATOMIC_RELAXED, __HIP_MEMORY_SCOPE_AGENT) < limit)) { j = (int)__hip_atomic_fetch_add(layer ? c.q1 : c.q0, 2u, __ATOMIC_RELAXED, __HIP_MEMORY_SCOPE_AGENT); if (j >= MOE_QN) { sl[2 + layer] = 1; j = -1; } else j += layer * MOE_QN; } sl[0] = j; }
        __syncthreads();
        const int item = __builtin_amdgcn_readfirstlane(sl[0]);
        __syncthreads();
        if (item < 0) break;
#pragma unroll 1
        for (int k = 0; k < 2; ++k) if (item + k < (layer + 1) * MOE_QN) moe_conv_item(c, item + k, lds, wave, lane);
    }
}
DI void xcd_barrier_steal(const XcdBarrier& b, const ConvCtx& c, bool q0_only, LAS unsigned char* lds) {
    int tid = threadIdx.x; asm volatile("" : "+v"(tid)); const int wave = __builtin_amdgcn_readfirstlane(tid >> 6), lane = tid & 63;
    volatile LAS int* sl = (volatile LAS int*)(lds + LDSCTL_OFF) + 8;
    asm volatile("s_waitcnt vmcnt(0)" ::: "memory");
    __syncthreads();
    if (tid == 0) {
        unsigned* bar = b.bar;
        __builtin_amdgcn_s_waitcnt(0);
        unsigned nloc = b.st[0], nx = b.st[1];
        if (nloc == 0u) { xcd_barrier_complete(bar, b.x, nloc, nx); b.st[0] = nloc; b.st[1] = nx; }
        const unsigned old = xb_add(&bar[XB_XSUB(b.x)], 1u);
        const unsigned gen = old / nloc;
        if (old + 1u == (gen + 1u) * nloc) {
            __builtin_amdgcn_fence(__ATOMIC_RELEASE, "agent");
            asm volatile("s_waitcnt vmcnt(0)" ::: "memory");
            const unsigned og = xb_add(&bar[XB_TOP], 1u);
            const unsigned tg = og / nx;
            if (og + 1u == (tg + 1u) * nx) xb_add(&bar[XB_TOPGEN], 1u);
            else XB_SPIN(xb_ld(&bar[XB_TOPGEN]) == tg, bar);
            __builtin_amdgcn_fence(__ATOMIC_ACQUIRE, "agent");
            xb_add(&bar[XB_XGEN(b.x)], 1u);
            asm volatile("s_waitcnt vmcnt(0)" ::: "memory");
            sl[1] = -1;
        } else sl[1] = (int)gen;
    }
    __syncthreads();
    const int st = __builtin_amdgcn_readfirstlane(sl[1]);
    __syncthreads();
    if (st != -1) {
        unsigned spins = 0;
        for (;;) {
            if (tid == 0) { unsigned* bar = b.bar; int j = -3;
                const unsigned g = xb_ld(&bar[XB_XGEN(b.x)]), tm = xb_ld(&bar[XB_TMO]), xs = xb_ld(&bar[XB_XSUB(b.x)]);
                if (g != (unsigned)st || tm) j = -2;
                else if (++spins > XB_SPIN_CAP) { atomicAdd(&bar[XB_TMO], 1u); j = -2; }
                else { const unsigned nloc = b.st[0]; const unsigned arrived = xs - (unsigned)st * nloc;
                       if (arrived + 2u <= nloc) { const int t = moe_take(c, sl + 2, q0_only); if (t >= 0) j = t; } }
                sl[0] = j; }
            __syncthreads();
            const int j = __builtin_amdgcn_readfirstlane(sl[0]);
            __syncthreads();
            if (j == -2) break;
            if (j >= 0) moe_conv_item(c, j, lds, wave, lane); else __builtin_amdgcn_s_sleep(4);
        }
        if (tid == 0) { __builtin_amdgcn_fence(__ATOMIC_ACQUIRE, "agent"); asm volatile("s_waitcnt vmcnt(0)" ::: "memory"); }
    }
    __syncthreads();
}
DI void p0_dft(bf16* CSB, int gtid, int GT) {
    for (int i = gtid; i < 512 * 128; i += GT) { const int cp = i >> 7, k8 = (i & 127) * 8; unsigned w[4];
#pragma unroll
        for (int e = 0; e < 4; ++e) { float v[2];
#pragma unroll
            for (int q = 0; q < 2; ++q) { const int kk = k8 + 2 * e + q; const int m = (cp * (kk & 511)) & 511; const float ang = (float)m * (1.f / 256.f); v[q] = (kk < 512 ? cospif(ang) : sinpif(ang)) * 0.04419417382415922f; }
            w[e] = pk2(v[0], v[1]); }
        *(u32x4*)(CSB + (size_t)cp * 1024 + k8) = (u32x4){w[0], w[1], w[2], w[3]}; }
}
DI void ln_mod_phase(const float* x, const float* ctx, const float* mods_l, int sh_chunk, bf16* U, int nrows, LAS unsigned char* lds, int tid, int wave, int lane) {
    LAS f32x4* par = (LAS f32x4*)lds;
    const int step = gridDim.x * 8; int cur_b = -1;
    int base = blockIdx.x * 8;
    Row nxt;
    if (base < nrows) { const int row = base + wave; row_load_nt(nxt, row < T ? x + (size_t)row * D : ctx + (size_t)(row - T) * D, lane); }
    asm volatile("" : "+v"(nxt.v[0]), "+v"(nxt.v[1]), "+v"(nxt.v[2]), "+v"(nxt.v[3]), "+v"(nxt.v[4]), "+v"(nxt.v[5]), "+v"(nxt.v[6]), "+v"(nxt.v[7]));
    for (; base < nrows; base += step) {
        const int row = base + wave, rb = base < T ? (base >> 12) : 4;
        if (rb != cur_b) { cur_b = rb; __syncthreads(); const float* mr = mods_l + (size_t)rb * MODW + sh_chunk * D; par[tid] = ((const f32x4*)mr)[tid]; par[512 + tid] = ((const f32x4*)(mr + D))[tid]; __syncthreads(); }
        Row cur = nxt;
        asm volatile("" : "+v"(cur.v[0]), "+v"(cur.v[1]), "+v"(cur.v[2]), "+v"(cur.v[3]), "+v"(cur.v[4]), "+v"(cur.v[5]), "+v"(cur.v[6]), "+v"(cur.v[7]));
        if (base + step < nrows) { const int nr = row + step; row_load_nt(nxt, nr < T ? x + (size_t)nr * D : ctx + (size_t)(nr - T) * D, lane); }
        __builtin_amdgcn_sched_barrier(0);
        row_ln(cur);
#pragma unroll
        for (int j = 0; j < 8; ++j) cur.v[j] = cur.v[j] * (par[512 + lane + 64 * j] + 1.f) + par[lane + 64 * j];
        row_store_bf16(cur, U + (size_t)row * D, lane);
    }
}
constexpr int ATT_RS = 288, ATT_TILE = 64 * ATT_RS, ATT_BUF = 2 * ATT_TILE;
typedef short s16x4 __attribute__((ext_vector_type(4)));
struct AttState { f32x4 sc[32]; unsigned pk[32][2]; f32x4 o[8]; u32x4 stg[4]; bf16x8 qf[4]; float inv; unsigned g_off, w_off, ka_off, va_off; };
struct AttCtx { const bf16* P; LAS unsigned char* lds; const LAS float* lrpb; int b, r, rs, hp, hs, c0, qc, csq, quad; };
template <int STEP> DI void att_load(AttState& S, const AttCtx& C) {
    constexpr int ti = STEP % 12; const int colb = (STEP < 12 ? 1024 : 2048) + C.hp * 256;
    const size_t tok0 = ti < 8 ? (size_t)C.b * SEQ + 64 * (C.rs + ti) : (size_t)T + C.b * CTXL + (ti - 8) * 64;
    const char* ub = (const char*)(C.P + tok0 * PLD + colb);
#pragma unroll
    for (int k = 0; k < 4; ++k) S.stg[k] = *(const u32x4*)(ub + (size_t)(32 * (k & 1)) * PLD * 2 + (k >> 1) * 256 + S.g_off);
}
template <int BUFI> DI void att_write(AttState& S, const AttCtx& C) {
#pragma unroll
    for (int k = 0; k < 4; ++k) *(LAS u32x4*)(C.lds + BUFI * ATT_BUF + (k >> 1) * ATT_TILE + 32 * (k & 1) * ATT_RS + S.w_off) = S.stg[k];
}
template <int STEP> DI void att_step(AttState& S, const AttCtx& C) {
    const float scale = 0.08838834764831845f;
    asm volatile("" : "+v"(S.g_off), "+v"(S.w_off), "+v"(S.ka_off), "+v"(S.va_off));
    if constexpr (STEP + 1 < 24) att_load<STEP + 1>(S, C);
    constexpr int bo = (STEP & 1) * ATT_BUF;
    if constexpr (STEP < 12) {
        constexpr int ti = STEP;
        if constexpr (ti < 8) {
            const int aidx = C.rs + ti - C.r + 7;
            const LAS float* brow = C.lrpb + C.hs * 465 + aidx * 31;
            bf16x8 kf[2][4]; f32x4 accs[2];
#pragma unroll
            for (int t = 0; t < 2; ++t) { const LAS unsigned char* ka = C.lds + bo + (C.c0 + 16 * t) * ATT_RS + S.ka_off; accs[t] = (f32x4){0.f, 0.f, 0.f, 0.f};
#pragma unroll
                for (int s4 = 0; s4 < 4; ++s4) kf[t][s4] = *(const LAS bf16x8*)(ka + s4 * 64); }
            asm volatile("" : "+v"(kf[0][0]), "+v"(kf[0][1]), "+v"(kf[0][2]), "+v"(kf[0][3]), "+v"(kf[1][0]), "+v"(kf[1][1]), "+v"(kf[1][2]), "+v"(kf[1][3]));
#pragma unroll
            for (int s4 = 0; s4 < 4; ++s4)
#pragma unroll
                for (int t = 0; t < 2; ++t) accs[t] = __builtin_amdgcn_mfma_f32_16x16x32_bf16(kf[t][s4], S.qf[s4], accs[t], 0, 0, 0);
#pragma unroll
            for (int t = 0; t < 2; ++t) { const int krow0 = C.c0 + 16 * t; const f32x4 acc = accs[t];
                float bias[4];
#pragma unroll
                for (int i = 0; i < 4; ++i) bias[i] = brow[min(max(krow0 + C.quad * 4 + i - C.qc + 15, 0), 30)];
                asm volatile("" : "+v"(bias[0]), "+v"(bias[1]), "+v"(bias[2]), "+v"(bias[3]));
#pragma unroll
                for (int i = 0; i < 4; ++i) { const int kcol = krow0 + C.quad * 4 + i; const bool ok = kcol >= C.csq && kcol < C.csq + 16; S.sc[ti * 2 + t][i] = ok ? acc[i] * scale + bias[i] : -1e30f; } }
        } else {
#pragma unroll
            for (int tp = 0; tp < 2; ++tp) {
                bf16x8 kf[2][4]; f32x4 accs[2];
#pragma unroll
                for (int t = 0; t < 2; ++t) { const LAS unsigned char* ka = C.lds + bo + 16 * (2 * tp + t) * ATT_RS + S.ka_off; accs[t] = (f32x4){0.f, 0.f, 0.f, 0.f};
#pragma unroll
                    for (int s4 = 0; s4 < 4; ++s4) kf[t][s4] = *(const LAS bf16x8*)(ka + s4 * 64); }
                asm volatile("" : "+v"(kf[0][0]), "+v"(kf[0][1]), "+v"(kf[0][2]), "+v"(kf[0][3]), "+v"(kf[1][0]), "+v"(kf[1][1]), "+v"(kf[1][2]), "+v"(kf[1][3]));
#pragma unroll
                for (int s4 = 0; s4 < 4; ++s4)
#pragma unroll
                    for (int t = 0; t < 2; ++t) accs[t] = __builtin_amdgcn_mfma_f32_16x16x32_bf16(kf[t][s4], S.qf[s4], accs[t], 0, 0, 0);
#pragma unroll
                for (int t = 0; t < 2; ++t) S.sc[16 + (ti - 8) * 4 + 2 * tp + t] = accs[t] * scale; }
        }
    } else {
        if constexpr (STEP == 12) {
            float m = -1e30f;
#pragma unroll
            for (int sl = 0; sl < 32; ++sl) m = fmaxf(fmaxf(m, fmaxf(S.sc[sl][0], S.sc[sl][1])), fmaxf(S.sc[sl][2], S.sc[sl][3]));
            m = fmaxf(m, __shfl_xor(m, 16)); m = fmaxf(m, __shfl_xor(m, 32));
            float sum = 0.f;
#pragma unroll
            for (int sl = 0; sl < 32; ++sl) { const float e0 = __expf(S.sc[sl][0] - m), e1 = __expf(S.sc[sl][1] - m), e2 = __expf(S.sc[sl][2] - m), e3 = __expf(S.sc[sl][3] - m);
                sum += (e0 + e1) + (e2 + e3); S.pk[sl][0] = pk2(e0, e1); S.pk[sl][1] = pk2(e2, e3); }
            sum += __shfl_xor(sum, 16); sum += __shfl_xor(sum, 32); S.inv = 1.f / sum;
#pragma unroll
            for (int dt = 0; dt < 8; ++dt) S.o[dt] = (f32x4){0.f, 0.f, 0.f, 0.f};
        }
        constexpr int ti = STEP - 12; constexpr int nks = ti < 8 ? 1 : 2;
#pragma unroll
        for (int kk = 0; kk < nks; ++kk) {
            const int sa = ti < 8 ? ti * 2 : 16 + (ti - 8) * 4 + 2 * kk; const int rb = ti < 8 ? C.c0 : 32 * kk;
            const u32x4 pw = (u32x4){S.pk[sa][0], S.pk[sa][1], S.pk[sa + 1][0], S.pk[sa + 1][1]}; const bf16x8 pf = __builtin_bit_cast(bf16x8, pw);
            const LAS unsigned char* va = C.lds + bo + rb * ATT_RS + S.va_off;
            s16x4 v1[8], v2[8];
#pragma unroll
            for (int dt = 0; dt < 8; ++dt) { v1[dt] = __builtin_amdgcn_ds_read_tr16_b64_v4i16((LAS s16x4*)(va + dt * 32)); v2[dt] = __builtin_amdgcn_ds_read_tr16_b64_v4i16((LAS s16x4*)(va + 16 * ATT_RS + dt * 32)); }
            asm volatile("s_waitcnt lgkmcnt(0)" : "+v"(v1[0]), "+v"(v1[1]), "+v"(v1[2]), "+v"(v1[3]), "+v"(v1[4]), "+v"(v1[5]), "+v"(v1[6]), "+v"(v1[7]),
                                                  "+v"(v2[0]), "+v"(v2[1]), "+v"(v2[2]), "+v"(v2[3]), "+v"(v2[4]), "+v"(v2[5]), "+v"(v2[6]), "+v"(v2[7]));
#pragma unroll
            for (int dt = 0; dt < 8; ++dt) { const bf16x8 vf = __builtin_shufflevector(v1[dt], v2[dt], 0, 1, 2, 3, 4, 5, 6, 7); S.o[dt] = __builtin_amdgcn_mfma_f32_16x16x32_bf16(vf, pf, S.o[dt], 0, 0, 0); }
        }
    }
    if constexpr (STEP + 1 < 24) { if constexpr (STEP >= 12) asm volatile("s_waitcnt lgkmcnt(0)" ::: "memory");
        att_write<(STEP + 1) & 1>(S, C); }
    __syncthreads();
}
DI void attn_phase(const bf16* P, const float* rpb, bf16* MIX, LAS unsigned char* lds, LAS float* lrpb) {
    const int tid = threadIdx.x, wid = __builtin_amdgcn_readfirstlane(tid >> 6), lane = tid & 63, hs = wid >> 2, j = wid & 3, lq = lane & 15, quad = lane >> 4;
    const int srow = tid >> 4, sch = tid & 15;
    AttState S; AttCtx C;
    C.P = P; C.lds = lds; C.lrpb = lrpb; C.hs = hs; C.quad = quad;
    C.c0 = (j == 0) ? 0 : (j == 1) ? 8 : (j == 2) ? 24 : 32;
    C.qc = 16 * j + lq; C.csq = min(max(C.qc - 8, 0), 48);
    S.g_off = (unsigned)(srow * PLD + sch * 8) * 2u;
    S.w_off = (unsigned)(srow * ATT_RS + sch * 16);
    S.ka_off = (unsigned)(hs * ATT_TILE + lq * ATT_RS + quad * 16);
    S.va_off = (unsigned)(hs * ATT_TILE + (4 * quad + (lq >> 2)) * ATT_RS + 8 * (lq & 3));
    const bool split = gridDim.x == 256;
    if (split && ((blockIdx.x >> 3) & 1)) return;
    const int L0 = split ? (int)((blockIdx.x >> 4) * 8 + (blockIdx.x & 7)) : (int)blockIdx.x, Ls = split ? 128 : (int)gridDim.x;
    for (int L = L0; L < 1024; L += Ls) {
        const int unit = xcd_remap(L, 1024);
        const int r = unit & 63, hp = (unit >> 6) & 3, b = unit >> 8, h = 2 * hp + hs;
        C.r = r; C.hp = hp; C.b = b; C.rs = min(max(r - 4, 0), 56);
        __syncthreads();
        for (int i = tid; i < 930; i += 512) lrpb[i] = rpb[(size_t)hp * 930 + i];
        const size_t tq = (size_t)b * SEQ + 64 * r + C.qc;
#pragma unroll
        for (int s4 = 0; s4 < 4; ++s4) S.qf[s4] = *(const bf16x8*)(P + tq * PLD + h * HD + s4 * 32 + quad * 8);
        att_load<0>(S, C); att_write<0>(S, C); __syncthreads();
        att_step<0>(S, C); att_step<1>(S, C); att_step<2>(S, C); att_step<3>(S, C); att_step<4>(S, C); att_step<5>(S, C); att_step<6>(S, C); att_step<7>(S, C);
        att_step<8>(S, C); att_step<9>(S, C); att_step<10>(S, C); att_step<11>(S, C); att_step<12>(S, C); att_step<13>(S, C); att_step<14>(S, C); att_step<15>(S, C);
        att_step<16>(S, C); att_step<17>(S, C); att_step<18>(S, C); att_step<19>(S, C); att_step<20>(S, C); att_step<21>(S, C); att_step<22>(S, C); att_step<23>(S, C);
        bf16* op = MIX + tq * D + h * HD + quad * 4;
#pragma unroll
        for (int dt = 0; dt < 8; ++dt) st_bf16x4(op + dt * 16, S.o[dt] * S.inv);
    }
}


constexpr int FF_RS = 544;
DI bf16x8 fft_frag(int kind  , int k, int s, int kq) {
    unsigned w[4];
#pragma unroll
    for (int p = 0; p < 4; ++p) { float v[2];
#pragma unroll
        for (int q = 0; q < 2; ++q) { const int j = 2 * p + q; const int jj = 32 * s + (j < 4 ? 4 * kq + j : 16 + 4 * kq + (j - 4)); const float rev = (float)((k * jj) & 63) * (1.f / 64.f);
            v[q] = (kind == 0 ? __builtin_amdgcn_cosf(rev) : kind == 1 ? -__builtin_amdgcn_sinf(rev) : __builtin_amdgcn_sinf(rev)) * 0.125f; }
        w[p] = pk2(v[0], v[1]); }
    return __builtin_bit_cast(bf16x8, (u32x4){w[0], w[1], w[2], w[3]});
}
DI bf16x8 fft_tr(const LAS unsigned char* p) { const s16x4 v1 = __builtin_amdgcn_ds_read_tr16_b64_v4i16((LAS s16x4*)p), v2 = __builtin_amdgcn_ds_read_tr16_b64_v4i16((LAS s16x4*)(p + 16 * FF_RS));
    return __builtin_shufflevector(v1, v2, 0, 1, 2, 3, 4, 5, 6, 7); }
DI void fft1_phase(const bf16* Up, bf16* YP, LAS unsigned char* lds) {
    const int tid = threadIdx.x, wave = __builtin_amdgcn_readfirstlane(tid >> 6), lane = tid & 63, ml = lane & 15, quad = lane >> 4;
    bf16x8 Ff[8][2];
#pragma unroll
    for (int mt = 0; mt < 8; ++mt)
#pragma unroll
        for (int s2 = 0; s2 < 2; ++s2) Ff[mt][s2] = fft_frag(mt < 4 ? 0 : 1, (16 * mt + ml) & 63, s2, quad);
    LAS float* tw = (LAS float*)(lds + 64 * FF_RS);
    const unsigned va_off = (unsigned)((4 * quad + (ml >> 2)) * FF_RS + 8 * (ml & 3) + 64 * wave);
    for (int unit = blockIdx.x; unit < 2048; unit += gridDim.x) {
        const int b = unit >> 9, j2 = (unit >> 3) & 63, c0 = (unit & 7) * 256;
        __syncthreads();
#pragma unroll
        for (int q = 0; q < 4; ++q) { const int j1 = (tid >> 5) + 16 * q;
            const u32x4 v = __builtin_nontemporal_load((const u32x4*)(Up + ((size_t)b * SEQ + 64 * j1 + j2) * D + c0 + (tid & 31) * 8));
            LAS unsigned char* wp = lds + j1 * FF_RS + (tid & 28) * 16 + (tid & 3) * 8;
            *(LAS u32x2*)wp = (u32x2){v.x, v.y}; *(LAS u32x2*)(wp + 32) = (u32x2){v.z, v.w}; }
        if (tid < 64) { const float rev = (float)(j2 * tid) * (1.f / 4096.f); tw[2 * tid] = __builtin_amdgcn_cosf(rev); tw[2 * tid + 1] = __builtin_amdgcn_sinf(rev); }
        __syncthreads();
        float cth4[4], sth4[4];
#pragma unroll
        for (int mp = 0; mp < 4; ++mp) { cth4[mp] = tw[2 * (16 * mp + ml)]; sth4[mp] = tw[2 * (16 * mp + ml) + 1]; }
        asm volatile("s_waitcnt lgkmcnt(0)" : "+v"(cth4[0]), "+v"(cth4[1]), "+v"(cth4[2]), "+v"(cth4[3]), "+v"(sth4[0]), "+v"(sth4[1]), "+v"(sth4[2]), "+v"(sth4[3]) :: "memory");
        f32x4 acc[8][2];
#pragma unroll
        for (int mt = 0; mt < 8; ++mt) { acc[mt][0] = (f32x4){0.f, 0.f, 0.f, 0.f}; acc[mt][1] = acc[mt][0]; }
#pragma unroll
        for (int s2 = 0; s2 < 2; ++s2)
#pragma unroll
            for (int nt = 0; nt < 2; ++nt) { const bf16x8 zf = fft_tr(lds + va_off + 32 * s2 * FF_RS + 32 * nt);
#pragma unroll
                for (int mt = 0; mt < 8; ++mt) acc[mt][nt] = __builtin_amdgcn_mfma_f32_16x16x32_bf16(zf, Ff[mt][s2], acc[mt][nt], 0, 0, 0); }
#pragma unroll
        for (int mp = 0; mp < 4; ++mp) { const int k1 = 16 * mp + ml; const float cth = cth4[mp], sth = sth4[mp];
            bf16* dr = YP + ((((size_t)b * 64 + k1) * 2) * 64 + j2) * D + c0 + 32 * wave + 8 * quad;
            st_bf16x8(dr, acc[mp][0] * cth + acc[mp + 4][0] * sth, acc[mp][1] * cth + acc[mp + 4][1] * sth);
            st_bf16x8(dr + (size_t)64 * D, acc[mp + 4][0] * cth - acc[mp][0] * sth, acc[mp + 4][1] * cth - acc[mp][1] * sth); }
    }
}
DI void fft2_phase(const bf16* YP, bf16* PCAT, LAS unsigned char* lds) {
    const int tid = threadIdx.x, wave = __builtin_amdgcn_readfirstlane(tid >> 6), lane = tid & 63, ml = lane & 15, quad = lane >> 4;
    bf16x8 Cf[4][2], Sf[4][2], Nf[4][2];
#pragma unroll
    for (int mt = 0; mt < 4; ++mt)
#pragma unroll
        for (int s2 = 0; s2 < 2; ++s2) { Cf[mt][s2] = fft_frag(0, 16 * mt + ml, s2, quad); Nf[mt][s2] = fft_frag(1, 16 * mt + ml, s2, quad); Sf[mt][s2] = fft_frag(2, 16 * mt + ml, s2, quad); }
    const unsigned va_off = (unsigned)((4 * quad + (ml >> 2)) * FF_RS + 8 * (ml & 3) + 64 * wave);
    for (int unit = blockIdx.x; unit < 2048; unit += gridDim.x) {
        const int b = unit >> 9, k1 = (unit >> 3) & 63, cc = unit & 7, c0 = cc * 256;
        __syncthreads();
#pragma unroll
        for (int q = 0; q < 8; ++q) { const int kr = (tid >> 5) + 16 * q;
            const u32x4 v = __builtin_nontemporal_load((const u32x4*)(YP + (((size_t)b * 64 + k1) * 128 + kr) * D + c0 + (tid & 31) * 8));
            LAS unsigned char* wp = lds + kr * FF_RS + (tid & 28) * 16 + (tid & 3) * 8;
            *(LAS u32x2*)wp = (u32x2){v.x, v.y}; *(LAS u32x2*)(wp + 32) = (u32x2){v.z, v.w}; }
        __syncthreads();
        f32x4 acc[8][2];
#pragma unroll
        for (int mt = 0; mt < 8; ++mt) { acc[mt][0] = (f32x4){0.f, 0.f, 0.f, 0.f}; acc[mt][1] = acc[mt][0]; }
#pragma unroll
        for (int s4 = 0; s4 < 4; ++s4)
#pragma unroll
            for (int nt = 0; nt < 2; ++nt) { const bf16x8 yf = fft_tr(lds + va_off + 32 * s4 * FF_RS + 32 * nt);
#pragma unroll
                for (int mt = 0; mt < 4; ++mt) {
                    if (s4 < 2) { acc[mt][nt] = __builtin_amdgcn_mfma_f32_16x16x32_bf16(yf, Cf[mt][s4], acc[mt][nt], 0, 0, 0); acc[mt + 4][nt] = __builtin_amdgcn_mfma_f32_16x16x32_bf16(yf, Nf[mt][s4], acc[mt + 4][nt], 0, 0, 0); }
                    else { acc[mt][nt] = __builtin_amdgcn_mfma_f32_16x16x32_bf16(yf, Sf[mt][s4 - 2], acc[mt][nt], 0, 0, 0); acc[mt + 4][nt] = __builtin_amdgcn_mfma_f32_16x16x32_bf16(yf, Cf[mt][s4 - 2], acc[mt + 4][nt], 0, 0, 0); } } }
        const int g = cc >> 1, cp0 = (cc & 1) * 256 + 32 * wave + 8 * quad;
#pragma unroll
        for (int mt = 0; mt < 8; ++mt) { const int part = mt >> 2, k2 = 16 * (mt & 3) + ml;
            bf16* dp = PCAT + ((size_t)b * SEQ + k1 + 64 * k2) * 4096 + g * 1024 + part * 512 + cp0;
            st_bf16x8(dp, acc[mt][0], acc[mt][1]); }
    }
}

DI void conv_phase(const bf16* P, const float* cw, bf16* MIX, int gtid, int GT) {
    const int c8 = (gtid & 127) * 8;
    float w[3][8];
#pragma unroll
    for (int j = 0; j < 3; ++j) { const f32x4 a = *(const f32x4*)(cw + j * 1024 + c8), b = *(const f32x4*)(cw + j * 1024 + c8 + 4); w[j][0] = a.x; w[j][1] = a.y; w[j][2] = a.z; w[j][3] = a.w; w[j][4] = b.x; w[j][5] = b.y; w[j][6] = b.z; w[j][7] = b.w; }
    for (int tp = gtid >> 7; tp < T / 2; tp += GT >> 7) {
        const int tok = tp * 2, l = tok & 4095;
        const bf16* base = P + (size_t)tok * PLD + 3072 + c8;
        u32x4 gc[4], xi[4];
#pragma unroll
        for (int j = 0; j < 4; ++j) { int d = j - 1; if (j == 0 && l == 0) d = 0; if (j == 3 && l + 2 >= SEQ) d = 1; const bf16* pj = base + (ptrdiff_t)d * PLD; gc[j] = *(const u32x4*)(pj + 1024); xi[j] = *(const u32x4*)(pj + 2048); }
        const u32x4 gb0 = *(const u32x4*)base, gb1 = *(const u32x4*)(base + PLD);
        float z[4][8];
#pragma unroll
        for (int j = 0; j < 4; ++j) { const float m = (j == 0 && l == 0) || (j == 3 && l + 2 >= SEQ) ? 0.f : 1.f;
            z[j][0] = m * bflo(gc[j].x) * bflo(xi[j].x); z[j][1] = m * bfhi(gc[j].x) * bfhi(xi[j].x); z[j][2] = m * bflo(gc[j].y) * bflo(xi[j].y); z[j][3] = m * bfhi(gc[j].y) * bfhi(xi[j].y);
            z[j][4] = m * bflo(gc[j].z) * bflo(xi[j].z); z[j][5] = m * bfhi(gc[j].z) * bfhi(xi[j].z); z[j][6] = m * bflo(gc[j].w) * bflo(xi[j].w); z[j][7] = m * bfhi(gc[j].w) * bfhi(xi[j].w); }
        const float g0[8] = {bflo(gb0.x), bfhi(gb0.x), bflo(gb0.y), bfhi(gb0.y), bflo(gb0.z), bfhi(gb0.z), bflo(gb0.w), bfhi(gb0.w)};
        const float g1[8] = {bflo(gb1.x), bfhi(gb1.x), bflo(gb1.y), bfhi(gb1.y), bflo(gb1.z), bfhi(gb1.z), bflo(gb1.w), bfhi(gb1.w)};
        float o0[8], o1[8];
#pragma unroll
        for (int e = 0; e < 8; ++e) { o0[e] = g0[e] * (w[0][e] * z[0][e] + w[1][e] * z[1][e] + w[2][e] * z[2][e]); o1[e] = g1[e] * (w[0][e] * z[1][e] + w[1][e] * z[2][e] + w[2][e] * z[3][e]); }
        *(u32x4*)(MIX + (size_t)tok * D + 1024 + c8) = (u32x4){pk2(o0[0], o0[1]), pk2(o0[2], o0[3]), pk2(o0[4], o0[5]), pk2(o0[6], o0[7])};
        *(u32x4*)(MIX + (size_t)(tok + 1) * D + 1024 + c8) = (u32x4){pk2(o1[0], o1[1]), pk2(o1[2], o1[3]), pk2(o1[4], o1[5]), pk2(o1[6], o1[7])};
    }
}
constexpr int RT_RS = 4112, RT_IMG = 16 * RT_RS;
DI void split_bf16(const float* w8, bf16x8& hi, bf16x8& lo) {
    unsigned h[4], l[4];
#pragma unroll
    for (int p = 0; p < 4; ++p) { const unsigned a = f2bf(w8[2 * p]), b = f2bf(w8[2 * p + 1]); h[p] = a | (b << 16);
        l[p] = pk2(w8[2 * p] - __uint_as_float(a << 16), w8[2 * p + 1] - __uint_as_float(b << 16)); }
    hi = __builtin_bit_cast(bf16x8, (u32x4){h[0], h[1], h[2], h[3]}); lo = __builtin_bit_cast(bf16x8, (u32x4){l[0], l[1], l[2], l[3]});
}
template <typename TX>
DI void ln_router_phase(const TX* XSp, const bf16* YMp, const float* lng, const float* lnb, const float* mods_l, const float* rw, const float* rbias,
                        bf16* X1p, bf16* Up, unsigned* counts, int* tablep, unsigned* tokinfop, LAS unsigned char* lds) {
    const int tid = threadIdx.x, wave = __builtin_amdgcn_readfirstlane(tid >> 6), lane = tid & 63, fr = lane & 15, fq = lane >> 4;
    bf16x8 bh[8][2], bl[8][2];
#pragma unroll
    for (int ks = 0; ks < 8; ++ks)
#pragma unroll
        for (int nt = 0; nt < 2; ++nt) { float w8[8];
#pragma unroll
            for (int j = 0; j < 8; ++j) w8[j] = rw[(size_t)(256 * wave + 32 * ks + 8 * fq + j) * NE + nt * 16 + fr];
            split_bf16(w8, bh[ks][nt], bl[ks][nt]); }
    LAS unsigned char* par = lds + RT_IMG; LAS float* part = (LAS float*)(lds + RT_IMG + 40960); LAS float* lgs = (LAS float*)(lds + RT_IMG + 40960 + 16384);
    LAS unsigned* lcnt = (LAS unsigned*)(lds + RT_IMG + 40960 + 16384 + 4608); LAS unsigned* lbase = lcnt + 32; LAS unsigned* rinfo = lcnt + 64;
    if (tid < 32) lcnt[tid] = 0u;
    int nq = 0;
    for (int rg = blockIdx.x; rg < T / 16; rg += gridDim.x) {
        __syncthreads();
        { const float* mb = mods_l + (size_t)((rg * 16) >> 12) * MODW;
          const f32x4 p0 = ((const f32x4*)(mb + 2 * D))[tid], p1 = ((const f32x4*)lng)[tid], p2 = ((const f32x4*)lnb)[tid], p3 = ((const f32x4*)(mb + 3 * D))[tid], p4 = ((const f32x4*)(mb + 4 * D))[tid];
          ((LAS f32x4*)par)[tid] = p0; ((LAS f32x4*)(par + 8192))[tid] = p1; ((LAS f32x4*)(par + 16384))[tid] = p2; ((LAS f32x4*)(par + 24576))[tid] = p3; ((LAS f32x4*)(par + 32768))[tid] = p4; }
        __syncthreads();
#pragma unroll 1
        for (int rr = 0; rr < 2; ++rr) {
            const int lr = 2 * wave + rr, row = rg * 16 + lr;
            Row r; row_load_nt(r, XSp + (size_t)row * D, lane);
            { const u32x2* yq = (const u32x2*)(YMp + (size_t)row * D) + lane; const LAS f32x4* g1 = (const LAS f32x4*)par + lane;
              u32x2 yv[8];
#pragma unroll
              for (int j = 0; j < 8; ++j) yv[j] = __builtin_nontemporal_load(yq + 64 * j);
              asm volatile("" : "+v"(yv[0]), "+v"(yv[1]), "+v"(yv[2]), "+v"(yv[3]), "+v"(yv[4]), "+v"(yv[5]), "+v"(yv[6]), "+v"(yv[7]));
#pragma unroll
              for (int j = 0; j < 8; ++j) { const f32x4 yf = (f32x4){bflo(yv[j].x), bfhi(yv[j].x), bflo(yv[j].y), bfhi(yv[j].y)}; r.v[j] = r.v[j] * ALPHA + g1[64 * j] * yf; } }
            row_ln(r);
            { const LAS f32x4* gq = (const LAS f32x4*)(par + 8192) + lane; const LAS f32x4* bq = (const LAS f32x4*)(par + 16384) + lane;
#pragma unroll
              for (int j = 0; j < 8; ++j) r.v[j] = r.v[j] * gq[64 * j] + bq[64 * j]; }
            row_store_nt(r, X1p + (size_t)row * D, lane);
            row_ln(r);
            { const LAS f32x4* hq = (const LAS f32x4*)(par + 24576) + lane; const LAS f32x4* cq = (const LAS f32x4*)(par + 32768) + lane;
#pragma unroll
              for (int j = 0; j < 8; ++j) r.v[j] = r.v[j] * (cq[64 * j] + 1.f) + hq[64 * j]; }
            u32x2* uq = (u32x2*)(Up + (size_t)row * D) + lane;
#pragma unroll
            for (int j = 0; j < 8; ++j) { const unsigned a = f2bf(r.v[j].x), b = f2bf(r.v[j].y), c = f2bf(r.v[j].z), d = f2bf(r.v[j].w);
                u32x2 hi; hi.x = a | (b << 16); hi.y = c | (d << 16); uq[64 * j] = hi;
                u32x2 lo; lo.x = pk2(r.v[j].x - __uint_as_float(a << 16), r.v[j].y - __uint_as_float(b << 16)); lo.y = pk2(r.v[j].z - __uint_as_float(c << 16), r.v[j].w - __uint_as_float(d << 16));
                *(LAS u32x2*)(lds + lr * RT_RS + (4 * lane + 256 * j) * 2) = lo; }
        }
        asm volatile("s_waitcnt vmcnt(0)" ::: "memory");
        __syncthreads();
        f32x4 acc[2]; acc[0] = (f32x4){0.f, 0.f, 0.f, 0.f}; acc[1] = acc[0];
        const LAS unsigned char* ap = lds + fr * RT_RS + (256 * wave + 8 * fq) * 2;
        const bf16* hp = Up + (size_t)(rg * 16 + fr) * D + 256 * wave + 8 * fq;
        bf16x8 ahv[8];
#pragma unroll
        for (int ks = 0; ks < 8; ++ks) ahv[ks] = __builtin_nontemporal_load((const bf16x8*)(hp + 32 * ks));
#pragma unroll
        for (int ks = 0; ks < 8; ++ks) { const bf16x8 ah = ahv[ks], al = *(const LAS bf16x8*)(ap + ks * 64);
#pragma unroll
            for (int nt = 0; nt < 2; ++nt) { acc[nt] = __builtin_amdgcn_mfma_f32_16x16x32_bf16(ah, bh[ks][nt], acc[nt], 0, 0, 0); acc[nt] = __builtin_amdgcn_mfma_f32_16x16x32_bf16(ah, bl[ks][nt], acc[nt], 0, 0, 0);
                acc[nt] = __builtin_amdgcn_mfma_f32_16x16x32_bf16(al, bh[ks][nt], acc[nt], 0, 0, 0); } }
#pragma unroll
        for (int nt = 0; nt < 2; ++nt)
#pragma unroll
            for (int i = 0; i < 4; ++i) part[(wave * 16 + fq * 4 + i) * 32 + nt * 16 + fr] = acc[nt][i];
        __syncthreads();
        { const int r16 = tid >> 5, e = tid & 31; float sacc = 0.f;
#pragma unroll
            for (int w = 0; w < 8; ++w) sacc += part[(w * 16 + r16) * 32 + e];
            const float af = 1.f / (1.f + expf(-sacc)); const float bi = af + rbias[e];
            lgs[r16 * 32 + e] = af; lgs[512 + r16 * 32 + e] = bi;
            const float b1 = dpp_f<0xB1>(bi), b2 = dpp_f<0x4E>(bi), b3 = dpp_f<0x1B>(bi);
            const float hi1 = fmaxf(bi, b1), lo1 = fminf(bi, b1), hi2 = fmaxf(b2, b3), lo2 = fminf(b2, b3);
            const float scg = fmaxf(hi1, hi2) + fmaxf(fminf(hi1, hi2), fmaxf(lo1, lo2));
            if ((e & 3) == 0) lgs[1024 + r16 * 8 + (e >> 2)] = scg; }
        __syncthreads();
        if (tid < 16) {
            const int row = rg * 16 + tid; const LAS float* gs = lgs + 1024 + tid * 8;
            float best = -1e30f; int grp = 0;
#pragma unroll
            for (int g = 0; g < 8; ++g) { const float scg = gs[g]; if (scg > best) { best = scg; grp = g; } }
            float ga[4], gv[4];
#pragma unroll
            for (int i = 0; i < 4; ++i) { ga[i] = lgs[tid * 32 + 4 * grp + i]; gv[i] = lgs[512 + tid * 32 + 4 * grp + i]; }
            int i1 = 0; float v1 = gv[0]; if (gv[1] > v1) { v1 = gv[1]; i1 = 1; } if (gv[2] > v1) { v1 = gv[2]; i1 = 2; } if (gv[3] > v1) { v1 = gv[3]; i1 = 3; }
            int i2 = -1; float v2 = -1e30f;
            if (i1 != 0 && gv[0] > v2) { v2 = gv[0]; i2 = 0; } if (i1 != 1 && gv[1] > v2) { v2 = gv[1]; i2 = 1; } if (i1 != 2 && gv[2] > v2) { v2 = gv[2]; i2 = 2; } if (i1 != 3 && gv[3] > v2) { v2 = gv[3]; i2 = 3; }
            const float a1 = i1 == 0 ? ga[0] : i1 == 1 ? ga[1] : i1 == 2 ? ga[2] : ga[3], a2 = i2 == 0 ? ga[0] : i2 == 1 ? ga[1] : i2 == 2 ? ga[2] : ga[3];
            const float w1 = a1 / (a1 + a2), w2 = a2 / (a1 + a2);
            const int e1 = grp * 4 + i1, e2 = grp * 4 + i2;
            const unsigned l1 = __hip_atomic_fetch_add(lcnt + e1, 1u, __ATOMIC_RELAXED, __HIP_MEMORY_SCOPE_WORKGROUP);
            const unsigned l2 = __hip_atomic_fetch_add(lcnt + e2, 1u, __ATOMIC_RELAXED, __HIP_MEMORY_SCOPE_WORKGROUP);
            LAS unsigned* ri = rinfo + (nq * 16 + tid) * 8;
            ri[0] = (unsigned)row; ri[1] = (unsigned)e1; ri[2] = (unsigned)e2; ri[3] = l1; ri[4] = l2; ri[5] = __float_as_uint(w1); ri[6] = __float_as_uint(w2);
        }
        ++nq;
        if (nq == 4 || rg + (int)gridDim.x >= T / 16) {
            __syncthreads();
            if (tid < 32) { const unsigned c = lcnt[tid]; lbase[tid] = c ? __hip_atomic_fetch_add(counts + tid, c, __ATOMIC_RELAXED, __HIP_MEMORY_SCOPE_AGENT) : 0u; }
            __syncthreads();
            if (tid < nq * 16) { const LAS unsigned* ri = rinfo + tid * 8;
                const unsigned row = ri[0], e1 = ri[1], e2 = ri[2], p1 = lbase[e1] + ri[3], p2 = lbase[e2] + ri[4];
                tablep[(size_t)e1 * T + p1] = (int)row; tablep[(size_t)e2 * T + p2] = (int)row;
                u32x4 ta; ta.x = e1; ta.y = e2; ta.z = p1; ta.w = p2; u32x4 tb2; tb2.x = ri[5]; tb2.y = ri[6]; tb2.z = 0u; tb2.w = 0u;
                *(u32x4*)(tokinfop + (size_t)row * 8) = ta; *(u32x4*)(tokinfop + (size_t)row * 8 + 4) = tb2; }
            __syncthreads();
            if (tid < 32) lcnt[tid] = 0u;
            nq = 0;
        }
    }
}
DI void moe_prefix(const unsigned* counts, LAS int* cnt, LAS int* tb, int tid) {
    __syncthreads();
    if (tid < 32) cnt[tid] = (int)__hip_atomic_load(counts + tid, __ATOMIC_RELAXED, __HIP_MEMORY_SCOPE_AGENT);
    __syncthreads();
    if (tid == 0) { int a = 0; for (int e = 0; e < 32; ++e) { tb[e] = a; a += (cnt[e] + 255) >> 8; } tb[32] = a; }
    __syncthreads();
}
template <typename TO>
DI void combine_phase(const bf16* X1, const bf16* Y, const unsigned* tokinfo, const LAS int* tb, const float* mods_l, const float* lng, const float* lnb,
                      TO* XO, const float* mods_next, bf16* U, LAS unsigned char* lds, int tid, int wave, int lane) {
    LAS f32x4* par = (LAS f32x4*)lds;
    par[tid] = ((const f32x4*)lng)[tid]; par[512 + tid] = ((const f32x4*)lnb)[tid];
    const int step = gridDim.x * 8; int cur_b = -1;
    volatile LAS unsigned* tiw = (volatile LAS unsigned*)(lds + 40960) + wave * 64;
#define COMB_ISSUE(kq, rowq) do { const int e0_ = __builtin_amdgcn_readfirstlane((int)tiw[(kq) * 8]), e1_ = __builtin_amdgcn_readfirstlane((int)tiw[(kq) * 8 + 1]); \
        const size_t r0_ = (size_t)(__builtin_amdgcn_readfirstlane(tb[e0_]) * 256 + __builtin_amdgcn_readfirstlane((int)tiw[(kq) * 8 + 2])), r1_ = (size_t)(__builtin_amdgcn_readfirstlane(tb[e1_]) * 256 + __builtin_amdgcn_readfirstlane((int)tiw[(kq) * 8 + 3])); \
        nw0 = __uint_as_float(tiw[(kq) * 8 + 4]); nw1 = __uint_as_float(tiw[(kq) * 8 + 5]); \
        const u32x2* xq_ = (const u32x2*)(X1 + (size_t)(rowq) * D) + lane; const u32x2* y0_ = (const u32x2*)(Y + r0_ * D) + lane; const u32x2* y1_ = (const u32x2*)(Y + r1_ * D) + lane; \
        _Pragma("unroll") for (int j = 0; j < 8; ++j) { nx[j] = __builtin_nontemporal_load(xq_ + 64 * j); na[j] = __builtin_nontemporal_load(y0_ + 64 * j); nb[j] = __builtin_nontemporal_load(y1_ + 64 * j); } } while (0)
    u32x2 nx[8], na[8], nb[8]; float nw0 = 0.f, nw1 = 0.f;
    for (int base = blockIdx.x * 8; base < T; base += 8 * step) {
      { const int rr = base + wave + (lane >> 3) * step; tiw[lane] = rr < T ? tokinfo[(size_t)rr * 8 + (lane & 7)] : 0u; }
      COMB_ISSUE(0, base + wave);
      asm volatile("" : "+v"(nx[0]), "+v"(nx[1]), "+v"(nx[2]), "+v"(nx[3]), "+v"(nx[4]), "+v"(nx[5]), "+v"(nx[6]), "+v"(nx[7]), "+v"(na[0]), "+v"(na[1]), "+v"(na[2]), "+v"(na[3]), "+v"(na[4]), "+v"(na[5]), "+v"(na[6]), "+v"(na[7]),
                       "+v"(nb[0]), "+v"(nb[1]), "+v"(nb[2]), "+v"(nb[3]), "+v"(nb[4]), "+v"(nb[5]), "+v"(nb[6]), "+v"(nb[7]));
#pragma unroll 1
      for (int kk = 0; kk < 8; ++kk) {
        const int row = base + wave + kk * step;
        if (row - wave >= T) break;
        const int b = row >> 12;
        if (b != cur_b) { cur_b = b; __syncthreads();
            par[1024 + tid] = ((const f32x4*)(mods_l + (size_t)b * MODW + 5 * D))[tid];
            if (U) { const float* mn = mods_next + (size_t)b * MODW; par[1536 + tid] = ((const f32x4*)mn)[tid]; par[2048 + tid] = ((const f32x4*)(mn + D))[tid]; }
            __syncthreads(); }
        u32x2 xv[8], av[8], bv[8];
#pragma unroll
        for (int j = 0; j < 8; ++j) { xv[j] = nx[j]; av[j] = na[j]; bv[j] = nb[j]; }
        const float w0 = nw0, w1 = nw1;
        asm volatile("" : "+v"(xv[0]), "+v"(xv[1]), "+v"(xv[2]), "+v"(xv[3]), "+v"(xv[4]), "+v"(xv[5]), "+v"(xv[6]), "+v"(xv[7]), "+v"(av[0]), "+v"(av[1]), "+v"(av[2]), "+v"(av[3]), "+v"(av[4]), "+v"(av[5]), "+v"(av[6]), "+v"(av[7]),
                         "+v"(bv[0]), "+v"(bv[1]), "+v"(bv[2]), "+v"(bv[3]), "+v"(bv[4]), "+v"(bv[5]), "+v"(bv[6]), "+v"(bv[7]));
        if (kk + 1 < 8 && row - wave + step < T) COMB_ISSUE(kk + 1, row + step);
        __builtin_amdgcn_sched_barrier(0);
        Row r;
#pragma unroll
        for (int j = 0; j < 8; ++j) { const u32x2 x = xv[j], a = av[j], c = bv[j]; f32x4 f;
            f.x = w0 * bflo(a.x) + w1 * bflo(c.x); f.y = w0 * bfhi(a.x) + w1 * bfhi(c.x); f.z = w0 * bflo(a.y) + w1 * bflo(c.y); f.w = w0 * bfhi(a.y) + w1 * bfhi(c.y);
            r.v[j] = (f32x4){bflo(x.x), bfhi(x.x), bflo(x.y), bfhi(x.y)} * ALPHA + par[1024 + lane + 64 * j] * f; }
        row_ln(r);
#pragma unroll
        for (int j = 0; j < 8; ++j) r.v[j] = r.v[j] * par[lane + 64 * j] + par[512 + lane + 64 * j];
        row_store_nt(r, XO + (size_t)row * D, lane);
        if (U) { row_ln(r);
#pragma unroll
            for (int j = 0; j < 8; ++j) r.v[j] = r.v[j] * (par[2048 + lane + 64 * j] + 1.f) + par[1536 + lane + 64 * j];
            row_store_bf16(r, U + (size_t)row * D, lane); }
      }
    }
#undef COMB_ISSUE
}

struct Args { const float* in[18]; float* out; unsigned char* ws; int ph_lo, ph_hi; };
__global__ void __launch_bounds__(512, 2) fwd(Args args) {
    extern __shared__ __attribute__((aligned(16))) unsigned char lds_raw[];
    LAS unsigned char* lds = (LAS unsigned char*)lds_raw;
#define PH_IDS int tid = threadIdx.x; asm volatile("" : "+v"(tid)); const int lane = tid & 63, wave = __builtin_amdgcn_readfirstlane(tid >> 6); \
    const int gw = blockIdx.x * 8 + wave, NGW = gridDim.x * 8, gtid = blockIdx.x * 512 + tid, GT = gridDim.x * 512; (void)lane; (void)gw; (void)NGW; (void)gtid; (void)GT;
    volatile LAS unsigned* LCTL = (volatile LAS unsigned*)(lds + LDSCTL_OFF);
    LAS int* l_cnt = (LAS int*)(lds + LDSCTL_OFF) + 16; LAS int* l_tb = (LAS int*)(lds + LDSCTL_OFF) + 48;
    for (int u = threadIdx.x; u < (LDS_BYTES - LDSCTL_OFF) / 4; u += 512) ((LAS unsigned*)(lds + LDSCTL_OFF))[u] = 0u;
    __syncthreads();
    unsigned char* ws = args.ws;
    unsigned* ctl = (unsigned*)(ws + WS_CTL);
#define XIN ((const float*)args.in[0])
#define c_in args.in[1]
#define ctx args.in[2]
#define c_ctx args.in[3]
#define ada_w args.in[4]
#define ada_b args.in[5]
#define w_mix_in args.in[6]
#define rpb args.in[7]
#define conv_w args.in[8]
#define w_mix_out args.in[9]
#define w_fourier args.in[10]
#define router_w args.in[11]
#define router_b args.in[12]
#define w_gate args.in[13]
#define w_up args.in[14]
#define w_down args.in[15]
#define ln_g args.in[16]
#define ln_b args.in[17]
#define mods ((float*)(ws + WS_MODS))
#define tokinfo ((unsigned*)(ws + WS_TOKINFO))
#define table ((int*)(ws + WS_TABLE))
#define WIN ((bf16*)(ws + WS_WIN))
#define WO ((bf16*)(ws + WS_WO))
#define WF ((bf16*)(ws + WS_WF))
#define CSM ((bf16*)(ws + WS_CS))
#define U ((bf16*)(ws + WS_U))
#define P ((bf16*)(ws + WS_P))
#define YB ((bf16*)(ws + WS_P))
#define YPB ((bf16*)(ws + WS_P))
#define PCATB ((bf16*)(ws + WS_TB))
#define MIX ((bf16*)(ws + WS_MIX))
#define REZ ((bf16*)(ws + WS_MIX))
#define HB ((bf16*)(ws + WS_H))
#define WGU ((bf16*)(ws + WS_WGU))
#define WD ((bf16*)(ws + WS_WD))
#define TB ((float*)(ws + WS_TB))
#define YMB ((bf16*)(ws + WS_TB))
#define X1 ((bf16*)(ws + WS_X1))
#define X2 ((bf16*)(ws + WS_X2))
    XcdBarrier bar; bar.bar = ctl + CW_BAR; bar.x = 0; bar.st = nullptr;
    if (N_LAUNCHES != NPHASE) bar = xcd_barrier_post(ctl + CW_BAR, LCTL);
    const int lo = args.ph_lo, hi = args.ph_hi;
#ifndef DUP_MASK
#define DUP_MASK 0x0000
#endif
#define RUN(k, ...) do { __VA_ARGS__ if constexpr ((((DUP_MASK) >> (k)) & 1) != 0) { __VA_ARGS__ } } while (0)
#ifndef PH_MASK
#define PH_MASK 0x1ffff
#endif
#define IN(k) ((((PH_MASK) >> (k)) & 1) && lo <= (k) && (k) < hi)
    const ConvCtx cvx{w_mix_in, w_mix_out, w_fourier, w_gate, w_up, w_down, WIN, WO, WF, WGU, WD, ctl + 161, ctl + 162};
#define SEAM(k) do { if (IN(k) && IN((k) + 1)) { if ((k) == 5) moe_drain(cvx, 0, lds); if ((k) == 13) moe_drain(cvx, 1, lds, 4096); \
        if (((k) < 13 && (k) != 5) || (k) == 14) xcd_barrier_steal(bar, cvx, false, lds); else xcd_barrier(bar); \
        if ((k) == 14) { moe_drain(cvx, 1, lds); xcd_barrier(bar); } } } while (0)

    RUN(0, if (IN(0)) { PH_IDS
        LAS float* sl = (LAS float*)lds; LAS float* red = sl + 5 * D; volatile LAS int* qslot = (volatile LAS int*)(lds + LDSCTL_OFF) + 8;
        for (int i = tid; i < 5 * D; i += 512) { const float v = i < 4 * D ? c_in[i] : c_ctx[i - 4 * D]; sl[i] = silu_f(v); }
        __syncthreads();
        for (bool first = true;; first = false) {
            if (tid == 0) *qslot = first ? (int)blockIdx.x : (int)gridDim.x + (int)__hip_atomic_fetch_add(ctl + 160, 1u, __ATOMIC_RELAXED, __HIP_MEMORY_SCOPE_AGENT);
            __syncthreads();
            const int item = __builtin_amdgcn_readfirstlane(*qslot);
            __syncthreads();
            if (item >= P0_NMODS + P0_S_IN + 2 * P0_S_SQ) break;
            if (item < P0_NMODS) p0_mods_unit(ada_w, ada_b, mods, sl, red, item, tid);
            else p0_weight_item(item - P0_NMODS, w_mix_in, w_mix_out, w_fourier, w_gate, w_up, w_down, WIN, WO, WF, WGU, WD, lds + wave * 16384, wave, lane);
        }
        p0_dft(CSM, gtid, GT);
    });
    SEAM(0);
    RUN(1, if (IN(1)) { PH_IDS ln_mod_phase(XIN, ctx, mods, 0, U, TALL, lds, tid, wave, lane); });
    SEAM(1);
    RUN(2, if (IN(2)) { SchedInProj S{U, WIN}; EpiStoreBf16 E{P, PLD}; gemm_pg8<false>(lds, S, E, D, D, D); });
    SEAM(2);
    RUN(3, if (IN(3)) { PH_IDS conv_phase(P, conv_w, MIX, gtid, GT); attn_phase(P, rpb, MIX, lds, (LAS float*)(lds + LDSCTL_OFF + 1024)); });
    SEAM(3);
    RUN(4, if (IN(4)) { SchedDense S{MIX, WO, 64, 8, (size_t)256 * D, (size_t)256 * D}; EpiStoreBf16 E{YMB, D}; gemm_pg8<false>(lds, S, E, D, D, D); });
    SEAM(4);
    RUN(5, if (IN(5)) { PH_IDS ln_router_phase(XIN, YMB, ln_g, ln_b, mods, router_w, router_b, X1, U, ctl + CW_CNT, table, tokinfo, lds); });
    SEAM(5);
    RUN(6, if (IN(6)) { PH_IDS moe_prefix(ctl + CW_CNT, l_cnt, l_tb, tid); SchedMoe S{l_cnt, l_tb, U, WGU, table, 1, 0, (size_t)D * D, (size_t)256 * D}; EpiSwiglu E{HB}; gemm_pg8<true>(lds, S, E, D, D, D); });
    SEAM(6);
    RUN(7, if (IN(7)) { PH_IDS if (lo == 7) moe_prefix(ctl + CW_CNT, l_cnt, l_tb, tid);     SchedMoe S{l_cnt, l_tb, HB, WD, table, 0, (size_t)256 * DE, (size_t)D * DE, (size_t)256 * DE}; EpiStoreBf16 E{YB, D}; gemm_pg8<false>(lds, S, E, DE, DE, DE); });
    SEAM(7);
    RUN(8, if (IN(8)) { PH_IDS if (lo == 8) moe_prefix(ctl + CW_CNT, l_cnt, l_tb, tid);     combine_phase(X1, YB, tokinfo, l_tb, mods, ln_g + D, ln_b + D, X2, mods + 5 * MODW, U, lds, tid, wave, lane); });
    SEAM(8);
    RUN(9, if (IN(9)) { fft1_phase(U, YPB, lds); });
    SEAM(9);
    RUN(10, if (IN(10)) { fft2_phase(YPB, PCATB, lds); });
    SEAM(10);
    RUN(11, if (IN(11)) { SchedChan S{PCATB, CSM}; EpiStoreBf16 E{REZ, D}; gemm_pg8<false>(lds, S, E, 4096, 1024, 1024); });
    SEAM(11);
    RUN(12, if (IN(12)) { SchedDense S{REZ, WF, 64, 8, (size_t)256 * D, (size_t)256 * D}; EpiStoreBf16 E{YMB, D}; gemm_pg8<false>(lds, S, E, D, D, D); });
    SEAM(12);
    RUN(13, if (IN(13)) { PH_IDS ln_router_phase(X2, YMB, ln_g + 2 * D, ln_b + 2 * D, mods + 5 * MODW, router_w, router_b, X1, U, ctl + CW_CNT + 32, table + (size_t)NE * T, tokinfo + (size_t)T * 8, lds); });
    SEAM(13);
    RUN(14, if (IN(14)) { PH_IDS moe_prefix(ctl + CW_CNT + 32, l_cnt, l_tb, tid); SchedMoe S{l_cnt, l_tb, U, WGU + (size_t)NE * D * D, table + (size_t)NE * T, 1, 0, (size_t)D * D, (size_t)256 * D}; EpiSwiglu E{HB}; gemm_pg8<true>(lds, S, E, D, D, D); });
    SEAM(14);
    RUN(15, if (IN(15)) { PH_IDS if (lo == 15) moe_prefix(ctl + CW_CNT + 32, l_cnt, l_tb, tid);     SchedMoe S{l_cnt, l_tb, HB, WD + (size_t)NE * D * DE, table, 0, (size_t)256 * DE, (size_t)D * DE, (size_t)256 * DE}; EpiStoreBf16 E{YB, D}; gemm_pg8<false>(lds, S, E, DE, DE, DE); });
    SEAM(15);
    RUN(16, if (IN(16)) { PH_IDS if (lo == 16) moe_prefix(ctl + CW_CNT + 32, l_cnt, l_tb, tid);     combine_phase(X1, YB, tokinfo + (size_t)T * 8, l_tb, mods + 5 * MODW, ln_g + 3 * D, ln_b + 3 * D, args.out, (const float*)nullptr, (bf16*)nullptr, lds, tid, wave, lane); });
#undef IN
#undef SEAM
}

extern "C" void kernel_launch(void* const* d_in, const int* in_sizes, int n_in, void* d_out, int out_size, void* d_ws, size_t ws_size, hipStream_t stream) {
    static int grid = 0;
    if (grid == 0) {
        if (n_in != 18 || out_size != T * D || ws_size < WS_END) { fprintf(stderr, "kernel_launch: unexpected shapes (n_in %d, out %d, ws %zu)\n", n_in, out_size, ws_size); grid = -1; return; }
        int dev = 0, cus = 0, per_cu = 0;
        if (hipGetDevice(&dev) != hipSuccess || hipDeviceGetAttribute(&cus, hipDeviceAttributeMultiprocessorCount, dev) != hipSuccess) { grid = -1; return; }
        if (hipFuncSetAttribute((const void*)fwd, hipFuncAttributeMaxDynamicSharedMemorySize, LDS_BYTES) != hipSuccess) { fprintf(stderr, "kernel_launch: hipFuncSetAttribute failed\n"); grid = -1; return; }
        if (hipOccupancyMaxActiveBlocksPerMultiprocessor(&per_cu, (const void*)fwd, 512, LDS_BYTES) != hipSuccess || per_cu < 1) fprintf(stderr, "kernel_launch: occupancy query says %d\n", per_cu);
        (void)hipGetLastError();
        grid = cus;
    }
    if (grid < 0) return;
    (void)hipMemsetAsync((char*)d_ws + WS_CTL, 0, CTL_ZERO_BYTES, stream);
    Args a{};
    for (int i = 0; i < 18; ++i) a.in[i] = (const float*)d_in[i];
    a.out = (float*)d_out; a.ws = (unsigned char*)d_ws;
    if (N_LAUNCHES == 1) { a.ph_lo = 0; a.ph_hi = NPHASE; hipLaunchKernelGGL(fwd, dim3(grid), dim3(512), LDS_BYTES, stream, a); }
    else for (int p = 0; p < NPHASE; ++p) { a.ph_lo = p; a.ph_hi = p + 1; hipLaunchKernelGGL(fwd, dim3(grid), dim3(512), LDS_BYTES, stream, a); }
}
```

```cpp
#include <hip/hip_runtime.h>
#include <cstdio>
#include <cstdint>

#define DI __device__ __forceinline__
#define LAS __attribute__((address_space(3)))
typedef unsigned short bf16;
typedef float f32x4 __attribute__((ext_vector_type(4)));
typedef short bf16x8 __attribute__((ext_vector_type(8)));
typedef unsigned u32x4 __attribute__((ext_vector_type(4)));
typedef unsigned u32x2 __attribute__((ext_vector_type(2)));

constexpr int D = 2048, NB = 4, SEQ = 4096, T = NB * SEQ, CTXL = 256, TC = NB * CTXL, TALL = T + TC;
constexpr int NMIX = 6144, PLD = 6272  , NE = 32, DE = 1024, NH = 8, HD = 128, MODW = 6 * D;
constexpr float ALPHA = 1.41421356237309515f;
constexpr float LN_EPS = 1e-6f;
constexpr int NPHASE = 17;
#ifndef MK_N_LAUNCHES
#define MK_N_LAUNCHES 1
#endif
constexpr int N_LAUNCHES = MK_N_LAUNCHES;

constexpr size_t MiB = 1u << 20;
constexpr size_t WS_CTL = 0, CTL_ZERO_BYTES = 64 * 1024;
constexpr size_t WS_MODS = 1 * MiB;
constexpr size_t WS_TOKINFO = 2 * MiB;
constexpr size_t WS_TABLE = 4 * MiB;
constexpr size_t WS_WIN = 8 * MiB, WS_WO = 32 * MiB, WS_WF = 40 * MiB, WS_CS = 48 * MiB, WS_ACS = 64 * MiB;
constexpr size_t WS_U = 116 * MiB;
constexpr size_t WS_P = 184 * MiB;
constexpr size_t WS_MIX = 400 * MiB;
constexpr size_t WS_TB = 464 * MiB, WS_X1 = 592 * MiB, WS_X2 = 720 * MiB;
constexpr size_t WS_H = 848 * MiB;
constexpr size_t WS_WGU = 928 * MiB;
constexpr size_t WS_WD = 1440 * MiB;
constexpr size_t WS_END = 1696 * MiB;
constexpr int CW_CNT = 64;
constexpr int CW_BAR = 1024;

constexpr int LDS_SCR = 133120;
constexpr int LDSCTL_OFF = LDS_SCR;
constexpr int LDS_BYTES = 147456;

template <int CTRL> DI float dpp_f(float v) { return __builtin_bit_cast(float, __builtin_amdgcn_mov_dpp(__builtin_bit_cast(int, v), CTRL, 0xF, 0xF, true)); }
DI float wave_sum(float v) {
    v += dpp_f<0xB1>(v); v += dpp_f<0x4E>(v); v += dpp_f<0x141>(v); v += dpp_f<0x140>(v);
    const int iv = __builtin_bit_cast(int, v);
    const float r0 = __builtin_bit_cast(float, __builtin_amdgcn_readlane(iv, 0)), r1 = __builtin_bit_cast(float, __builtin_amdgcn_readlane(iv, 16)),
                r2 = __builtin_bit_cast(float, __builtin_amdgcn_readlane(iv, 32)), r3 = __builtin_bit_cast(float, __builtin_amdgcn_readlane(iv, 48));
    return (r0 + r1) + (r2 + r3);
}
DI float wave_max(float v) {
    v = fmaxf(v, dpp_f<0xB1>(v)); v = fmaxf(v, dpp_f<0x4E>(v)); v = fmaxf(v, dpp_f<0x141>(v)); v = fmaxf(v, dpp_f<0x140>(v));
    const int iv = __builtin_bit_cast(int, v);
    const float r0 = __builtin_bit_cast(float, __builtin_amdgcn_readlane(iv, 0)), r1 = __builtin_bit_cast(float, __builtin_amdgcn_readlane(iv, 16)),
                r2 = __builtin_bit_cast(float, __builtin_amdgcn_readlane(iv, 32)), r3 = __builtin_bit_cast(float, __builtin_amdgcn_readlane(iv, 48));
    return fmaxf(fmaxf(r0, r1), fmaxf(r2, r3));
}
DI unsigned f2bf(float f) { unsigned u = __float_as_uint(f); return (u + 0x7fffu + ((u >> 16) & 1u)) >> 16; }
typedef float f32x2_t __attribute__((ext_vector_type(2)));
typedef __bf16 bf16x2_t __attribute__((ext_vector_type(2)));
DI unsigned pk2(float lo, float hi) { const f32x2_t v = {lo, hi}; return __builtin_bit_cast(unsigned, __builtin_convertvector(v, bf16x2_t)); }
DI float bflo(unsigned w) { return __uint_as_float(w << 16); }
DI float bfhi(unsigned w) { return __uint_as_float(w & 0xffff0000u); }
DI float silu_f(float v) { return v / (1.f + expf(-v)); }
DI float silu_fast(float v) { return v * __builtin_amdgcn_rcpf(1.f + __builtin_amdgcn_exp2f(v * -1.4426950408889634f)); }

#define XB_TMO      128
#define XB_XCNT(j)  (256  + 64 * (j))
#define XB_XSUB(j)  (1280 + 64 * (j))
#define XB_XGEN(j)  (2304 + 64 * (j))
#define XB_TOP      3328
#define XB_TOPGEN   3392
#define XCD_BAR_WORDS 3456
#define XB_SPIN_CAP (1u << 18)
__device__ __forceinline__ unsigned xb_ld(unsigned* p)              { return __hip_atomic_load(p, __ATOMIC_RELAXED, __HIP_MEMORY_SCOPE_AGENT); }
__device__ __forceinline__ unsigned xb_add(unsigned* p, unsigned v) { return __hip_atomic_fetch_add(p, v, __ATOMIC_RELAXED, __HIP_MEMORY_SCOPE_AGENT); }
__device__ __forceinline__ unsigned xb_xcc_id() { return (unsigned)__builtin_amdgcn_s_getreg((3 << 11) | 20) & 0xFu; }
#define XB_SPIN(cond, bar) do { unsigned _sp = 0; while (cond) { __builtin_amdgcn_s_sleep(1); \
    if ((++_sp & 255u) == 0u) { if (xb_ld(&(bar)[XB_TMO])) break; if (_sp > XB_SPIN_CAP) { atomicAdd(&(bar)[XB_TMO], 1u); break; } } } } while (0)
struct XcdBarrier { unsigned* bar; unsigned x; volatile LAS unsigned* st; };
__device__ __forceinline__ XcdBarrier xcd_barrier_post(unsigned* bar, volatile LAS unsigned* st) {
    XcdBarrier b; b.bar = bar; b.x = xb_xcc_id(); b.st = st;
    if (threadIdx.x == 0) (void)xb_add(&bar[XB_XCNT(b.x)], 1u);
    return b;
}
__device__ __forceinline__ void xcd_barrier_complete(unsigned* bar, unsigned x, unsigned& nloc, unsigned& nx) {
    const unsigned G = gridDim.x * gridDim.y * gridDim.z;
    unsigned sum, cnt, mine, sp = 0u;
    for (;;) {
        sum = 0u; cnt = 0u; mine = 0u;
#pragma unroll
        for (unsigned j = 0; j < 16; ++j) { const unsigned c = xb_ld(&bar[XB_XCNT(j)]); sum += c; cnt += (c > 0u) ? 1u : 0u; mine = (j == x) ? c : mine; }
        if (sum == G) break;
        __builtin_amdgcn_s_sleep(1);
        if ((++sp & 255u) == 0u) { if (xb_ld(&bar[XB_TMO])) break; if (sp > XB_SPIN_CAP) { atomicAdd(&bar[XB_TMO], 1u); break; } }
    }
    nloc = mine > 0u ? mine : 1u; nx = cnt > 0u ? cnt : 1u;
}
__device__ __forceinline__ void xcd_barrier(const XcdBarrier& b) {
    asm volatile("s_waitcnt vmcnt(0)" ::: "memory");
    __syncthreads();
    if (threadIdx.x == 0) {
        unsigned* bar = b.bar;
        __builtin_amdgcn_s_waitcnt(0);
        unsigned nloc = b.st[0], nx = b.st[1];
        if (nloc == 0u) { xcd_barrier_complete(bar, b.x, nloc, nx); b.st[0] = nloc; b.st[1] = nx; }
        const unsigned old = xb_add(&bar[XB_XSUB(b.x)], 1u);
        const unsigned gen = old / nloc;
        if (old + 1u == (gen + 1u) * nloc) {
            __builtin_amdgcn_fence(__ATOMIC_RELEASE, "agent");
            asm volatile("s_waitcnt vmcnt(0)" ::: "memory");
            const unsigned og = xb_add(&bar[XB_TOP], 1u);
            const unsigned tg = og / nx;
            if (og + 1u == (tg + 1u) * nx) xb_add(&bar[XB_TOPGEN], 1u);
            else XB_SPIN(xb_ld(&bar[XB_TOPGEN]) == tg, bar);
            __builtin_amdgcn_fence(__ATOMIC_ACQUIRE, "agent");
            xb_add(&bar[XB_XGEN(b.x)], 1u);
            asm volatile("s_waitcnt vmcnt(0)" ::: "memory");
        } else {
            XB_SPIN(xb_ld(&bar[XB_XGEN(b.x)]) == gen, bar);
            __builtin_amdgcn_fence(__ATOMIC_ACQUIRE, "agent");
            asm volatile("s_waitcnt vmcnt(0)" ::: "memory");
        }
    }
    __syncthreads();
}

struct Row { f32x4 v[8]; };
DI void row_load(Row& r, const float* p, int lane) { const f32x4* q = (const f32x4*)p + lane;
#pragma unroll
    for (int j = 0; j < 8; ++j) r.v[j] = q[64 * j]; }
DI void row_store(const Row& r, float* p, int lane) { f32x4* q = (f32x4*)p + lane;
#pragma unroll
    for (int j = 0; j < 8; ++j) q[64 * j] = r.v[j]; }
DI void row_store_bf16(const Row& r, bf16* p, int lane) { u32x2* q = (u32x2*)p + lane;
#pragma unroll
    for (int j = 0; j < 8; ++j) { u32x2 w; w.x = pk2(r.v[j].x, r.v[j].y); w.y = pk2(r.v[j].z, r.v[j].w); q[64 * j] = w; } }
DI void row_load(Row& r, const bf16* p, int lane) { const u32x2* q = (const u32x2*)p + lane; u32x2 w[8];
#pragma unroll
    for (int j = 0; j < 8; ++j) w[j] = q[64 * j];
#pragma unroll
    for (int j = 0; j < 8; ++j) r.v[j] = (f32x4){bflo(w[j].x), bfhi(w[j].x), bflo(w[j].y), bfhi(w[j].y)}; }
DI void row_store(const Row& r, bf16* p, int lane) { row_store_bf16(r, p, lane); }
DI void row_load_nt(Row& r, const float* p, int lane) { const f32x4* q = (const f32x4*)p + lane;
#pragma unroll
    for (int j = 0; j < 8; ++j) r.v[j] = __builtin_nontemporal_load(q + 64 * j); }
DI void row_load_nt(Row& r, const bf16* p, int lane) { const u32x2* q = (const u32x2*)p + lane; u32x2 w[8];
#pragma unroll
    for (int j = 0; j < 8; ++j) w[j] = __builtin_nontemporal_load(q + 64 * j);
#pragma unroll
    for (int j = 0; j < 8; ++j) r.v[j] = (f32x4){bflo(w[j].x), bfhi(w[j].x), bflo(w[j].y), bfhi(w[j].y)}; }
DI void row_store_nt(const Row& r, float* p, int lane) { f32x4* q = (f32x4*)p + lane;
#pragma unroll
    for (int j = 0; j < 8; ++j) __builtin_nontemporal_store(r.v[j], q + 64 * j); }
DI void row_store_nt(const Row& r, bf16* p, int lane) { u32x2* q = (u32x2*)p + lane;
#pragma unroll
    for (int j = 0; j < 8; ++j) { u32x2 w; w.x = pk2(r.v[j].x, r.v[j].y); w.y = pk2(r.v[j].z, r.v[j].w); __builtin_nontemporal_store(w, q + 64 * j); } }
DI void row_ln(Row& r) {
    float s = 0.f;
#pragma unroll
    for (int j = 0; j < 8; ++j) s += (r.v[j].x + r.v[j].y) + (r.v[j].z + r.v[j].w);
    const float mean = wave_sum(s) * (1.f / D); float s2 = 0.f;
#pragma unroll
    for (int j = 0; j < 8; ++j) { r.v[j] = r.v[j] - mean; s2 += (r.v[j].x * r.v[j].x + r.v[j].y * r.v[j].y) + (r.v[j].z * r.v[j].z + r.v[j].w * r.v[j].w); }
    const float rstd = 1.f / sqrtf(wave_sum(s2) * (1.f / D) + LN_EPS);
#pragma unroll
    for (int j = 0; j < 8; ++j) r.v[j] = r.v[j] * rstd;
}
DI void row_affine(Row& r, const float* g, const float* b, int lane) {
    const f32x4* gq = (const f32x4*)g + lane; const f32x4* bq = (const f32x4*)b + lane;
#pragma unroll
    for (int j = 0; j < 8; ++j) r.v[j] = r.v[j] * gq[64 * j] + bq[64 * j];
}
DI void row_modulate(Row& r, const float* sh, const float* sc, int lane) {
    const f32x4* hq = (const f32x4*)sh + lane; const f32x4* cq = (const f32x4*)sc + lane;
#pragma unroll
    for (int j = 0; j < 8; ++j) r.v[j] = r.v[j] * (cq[64 * j] + 1.f) + hq[64 * j];
}

struct Unit { const bf16* A; const bf16* B; const int* gat; int nvalid; int m0, n0, aux; };

namespace pg8 {
constexpr int BK = 64, HALF = 128, HTB = HALF * BK * 2, STAGE_BYTES = 8 * HTB;
DI int lds_byte(int r, int c) { const int st = (r >> 4) * 2 + (c >> 5), rr = r & 15, cc = c & 31, ob = rr * 64 + cc * 2; return st * 1024 + (ob ^ (((ob >> 9) & 1) << 5)); }
DI void stage_rc(int b, int& R, int& C) { const int st = b / 1024, sb = b % 1024, swz = sb ^ (((sb >> 9) & 1) << 5); R = (st >> 1) * 16 + swz / 64; C = (st & 1) * 32 + (swz % 64) / 2; }
}
template <bool GATHER, class Sched, class Epi>
DI void gemm_pg8(LAS unsigned char* lds, const Sched& S, const Epi& E, const int lda, const int ldb, const int K) {
    using namespace pg8;
    const int tid = threadIdx.x, wid = __builtin_amdgcn_readfirstlane(tid >> 6), lane = tid & 63, wr = wid >> 2, wc = wid & 3, fr = lane & 15, fq = lane >> 4;
    const int nt = K / BK, G = gridDim.x, cblk = blockIdx.x;
    unsigned voffB[2], vA[2][2];
#pragma unroll
    for (int i = 0; i < 2; ++i) { int R_, C_; stage_rc(tid * 16 + i * 8192, R_, C_); const int n_ = (R_ >> 4) & 1, i_ = R_ & 15, Rb = (R_ & ~31) + 8 * (i_ >> 2) + 4 * n_ + (i_ & 3);
        voffB[i] = (unsigned)(Rb * ldb + C_) * 2u; }
    const size_t kstep = (size_t)(BK * 2), hstepA = (size_t)HALF * lda * 2, hstepB = (size_t)HALF * ldb * 2;
    const unsigned ldsw = (unsigned)wid * 1024u;
    const int aoff = lds_byte(wr * 64 + fr, fq * 8), boff = lds_byte(wc * 32 + fr, fq * 8);
#define PG8_SA(b, h) (((b) * 2 + (h)) * HTB)
#define PG8_SB(b, h) ((4 + (b) * 2 + (h)) * HTB)
#define PG8_STAGE(bufoff, gbase, voff) do { _Pragma("unroll") for (int _i = 0; _i < 2; ++_i) \
        __builtin_amdgcn_global_load_lds((const unsigned*)((const char*)(gbase) + (voff)[_i]), (LAS unsigned*)(lds + (bufoff) + ldsw + _i * 8192), 16, 0, 0); } while (0)
#define PG8_STAGE_A(bufoff, gbase, h) do { if constexpr (GATHER) PG8_STAGE(bufoff, gbase, vA[h]); else PG8_STAGE(bufoff, (gbase) + (h) * hstepA, vA[0]); } while (0)
#define PG8_LDA(dst, b, h) do { _Pragma("unroll") for (int m = 0; m < 4; ++m) _Pragma("unroll") for (int k = 0; k < 2; ++k) dst[m][k] = *(const LAS bf16x8*)(lds + PG8_SA(b, h) + aoff + m * 2048 + k * 1024); } while (0)
#define PG8_LDB(dst, b, h) do { _Pragma("unroll") for (int n = 0; n < 2; ++n) _Pragma("unroll") for (int k = 0; k < 2; ++k) dst[n][k] = *(const LAS bf16x8*)(lds + PG8_SB(b, h) + boff + n * 2048 + k * 1024); } while (0)
#define PG8_MMA(ai, bj, At, Bt) do { __builtin_amdgcn_s_setprio(1); _Pragma("unroll") for (int m = 0; m < 4; ++m) _Pragma("unroll") for (int n = 0; n < 2; ++n) _Pragma("unroll") for (int k = 0; k < 2; ++k) \
        acc[ai][bj][m][n] = __builtin_amdgcn_mfma_f32_16x16x32_bf16(Bt[n][k], At[m][k], acc[ai][bj][m][n], 0, 0, 0); __builtin_amdgcn_s_setprio(0); } while (0)
#define PG8_WAIT_V(n) asm volatile("s_waitcnt vmcnt(" #n ")" ::: "memory")
#define PG8_WAIT_L(n) asm volatile("s_waitcnt lgkmcnt(" #n ")" ::: "memory")
#define PG8_BAR __builtin_amdgcn_s_barrier()
#define PG8_SCHED __builtin_amdgcn_sched_barrier(0)
#define PG8_SETV(dst, u) do { _Pragma("unroll") for (int _h = 0; _h < 2; ++_h) _Pragma("unroll") for (int _i = 0; _i < 2; ++_i) { int _R, _C; stage_rc(tid * 16 + _i * 8192, _R, _C); const int _r = _h * HALF + _R; \
        if constexpr (GATHER) { const int _g = (u).gat[_r < (u).nvalid ? _r : (u).nvalid - 1]; dst[_h][_i] = (unsigned)(_g * lda + _C) * 2u; }     else dst[_h][_i] = (unsigned)(_R * lda + _C) * 2u; } } while (0)
    Unit cur, nxt; int ui = 0;
    if (!S.get(cblk, cur)) return;
    f32x4 acc[2][2][4][2];
#pragma unroll
    for (int a = 0; a < 2; ++a)
#pragma unroll
        for (int b = 0; b < 2; ++b)
#pragma unroll
            for (int m = 0; m < 4; ++m)
#pragma unroll
                for (int n = 0; n < 2; ++n) acc[a][b][m][n] = (f32x4){0.f, 0.f, 0.f, 0.f};
    bf16x8 At[4][2], B0[2][2], B1[2][2];
    const char* cA = (const char*)cur.A; const char* cB = (const char*)cur.B;
    PG8_SETV(vA, cur);
    PG8_STAGE(PG8_SB(0, 0), cB, voffB); PG8_STAGE(PG8_SB(0, 1), cB + hstepB, voffB); PG8_STAGE_A(PG8_SA(0, 0), cA, 0); PG8_STAGE_A(PG8_SA(0, 1), cA, 1);
    if (wr == 1) PG8_BAR;
    PG8_WAIT_V(2); PG8_BAR;
    PG8_STAGE(PG8_SB(1, 0), cB + kstep, voffB); PG8_STAGE_A(PG8_SA(1, 0), cA + kstep, 0); PG8_STAGE(PG8_SB(1, 1), cB + hstepB + kstep, voffB);
    PG8_WAIT_V(6); PG8_BAR;
    for (;;) {
        const bool has_next = S.get((ui + 1) * G + cblk, nxt);
        const char* nA = has_next ? (const char*)nxt.A : cA; const char* nB = has_next ? (const char*)nxt.B : cB;
        for (int t = 0; t < nt; t += 2) {
            const bool last = (t == nt - 2);
            const char* a1 = cA + (size_t)(t + 1) * kstep;
            const char* a2 = last ? nA : cA + (size_t)(t + 2) * kstep; const char* b2 = last ? nB : cB + (size_t)(t + 2) * kstep;
            const char* a3 = a2 + kstep; const char* b3 = b2 + kstep;
            PG8_LDB(B0, 0, 0); PG8_LDB(B1, 0, 1); PG8_SCHED; PG8_LDA(At, 0, 0); PG8_STAGE_A(PG8_SA(1, 1), a1, 1);
            PG8_WAIT_V(8); PG8_WAIT_L(0); PG8_BAR; PG8_MMA(0, 0, At, B0); PG8_MMA(0, 1, At, B1); PG8_BAR; PG8_SCHED;
            if constexpr (GATHER) { if (last && has_next) PG8_SETV(vA, nxt); }
            PG8_LDA(At, 0, 1); PG8_STAGE(PG8_SB(0, 0), b2, voffB); PG8_STAGE(PG8_SB(0, 1), b2 + hstepB, voffB); PG8_STAGE_A(PG8_SA(0, 0), a2, 0);
            PG8_WAIT_V(8); PG8_WAIT_L(0); PG8_BAR; PG8_MMA(1, 0, At, B0); PG8_MMA(1, 1, At, B1); PG8_BAR; PG8_SCHED;
            PG8_LDB(B0, 1, 0); PG8_LDB(B1, 1, 1); PG8_SCHED; PG8_LDA(At, 1, 0); PG8_STAGE_A(PG8_SA(0, 1), a2, 1);
            PG8_WAIT_V(8); PG8_WAIT_L(0); PG8_BAR; PG8_MMA(0, 0, At, B0); PG8_MMA(0, 1, At, B1); PG8_BAR; PG8_SCHED;
            PG8_LDA(At, 1, 1); PG8_STAGE(PG8_SB(1, 0), b3, voffB); PG8_STAGE(PG8_SB(1, 1), b3 + hstepB, voffB); PG8_STAGE_A(PG8_SA(1, 0), a3, 0);
            PG8_WAIT_V(8); PG8_WAIT_L(0); PG8_BAR; PG8_MMA(1, 0, At, B0); PG8_MMA(1, 1, At, B1); PG8_BAR; PG8_SCHED;
        }
        if (wr == 0) PG8_BAR;
#pragma unroll
        for (int ai = 0; ai < 2; ++ai)
#pragma unroll
            for (int m = 0; m < 4; ++m) E(cur, ai * HALF + wr * 64 + m * 16 + fr, wc * 32 + 8 * fq, acc[ai][0][m][0], acc[ai][0][m][1], acc[ai][1][m][0], acc[ai][1][m][1]);
        if (!has_next) break;
#pragma unroll
        for (int a = 0; a < 2; ++a)
#pragma unroll
            for (int b = 0; b < 2; ++b)
#pragma unroll
                for (int m = 0; m < 4; ++m)
#pragma unroll
                    for (int n = 0; n < 2; ++n) acc[a][b][m][n] = (f32x4){0.f, 0.f, 0.f, 0.f};
        cur = nxt; cA = nA; cB = nB; ++ui;
        if (wr == 1) PG8_BAR;
    }
    PG8_WAIT_V(0);
    PG8_BAR;
#undef PG8_SA
#undef PG8_SB
#undef PG8_STAGE
#undef PG8_STAGE_A
#undef PG8_LDA
#undef PG8_LDB
#undef PG8_MMA
#undef PG8_WAIT_V
#undef PG8_WAIT_L
#undef PG8_BAR
#undef PG8_SCHED
#undef PG8_SETV
}

DI int xcd_remap(int L, int n) { const int q = n >> 3, r = n & 7, xcd = L & 7, off = L >> 3; return (xcd < r ? xcd * (q + 1) : r * (q + 1) + (xcd - r) * q) + off; }
DI void grouped(int wgid, int nM, int nN, int& pm, int& pn) { const int nig = 8 * nN, gid = wgid / nig, fm = gid * 8, gsz = min(nM - fm, 8); pm = fm + (wgid % nig) % gsz; pn = (wgid % nig) / gsz; }

struct SchedInProj { const bf16* U; const bf16* W;
    DI bool get(int L, Unit& u) const { int pm, pn;
        if (L >= 64 * 24 + 32) return false; const int w = xcd_remap(L, 64 * 24 + 32);
        if (w < 64 * 24) grouped(w, 64, 24, pm, pn); else { const int l2 = w - 64 * 24; pm = 64 + (l2 >> 3); pn = 4 + (l2 & 7); }
        u.A = U + (size_t)pm * 256 * D; u.B = W + (size_t)pn * 256 * D; u.gat = nullptr; u.nvalid = 256; u.m0 = pm * 256; u.n0 = pn * 256; u.aux = 0; return true; } };
struct SchedDense { const bf16* A; const bf16* B; int nM, nN; size_t a_t, b_t;
    DI bool get(int L, Unit& u) const { if (L >= nM * nN) return false; int pm, pn; grouped(xcd_remap(L, nM * nN), nM, nN, pm, pn);
        u.A = A + (size_t)pm * a_t; u.B = B + (size_t)pn * b_t; u.gat = nullptr; u.nvalid = 256; u.m0 = pm * 256; u.n0 = pn * 256; u.aux = 0; return true; } };
struct SchedMoe { const LAS int* cnt; const LAS int* tb; const bf16* A; const bf16* W; const int* table; int gather; size_t a_t, w_e, w_t;
    DI bool get(int L, Unit& u) const { const int nT = __builtin_amdgcn_readfirstlane(tb[32]); if (L >= nT * 8) return false; int t, pn; grouped(xcd_remap(L, nT * 8), nT, 8, t, pn);
        int e = 0;
        for (int i = 1; i < 32; ++i) e = (tb[i] <= t) ? i : e;
        e = __builtin_amdgcn_readfirstlane(e); t = __builtin_amdgcn_readfirstlane(t); pn = __builtin_amdgcn_readfirstlane(pn);
        const int mt = __builtin_amdgcn_readfirstlane(t - tb[e]);
        if (gather) { u.A = A; u.gat = table + (size_t)e * T + mt * 256; } else { u.A = A + (size_t)t * a_t; u.gat = nullptr; }
        u.nvalid = __builtin_amdgcn_readfirstlane(min(256, cnt[e] - mt * 256));
        u.B = W + (size_t)e * w_e + (size_t)pn * w_t; u.m0 = t * 256; u.n0 = pn * 256; u.aux = e; return true; } };
struct SchedChan { const bf16* PCAT; const bf16* CSB;
    DI bool get(int L, Unit& u) const { if (L >= 512) return false; int pm, q; grouped(xcd_remap(L, 512), 64, 8, pm, q); const int g = q >> 1, pn = q & 1;
        u.A = PCAT + (size_t)pm * 256 * 4096 + g * 1024; u.B = CSB + (size_t)pn * 256 * 1024; u.gat = nullptr; u.nvalid = 256; u.m0 = pm * 256; u.n0 = g * 512 + pn * 256; u.aux = g; return true; } };

DI void st_bf16x4(bf16* p, f32x4 v) { u32x2 w; w.x = pk2(v.x, v.y); w.y = pk2(v.z, v.w); *(u32x2*)p = w; }
DI void st_bf16x8(bf16* p, f32x4 a, f32x4 b) { u32x4 w; w.x = pk2(a.x, a.y); w.y = pk2(a.z, a.w); w.z = pk2(b.x, b.y); w.w = pk2(b.z, b.w); *(u32x4*)p = w; }
struct EpiStoreBf16 { bf16* O; int ldc;
    DI void operator()(const Unit& u, int r, int c, f32x4 l0, f32x4 l1, f32x4 h0, f32x4 h1) const { bf16* p = O + (size_t)(u.m0 + r) * ldc + u.n0 + c; st_bf16x8(p, l0, l1); st_bf16x8(p + 128, h0, h1); } };
struct EpiSwiglu { bf16* H;
    DI void operator()(const Unit& u, int r, int c, f32x4 l0, f32x4 l1, f32x4 h0, f32x4 h1) const { f32x4 a, b;
        a.x = silu_fast(l0.x) * h0.x; a.y = silu_fast(l0.y) * h0.y; a.z = silu_fast(l0.z) * h0.z; a.w = silu_fast(l0.w) * h0.w;
        b.x = silu_fast(l1.x) * h1.x; b.y = silu_fast(l1.y) * h1.y; b.z = silu_fast(l1.z) * h1.z; b.w = silu_fast(l1.w) * h1.w;
        st_bf16x8(H + (size_t)(u.m0 + r) * DE + (u.n0 >> 1) + c, a, b); } };
DI void p0_mods_unit(const float* ada_w, const float* ada_b, float* mods, const LAS float* sl, LAS float* red, int unit, int tid) {
    const int cg = tid & 31, ks = tid >> 5, l = unit / 96, n0 = (unit % 96) * 128;
    const float* W = ada_w + (size_t)l * D * MODW + n0 + 4 * cg;
    f32x4 a0 = (f32x4){0.f, 0.f, 0.f, 0.f}, a1 = a0, a2 = a0, a3 = a0, a4 = a0;
#pragma unroll 8
    for (int k = ks * 128; k < ks * 128 + 128; ++k) { const f32x4 w = __builtin_nontemporal_load((const f32x4*)(W + (size_t)k * MODW)); a0 += w * sl[k]; a1 += w * sl[D + k]; a2 += w * sl[2 * D + k]; a3 += w * sl[3 * D + k]; a4 += w * sl[4 * D + k]; }
    *(LAS f32x4*)(red + (ks * 5 + 0) * 128 + 4 * cg) = a0; *(LAS f32x4*)(red + (ks * 5 + 1) * 128 + 4 * cg) = a1; *(LAS f32x4*)(red + (ks * 5 + 2) * 128 + 4 * cg) = a2;
    *(LAS f32x4*)(red + (ks * 5 + 3) * 128 + 4 * cg) = a3; *(LAS f32x4*)(red + (ks * 5 + 4) * 128 + 4 * cg) = a4;
    __syncthreads();
    for (int i = tid; i < 640; i += 512) { const int r = i >> 7, q = i & 127; float sacc = 0.f;
#pragma unroll
        for (int k2 = 0; k2 < 16; ++k2) sacc += red[(k2 * 5 + r) * 128 + q];
        mods[((size_t)l * 5 + r) * MODW + n0 + q] = sacc + ada_b[(size_t)l * MODW + n0 + q]; }
    __syncthreads();
}
DI void tr_item(const float* W, int N, int Kd, int k0, int n0, bf16* WT, int drow0, LAS unsigned char* scr, int lane) {
    const int ng = lane & 15, kl = lane >> 4;
    f32x4 v[2][8];
    const float* src = W + (size_t)(k0 + 16 * kl) * N + n0 + 4 * ng;
#pragma unroll
    for (int pp = 0; pp < 2; ++pp)
#pragma unroll
        for (int i = 0; i < 8; ++i) v[pp][i] = __builtin_nontemporal_load((const f32x4*)(src + (size_t)(8 * pp + i) * N));
#pragma unroll
    for (int pp = 0; pp < 2; ++pp)
#pragma unroll
        for (int c = 0; c < 4; ++c) { u32x4 o; o.x = pk2(v[pp][0][c], v[pp][1][c]); o.y = pk2(v[pp][2][c], v[pp][3][c]); o.z = pk2(v[pp][4][c], v[pp][5][c]); o.w = pk2(v[pp][6][c], v[pp][7][c]);
            *(LAS u32x4*)(scr + (4 * ng + c) * 144 + (16 * kl + 8 * pp) * 2) = o; }
    asm volatile("s_waitcnt lgkmcnt(0)" ::: "memory");
#pragma unroll
    for (int j = 0; j < 8; ++j) { const int row = (lane >> 3) + 8 * j, ch = lane & 7;
        const u32x4 o = *(const LAS u32x4*)(scr + row * 144 + ch * 16);
        __builtin_nontemporal_store(o, (u32x4*)(WT + (size_t)(drow0 + row) * Kd + k0 + 8 * ch)); }
    asm volatile("s_waitcnt lgkmcnt(0)" ::: "memory");
}
constexpr int P0_S_IN = 8 * 48, P0_S_SQ = 8 * 16, P0_S_E = 64 * 64, P0_NSI = P0_S_IN + 2 * P0_S_SQ + 3 * P0_S_E, P0_NMODS = 192;
DI void p0_weight_item(int si, const float* w_in, const float* w_out, const float* w_f, const float* w_gate, const float* w_up, const float* w_down,
                       bf16* WIN, bf16* WO, bf16* WF, bf16* WGU, bf16* WD, LAS unsigned char* scr, int wave, int lane) {
    const int dk = wave >> 1, dn = wave & 1; int r = si;
    if (r < P0_S_IN) { const int kb = (r / 48) * 4 + dk, nb = (r % 48) * 2 + dn; tr_item(w_in, NMIX, D, kb * 64, nb * 64, WIN, nb * 64, scr, lane); return; } r -= P0_S_IN;
    if (r < P0_S_SQ) { const int kb = (r >> 4) * 4 + dk, nb = (r & 15) * 2 + dn; tr_item(w_out, D, D, kb * 64, nb * 64, WO, nb * 64, scr, lane); return; } r -= P0_S_SQ;
    if (r < P0_S_SQ) { const int kb = (r >> 4) * 4 + dk, nb = (r & 15) * 2 + dn; tr_item(w_f, D, D, kb * 64, nb * 64, WF, nb * 64, scr, lane); return; } r -= P0_S_SQ;
    if (r < 2 * P0_S_E) { const int up = r >= P0_S_E; if (up) r -= P0_S_E; const int mat = r >> 6, rr = r & 63, kb = (rr >> 3) * 4 + dk, nb = (rr & 7) * 2 + dn, n0 = nb * 64;
        tr_item((up ? w_up : w_gate) + (size_t)mat * D * DE, DE, D, kb * 64, n0, WGU + (size_t)mat * D * D, (n0 >> 7) * 256 + (n0 & 127) + (up ? 128 : 0), scr, lane); return; } r -= 2 * P0_S_E;
    { const int mat = r >> 6, rr = r & 63, kb = (rr >> 4) * 4 + dk, nb = (rr & 15) * 2 + dn; tr_item(w_down + (size_t)mat * DE * D, D, DE, kb * 64, nb * 64, WD + (size_t)mat * D * DE, nb * 64, scr, lane); }
}
struct ConvCtx { const float *w_in, *w_out, *w_f, *w_gate, *w_up, *w_down; bf16 *WIN_, *WO_, *WF_, *WGU_, *WD_; unsigned *q0, *q1; };
constexpr int MOE_QN = 6144;
DI int moe_item_si(int item) { const int layer = item >= MOE_QN, j = item - layer * MOE_QN, part = j >> 11, jj = j & 2047; return P0_S_IN + 2 * P0_S_SQ + part * P0_S_E + (layer * 32 + (jj >> 6)) * 64 + (jj & 63); }
DI int moe_take(const ConvCtx& c, volatile LAS int* fl  , bool q0_only) {
    if (!fl[0]) { const int j = (int)__hip_atomic_fetch_add(c.q0, 1u, __ATOMIC_RELAXED, __HIP_MEMORY_SCOPE_AGENT); if (j < MOE_QN) return j; fl[0] = 1; }
    if (!q0_only && !fl[1]) { const int j = (int)__hip_atomic_fetch_add(c.q1, 1u, __ATOMIC_RELAXED, __HIP_MEMORY_SCOPE_AGENT); if (j < MOE_QN) return MOE_QN + j; fl[1] = 1; }
    return -1;
}
DI void moe_conv_item(const ConvCtx& c, int item, LAS unsigned char* lds, int wave, int lane) {
    p0_weight_item(moe_item_si(item), c.w_in, c.w_out, c.w_f, c.w_gate, c.w_up, c.w_down, c.WIN_, c.WO_, c.WF_, c.WGU_, c.WD_, lds + wave * 16384, wave, lane);
}
DI void moe_drain(const ConvCtx& c, int layer, LAS unsigned char* lds, int limit = MOE_QN) {
    int tid = threadIdx.x; asm volatile("" : "+v"(tid)); const int wave = __builtin_amdgcn_readfirstlane(tid >> 6), lane = tid & 63;
    volatile LAS int* sl = (volatile LAS int*)(lds + LDSCTL_OFF) + 8;
    for (;;) {
        if (tid == 0) { int j = -1; if (!sl[2 + layer] && (limit >= MOE_QN || (int)__hip_atomic_load(layer ? c.q1 : c.q0, __ATOMIC_RELAXED, __HIP_MEMORY_SCOPE_AGENT) < limit)) { j = (int)__hip_atomic_fetch_add(layer ? c.q1 : c.q0, 2u, __ATOMIC_RELAXED, __HIP_MEMORY_SCOPE_AGENT); if (j >= MOE_QN) { sl[2 + layer] = 1; j = -1; } else j += layer * MOE_QN; } sl[0] = j; }
        __syncthreads();
        const int item = __builtin_amdgcn_readfirstlane(sl[0]);
        __syncthreads();
        if (item < 0) break;
#pragma unroll 1
        for (int k = 0; k < 2; ++k) if (item + k < (layer + 1) * MOE_QN) moe_conv_item(c, item + k, lds, wave, lane);
    }
}
DI void xcd_barrier_steal(const XcdBarrier& b, const ConvCtx& c, bool q0_only, LAS unsigned char* lds) {
    int tid = threadIdx.x; asm volatile("" : "+v"(tid)); const int wave = __builtin_amdgcn_readfirstlane(tid >> 6), lane = tid & 63;
    volatile LAS int* sl = (volatile LAS int*)(lds + LDSCTL_OFF) + 8;
    asm volatile("s_waitcnt vmcnt(0)" ::: "memory");
    __syncthreads();
    if (tid == 0) {
        unsigned* bar = b.bar;
        __builtin_amdgcn_s_waitcnt(0);
        unsigned nloc = b.st[0], nx = b.st[1];
        if (nloc == 0u) { xcd_barrier_complete(bar, b.x, nloc, nx); b.st[0] = nloc; b.st[1] = nx; }
        const unsigned old = xb_add(&bar[XB_XSUB(b.x)], 1u);
        const unsigned gen = old / nloc;
        if (old + 1u == (gen + 1u) * nloc) {
            __builtin_amdgcn_fence(__ATOMIC_RELEASE, "agent");
            asm volatile("s_waitcnt vmcnt(0)" ::: "memory");
            const unsigned og = xb_add(&bar[XB_TOP], 1u);
            const unsigned tg = og / nx;
            if (og + 1u == (tg + 1u) * nx) xb_add(&bar[XB_TOPGEN], 1u);
            else XB_SPIN(xb_ld(&bar[XB_TOPGEN]) == tg, bar);
            __builtin_amdgcn_fence(__ATOMIC_ACQUIRE, "agent");
            xb_add(&bar[XB_XGEN(b.x)], 1u);
            asm volatile("s_waitcnt vmcnt(0)" ::: "memory");
            sl[1] = -1;
        } else sl[1] = (int)gen;
    }
    __syncthreads();
    const int st = __builtin_amdgcn_readfirstlane(sl[1]);
    __syncthreads();
    if (st != -1) {
        unsigned spins = 0;
        for (;;) {
            if (tid == 0) { unsigned* bar = b.bar; int j = -3;
                const unsigned g = xb_ld(&bar[XB_XGEN(b.x)]), tm = xb_ld(&bar[XB_TMO]), xs = xb_ld(&bar[XB_XSUB(b.x)]);
                if (g != (unsigned)st || tm) j = -2;
                else if (++spins > XB_SPIN_CAP) { atomicAdd(&bar[XB_TMO], 1u); j = -2; }
                else { const unsigned nloc = b.st[0]; const unsigned arrived = xs - (unsigned)st * nloc;
                       if (arrived + 2u <= nloc) { const int t = moe_take(c, sl + 2, q0_only); if (t >= 0) j = t; } }
                sl[0] = j; }
            __syncthreads();
            const int j = __builtin_amdgcn_readfirstlane(sl[0]);
            __syncthreads();
            if (j == -2) break;
            if (j >= 0) moe_conv_item(c, j, lds, wave, lane); else __builtin_amdgcn_s_sleep(4);
        }
        if (tid == 0) { __builtin_amdgcn_fence(__ATOMIC_ACQUIRE, "agent"); asm volatile("s_waitcnt vmcnt(0)" ::: "memory"); }
    }
    __syncthreads();
}
DI void p0_dft(bf16* CSB, int gtid, int GT) {
    for (int i = gtid; i < 512 * 128; i += GT) { const int cp = i >> 7, k8 = (i & 127) * 8; unsigned w[4];
#pragma unroll
        for (int e = 0; e < 4; ++e) { float v[2];
#pragma unroll
            for (int q = 0; q < 2; ++q) { const int kk = k8 + 2 * e + q; const int m = (cp * (kk & 511)) & 511; const float ang = (float)m * (1.f / 256.f); v[q] = (kk < 512 ? cospif(ang) : sinpif(ang)) * 0.04419417382415922f; }
            w[e] = pk2(v[0], v[1]); }
        *(u32x4*)(CSB + (size_t)cp * 1024 + k8) = (u32x4){w[0], w[1], w[2], w[3]}; }
}
DI void ln_mod_phase(const float* x, const float* ctx, const float* mods_l, int sh_chunk, bf16* U, int nrows, LAS unsigned char* lds, int tid, int wave, int lane) {
    LAS f32x4* par = (LAS f32x4*)lds;
    const int step = gridDim.x * 8; int cur_b = -1;
    int base = blockIdx.x * 8;
    Row nxt;
    if (base < nrows) { const int row = base + wave; row_load_nt(nxt, row < T ? x + (size_t)row * D : ctx + (size_t)(row - T) * D, lane); }
    asm volatile("" : "+v"(nxt.v[0]), "+v"(nxt.v[1]), "+v"(nxt.v[2]), "+v"(nxt.v[3]), "+v"(nxt.v[4]), "+v"(nxt.v[5]), "+v"(nxt.v[6]), "+v"(nxt.v[7]));
    for (; base < nrows; base += step) {
        const int row = base + wave, rb = base < T ? (base >> 12) : 4;
        if (rb != cur_b) { cur_b = rb; __syncthreads(); const float* mr = mods_l + (size_t)rb * MODW + sh_chunk * D; par[tid] = ((const f32x4*)mr)[tid]; par[512 + tid] = ((const f32x4*)(mr + D))[tid]; __syncthreads(); }
        Row cur = nxt;
        asm volatile("" : "+v"(cur.v[0]), "+v"(cur.v[1]), "+v"(cur.v[2]), "+v"(cur.v[3]), "+v"(cur.v[4]), "+v"(cur.v[5]), "+v"(cur.v[6]), "+v"(cur.v[7]));
        if (base + step < nrows) { const int nr = row + step; row_load_nt(nxt, nr < T ? x + (size_t)nr * D : ctx + (size_t)(nr - T) * D, lane); }
        __builtin_amdgcn_sched_barrier(0);
        row_ln(cur);
#pragma unroll
        for (int j = 0; j < 8; ++j) cur.v[j] = cur.v[j] * (par[512 + lane + 64 * j] + 1.f) + par[lane + 64 * j];
        row_store_bf16(cur, U + (size_t)row * D, lane);
    }
}
constexpr int ATT_RS = 288, ATT_TILE = 64 * ATT_RS, ATT_BUF = 2 * ATT_TILE;
typedef short s16x4 __attribute__((ext_vector_type(4)));
struct AttState { f32x4 sc[32]; unsigned pk[32][2]; f32x4 o[8]; u32x4 stg[4]; bf16x8 qf[4]; float inv; unsigned g_off, w_off, ka_off, va_off; };
struct AttCtx { const bf16* P; LAS unsigned char* lds; const LAS float* lrpb; int b, r, rs, hp, hs, c0, qc, csq, quad; };
template <int STEP> DI void att_load(AttState& S, const AttCtx& C) {
    constexpr int ti = STEP % 12; const int colb = (STEP < 12 ? 1024 : 2048) + C.hp * 256;
    const size_t tok0 = ti < 8 ? (size_t)C.b * SEQ + 64 * (C.rs + ti) : (size_t)T + C.b * CTXL + (ti - 8) * 64;
    const char* ub = (const char*)(C.P + tok0 * PLD + colb);
#pragma unroll
    for (int k = 0; k < 4; ++k) S.stg[k] = *(const u32x4*)(ub + (size_t)(32 * (k & 1)) * PLD * 2 + (k >> 1) * 256 + S.g_off);
}
template <int BUFI> DI void att_write(AttState& S, const AttCtx& C) {
#pragma unroll
    for (int k = 0; k < 4; ++k) *(LAS u32x4*)(C.lds + BUFI * ATT_BUF + (k >> 1) * ATT_TILE + 32 * (k & 1) * ATT_RS + S.w_off) = S.stg[k];
}
template <int STEP> DI void att_step(AttState& S, const AttCtx& C) {
    const float scale = 0.08838834764831845f;
    asm volatile("" : "+v"(S.g_off), "+v"(S.w_off), "+v"(S.ka_off), "+v"(S.va_off));
    if constexpr (STEP + 1 < 24) att_load<STEP + 1>(S, C);
    constexpr int bo = (STEP & 1) * ATT_BUF;
    if constexpr (STEP < 12) {
        constexpr int ti = STEP;
        if constexpr (ti < 8) {
            const int aidx = C.rs + ti - C.r + 7;
            const LAS float* brow = C.lrpb + C.hs * 465 + aidx * 31;
            bf16x8 kf[2][4]; f32x4 accs[2];
#pragma unroll
            for (int t = 0; t < 2; ++t) { const LAS unsigned char* ka = C.lds + bo + (C.c0 + 16 * t) * ATT_RS + S.ka_off; accs[t] = (f32x4){0.f, 0.f, 0.f, 0.f};
#pragma unroll
                for (int s4 = 0; s4 < 4; ++s4) kf[t][s4] = *(const LAS bf16x8*)(ka + s4 * 64); }
            asm volatile("" : "+v"(kf[0][0]), "+v"(kf[0][1]), "+v"(kf[0][2]), "+v"(kf[0][3]), "+v"(kf[1][0]), "+v"(kf[1][1]), "+v"(kf[1][2]), "+v"(kf[1][3]));
#pragma unroll
            for (int s4 = 0; s4 < 4; ++s4)
#pragma unroll
                for (int t = 0; t < 2; ++t) accs[t] = __builtin_amdgcn_mfma_f32_16x16x32_bf16(kf[t][s4], S.qf[s4], accs[t], 0, 0, 0);
#pragma unroll
            for (int t = 0; t < 2; ++t) { const int krow0 = C.c0 + 16 * t; const f32x4 acc = accs[t];
                float bias[4];
#pragma unroll
                for (int i = 0; i < 4; ++i) bias[i] = brow[min(max(krow0 + C.quad * 4 + i - C.qc + 15, 0), 30)];
                asm volatile("" : "+v"(bias[0]), "+v"(bias[1]), "+v"(bias[2]), "+v"(bias[3]));
#pragma unroll
                for (int i = 0; i < 4; ++i) { const int kcol = krow0 + C.quad * 4 + i; const bool ok = kcol >= C.csq && kcol < C.csq + 16; S.sc[ti * 2 + t][i] = ok ? acc[i] * scale + bias[i] : -1e30f; } }
        } else {
#pragma unroll
            for (int tp = 0; tp < 2; ++tp) {
                bf16x8 kf[2][4]; f32x4 accs[2];
#pragma unroll
                for (int t = 0; t < 2; ++t) { const LAS unsigned char* ka = C.lds + bo + 16 * (2 * tp + t) * ATT_RS + S.ka_off; accs[t] = (f32x4){0.f, 0.f, 0.f, 0.f};
#pragma unroll
                    for (int s4 = 0; s4 < 4; ++s4) kf[t][s4] = *(const LAS bf16x8*)(ka + s4 * 64); }
                asm volatile("" : "+v"(kf[0][0]), "+v"(kf[0][1]), "+v"(kf[0][2]), "+v"(kf[0][3]), "+v"(kf[1][0]), "+v"(kf[1][1]), "+v"(kf[1][2]), "+v"(kf[1][3]));
#pragma unroll
                for (int s4 = 0; s4 < 4; ++s4)
#pragma unroll
                    for (int t = 0; t < 2; ++t) accs[t] = __builtin_amdgcn_mfma_f32_16x16x32_bf16(kf[t][s4], S.qf[s4], accs[t], 0, 0, 0);
#pragma unroll
                for (int t = 0; t < 2; ++t) S.sc[16 + (ti - 8) * 4 + 2 * tp + t] = accs[t] * scale; }
        }
    } else {
        if constexpr (STEP == 12) {
            float m = -1e30f;
#pragma unroll
            for (int sl = 0; sl < 32; ++sl) m = fmaxf(fmaxf(m, fmaxf(S.sc[sl][0], S.sc[sl][1])), fmaxf(S.sc[sl][2], S.sc[sl][3]));
            m = fmaxf(m, __shfl_xor(m, 16)); m = fmaxf(m, __shfl_xor(m, 32));
            float sum = 0.f;
#pragma unroll
            for (int sl = 0; sl < 32; ++sl) { const float e0 = __expf(S.sc[sl][0] - m), e1 = __expf(S.sc[sl][1] - m), e2 = __expf(S.sc[sl][2] - m), e3 = __expf(S.sc[sl][3] - m);
                sum += (e0 + e1) + (e2 + e3); S.pk[sl][0] = pk2(e0, e1); S.pk[sl][1] = pk2(e2, e3); }
            sum += __shfl_xor(sum, 16); sum += __shfl_xor(sum, 32); S.inv = 1.f / sum;
#pragma unroll
            for (int dt = 0; dt < 8; ++dt) S.o[dt] = (f32x4){0.f, 0.f, 0.f, 0.f};
        }
        constexpr int ti = STEP - 12; constexpr int nks = ti < 8 ? 1 : 2;
#pragma unroll
        for (int kk = 0; kk < nks; ++kk) {
            const int sa = ti < 8 ? ti * 2 : 16 + (ti - 8) * 4 + 2 * kk; const int rb = ti < 8 ? C.c0 : 32 * kk;
            const u32x4 pw = (u32x4){S.pk[sa][0], S.pk[sa][1], S.pk[sa + 1][0], S.pk[sa + 1][1]}; const bf16x8 pf = __builtin_bit_cast(bf16x8, pw);
            const LAS unsigned char* va = C.lds + bo + rb * ATT_RS + S.va_off;
            s16x4 v1[8], v2[8];
#pragma unroll
            for (int dt = 0; dt < 8; ++dt) { v1[dt] = __builtin_amdgcn_ds_read_tr16_b64_v4i16((LAS s16x4*)(va + dt * 32)); v2[dt] = __builtin_amdgcn_ds_read_tr16_b64_v4i16((LAS s16x4*)(va + 16 * ATT_RS + dt * 32)); }
            asm volatile("s_waitcnt lgkmcnt(0)" : "+v"(v1[0]), "+v"(v1[1]), "+v"(v1[2]), "+v"(v1[3]), "+v"(v1[4]), "+v"(v1[5]), "+v"(v1[6]), "+v"(v1[7]),
                                                  "+v"(v2[0]), "+v"(v2[1]), "+v"(v2[2]), "+v"(v2[3]), "+v"(v2[4]), "+v"(v2[5]), "+v"(v2[6]), "+v"(v2[7]));
#pragma unroll
            for (int dt = 0; dt < 8; ++dt) { const bf16x8 vf = __builtin_shufflevector(v1[dt], v2[dt], 0, 1, 2, 3, 4, 5, 6, 7); S.o[dt] = __builtin_amdgcn_mfma_f32_16x16x32_bf16(vf, pf, S.o[dt], 0, 0, 0); }
        }
    }
    if constexpr (STEP + 1 < 24) { if constexpr (STEP >= 12) asm volatile("s_waitcnt lgkmcnt(0)" ::: "memory");
        att_write<(STEP + 1) & 1>(S, C); }
    __syncthreads();
}
DI void attn_phase(const bf16* P, const float* rpb, bf16* MIX, LAS unsigned char* lds, LAS float* lrpb) {
    const int tid = threadIdx.x, wid = __builtin_amdgcn_readfirstlane(tid >> 6), lane = tid & 63, hs = wid >> 2, j = wid & 3, lq = lane & 15, quad = lane >> 4;
    const int srow = tid >> 4, sch = tid & 15;
    AttState S; AttCtx C;
    C.P = P; C.lds = lds; C.lrpb = lrpb; C.hs = hs; C.quad = quad;
    C.c0 = (j == 0) ? 0 : (j == 1) ? 8 : (j == 2) ? 24 : 32;
    C.qc = 16 * j + lq; C.csq = min(max(C.qc - 8, 0), 48);
    S.g_off = (unsigned)(srow * PLD + sch * 8) * 2u;
    S.w_off = (unsigned)(srow * ATT_RS + sch * 16);
    S.ka_off = (unsigned)(hs * ATT_TILE + lq * ATT_RS + quad * 16);
    S.va_off = (unsigned)(hs * ATT_TILE + (4 * quad + (lq >> 2)) * ATT_RS + 8 * (lq & 3));
    const bool split = gridDim.x == 256;
    if (split && ((blockIdx.x >> 3) & 1)) return;
    const int L0 = split ? (int)((blockIdx.x >> 4) * 8 + (blockIdx.x & 7)) : (int)blockIdx.x, Ls = split ? 128 : (int)gridDim.x;
    for (int L = L0; L < 1024; L += Ls) {
        const int unit = xcd_remap(L, 1024);
        const int r = unit & 63, hp = (unit >> 6) & 3, b = unit >> 8, h = 2 * hp + hs;
        C.r = r; C.hp = hp; C.b = b; C.rs = min(max(r - 4, 0), 56);
        __syncthreads();
        for (int i = tid; i < 930; i += 512) lrpb[i] = rpb[(size_t)hp * 930 + i];
        const size_t tq = (size_t)b * SEQ + 64 * r + C.qc;
#pragma unroll
        for (int s4 = 0; s4 < 4; ++s4) S.qf[s4] = *(const bf16x8*)(P + tq * PLD + h * HD + s4 * 32 + quad * 8);
        att_load<0>(S, C); att_write<0>(S, C); __syncthreads();
        att_step<0>(S, C); att_step<1>(S, C); att_step<2>(S, C); att_step<3>(S, C); att_step<4>(S, C); att_step<5>(S, C); att_step<6>(S, C); att_step<7>(S, C);
        att_step<8>(S, C); att_step<9>(S, C); att_step<10>(S, C); att_step<11>(S, C); att_step<12>(S, C); att_step<13>(S, C); att_step<14>(S, C); att_step<15>(S, C);
        att_step<16>(S, C); att_step<17>(S, C); att_step<18>(S, C); att_step<19>(S, C); att_step<20>(S, C); att_step<21>(S, C); att_step<22>(S, C); att_step<23>(S, C);
        bf16* op = MIX + tq * D + h * HD + quad * 4;
#pragma unroll
        for (int dt = 0; dt < 8; ++dt) st_bf16x4(op + dt * 16, S.o[dt] * S.inv);
    }
}


constexpr int FF_RS = 544;
DI bf16x8 fft_frag(int kind  , int k, int s, int kq) {
    unsigned w[4];
#pragma unroll
    for (int p = 0; p < 4; ++p) { float v[2];
#pragma unroll
        for (int q = 0; q < 2; ++q) { const int j = 2 * p + q; const int jj = 32 * s + (j < 4 ? 4 * kq + j : 16 + 4 * kq + (j - 4)); const float rev = (float)((k * jj) & 63) * (1.f / 64.f);
            v[q] = (kind == 0 ? __builtin_amdgcn_cosf(rev) : kind == 1 ? -__builtin_amdgcn_sinf(rev) : __builtin_amdgcn_sinf(rev)) * 0.125f; }
        w[p] = pk2(v[0], v[1]); }
    return __builtin_bit_cast(bf16x8, (u32x4){w[0], w[1], w[2], w[3]});
}
DI bf16x8 fft_tr(const LAS unsigned char* p) { const s16x4 v1 = __builtin_amdgcn_ds_read_tr16_b64_v4i16((LAS s16x4*)p), v2 = __builtin_amdgcn_ds_read_tr16_b64_v4i16((LAS s16x4*)(p + 16 * FF_RS));
    return __builtin_shufflevector(v1, v2, 0, 1, 2, 3, 4, 5, 6, 7); }
DI void fft1_phase(const bf16* Up, bf16* YP, LAS unsigned char* lds) {
    const int tid = threadIdx.x, wave = __builtin_amdgcn_readfirstlane(tid >> 6), lane = tid & 63, ml = lane & 15, quad = lane >> 4;
    bf16x8 Ff[8][2];
#pragma unroll
    for (int mt = 0; mt < 8; ++mt)
#pragma unroll
        for (int s2 = 0; s2 < 2; ++s2) Ff[mt][s2] = fft_frag(mt < 4 ? 0 : 1, (16 * mt + ml) & 63, s2, quad);
    LAS float* tw = (LAS float*)(lds + 64 * FF_RS);
    const unsigned va_off = (unsigned)((4 * quad + (ml >> 2)) * FF_RS + 8 * (ml & 3) + 64 * wave);
    for (int unit = blockIdx.x; unit < 2048; unit += gridDim.x) {
        const int b = unit >> 9, j2 = (unit >> 3) & 63, c0 = (unit & 7) * 256;
        __syncthreads();
#pragma unroll
        for (int q = 0; q < 4; ++q) { const int j1 = (tid >> 5) + 16 * q;
            const u32x4 v = __builtin_nontemporal_load((const u32x4*)(Up + ((size_t)b * SEQ + 64 * j1 + j2) * D + c0 + (tid & 31) * 8));
            LAS unsigned char* wp = lds + j1 * FF_RS + (tid & 28) * 16 + (tid & 3) * 8;
            *(LAS u32x2*)wp = (u32x2){v.x, v.y}; *(LAS u32x2*)(wp + 32) = (u32x2){v.z, v.w}; }
        if (tid < 64) { const float rev = (float)(j2 * tid) * (1.f / 4096.f); tw[2 * tid] = __builtin_amdgcn_cosf(rev); tw[2 * tid + 1] = __builtin_amdgcn_sinf(rev); }
        __syncthreads();
        float cth4[4], sth4[4];
#pragma unroll
        for (int mp = 0; mp < 4; ++mp) { cth4[mp] = tw[2 * (16 * mp + ml)]; sth4[mp] = tw[2 * (16 * mp + ml) + 1]; }
        asm volatile("s_waitcnt lgkmcnt(0)" : "+v"(cth4[0]), "+v"(cth4[1]), "+v"(cth4[2]), "+v"(cth4[3]), "+v"(sth4[0]), "+v"(sth4[1]), "+v"(sth4[2]), "+v"(sth4[3]) :: "memory");
        f32x4 acc[8][2];
#pragma unroll
        for (int mt = 0; mt < 8; ++mt) { acc[mt][0] = (f32x4){0.f, 0.f, 0.f, 0.f}; acc[mt][1] = acc[mt][0]; }
#pragma unroll
        for (int s2 = 0; s2 < 2; ++s2)
#pragma unroll
            for (int nt = 0; nt < 2; ++nt) { const bf16x8 zf = fft_tr(lds + va_off + 32 * s2 * FF_RS + 32 * nt);
#pragma unroll
                for (int mt = 0; mt < 8; ++mt) acc[mt][nt] = __builtin_amdgcn_mfma_f32_16x16x32_bf16(zf, Ff[mt][s2], acc[mt][nt], 0, 0, 0); }
#pragma unroll
        for (int mp = 0; mp < 4; ++mp) { const int k1 = 16 * mp + ml; const float cth = cth4[mp], sth = sth4[mp];
            bf16* dr = YP + ((((size_t)b * 64 + k1) * 2) * 64 + j2) * D + c0 + 32 * wave + 8 * quad;
            st_bf16x8(dr, acc[mp][0] * cth + acc[mp + 4][0] * sth, acc[mp][1] * cth + acc[mp + 4][1] * sth);
            st_bf16x8(dr + (size_t)64 * D, acc[mp + 4][0] * cth - acc[mp][0] * sth, acc[mp + 4][1] * cth - acc[mp][1] * sth); }
    }
}
DI void fft2_phase(const bf16* YP, bf16* PCAT, LAS unsigned char* lds) {
    const int tid = threadIdx.x, wave = __builtin_amdgcn_readfirstlane(tid >> 6), lane = tid & 63, ml = lane & 15, quad = lane >> 4;
    bf16x8 Cf[4][2], Sf[4][2], Nf[4][2];
#pragma unroll
    for (int mt = 0; mt < 4; ++mt)
#pragma unroll
        for (int s2 = 0; s2 < 2; ++s2) { Cf[mt][s2] = fft_frag(0, 16 * mt + ml, s2, quad); Nf[mt][s2] = fft_frag(1, 16 * mt + ml, s2, quad); Sf[mt][s2] = fft_frag(2, 16 * mt + ml, s2, quad); }
    const unsigned va_off = (unsigned)((4 * quad + (ml >> 2)) * FF_RS + 8 * (ml & 3) + 64 * wave);
    for (int unit = blockIdx.x; unit < 2048; unit += gridDim.x) {
        const int b = unit >> 9, k1 = (unit >> 3) & 63, cc = unit & 7, c0 = cc * 256;
        __syncthreads();
#pragma unroll
        for (int q = 0; q < 8; ++q) { const int kr = (tid >> 5) + 16 * q;
            const u32x4 v = __builtin_nontemporal_load((const u32x4*)(YP + (((size_t)b * 64 + k1) * 128 + kr) * D + c0 + (tid & 31) * 8));
            LAS unsigned char* wp = lds + kr * FF_RS + (tid & 28) * 16 + (tid & 3) * 8;
            *(LAS u32x2*)wp = (u32x2){v.x, v.y}; *(LAS u32x2*)(wp + 32) = (u32x2){v.z, v.w}; }
        __syncthreads();
        f32x4 acc[8][2];
#pragma unroll
        for (int mt = 0; mt < 8; ++mt) { acc[mt][0] = (f32x4){0.f, 0.f, 0.f, 0.f}; acc[mt][1] = acc[mt][0]; }
#pragma unroll
        for (int s4 = 0; s4 < 4; ++s4)
#pragma unroll
            for (int nt = 0; nt < 2; ++nt) { const bf16x8 yf = fft_tr(lds + va_off + 32 * s4 * FF_RS + 32 * nt);
#pragma unroll
                for (int mt = 0; mt < 4; ++mt) {
                    if (s4 < 2) { acc[mt][nt] = __builtin_amdgcn_mfma_f32_16x16x32_bf16(yf, Cf[mt][s4], acc[mt][nt], 0, 0, 0); acc[mt + 4][nt] = __builtin_amdgcn_mfma_f32_16x16x32_bf16(yf, Nf[mt][s4], acc[mt + 4][nt], 0, 0, 0); }
                    else { acc[mt][nt] = __builtin_amdgcn_mfma_f32_16x16x32_bf16(yf, Sf[mt][s4 - 2], acc[mt][nt], 0, 0, 0); acc[mt + 4][nt] = __builtin_amdgcn_mfma_f32_16x16x32_bf16(yf, Cf[mt][s4 - 2], acc[mt + 4][nt], 0, 0, 0); } } }
        const int g = cc >> 1, cp0 = (cc & 1) * 256 + 32 * wave + 8 * quad;
#pragma unroll
        for (int mt = 0; mt < 8; ++mt) { const int part = mt >> 2, k2 = 16 * (mt & 3) + ml;
            bf16* dp = PCAT + ((size_t)b * SEQ + k1 + 64 * k2) * 4096 + g * 1024 + part * 512 + cp0;
            st_bf16x8(dp, acc[mt][0], acc[mt][1]); }
    }
}

DI void conv_phase(const bf16* P, const float* cw, bf16* MIX, int gtid, int GT) {
    const int c8 = (gtid & 127) * 8;
    float w[3][8];
#pragma unroll
    for (int j = 0; j < 3; ++j) { const f32x4 a = *(const f32x4*)(cw + j * 1024 + c8), b = *(const f32x4*)(cw + j * 1024 + c8 + 4); w[j][0] = a.x; w[j][1] = a.y; w[j][2] = a.z; w[j][3] = a.w; w[j][4] = b.x; w[j][5] = b.y; w[j][6] = b.z; w[j][7] = b.w; }
    for (int tp = gtid >> 7; tp < T / 2; tp += GT >> 7) {
        const int tok = tp * 2, l = tok & 4095;
        const bf16* base = P + (size_t)tok * PLD + 3072 + c8;
        u32x4 gc[4], xi[4];
#pragma unroll
        for (int j = 0; j < 4; ++j) { int d = j - 1; if (j == 0 && l == 0) d = 0; if (j == 3 && l + 2 >= SEQ) d = 1; const bf16* pj = base + (ptrdiff_t)d * PLD; gc[j] = *(const u32x4*)(pj + 1024); xi[j] = *(const u32x4*)(pj + 2048); }
        const u32x4 gb0 = *(const u32x4*)base, gb1 = *(const u32x4*)(base + PLD);
        float z[4][8];
#pragma unroll
        for (int j = 0; j < 4; ++j) { const float m = (j == 0 && l == 0) || (j == 3 && l + 2 >= SEQ) ? 0.f : 1.f;
            z[j][0] = m * bflo(gc[j].x) * bflo(xi[j].x); z[j][1] = m * bfhi(gc[j].x) * bfhi(xi[j].x); z[j][2] = m * bflo(gc[j].y) * bflo(xi[j].y); z[j][3] = m * bfhi(gc[j].y) * bfhi(xi[j].y);
            z[j][4] = m * bflo(gc[j].z) * bflo(xi[j].z); z[j][5] = m * bfhi(gc[j].z) * bfhi(xi[j].z); z[j][6] = m * bflo(gc[j].w) * bflo(xi[j].w); z[j][7] = m * bfhi(gc[j].w) * bfhi(xi[j].w); }
        const float g0[8] = {bflo(gb0.x), bfhi(gb0.x), bflo(gb0.y), bfhi(gb0.y), bflo(gb0.z), bfhi(gb0.z), bflo(gb0.w), bfhi(gb0.w)};
        const float g1[8] = {bflo(gb1.x), bfhi(gb1.x), bflo(gb1.y), bfhi(gb1.y), bflo(gb1.z), bfhi(gb1.z), bflo(gb1.w), bfhi(gb1.w)};
        float o0[8], o1[8];
#pragma unroll
        for (int e = 0; e < 8; ++e) { o0[e] = g0[e] * (w[0][e] * z[0][e] + w[1][e] * z[1][e] + w[2][e] * z[2][e]); o1[e] = g1[e] * (w[0][e] * z[1][e] + w[1][e] * z[2][e] + w[2][e] * z[3][e]); }
        *(u32x4*)(MIX + (size_t)tok * D + 1024 + c8) = (u32x4){pk2(o0[0], o0[1]), pk2(o0[2], o0[3]), pk2(o0[4], o0[5]), pk2(o0[6], o0[7])};
        *(u32x4*)(MIX + (size_t)(tok + 1) * D + 1024 + c8) = (u32x4){pk2(o1[0], o1[1]), pk2(o1[2], o1[3]), pk2(o1[4], o1[5]), pk2(o1[6], o1[7])};
    }
}
constexpr int RT_RS = 4112, RT_IMG = 16 * RT_RS;
DI void split_bf16(const float* w8, bf16x8& hi, bf16x8& lo) {
    unsigned h[4], l[4];
#pragma unroll
    for (int p = 0; p < 4; ++p) { const unsigned a = f2bf(w8[2 * p]), b = f2bf(w8[2 * p + 1]); h[p] = a | (b << 16);
        l[p] = pk2(w8[2 * p] - __uint_as_float(a << 16), w8[2 * p + 1] - __uint_as_float(b << 16)); }
    hi = __builtin_bit_cast(bf16x8, (u32x4){h[0], h[1], h[2], h[3]}); lo = __builtin_bit_cast(bf16x8, (u32x4){l[0], l[1], l[2], l[3]});
}
template <typename TX>
DI void ln_router_phase(const TX* XSp, const bf16* YMp, const float* lng, const float* lnb, const float* mods_l, const float* rw, const float* rbias,
                        bf16* X1p, bf16* Up, unsigned* counts, int* tablep, unsigned* tokinfop, LAS unsigned char* lds) {
    const int tid = threadIdx.x, wave = __builtin_amdgcn_readfirstlane(tid >> 6), lane = tid & 63, fr = lane & 15, fq = lane >> 4;
    bf16x8 bh[8][2], bl[8][2];
#pragma unroll
    for (int ks = 0; ks < 8; ++ks)
#pragma unroll
        for (int nt = 0; nt < 2; ++nt) { float w8[8];
#pragma unroll
            for (int j = 0; j < 8; ++j) w8[j] = rw[(size_t)(256 * wave + 32 * ks + 8 * fq + j) * NE + nt * 16 + fr];
            split_bf16(w8, bh[ks][nt], bl[ks][nt]); }
    LAS unsigned char* par = lds + RT_IMG; LAS float* part = (LAS float*)(lds + RT_IMG + 40960); LAS float* lgs = (LAS float*)(lds + RT_IMG + 40960 + 16384);
    LAS unsigned* lcnt = (LAS unsigned*)(lds + RT_IMG + 40960 + 16384 + 4608); LAS unsigned* lbase = lcnt + 32; LAS unsigned* rinfo = lcnt + 64;
    if (tid < 32) lcnt[tid] = 0u;
    int nq = 0;
    for (int rg = blockIdx.x; rg < T / 16; rg += gridDim.x) {
        __syncthreads();
        { const float* mb = mods_l + (size_t)((rg * 16) >> 12) * MODW;
          const f32x4 p0 = ((const f32x4*)(mb + 2 * D))[tid], p1 = ((const f32x4*)lng)[tid], p2 = ((const f32x4*)lnb)[tid], p3 = ((const f32x4*)(mb + 3 * D))[tid], p4 = ((const f32x4*)(mb + 4 * D))[tid];
          ((LAS f32x4*)par)[tid] = p0; ((LAS f32x4*)(par + 8192))[tid] = p1; ((LAS f32x4*)(par + 16384))[tid] = p2; ((LAS f32x4*)(par + 24576))[tid] = p3; ((LAS f32x4*)(par + 32768))[tid] = p4; }
        __syncthreads();
#pragma unroll 1
        for (int rr = 0; rr < 2; ++rr) {
            const int lr = 2 * wave + rr, row = rg * 16 + lr;
            Row r; row_load_nt(r, XSp + (size_t)row * D, lane);
            { const u32x2* yq = (const u32x2*)(YMp + (size_t)row * D) + lane; const LAS f32x4* g1 = (const LAS f32x4*)par + lane;
              u32x2 yv[8];
#pragma unroll
              for (int j = 0; j < 8; ++j) yv[j] = __builtin_nontemporal_load(yq + 64 * j);
              asm volatile("" : "+v"(yv[0]), "+v"(yv[1]), "+v"(yv[2]), "+v"(yv[3]), "+v"(yv[4]), "+v"(yv[5]), "+v"(yv[6]), "+v"(yv[7]));
#pragma unroll
              for (int j = 0; j < 8; ++j) { const f32x4 yf = (f32x4){bflo(yv[j].x), bfhi(yv[j].x), bflo(yv[j].y), bfhi(yv[j].y)}; r.v[j] = r.v[j] * ALPHA + g1[64 * j] * yf; } }
            row_ln(r);
            { const LAS f32x4* gq = (const LAS f32x4*)(par + 8192) + lane; const LAS f32x4* bq = (const LAS f32x4*)(par + 16384) + lane;
#pragma unroll
              for (int j = 0; j < 8; ++j) r.v[j] = r.v[j] * gq[64 * j] + bq[64 * j]; }
            row_store_nt(r, X1p + (size_t)row * D, lane);
            row_ln(r);
            { const LAS f32x4* hq = (const LAS f32x4*)(par + 24576) + lane; const LAS f32x4* cq = (const LAS f32x4*)(par + 32768) + lane;
#pragma unroll
              for (int j = 0; j < 8; ++j) r.v[j] = r.v[j] * (cq[64 * j] + 1.f) + hq[64 * j]; }
            u32x2* uq = (u32x2*)(Up + (size_t)row * D) + lane;
#pragma unroll
            for (int j = 0; j < 8; ++j) { const unsigned a = f2bf(r.v[j].x), b = f2bf(r.v[j].y), c = f2bf(r.v[j].z), d = f2bf(r.v[j].w);
                u32x2 hi; hi.x = a | (b << 16); hi.y = c | (d << 16); uq[64 * j] = hi;
                u32x2 lo; lo.x = pk2(r.v[j].x - __uint_as_float(a << 16), r.v[j].y - __uint_as_float(b << 16)); lo.y = pk2(r.v[j].z - __uint_as_float(c << 16), r.v[j].w - __uint_as_float(d << 16));
                *(LAS u32x2*)(lds + lr * RT_RS + (4 * lane + 256 * j) * 2) = lo; }
        }
        asm volatile("s_waitcnt vmcnt(0)" ::: "memory");
        __syncthreads();
        f32x4 acc[2]; acc[0] = (f32x4){0.f, 0.f, 0.f, 0.f}; acc[1] = acc[0];
        const LAS unsigned char* ap = lds + fr * RT_RS + (256 * wave + 8 * fq) * 2;
        const bf16* hp = Up + (size_t)(rg * 16 + fr) * D + 256 * wave + 8 * fq;
        bf16x8 ahv[8];
#pragma unroll
        for (int ks = 0; ks < 8; ++ks) ahv[ks] = __builtin_nontemporal_load((const bf16x8*)(hp + 32 * ks));
#pragma unroll
        for (int ks = 0; ks < 8; ++ks) { const bf16x8 ah = ahv[ks], al = *(const LAS bf16x8*)(ap + ks * 64);
#pragma unroll
            for (int nt = 0; nt < 2; ++nt) { acc[nt] = __builtin_amdgcn_mfma_f32_16x16x32_bf16(ah, bh[ks][nt], acc[nt], 0, 0, 0); acc[nt] = __builtin_amdgcn_mfma_f32_16x16x32_bf16(ah, bl[ks][nt], acc[nt], 0, 0, 0);
                acc[nt] = __builtin_amdgcn_mfma_f32_16x16x32_bf16(al, bh[ks][nt], acc[nt], 0, 0, 0); } }
#pragma unroll
        for (int nt = 0; nt < 2; ++nt)
#pragma unroll
            for (int i = 0; i < 4; ++i) part[(wave * 16 + fq * 4 + i) * 32 + nt * 16 + fr] = acc[nt][i];
        __syncthreads();
        { const int r16 = tid >> 5, e = tid & 31; float sacc = 0.f;
#pragma unroll
            for (int w = 0; w < 8; ++w) sacc += part[(w * 16 + r16) * 32 + e];
            const float af = 1.f / (1.f + expf(-sacc)); const float bi = af + rbias[e];
            lgs[r16 * 32 + e] = af; lgs[512 + r16 * 32 + e] = bi;
            const float b1 = dpp_f<0xB1>(bi), b2 = dpp_f<0x4E>(bi), b3 = dpp_f<0x1B>(bi);
            const float hi1 = fmaxf(bi, b1), lo1 = fminf(bi, b1), hi2 = fmaxf(b2, b3), lo2 = fminf(b2, b3);
            const float scg = fmaxf(hi1, hi2) + fmaxf(fminf(hi1, hi2), fmaxf(lo1, lo2));
            if ((e & 3) == 0) lgs[1024 + r16 * 8 + (e >> 2)] = scg; }
        __syncthreads();
        if (tid < 16) {
            const int row = rg * 16 + tid; const LAS float* gs = lgs + 1024 + tid * 8;
            float best = -1e30f; int grp = 0;
#pragma unroll
            for (int g = 0; g < 8; ++g) { const float scg = gs[g]; if (scg > best) { best = scg; grp = g; } }
            float ga[4], gv[4];
#pragma unroll
            for (int i = 0; i < 4; ++i) { ga[i] = lgs[tid * 32 + 4 * grp + i]; gv[i] = lgs[512 + tid * 32 + 4 * grp + i]; }
            int i1 = 0; float v1 = gv[0]; if (gv[1] > v1) { v1 = gv[1]; i1 = 1; } if (gv[2] > v1) { v1 = gv[2]; i1 = 2; } if (gv[3] > v1) { v1 = gv[3]; i1 = 3; }
            int i2 = -1; float v2 = -1e30f;
            if (i1 != 0 && gv[0] > v2) { v2 = gv[0]; i2 = 0; } if (i1 != 1 && gv[1] > v2) { v2 = gv[1]; i2 = 1; } if (i1 != 2 && gv[2] > v2) { v2 = gv[2]; i2 = 2; } if (i1 != 3 && gv[3] > v2) { v2 = gv[3]; i2 = 3; }
            const float a1 = i1 == 0 ? ga[0] : i1 == 1 ? ga[1] : i1 == 2 ? ga[2] : ga[3], a2 = i2 == 0 ? ga[0] : i2 == 1 ? ga[1] : i2 == 2 ? ga[2] : ga[3];
            const float w1 = a1 / (a1 + a2), w2 = a2 / (a1 + a2);
            const int e1 = grp * 4 + i1, e2 = grp * 4 + i2;
            const unsigned l1 = __hip_atomic_fetch_add(lcnt + e1, 1u, __ATOMIC_RELAXED, __HIP_MEMORY_SCOPE_WORKGROUP);
            const unsigned l2 = __hip_atomic_fetch_add(lcnt + e2, 1u, __ATOMIC_RELAXED, __HIP_MEMORY_SCOPE_WORKGROUP);
            LAS unsigned* ri = rinfo + (nq * 16 + tid) * 8;
            ri[0] = (unsigned)row; ri[1] = (unsigned)e1; ri[2] = (unsigned)e2; ri[3] = l1; ri[4] = l2; ri[5] = __float_as_uint(w1); ri[6] = __float_as_uint(w2);
        }
        ++nq;
        if (nq == 4 || rg + (int)gridDim.x >= T / 16) {
            __syncthreads();
            if (tid < 32) { const unsigned c = lcnt[tid]; lbase[tid] = c ? __hip_atomic_fetch_add(counts + tid, c, __ATOMIC_RELAXED, __HIP_MEMORY_SCOPE_AGENT) : 0u; }
            __syncthreads();
            if (tid < nq * 16) { const LAS unsigned* ri = rinfo + tid * 8;
                const unsigned row = ri[0], e1 = ri[1], e2 = ri[2], p1 = lbase[e1] + ri[3], p2 = lbase[e2] + ri[4];
                tablep[(size_t)e1 * T + p1] = (int)row; tablep[(size_t)e2 * T + p2] = (int)row;
                u32x4 ta; ta.x = e1; ta.y = e2; ta.z = p1; ta.w = p2; u32x4 tb2; tb2.x = ri[5]; tb2.y = ri[6]; tb2.z = 0u; tb2.w = 0u;
                *(u32x4*)(tokinfop + (size_t)row * 8) = ta; *(u32x4*)(tokinfop + (size_t)row * 8 + 4) = tb2; }
            __syncthreads();
            if (tid < 32) lcnt[tid] = 0u;
            nq = 0;
        }
    }
}
DI void moe_prefix(const unsigned* counts, LAS int* cnt, LAS int* tb, int tid) {
    __syncthreads();
    if (tid < 32) cnt[tid] = (int)__hip_atomic_load(counts + tid, __ATOMIC_RELAXED, __HIP_MEMORY_SCOPE_AGENT);
    __syncthreads();
    if (tid == 0) { int a = 0; for (int e = 0; e < 32; ++e) { tb[e] = a; a += (cnt[e] + 255) >> 8; } tb[32] = a; }
    __syncthreads();
}
template <typename TO>
DI void combine_phase(const bf16* X1, const bf16* Y, const unsigned* tokinfo, const LAS int* tb, const float* mods_l, const float* lng, const float* lnb,
                      TO* XO, const float* mods_next, bf16* U, LAS unsigned char* lds, int tid, int wave, int lane) {
    LAS f32x4* par = (LAS f32x4*)lds;
    par[tid] = ((const f32x4*)lng)[tid]; par[512 + tid] = ((const f32x4*)lnb)[tid];
    const int step = gridDim.x * 8; int cur_b = -1;
    volatile LAS unsigned* tiw = (volatile LAS unsigned*)(lds + 40960) + wave * 64;
#define COMB_ISSUE(kq, rowq) do { const int e0_ = __builtin_amdgcn_readfirstlane((int)tiw[(kq) * 8]), e1_ = __builtin_amdgcn_readfirstlane((int)tiw[(kq) * 8 + 1]); \
        const size_t r0_ = (size_t)(__builtin_amdgcn_readfirstlane(tb[e0_]) * 256 + __builtin_amdgcn_readfirstlane((int)tiw[(kq) * 8 + 2])), r1_ = (size_t)(__builtin_amdgcn_readfirstlane(tb[e1_]) * 256 + __builtin_amdgcn_readfirstlane((int)tiw[(kq) * 8 + 3])); \
        nw0 = __uint_as_float(tiw[(kq) * 8 + 4]); nw1 = __uint_as_float(tiw[(kq) * 8 + 5]); \
        const u32x2* xq_ = (const u32x2*)(X1 + (size_t)(rowq) * D) + lane; const u32x2* y0_ = (const u32x2*)(Y + r0_ * D) + lane; const u32x2* y1_ = (const u32x2*)(Y + r1_ * D) + lane; \
        _Pragma("unroll") for (int j = 0; j < 8; ++j) { nx[j] = __builtin_nontemporal_load(xq_ + 64 * j); na[j] = __builtin_nontemporal_load(y0_ + 64 * j); nb[j] = __builtin_nontemporal_load(y1_ + 64 * j); } } while (0)
    u32x2 nx[8], na[8], nb[8]; float nw0 = 0.f, nw1 = 0.f;
    for (int base = blockIdx.x * 8; base < T; base += 8 * step) {
      { const int rr = base + wave + (lane >> 3) * step; tiw[lane] = rr < T ? tokinfo[(size_t)rr * 8 + (lane & 7)] : 0u; }
      COMB_ISSUE(0, base + wave);
      asm volatile("" : "+v"(nx[0]), "+v"(nx[1]), "+v"(nx[2]), "+v"(nx[3]), "+v"(nx[4]), "+v"(nx[5]), "+v"(nx[6]), "+v"(nx[7]), "+v"(na[0]), "+v"(na[1]), "+v"(na[2]), "+v"(na[3]), "+v"(na[4]), "+v"(na[5]), "+v"(na[6]), "+v"(na[7]),
                       "+v"(nb[0]), "+v"(nb[1]), "+v"(nb[2]), "+v"(nb[3]), "+v"(nb[4]), "+v"(nb[5]), "+v"(nb[6]), "+v"(nb[7]));
#pragma unroll 1
      for (int kk = 0; kk < 8; ++kk) {
        const int row = base + wave + kk * step;
        if (row - wave >= T) break;
        const int b = row >> 12;
        if (b != cur_b) { cur_b = b; __syncthreads();
            par[1024 + tid] = ((const f32x4*)(mods_l + (size_t)b * MODW + 5 * D))[tid];
            if (U) { const float* mn = mods_next + (size_t)b * MODW; par[1536 + tid] = ((const f32x4*)mn)[tid]; par[2048 + tid] = ((const f32x4*)(mn + D))[tid]; }
            __syncthreads(); }
        u32x2 xv[8], av[8], bv[8];
#pragma unroll
        for (int j = 0; j < 8; ++j) { xv[j] = nx[j]; av[j] = na[j]; bv[j] = nb[j]; }
        const float w0 = nw0, w1 = nw1;
        asm volatile("" : "+v"(xv[0]), "+v"(xv[1]), "+v"(xv[2]), "+v"(xv[3]), "+v"(xv[4]), "+v"(xv[5]), "+v"(xv[6]), "+v"(xv[7]), "+v"(av[0]), "+v"(av[1]), "+v"(av[2]), "+v"(av[3]), "+v"(av[4]), "+v"(av[5]), "+v"(av[6]), "+v"(av[7]),
                         "+v"(bv[0]), "+v"(bv[1]), "+v"(bv[2]), "+v"(bv[3]), "+v"(bv[4]), "+v"(bv[5]), "+v"(bv[6]), "+v"(bv[7]));
        if (kk + 1 < 8 && row - wave + step < T) COMB_ISSUE(kk + 1, row + step);
        __builtin_amdgcn_sched_barrier(0);
        Row r;
#pragma unroll
        for (int j = 0; j < 8; ++j) { const u32x2 x = xv[j], a = av[j], c = bv[j]; f32x4 f;
            f.x = w0 * bflo(a.x) + w1 * bflo(c.x); f.y = w0 * bfhi(a.x) + w1 * bfhi(c.x); f.z = w0 * bflo(a.y) + w1 * bflo(c.y); f.w = w0 * bfhi(a.y) + w1 * bfhi(c.y);
            r.v[j] = (f32x4){bflo(x.x), bfhi(x.x), bflo(x.y), bfhi(x.y)} * ALPHA + par[1024 + lane + 64 * j] * f; }
        row_ln(r);
#pragma unroll
        for (int j = 0; j < 8; ++j) r.v[j] = r.v[j] * par[lane + 64 * j] + par[512 + lane + 64 * j];
        row_store_nt(r, XO + (size_t)row * D, lane);
        if (U) { row_ln(r);
#pragma unroll
            for (int j = 0; j < 8; ++j) r.v[j] = r.v[j] * (par[2048 + lane + 64 * j] + 1.f) + par[1536 + lane + 64 * j];
            row_store_bf16(r, U + (size_t)row * D, lane); }
      }
    }
#undef COMB_ISSUE
}

struct Args { const float* in[18]; float* out; unsigned char* ws; int ph_lo, ph_hi; };
__global__ void __launch_bounds__(512, 2) fwd(Args args) {
    extern __shared__ __attribute__((aligned(16))) unsigned char lds_raw[];
    LAS unsigned char* lds = (LAS unsigned char*)lds_raw;
#define PH_IDS int tid = threadIdx.x; asm volatile("" : "+v"(tid)); const int lane = tid & 63, wave = __builtin_amdgcn_readfirstlane(tid >> 6); \
    const int gw = blockIdx.x * 8 + wave, NGW = gridDim.x * 8, gtid = blockIdx.x * 512 + tid, GT = gridDim.x * 512; (void)lane; (void)gw; (void)NGW; (void)gtid; (void)GT;
    volatile LAS unsigned* LCTL = (volatile LAS unsigned*)(lds + LDSCTL_OFF);
    LAS int* l_cnt = (LAS int*)(lds + LDSCTL_OFF) + 16; LAS int* l_tb = (LAS int*)(lds + LDSCTL_OFF) + 48;
    for (int u = threadIdx.x; u < (LDS_BYTES - LDSCTL_OFF) / 4; u += 512) ((LAS unsigned*)(lds + LDSCTL_OFF))[u] = 0u;
    __syncthreads();
    unsigned char* ws = args.ws;
    unsigned* ctl = (unsigned*)(ws + WS_CTL);
#define XIN ((const float*)args.in[0])
#define c_in args.in[1]
#define ctx args.in[2]
#define c_ctx args.in[3]
#define ada_w args.in[4]
#define ada_b args.in[5]
#define w_mix_in args.in[6]
#define rpb args.in[7]
#define conv_w args.in[8]
#define w_mix_out args.in[9]
#define w_fourier args.in[10]
#define router_w args.in[11]
#define router_b args.in[12]
#define w_gate args.in[13]
#define w_up args.in[14]
#define w_down args.in[15]
#define ln_g args.in[16]
#define ln_b args.in[17]
#define mods ((float*)(ws + WS_MODS))
#define tokinfo ((unsigned*)(ws + WS_TOKINFO))
#define table ((int*)(ws + WS_TABLE))
#define WIN ((bf16*)(ws + WS_WIN))
#define WO ((bf16*)(ws + WS_WO))
#define WF ((bf16*)(ws + WS_WF))
#define CSM ((bf16*)(ws + WS_CS))
#define U ((bf16*)(ws + WS_U))
#define P ((bf16*)(ws + WS_P))
#define YB ((bf16*)(ws + WS_P))
#define YPB ((bf16*)(ws + WS_P))
#define PCATB ((bf16*)(ws + WS_TB))
#define MIX ((bf16*)(ws + WS_MIX))
#define REZ ((bf16*)(ws + WS_MIX))
#define HB ((bf16*)(ws + WS_H))
#define WGU ((bf16*)(ws + WS_WGU))
#define WD ((bf16*)(ws + WS_WD))
#define TB ((float*)(ws + WS_TB))
#define YMB ((bf16*)(ws + WS_TB))
#define X1 ((bf16*)(ws + WS_X1))
#define X2 ((bf16*)(ws + WS_X2))
    XcdBarrier bar; bar.bar = ctl + CW_BAR; bar.x = 0; bar.st = nullptr;
    if (N_LAUNCHES != NPHASE) bar = xcd_barrier_post(ctl + CW_BAR, LCTL);
    const int lo = args.ph_lo, hi = args.ph_hi;
#ifndef DUP_MASK
#define DUP_MASK 0x0000
#endif
#define RUN(k, ...) do { __VA_ARGS__ if constexpr ((((DUP_MASK) >> (k)) & 1) != 0) { __VA_ARGS__ } } while (0)
#ifndef PH_MASK
#define PH_MASK 0x1ffff
#endif
#define IN(k) ((((PH_MASK) >> (k)) & 1) && lo <= (k) && (k) < hi)
    const ConvCtx cvx{w_mix_in, w_mix_out, w_fourier, w_gate, w_up, w_down, WIN, WO, WF, WGU, WD, ctl + 161, ctl + 162};
#define SEAM(k) do { if (IN(k) && IN((k) + 1)) { if ((k) == 5) moe_drain(cvx, 0, lds); if ((k) == 13) moe_drain(cvx, 1, lds, 4096); \
        if ((k) < 13 || (k) == 14) xcd_barrier_steal(bar, cvx, false, lds); else xcd_barrier(bar); \
        if ((k) == 14) { moe_drain(cvx, 1, lds); xcd_barrier(bar); } } } while (0)

    RUN(0, if (IN(0)) { PH_IDS
        LAS float* sl = (LAS float*)lds; LAS float* red = sl + 5 * D; volatile LAS int* qslot = (volatile LAS int*)(lds + LDSCTL_OFF) + 8;
        for (int i = tid; i < 5 * D; i += 512) { const float v = i < 4 * D ? c_in[i] : c_ctx[i - 4 * D]; sl[i] = silu_f(v); }
        __syncthreads();
        for (bool first = true;; first = false) {
            if (tid == 0) *qslot = first ? (int)blockIdx.x : (int)gridDim.x + (int)__hip_atomic_fetch_add(ctl + 160, 1u, __ATOMIC_RELAXED, __HIP_MEMORY_SCOPE_AGENT);
            __syncthreads();
            const int item = __builtin_amdgcn_readfirstlane(*qslot);
            __syncthreads();
            if (item >= P0_NMODS + P0_S_IN + 2 * P0_S_SQ) break;
            if (item < P0_NMODS) p0_mods_unit(ada_w, ada_b, mods, sl, red, item, tid);
            else p0_weight_item(item - P0_NMODS, w_mix_in, w_mix_out, w_fourier, w_gate, w_up, w_down, WIN, WO, WF, WGU, WD, lds + wave * 16384, wave, lane);
        }
        p0_dft(CSM, gtid, GT);
    });
    SEAM(0);
    RUN(1, if (IN(1)) { PH_IDS ln_mod_phase(XIN, ctx, mods, 0, U, TALL, lds, tid, wave, lane); });
    SEAM(1);
    RUN(2, if (IN(2)) { SchedInProj S{U, WIN}; EpiStoreBf16 E{P, PLD}; gemm_pg8<false>(lds, S, E, D, D, D); });
    SEAM(2);
    RUN(3, if (IN(3)) { PH_IDS conv_phase(P, conv_w, MIX, gtid, GT); attn_phase(P, rpb, MIX, lds, (LAS float*)(lds + LDSCTL_OFF + 1024)); });
    SEAM(3);
    RUN(4, if (IN(4)) { SchedDense S{MIX, WO, 64, 8, (size_t)256 * D, (size_t)256 * D}; EpiStoreBf16 E{YMB, D}; gemm_pg8<false>(lds, S, E, D, D, D); });
    SEAM(4);
    RUN(5, if (IN(5)) { PH_IDS ln_router_phase(XIN, YMB, ln_g, ln_b, mods, router_w, router_b, X1, U, ctl + CW_CNT, table, tokinfo, lds); });
    SEAM(5);
    RUN(6, if (IN(6)) { PH_IDS moe_prefix(ctl + CW_CNT, l_cnt, l_tb, tid); SchedMoe S{l_cnt, l_tb, U, WGU, table, 1, 0, (size_t)D * D, (size_t)256 * D}; EpiSwiglu E{HB}; gemm_pg8<true>(lds, S, E, D, D, D); });
    SEAM(6);
    RUN(7, if (IN(7)) { PH_IDS if (lo == 7) moe_prefix(ctl + CW_CNT, l_cnt, l_tb, tid);     SchedMoe S{l_cnt, l_tb, HB, WD, table, 0, (size_t)256 * DE, (size_t)D * DE, (size_t)256 * DE}; EpiStoreBf16 E{YB, D}; gemm_pg8<false>(lds, S, E, DE, DE, DE); });
    SEAM(7);
    RUN(8, if (IN(8)) { PH_IDS if (lo == 8) moe_prefix(ctl + CW_CNT, l_cnt, l_tb, tid);     combine_phase(X1, YB, tokinfo, l_tb, mods, ln_g + D, ln_b + D, X2, mods + 5 * MODW, U, lds, tid, wave, lane); });
    SEAM(8);
    RUN(9, if (IN(9)) { fft1_phase(U, YPB, lds); });
    SEAM(9);
    RUN(10, if (IN(10)) { fft2_phase(YPB, PCATB, lds); });
    SEAM(10);
    RUN(11, if (IN(11)) { SchedChan S{PCATB, CSM}; EpiStoreBf16 E{REZ, D}; gemm_pg8<false>(lds, S, E, 4096, 1024, 1024); });
    SEAM(11);
    RUN(12, if (IN(12)) { SchedDense S{REZ, WF, 64, 8, (size_t)256 * D, (size_t)256 * D}; EpiStoreBf16 E{YMB, D}; gemm_pg8<false>(lds, S, E, D, D, D); });
    SEAM(12);
    RUN(13, if (IN(13)) { PH_IDS ln_router_phase(X2, YMB, ln_g + 2 * D, ln_b + 2 * D, mods + 5 * MODW, router_w, router_b, X1, U, ctl + CW_CNT + 32, table + (size_t)NE * T, tokinfo + (size_t)T * 8, lds); });
    SEAM(13);
    RUN(14, if (IN(14)) { PH_IDS moe_prefix(ctl + CW_CNT + 32, l_cnt, l_tb, tid); SchedMoe S{l_cnt, l_tb, U, WGU + (size_t)NE * D * D, table + (size_t)NE * T, 1, 0, (size_t)D * D, (size_t)256 * D}; EpiSwiglu E{HB}; gemm_pg8<true>(lds, S, E, D, D, D); });
    SEAM(14);
    RUN(15, if (IN(15)) { PH_IDS if (lo == 15) moe_prefix(ctl + CW_CNT + 32, l_cnt, l_tb, tid);     SchedMoe S{l_cnt, l_tb, HB, WD + (size_t)NE * D * DE, table, 0, (size_t)256 * DE, (size_t)D * DE, (size_t)256 * DE}; EpiStoreBf16 E{YB, D}; gemm_pg8<false>(lds, S, E, DE, DE, DE); });
    SEAM(15);
    RUN(16, if (IN(16)) { PH_IDS if (lo == 16) moe_prefix(ctl + CW_CNT + 32, l_cnt, l_tb, tid);     combine_phase(X1, YB, tokinfo + (size_t)T * 8, l_tb, mods + 5 * MODW, ln_g + 3 * D, ln_b + 3 * D, args.out, (const float*)nullptr, (bf16*)nullptr, lds, tid, wave, lane); });
#undef IN
#undef SEAM
}

extern "C" void kernel_launch(void* const* d_in, const int* in_sizes, int n_in, void* d_out, int out_size, void* d_ws, size_t ws_size, hipStream_t stream) {
    static int grid = 0;
    if (grid == 0) {
        if (n_in != 18 || out_size != T * D || ws_size < WS_END) { fprintf(stderr, "kernel_launch: unexpected shapes (n_in %d, out %d, ws %zu)\n", n_in, out_size, ws_size); grid = -1; return; }
        int dev = 0, cus = 0, per_cu = 0;
        if (hipGetDevice(&dev) != hipSuccess || hipDeviceGetAttribute(&cus, hipDeviceAttributeMultiprocessorCount, dev) != hipSuccess) { grid = -1; return; }
        if (hipFuncSetAttribute((const void*)fwd, hipFuncAttributeMaxDynamicSharedMemorySize, LDS_BYTES) != hipSuccess) { fprintf(stderr, "kernel_launch: hipFuncSetAttribute failed\n"); grid = -1; return; }
        if (hipOccupancyMaxActiveBlocksPerMultiprocessor(&per_cu, (const void*)fwd, 512, LDS_BYTES) != hipSuccess || per_cu < 1) fprintf(stderr, "kernel_launch: occupancy query says %d\n", per_cu);
        (void)hipGetLastError();
        grid = cus;
    }
    if (grid < 0) return;
    (void)hipMemsetAsync((char*)d_ws + WS_CTL, 0, CTL_ZERO_BYTES, stream);
    Args a{};
    for (int i = 0; i < 18; ++i) a.in[i] = (const float*)d_in[i];
    a.out = (float*)d_out; a.ws = (unsigned char*)d_ws;
    if (N_LAUNCHES == 1) { a.ph_lo = 0; a.ph_hi = NPHASE; hipLaunchKernelGGL(fwd, dim3(grid), dim3(512), LDS_BYTES, stream, a); }
    else for (int p = 0; p < NPHASE; ++p) { a.ph_lo = p; a.ph_hi = p + 1; hipLaunchKernelGGL(fwd, dim3(grid), dim3(512), LDS_BYTES, stream, a); }
}
```
